# Optimizing an MI355X kernel written in HIP

```python
import math
import jax, jax.numpy as jnp
from jax import lax
import numpy as np

D_MODEL = 2048
BATCH = 4
SEQ = 2048
DEPTH = 1

Q_BLOCK = 128
DA_HEADS = 8
DA_HALF_DIM = 64
DA_V_DIM = 2 * DA_HALF_DIM
DA_WIDTH = DA_HEADS * DA_V_DIM
SB_HEADS = 8
SB_DIM = 128
SB_WIDTH = SB_HEADS * SB_DIM
REL_BUCKETS = 32
REL_MAX_DIST = 128
IN_COLS = 3 * DA_WIDTH + 3 * SB_WIDTH + 2 * D_MODEL
N_GROUPS = 8
EXPERTS_PER_GROUP = 8
N_EXPERTS = N_GROUPS * EXPERTS_PER_GROUP
TOP_K = 2
D_EXPERT = 1024
MOE_BLOCK = 128
N_MOD = 6
EPS = 1e-6

kernel_name = "hybrid_diffattn_stickbreak_hmoe_block"


def rms_norm(x, g):
    xf = x.astype(jnp.float32)
    y = xf * lax.rsqrt(jnp.mean(xf * xf, axis=-1, keepdims=True) + EPS)
    return (y * g.astype(jnp.float32)).astype(x.dtype)


def rel_bucket(q_pos, k_pos):
    n = jnp.maximum(q_pos[:, None] - k_pos[None, :], 0)
    max_exact = REL_BUCKETS // 2
    nf = jnp.maximum(n, 1).astype(jnp.float32)
    large = max_exact + (jnp.log(nf / max_exact) / math.log(REL_MAX_DIST / max_exact)
                         * (REL_BUCKETS - max_exact)).astype(jnp.int32)
    large = jnp.minimum(large, REL_BUCKETS - 1)
    return jnp.where(n < max_exact, n, large)


def split_heads(t, n_heads, dim):
    b, s, _ = t.shape
    return t.reshape(b, s, n_heads, dim).transpose(0, 2, 1, 3)


def merge_heads(t):
    b, h, s, d = t.shape
    return t.transpose(0, 2, 1, 3).reshape(b, s, h * d)


def to_blocks(t):
    b, h, s, d = t.shape
    return t.reshape(b, h, s // Q_BLOCK, Q_BLOCK, d).transpose(2, 0, 1, 3, 4)


def from_blocks(t):
    nqb, b, h, qb, d = t.shape
    return t.transpose(1, 2, 0, 3, 4).reshape(b, h, nqb * qb, d)


def diff_attention(q1, q2, k1, k2, v, lam, rel_table):
    s_len = q1.shape[2]
    k_pos = jnp.arange(s_len)
    scale = DA_HALF_DIM ** -0.5

    def block(args):
        q1b, q2b, blk = args
        q_pos = blk * Q_BLOCK + jnp.arange(Q_BLOCK)
        bias = rel_table[rel_bucket(q_pos, k_pos)].astype(jnp.float32).transpose(2, 0, 1)
        causal = k_pos[None, :] <= q_pos[:, None]

        def probs(qb, k):
            s = jnp.einsum('bhqd,bhkd->bhqk', qb, k).astype(jnp.float32) * scale + bias
            return jax.nn.softmax(jnp.where(causal, s, -jnp.inf), axis=-1)

        a = probs(q1b, k1) - lam * probs(q2b, k2)
        return jnp.einsum('bhqk,bhkd->bhqd', a.astype(v.dtype), v)

    out = lax.map(block, (to_blocks(q1), to_blocks(q2), jnp.arange(s_len // Q_BLOCK)))
    return from_blocks(out)


def stick_breaking_attention(q, k, v):
    s_len = q.shape[2]
    k_pos = jnp.arange(s_len)
    scale = SB_DIM ** -0.5

    def block(args):
        qb, blk = args
        q_pos = blk * Q_BLOCK + jnp.arange(Q_BLOCK)
        past = k_pos[None, :] < q_pos[:, None]
        z = jnp.einsum('bhqd,bhkd->bhqk', qb, k).astype(jnp.float32) * scale
        log_beta = jax.nn.log_sigmoid(z)
        log_keep = jnp.where(past, jax.nn.log_sigmoid(-z), 0.0)
        later = lax.cumsum(log_keep, axis=3, reverse=True) - log_keep
        w = jnp.where(past, jnp.exp(log_beta + later), 0.0)
        return jnp.einsum('bhqk,bhkd->bhqd', w.astype(v.dtype), v)

    out = lax.map(block, (to_blocks(q), jnp.arange(s_len // Q_BLOCK)))
    return from_blocks(out)


def hierarchical_moe(h, w_rg, b_rg, w_re, b_re, w_gate, w_up, w_down):
    bsz, slen, d = h.shape
    n_tok = bsz * slen
    hf = h.reshape(n_tok, d)
    g_logits = (hf @ w_rg).astype(jnp.float32) + b_rg.astype(jnp.float32)
    g_prob = jax.nn.softmax(g_logits, axis=-1)
    g_idx = jnp.argmax(g_logits, axis=-1)
    p_g = jnp.take_along_axis(g_prob, g_idx[:, None], axis=1)
    e_logits = ((hf @ w_re).astype(jnp.float32) + b_re.astype(jnp.float32)
                ).reshape(n_tok, N_GROUPS, EXPERTS_PER_GROUP)
    e_sel = jnp.take_along_axis(e_logits, g_idx[:, None, None], axis=1)[:, 0]
    top_p, top_i = lax.top_k(jax.nn.softmax(e_sel, axis=-1), TOP_K)
    top_p = top_p / jnp.sum(top_p, axis=-1, keepdims=True)
    gate = (p_g * top_p).reshape(-1)
    flat_e = (g_idx[:, None] * EXPERTS_PER_GROUP + top_i).reshape(-1)
    flat_tok = jnp.repeat(jnp.arange(n_tok, dtype=jnp.int32), TOP_K)
    m = n_tok * TOP_K
    n_blocks = -(-m // MOE_BLOCK) + N_EXPERTS
    rows = n_blocks * MOE_BLOCK
    onehot = jax.nn.one_hot(flat_e, N_EXPERTS, dtype=jnp.int32)
    rank = jnp.take_along_axis(jnp.cumsum(onehot, axis=0), flat_e[:, None], axis=1)[:, 0] - 1
    counts = jnp.sum(onehot, axis=0)
    padded = ((counts + MOE_BLOCK - 1) // MOE_BLOCK) * MOE_BLOCK
    pend = jnp.cumsum(padded)
    dest = (pend - padded)[flat_e] + rank
    buf_tok = jnp.zeros((rows,), jnp.int32).at[dest].set(flat_tok)
    buf_w = jnp.zeros((rows,), jnp.float32).at[dest].set(gate)
    starts = jnp.arange(n_blocks) * MOE_BLOCK
    block_e = jnp.minimum(jnp.sum(pend[None, :] <= starts[:, None], axis=1), N_EXPERTS - 1)
    xs = hf[buf_tok].reshape(n_blocks, MOE_BLOCK, d)

    def expert_block(args):
        xb, e = args
        a = xb @ w_gate[e]
        u = xb @ w_up[e]
        return (jax.nn.silu(a) * u) @ w_down[e]

    ys = lax.map(expert_block, (xs, block_e)).reshape(rows, d)
    out = jnp.zeros((n_tok, d), h.dtype).at[buf_tok].add(ys * buf_w[:, None].astype(h.dtype))
    return out.reshape(bsz, slen, d)


def setup_inputs(seed: int = 0) -> dict:
    key = jax.random.key(seed)
    ks = jax.random.split(key, 24)
    f32 = jnp.float32
    nrm = lambda k, shape, s: jax.random.normal(k, shape, f32) * s
    D = D_MODEL
    return {
        "x": nrm(ks[0], (BATCH, SEQ, D), 1.0),
        "c": nrm(ks[1], (BATCH, D), 1.0),
        "rel_bias_table": nrm(ks[2], (REL_BUCKETS, DA_HEADS), 0.5),
        "w_ada": nrm(ks[3], (DEPTH, D, N_MOD * D), D ** -0.5),
        "b_ada": nrm(ks[4], (DEPTH, N_MOD * D), 0.02),
        "g_mix": 1.0 + nrm(ks[5], (DEPTH, D), 0.02),
        "w_in": nrm(ks[6], (DEPTH, D, IN_COLS), D ** -0.5),
        "lambda_q1": nrm(ks[7], (DEPTH, DA_HALF_DIM), 0.1),
        "lambda_k1": nrm(ks[8], (DEPTH, DA_HALF_DIM), 0.1),
        "lambda_q2": nrm(ks[9], (DEPTH, DA_HALF_DIM), 0.1),
        "lambda_k2": nrm(ks[10], (DEPTH, DA_HALF_DIM), 0.1),
        "g_subln": 1.0 + nrm(ks[11], (DEPTH, DA_V_DIM), 0.02),
        "w_proj_a": nrm(ks[12], (DEPTH, DA_WIDTH, D), DA_WIDTH ** -0.5),
        "w_proj_b": nrm(ks[13], (DEPTH, SB_WIDTH, D), SB_WIDTH ** -0.5),
        "w_out": nrm(ks[14], (DEPTH, D, D), D ** -0.5),
        "g_ffn": 1.0 + nrm(ks[15], (DEPTH, D), 0.02),
        "w_router_group": nrm(ks[16], (DEPTH, D, N_GROUPS), D ** -0.5),
        "b_router_group": nrm(ks[17], (DEPTH, N_GROUPS), 0.01),
        "w_router_expert": nrm(ks[18], (DEPTH, D, N_EXPERTS), D ** -0.5),
        "b_router_expert": nrm(ks[19], (DEPTH, N_EXPERTS), 0.01),
        "w_expert_gate": nrm(ks[20], (DEPTH, N_EXPERTS, D, D_EXPERT), D ** -0.5),
        "w_expert_up": nrm(ks[21], (DEPTH, N_EXPERTS, D, D_EXPERT), D ** -0.5),
        "w_expert_down": nrm(ks[22], (DEPTH, N_EXPERTS, D_EXPERT, D), D_EXPERT ** -0.5),
        "g_final": 1.0 + nrm(ks[23], (D,), 0.02),
    }


def reference(x, c, rel_bias_table, w_ada, b_ada, g_mix, w_in, lambda_q1, lambda_k1,
              lambda_q2, lambda_k2, g_subln, w_proj_a, w_proj_b, w_out, g_ffn,
              w_router_group, b_router_group, w_router_expert, b_router_expert,
              w_expert_gate, w_expert_up, w_expert_down, g_final):
    D = D_MODEL
    cut = np.cumsum([DA_WIDTH, DA_WIDTH, DA_WIDTH, SB_WIDTH, SB_WIDTH, SB_WIDTH, D]).tolist()
    for l in range(DEPTH):
        lam_init = 0.8 - 0.6 * math.exp(-0.3 * l)
        mod = jax.nn.silu(c) @ w_ada[l] + b_ada[l]
        shift_m, scale_m, gate_m, shift_f, scale_f, gate_f = jnp.split(mod[:, None, :], N_MOD, axis=-1)

        h = rms_norm(x, g_mix[l]) * (1.0 + scale_m) + shift_m
        proj = h @ w_in[l]
        qa, ka, va, qb, kb, vb, gate_a, gate_b = jnp.split(proj, cut, axis=-1)
        qa = split_heads(qa, DA_HEADS, 2 * DA_HALF_DIM)
        ka = split_heads(ka, DA_HEADS, 2 * DA_HALF_DIM)
        va = split_heads(va, DA_HEADS, DA_V_DIM)
        lam = (jnp.exp(jnp.sum(lambda_q1[l].astype(jnp.float32) * lambda_k1[l].astype(jnp.float32)))
               - jnp.exp(jnp.sum(lambda_q2[l].astype(jnp.float32) * lambda_k2[l].astype(jnp.float32)))
               + lam_init)
        oa = diff_attention(qa[..., :DA_HALF_DIM], qa[..., DA_HALF_DIM:],
                            ka[..., :DA_HALF_DIM], ka[..., DA_HALF_DIM:], va, lam, rel_bias_table)
        oa = merge_heads(rms_norm(oa, g_subln[l]) * (1.0 - lam_init))
        ob = merge_heads(stick_breaking_attention(split_heads(qb, SB_HEADS, SB_DIM),
                                                  split_heads(kb, SB_HEADS, SB_DIM),
                                                  split_heads(vb, SB_HEADS, SB_DIM)))
        merged = (jax.nn.sigmoid(gate_a) * (oa @ w_proj_a[l])
                  + jax.nn.sigmoid(gate_b) * (ob @ w_proj_b[l]))
        x = x + gate_m * (merged @ w_out[l])

        h2 = rms_norm(x, g_ffn[l]) * (1.0 + scale_f) + shift_f
        x = x + gate_f * hierarchical_moe(h2, w_router_group[l], b_router_group[l],
                                          w_router_expert[l], b_router_expert[l],
                                          w_expert_gate[l], w_expert_up[l], w_expert_down[l])
    return rms_norm(x, g_final)
```

```cpp
#include <hip/hip_runtime.h>
#include <stdint.h>
#include <stdio.h>

#ifndef MK_SPLIT
#define MK_SPLIT 0
#endif

typedef unsigned short bf16_t;
typedef short bf16x8 __attribute__((ext_vector_type(8)));
typedef short bf16x4 __attribute__((ext_vector_type(4)));
typedef float f32x4 __attribute__((ext_vector_type(4)));
typedef unsigned u32x4 __attribute__((ext_vector_type(4)));
typedef unsigned u32x2 __attribute__((ext_vector_type(2)));
#define LAS __attribute__((address_space(3)))

constexpr int D = 2048, NB = 4, SEQ = 2048, NTOK = NB * SEQ;
constexpr int INC = 10240, NMOD = 6 * D;
constexpr int NE = 64, DE = 1024;
constexpr float EPS = 1e-6f;
constexpr int NPHASE = 10;

constexpr size_t WS_CTL = 0;
constexpr size_t CTL_BYTES = 32768;
constexpr size_t CW_CNT = 4096;
constexpr size_t CW_Q = 4096 + 256;
constexpr size_t WS_MOD = WS_CTL + CTL_BYTES;
constexpr size_t WS_H = WS_MOD + (size_t)NB * NMOD * 4;
constexpr size_t WS_QA = WS_H + (size_t)NTOK * D * 2;
constexpr size_t WS_KA = WS_QA + (size_t)NTOK * 1024 * 2;
constexpr size_t WS_VAT = WS_KA + (size_t)NTOK * 1024 * 2;
constexpr size_t WS_QB = WS_VAT + (size_t)NTOK * 1024 * 2;
constexpr size_t WS_KB = WS_QB + (size_t)NTOK * 1024 * 2;
constexpr size_t WS_VBT = WS_KB + (size_t)NTOK * 1024 * 2;
constexpr size_t WS_GA = WS_VBT + (size_t)NTOK * 1024 * 2;
constexpr size_t WS_GB = WS_GA + (size_t)NTOK * D * 2;
constexpr size_t WS_OA = WS_GB + (size_t)NTOK * D * 2;
constexpr size_t WS_OB = WS_OA + (size_t)NTOK * 1024 * 2;
constexpr size_t WS_MRG = WS_OB + (size_t)NTOK * 1024 * 2;
constexpr size_t WS_X1 = WS_MRG + (size_t)NTOK * D * 2;
constexpr size_t WS_H2 = WS_X1 + (size_t)NTOK * D * 4;
constexpr size_t WS_LTOK = WS_H2 + (size_t)NTOK * D * 2;
constexpr size_t WS_LW = WS_LTOK + (size_t)NE * NTOK * 4;
constexpr size_t WS_ACT = WS_LW + (size_t)NE * NTOK * 4;
constexpr size_t WS_Y = WS_ACT + (size_t)(2 * NTOK + 512) * DE * 2;
constexpr size_t WS_END = WS_Y + (size_t)2 * NTOK * D * 4;

#define XB_TMO      128
#define XB_XCNT(j)  (256  + 64 * (j))
#define XB_XSUB(j)  (1280 + 64 * (j))
#define XB_XGEN(j)  (2304 + 64 * (j))
#define XB_TOP      3328
#define XB_TOPGEN   3392
#define XCD_BAR_WORDS 3456
#define XB_SPIN_CAP (1u << 24)

__device__ __forceinline__ unsigned xb_ld(unsigned* p)              { return __hip_atomic_load(p, __ATOMIC_RELAXED, __HIP_MEMORY_SCOPE_AGENT); }
__device__ __forceinline__ unsigned xb_add(unsigned* p, unsigned v) { return __hip_atomic_fetch_add(p, v, __ATOMIC_RELAXED, __HIP_MEMORY_SCOPE_AGENT); }
__device__ __forceinline__ unsigned xb_xcc_id() { return (unsigned)__builtin_amdgcn_s_getreg((3 << 11) | 20) & 0xFu; }
#define XB_SPIN(cond, bar) do { unsigned _sp = 0; while (cond) { __builtin_amdgcn_s_sleep(1); \
    if ((++_sp & 255u) == 0u) { if (xb_ld(&(bar)[XB_TMO])) break; if (_sp > XB_SPIN_CAP) { atomicAdd(&(bar)[XB_TMO], 1u); break; } } } } while (0)

struct XcdBarrier { unsigned* bar; unsigned x; volatile LAS unsigned* st; };

__device__ __forceinline__ XcdBarrier xcd_barrier_post(unsigned* bar, volatile LAS unsigned* st) {
    XcdBarrier b; b.bar = bar; b.x = xb_xcc_id(); b.st = st;
    if (threadIdx.x == 0) (void)xb_add(&bar[XB_XCNT(b.x)], 1u);
    return b;
}
__device__ __forceinline__ void xcd_barrier_complete(unsigned* bar, unsigned x, unsigned& nloc, unsigned& nx) {
    const unsigned G = gridDim.x * gridDim.y * gridDim.z;
    unsigned sum, cnt, mine, sp = 0u;
    for (;;) {
        sum = 0u; cnt = 0u; mine = 0u;
#pragma unroll
        for (unsigned j = 0; j < 16; ++j) { const unsigned c = xb_ld(&bar[XB_XCNT(j)]); sum += c; cnt += (c > 0u) ? 1u : 0u; mine = (j == x) ? c : mine; }
        if (sum == G) break;
        __builtin_amdgcn_s_sleep(1);
        if ((++sp & 255u) == 0u) { if (xb_ld(&bar[XB_TMO])) break; if (sp > XB_SPIN_CAP) { atomicAdd(&bar[XB_TMO], 1u); break; } }
    }
    nloc = mine > 0u ? mine : 1u; nx = cnt > 0u ? cnt : 1u;
}
__device__ __forceinline__ void xcd_barrier(const XcdBarrier& b) {
    asm volatile("s_waitcnt vmcnt(0)" ::: "memory");
    __syncthreads();
    if (threadIdx.x == 0) {
        unsigned* bar = b.bar;
        __builtin_amdgcn_s_waitcnt(0);
        unsigned nloc = b.st[0], nx = b.st[1];
        if (nloc == 0u) { xcd_barrier_complete(bar, b.x, nloc, nx); b.st[0] = nloc; b.st[1] = nx; }
        const unsigned old = xb_add(&bar[XB_XSUB(b.x)], 1u);
        const unsigned gen = old / nloc;
        if (old + 1u == (gen + 1u) * nloc) {
            __builtin_amdgcn_fence(__ATOMIC_RELEASE, "agent");
            asm volatile("s_waitcnt vmcnt(0)" ::: "memory");
            const unsigned og = xb_add(&bar[XB_TOP], 1u);
            const unsigned tg = og / nx;
            if (og + 1u == (tg + 1u) * nx) xb_add(&bar[XB_TOPGEN], 1u);
            else XB_SPIN(xb_ld(&bar[XB_TOPGEN]) == tg, bar);
            __builtin_amdgcn_fence(__ATOMIC_ACQUIRE, "agent");
            xb_add(&bar[XB_XGEN(b.x)], 1u);
            asm volatile("s_waitcnt vmcnt(0)" ::: "memory");
        } else {
            XB_SPIN(xb_ld(&bar[XB_XGEN(b.x)]) == gen, bar);
            __builtin_amdgcn_fence(__ATOMIC_ACQUIRE, "agent");
            asm volatile("s_waitcnt vmcnt(0)" ::: "memory");
        }
    }
    __syncthreads();
}

typedef __bf16 bf16v2_t __attribute__((ext_vector_type(2)));
typedef float f32x2 __attribute__((ext_vector_type(2)));
__device__ __forceinline__ unsigned pack_bf16(float lo, float hi) {
    const f32x2 v = {lo, hi};
    return __builtin_bit_cast(unsigned, __builtin_convertvector(v, bf16v2_t));
}
__device__ __forceinline__ float wave_sum(float v) {
#pragma unroll
    for (int o = 32; o > 0; o >>= 1) v += __shfl_xor(v, o);
    return v;
}
__device__ __forceinline__ float sigmoidf_(float x) { return 1.0f / (1.0f + __expf(-x)); }

struct Params { const float* in[24]; float* out; unsigned char* ws; int ph_lo, ph_hi; };

struct Ctx {
    int tid, lane, wid, wr, wc, fr, fq, bid, nblk;
    LAS unsigned char* lds;
};

__device__ __forceinline__ int next_item(unsigned* ctr, const Ctx& c) {
    LAS int* slot = (LAS int*)(c.lds + 160 * 1024 - 64);
    __syncthreads();
    if (c.tid == 0) *slot = (int)__hip_atomic_fetch_add(ctr, 1u, __ATOMIC_RELAXED, __HIP_MEMORY_SCOPE_AGENT);
    __syncthreads();
    return *slot;
}

constexpr int G_STAGE = 49152, G_BOFF = 32768;
__device__ __forceinline__ void gemm_mainloop(f32x4 (&acc)[8][2], const bf16_t* const (&arow)[4], const float* bptr, const int ldb, const int K, const Ctx& c) {
    const int tid = c.tid, lane = c.lane, wid = c.wid;
    const int nt = K >> 6;
    const int ca = tid & 7, ra = tid >> 3;
    const int a_wr_off = ra * 128 + ((ca ^ (ra & 7)) << 4);
    const int half = lane & 1, nq = ((lane >> 1) & 7) | ((lane >> 4) << 3);
    const int b_wr_off = G_BOFF + (4 * nq) * 128 + ((wid ^ (nq & 7)) << 4) + half * 8;
    const int fr = c.fr, fq = c.fq;
    int a_rd[2], b_rd[2][2];
#pragma unroll
    for (int kb = 0; kb < 2; ++kb) {
        a_rd[kb] = (128 * c.wr + fr) * 128 + ((((4 * kb + fq) ^ (fr & 7))) << 4);
#pragma unroll
        for (int ni = 0; ni < 2; ++ni) { const int n = 32 * c.wc + 16 * ni + fr; b_rd[kb][ni] = G_BOFF + n * 128 + (((4 * kb + fq) ^ ((n >> 2) & 7)) << 4); }
    }
    u32x4 ra_[4]; f32x4 rb_[4];
#pragma unroll
    for (int i = 0; i < 4; ++i) { ra_[i] = *(const u32x4*)(arow[i]); rb_[i] = *(const f32x4*)(bptr + (size_t)i * ldb); }
    for (int t = 0; t < nt; ++t) {
        LAS unsigned char* st = c.lds + (t & 1) * G_STAGE;
#pragma unroll
        for (int i = 0; i < 4; ++i) *(LAS u32x4*)(st + a_wr_off + i * 8192) = ra_[i];
#pragma unroll
        for (int j = 0; j < 4; ++j) { u32x2 w; w.x = pack_bf16(rb_[0][j], rb_[1][j]); w.y = pack_bf16(rb_[2][j], rb_[3][j]); *(LAS u32x2*)(st + b_wr_off + j * 128) = w; }
        if (t + 1 < nt) {
#pragma unroll
            for (int i = 0; i < 4; ++i) { ra_[i] = *(const u32x4*)(arow[i] + (t + 1) * 64); rb_[i] = *(const f32x4*)(bptr + (size_t)((t + 1) * 64 + i) * ldb); }
        }
        __syncthreads();
#pragma unroll
        for (int kb = 0; kb < 2; ++kb) {
            bf16x8 bf[2];
#pragma unroll
            for (int ni = 0; ni < 2; ++ni) bf[ni] = *(const LAS bf16x8*)(st + b_rd[kb][ni]);
#pragma unroll
            for (int mi = 0; mi < 8; ++mi) {
                const bf16x8 af = *(const LAS bf16x8*)(st + a_rd[kb] + mi * 2048);
#pragma unroll
                for (int ni = 0; ni < 2; ++ni) acc[mi][ni] = __builtin_amdgcn_mfma_f32_16x16x32_bf16(bf[ni], af, acc[mi][ni], 0, 0, 0);
            }
        }
    }
    __syncthreads();
}
__device__ __forceinline__ void zero_acc(f32x4 (&acc)[8][2]) {
#pragma unroll
    for (int mi = 0; mi < 8; ++mi)
#pragma unroll
        for (int ni = 0; ni < 2; ++ni) acc[mi][ni] = (f32x4){0.f, 0.f, 0.f, 0.f};
}
__device__ __forceinline__ int b_nq(const Ctx& c) { return ((c.lane >> 1) & 7) | ((c.lane >> 4) << 3); }
__device__ __forceinline__ int b_k0(const Ctx& c) { return 8 * c.wid + 4 * (c.lane & 1); }

__device__ __forceinline__ void phase_mod(const Params& p, const Ctx& c) {
    const float* cc = p.in[1]; const float* w_ada = p.in[3]; const float* b_ada = p.in[4];
    float* mod = (float*)(p.ws + WS_MOD);
    LAS float* sc = (LAS float*)c.lds;
    LAS float* red = (LAS float*)(c.lds + 32768);
    for (int i = c.tid; i < NB * D; i += 512) { const float v = cc[i]; sc[i] = v / (1.0f + __expf(-v)); }
    __syncthreads();
    const int cq = c.tid % 12, kl = c.tid / 12;
    for (int item = c.bid; item < 256; item += c.nblk) {
        float acc[4][4];
#pragma unroll
        for (int b = 0; b < 4; ++b)
#pragma unroll
            for (int j = 0; j < 4; ++j) acc[b][j] = 0.f;
        if (kl < 42) {
            const float* wp = w_ada + item * 48 + cq * 4;
            for (int k = kl; k < D; k += 42) {
                const f32x4 w = *(const f32x4*)(wp + (size_t)k * NMOD);
#pragma unroll
                for (int b = 0; b < 4; ++b) { const float s = sc[b * D + k];
#pragma unroll
                    for (int j = 0; j < 4; ++j) acc[b][j] += s * w[j]; }
            }
#pragma unroll
            for (int b = 0; b < 4; ++b)
#pragma unroll
                for (int j = 0; j < 4; ++j) red[(kl * 12 + cq) * 16 + b * 4 + j] = acc[b][j];
        }
        __syncthreads();
        if (c.tid < 192) {
            const int b = c.tid / 48, col = c.tid % 48;
            float s = 0.f;
            for (int k2 = 0; k2 < 42; ++k2) s += red[(k2 * 12 + (col >> 2)) * 16 + b * 4 + (col & 3)];
            mod[b * NMOD + item * 48 + col] = s + b_ada[item * 48 + col];
        }
        __syncthreads();
    }
}

__device__ __forceinline__ void phase_norm1(const Params& p, const Ctx& c) {
    const float* x = p.in[0]; const float* g = p.in[5];
    const float* mod = (const float*)(p.ws + WS_MOD);
    bf16_t* h = (bf16_t*)(p.ws + WS_H);
    for (int row = c.bid * 8 + c.wid; row < NTOK; row += c.nblk * 8) {
        const int b = row >> 11;
        f32x4 v[8]; float ss = 0.f;
#pragma unroll
        for (int i = 0; i < 8; ++i) { v[i] = *(const f32x4*)(x + (size_t)row * D + i * 256 + c.lane * 4); ss += v[i][0] * v[i][0] + v[i][1] * v[i][1] + v[i][2] * v[i][2] + v[i][3] * v[i][3]; }
        ss = wave_sum(ss);
        const float rstd = rsqrtf(ss * (1.0f / D) + EPS);
#pragma unroll
        for (int i = 0; i < 8; ++i) {
            const int col = i * 256 + c.lane * 4;
            const f32x4 gg = *(const f32x4*)(g + col), sh = *(const f32x4*)(mod + b * NMOD + col), scl = *(const f32x4*)(mod + b * NMOD + D + col);
            float o[4];
#pragma unroll
            for (int j = 0; j < 4; ++j) o[j] = (v[i][j] * rstd * gg[j]) * (1.0f + scl[j]) + sh[j];
            u32x2 w; w.x = pack_bf16(o[0], o[1]); w.y = pack_bf16(o[2], o[3]);
            *(u32x2*)(h + (size_t)row * D + col) = w;
        }
    }
}

__device__ __forceinline__ void phase_proj_in(const Params& p, const Ctx& c) {
    const bf16_t* h = (const bf16_t*)(p.ws + WS_H); const float* w_in = p.in[6];
    for (int item = c.bid; item < 32 * 80; item += c.nblk) {
        const int mt = item & 31, ntile = item >> 5;
        const int m0 = mt * 256, n0 = ntile * 128;
        const bf16_t* arow[4];
#pragma unroll
        for (int i = 0; i < 4; ++i) arow[i] = h + (size_t)(m0 + (c.tid >> 3) + 64 * i) * D + (c.tid & 7) * 8;
        const float* bptr = w_in + (size_t)b_k0(c) * INC + n0 + 4 * b_nq(c);
        f32x4 acc[8][2]; zero_acc(acc);
        gemm_mainloop(acc, arow, bptr, INC, D, c);
        const int region = n0 >> 10;
#pragma unroll
        for (int mi = 0; mi < 8; ++mi)
#pragma unroll
            for (int ni = 0; ni < 2; ++ni) {
                const int row = m0 + 128 * c.wr + 16 * mi + c.fr;
                const int col = n0 + 32 * c.wc + 16 * ni + 4 * c.fq;
                const f32x4 a = acc[mi][ni];
                if (region < 6) {
                    const int cin = col & 1023;
                    if (region == 2 || region == 5) {
                        bf16_t* vt = (bf16_t*)(p.ws + (region == 2 ? WS_VAT : WS_VBT));
                        const int b = row >> 11, s = row & 2047, hh = cin >> 7, d = cin & 127;
                        const unsigned w0 = pack_bf16(a[0], a[1]), w1 = pack_bf16(a[2], a[3]);
                        bf16_t* base = vt + ((size_t)((b * 8 + hh) * 128 + d)) * SEQ + s;
                        base[0] = (bf16_t)(w0 & 0xffff); base[SEQ] = (bf16_t)(w0 >> 16); base[2 * SEQ] = (bf16_t)(w1 & 0xffff); base[3 * SEQ] = (bf16_t)(w1 >> 16);
                    } else {
                        const size_t off = region == 0 ? WS_QA : region == 1 ? WS_KA : region == 3 ? WS_QB : WS_KB;
                        bf16_t* dst = (bf16_t*)(p.ws + off);
                        u32x2 w; w.x = pack_bf16(a[0], a[1]); w.y = pack_bf16(a[2], a[3]);
                        *(u32x2*)(dst + (size_t)row * 1024 + cin) = w;
                    }
                } else {
                    bf16_t* dst = (bf16_t*)(p.ws + (region < 8 ? WS_GA : WS_GB));
                    const int cin = col - (region < 8 ? 6144 : 8192);
                    u32x2 w; w.x = pack_bf16(sigmoidf_(a[0]), sigmoidf_(a[1])); w.y = pack_bf16(sigmoidf_(a[2]), sigmoidf_(a[3]));
                    *(u32x2*)(dst + (size_t)row * D + cin) = w;
                }
            }
    }
}

constexpr int AT_STAGE = 32768, AT_VOFF = 16384, AT_BIAS = 65536;
__device__ __forceinline__ int rel_bucket_dev(int n) {
    if (n < 16) return n;
    int b = 16;
    b += (n >= 19) + (n >= 21) + (n >= 24) + (n >= 27) + (n >= 31) + (n >= 35) + (n >= 40) + (n >= 46) + (n >= 52) + (n >= 59) + (n >= 67) + (n >= 77) + (n >= 87) + (n >= 99) + (n >= 113);
    return b;
}
struct KVRegs { u32x4 k[2], v[2]; };
__device__ __forceinline__ void kv_load(KVRegs& r, const bf16_t* kbase, const bf16_t* vtbase, int kt, const Ctx& c) {
#pragma unroll
    for (int i = 0; i < 2; ++i) {
        const int key = (c.tid >> 4) + 32 * i, ck = c.tid & 15;
        r.k[i] = *(const u32x4*)(kbase + (size_t)(kt * 64 + key) * 1024 + ck * 8);
        const int d = (c.tid >> 3) + 64 * i, cv = c.tid & 7;
        r.v[i] = *(const u32x4*)(vtbase + (size_t)d * SEQ + kt * 64 + cv * 8);
    }
}
__device__ __forceinline__ void kv_store(const KVRegs& r, LAS unsigned char* st, const Ctx& c) {
#pragma unroll
    for (int i = 0; i < 2; ++i) {
        const int key = (c.tid >> 4) + 32 * i, ck = c.tid & 15;
        *(LAS u32x4*)(st + key * 256 + ((ck ^ (key & 15)) << 4)) = r.k[i];
        const int d = (c.tid >> 3) + 64 * i, cv = c.tid & 7;
        *(LAS u32x4*)(st + AT_VOFF + d * 128 + ((cv ^ ((d >> 1) & 7)) << 4)) = r.v[i];
    }
}
__device__ __forceinline__ bf16x8 v_frag(LAS unsigned char* st, int nf, int kb2, const Ctx& c) {
    const int d = 16 * nf + c.fr; const int sw = (c.fr >> 1) & 7;
    const int c0 = 4 * kb2 + (c.fq >> 1), c1 = c0 + 2;
    const bf16x4 lo = *(const LAS bf16x4*)(st + AT_VOFF + d * 128 + ((c0 ^ sw) << 4) + (c.fq & 1) * 8);
    const bf16x4 hi = *(const LAS bf16x4*)(st + AT_VOFF + d * 128 + ((c1 ^ sw) << 4) + (c.fq & 1) * 8);
    bf16x8 r; r[0] = lo[0]; r[1] = lo[1]; r[2] = lo[2]; r[3] = lo[3]; r[4] = hi[0]; r[5] = hi[1]; r[6] = hi[2]; r[7] = hi[3];
    return r;
}
__device__ __forceinline__ bf16x8 pack_p(const f32x4& a, const f32x4& b) {
    u32x4 w; w.x = pack_bf16(a[0], a[1]); w.y = pack_bf16(a[2], a[3]); w.z = pack_bf16(b[0], b[1]); w.w = pack_bf16(b[2], b[3]);
    return __builtin_bit_cast(bf16x8, w);
}

__device__ __forceinline__ void diff_attn_item(const Params& p, const Ctx& c, int b, int h, int qb, float lam) {
    const bf16_t* qa = (const bf16_t*)(p.ws + WS_QA); const bf16_t* ka = (const bf16_t*)(p.ws + WS_KA); const bf16_t* vat = (const bf16_t*)(p.ws + WS_VAT);
    bf16_t* oa = (bf16_t*)(p.ws + WS_OA);
    const float* rel = p.in[2]; const float* gsub = p.in[11];
    LAS float* bias = (LAS float*)(c.lds + AT_BIAS);
    __syncthreads();
    if (c.tid < 128) bias[c.tid] = rel[rel_bucket_dev(c.tid) * 8 + h];
    const int qpos = 128 * qb + 16 * c.wid + c.fr;
    const size_t qtok = (size_t)b * SEQ + qpos;
    bf16x8 qf[4];
#pragma unroll
    for (int kb = 0; kb < 4; ++kb) qf[kb] = *(const bf16x8*)(qa + qtok * 1024 + h * 128 + 32 * kb + 8 * c.fq);
    const bf16_t* kbase = ka + (size_t)b * SEQ * 1024 + h * 128;
    const bf16_t* vtbase = vat + (size_t)((b * 8 + h) * 128) * SEQ;
    f32x4 O1[8], O2[8];
#pragma unroll
    for (int nf = 0; nf < 8; ++nf) { O1[nf] = (f32x4){0.f, 0.f, 0.f, 0.f}; O2[nf] = (f32x4){0.f, 0.f, 0.f, 0.f}; }
    float m1 = -1e30f, m2 = -1e30f, l1 = 0.f, l2 = 0.f;
    const int ntiles = 2 * qb + 2;
    const int qmax_w = 128 * qb + 16 * c.wid + 15, qmin_w = 128 * qb + 16 * c.wid;
    const float L2E = 1.4426950408889634f;
    KVRegs kr; kv_load(kr, kbase, vtbase, 0, c);
    for (int kt = 0; kt < ntiles; ++kt) {
        LAS unsigned char* st = c.lds + (kt & 1) * AT_STAGE;
        kv_store(kr, st, c);
        if (kt + 1 < ntiles) kv_load(kr, kbase, vtbase, kt + 1, c);
        __syncthreads();
        if (64 * kt <= qmax_w) {
            f32x4 s1[4], s2[4];
#pragma unroll
            for (int f = 0; f < 4; ++f) {
                bf16x8 kf[4];
#pragma unroll
                for (int kb = 0; kb < 4; ++kb) kf[kb] = *(const LAS bf16x8*)(st + (16 * f + c.fr) * 256 + (((4 * kb + c.fq) ^ c.fr) << 4));
                f32x4 z = (f32x4){0.f, 0.f, 0.f, 0.f};
                z = __builtin_amdgcn_mfma_f32_16x16x32_bf16(kf[0], qf[0], z, 0, 0, 0);
                s1[f] = __builtin_amdgcn_mfma_f32_16x16x32_bf16(kf[1], qf[1], z, 0, 0, 0);
                z = (f32x4){0.f, 0.f, 0.f, 0.f};
                z = __builtin_amdgcn_mfma_f32_16x16x32_bf16(kf[2], qf[2], z, 0, 0, 0);
                s2[f] = __builtin_amdgcn_mfma_f32_16x16x32_bf16(kf[3], qf[3], z, 0, 0, 0);
            }
            const bool nearb = (qmin_w - (64 * kt + 63)) < 113;
            const float cfar = bias[127];
            float mx1 = -1e30f, mx2 = -1e30f;
#pragma unroll
            for (int f = 0; f < 4; ++f)
#pragma unroll
                for (int r = 0; r < 4; ++r) {
                    const int n = qpos - (64 * kt + 16 * f + 4 * c.fq + r);
                    float bv = cfar;
                    if (nearb) bv = bias[n < 0 ? 0 : (n > 127 ? 127 : n)];
                    float a1 = s1[f][r] * 0.125f + bv, a2 = s2[f][r] * 0.125f + bv;
                    if (n < 0) { a1 = -1e30f; a2 = -1e30f; }
                    s1[f][r] = a1; s2[f][r] = a2;
                    mx1 = fmaxf(mx1, a1); mx2 = fmaxf(mx2, a2);
                }
            mx1 = fmaxf(mx1, __shfl_xor(mx1, 16)); mx1 = fmaxf(mx1, __shfl_xor(mx1, 32));
            mx2 = fmaxf(mx2, __shfl_xor(mx2, 16)); mx2 = fmaxf(mx2, __shfl_xor(mx2, 32));
            const float mn1 = fmaxf(m1, mx1), mn2 = fmaxf(m2, mx2);
            const float al1 = exp2f((m1 - mn1) * L2E), al2 = exp2f((m2 - mn2) * L2E);
            m1 = mn1; m2 = mn2;
            float ps1 = 0.f, ps2 = 0.f;
#pragma unroll
            for (int f = 0; f < 4; ++f)
#pragma unroll
                for (int r = 0; r < 4; ++r) {
                    const float e1 = exp2f((s1[f][r] - mn1) * L2E), e2 = exp2f((s2[f][r] - mn2) * L2E);
                    s1[f][r] = e1; s2[f][r] = e2; ps1 += e1; ps2 += e2;
                }
            l1 = l1 * al1 + ps1; l2 = l2 * al2 + ps2;
#pragma unroll
            for (int nf = 0; nf < 8; ++nf) { O1[nf] *= al1; O2[nf] *= al2; }
#pragma unroll
            for (int kb2 = 0; kb2 < 2; ++kb2) {
                const bf16x8 p1 = pack_p(s1[2 * kb2], s1[2 * kb2 + 1]), p2 = pack_p(s2[2 * kb2], s2[2 * kb2 + 1]);
#pragma unroll
                for (int nf = 0; nf < 8; ++nf) {
                    const bf16x8 vf = v_frag(st, nf, kb2, c);
                    O1[nf] = __builtin_amdgcn_mfma_f32_16x16x32_bf16(vf, p1, O1[nf], 0, 0, 0);
                    O2[nf] = __builtin_amdgcn_mfma_f32_16x16x32_bf16(vf, p2, O2[nf], 0, 0, 0);
                }
            }
        }
    }
    l1 += __shfl_xor(l1, 16); l1 += __shfl_xor(l1, 32);
    l2 += __shfl_xor(l2, 16); l2 += __shfl_xor(l2, 32);
    const float i1 = 1.0f / l1, i2 = lam / l2;
    float ss = 0.f;
#pragma unroll
    for (int nf = 0; nf < 8; ++nf)
#pragma unroll
        for (int r = 0; r < 4; ++r) { const float o = O1[nf][r] * i1 - O2[nf][r] * i2; O1[nf][r] = o; ss += o * o; }
    ss += __shfl_xor(ss, 16); ss += __shfl_xor(ss, 32);
    const float rstd = rsqrtf(ss * (1.0f / 128.0f) + EPS) * 0.8f;
#pragma unroll
    for (int nf = 0; nf < 8; ++nf) {
        const int d = 16 * nf + 4 * c.fq;
        const f32x4 g = *(const f32x4*)(gsub + d);
        u32x2 w; w.x = pack_bf16(O1[nf][0] * rstd * g[0], O1[nf][1] * rstd * g[1]); w.y = pack_bf16(O1[nf][2] * rstd * g[2], O1[nf][3] * rstd * g[3]);
        *(u32x2*)(oa + qtok * 1024 + h * 128 + d) = w;
    }
}

__device__ __forceinline__ void sb_attn_item(const Params& p, const Ctx& c, int b, int h, int qb) {
    const bf16_t* qbuf = (const bf16_t*)(p.ws + WS_QB); const bf16_t* kbuf = (const bf16_t*)(p.ws + WS_KB); const bf16_t* vbt = (const bf16_t*)(p.ws + WS_VBT);
    bf16_t* ob = (bf16_t*)(p.ws + WS_OB);
    __syncthreads();
    const int qpos = 128 * qb + 16 * c.wid + c.fr;
    const size_t qtok = (size_t)b * SEQ + qpos;
    bf16x8 qf[4];
#pragma unroll
    for (int kb = 0; kb < 4; ++kb) qf[kb] = *(const bf16x8*)(qbuf + qtok * 1024 + h * 128 + 32 * kb + 8 * c.fq);
    const bf16_t* kbase = kbuf + (size_t)b * SEQ * 1024 + h * 128;
    const bf16_t* vtbase = vbt + (size_t)((b * 8 + h) * 128) * SEQ;
    f32x4 O[8];
#pragma unroll
    for (int nf = 0; nf < 8; ++nf) O[nf] = (f32x4){0.f, 0.f, 0.f, 0.f};
    float carry = 0.f;
    const int ntiles = 2 * qb + 2;
    const int qmax_w = 128 * qb + 16 * c.wid + 15;
    const float scale = 0.08838834764831845f;
    KVRegs kr; kv_load(kr, kbase, vtbase, ntiles - 1, c);
    for (int it = 0; it < ntiles; ++it) {
        const int kt = ntiles - 1 - it;
        LAS unsigned char* st = c.lds + (it & 1) * AT_STAGE;
        kv_store(kr, st, c);
        if (kt > 0) kv_load(kr, kbase, vtbase, kt - 1, c);
        __syncthreads();
        if (64 * kt < qmax_w) {
            f32x4 z[4];
#pragma unroll
            for (int f = 0; f < 4; ++f) {
                f32x4 a = (f32x4){0.f, 0.f, 0.f, 0.f};
#pragma unroll
                for (int kb = 0; kb < 4; ++kb) {
                    const bf16x8 kf = *(const LAS bf16x8*)(st + (16 * f + c.fr) * 256 + (((4 * kb + c.fq) ^ c.fr) << 4));
                    a = __builtin_amdgcn_mfma_f32_16x16x32_bf16(kf, qf[kb], a, 0, 0, 0);
                }
                z[f] = a;
            }
            f32x4 lb[4], lk[4]; float T[4];
#pragma unroll
            for (int f = 0; f < 4; ++f) {
                float t = 0.f;
#pragma unroll
                for (int r = 0; r < 4; ++r) {
                    const int kpos = 64 * kt + 16 * f + 4 * c.fq + r;
                    const float zz = z[f][r] * scale;
                    const float sp = __logf(1.0f + __expf(-fabsf(zz)));
                    const float lbv = fminf(zz, 0.f) - sp;
                    const bool valid = kpos < qpos;
                    const float lkv = valid ? (lbv - zz) : 0.f;
                    lb[f][r] = valid ? lbv : -1e30f; lk[f][r] = lkv; t += lkv;
                }
                T[f] = t;
            }
            float tile_tot = 0.f; float Gl[4], Ft[4];
#pragma unroll
            for (int f = 0; f < 4; ++f) {
                const float A1 = __shfl_xor(T[f], 16), A2 = __shfl_xor(T[f], 32), A3 = __shfl_xor(T[f], 48);
                Gl[f] = ((c.fq & 1) == 0 ? A1 : 0.f) + ((c.fq & 2) == 0 ? (A2 + A3) : 0.f);
                Ft[f] = T[f] + A1 + A2 + A3; tile_tot += Ft[f];
            }
            float after = carry;
#pragma unroll
            for (int f = 3; f >= 0; --f) {
                float suf = 0.f;
#pragma unroll
                for (int r = 3; r >= 0; --r) {
                    const float later = after + Gl[f] + suf;
                    z[f][r] = __expf(lb[f][r] + later);
                    suf += lk[f][r];
                }
                after += Ft[f];
            }
            carry += tile_tot;
#pragma unroll
            for (int kb2 = 0; kb2 < 2; ++kb2) {
                const bf16x8 pp = pack_p(z[2 * kb2], z[2 * kb2 + 1]);
#pragma unroll
                for (int nf = 0; nf < 8; ++nf) {
                    const bf16x8 vf = v_frag(st, nf, kb2, c);
                    O[nf] = __builtin_amdgcn_mfma_f32_16x16x32_bf16(vf, pp, O[nf], 0, 0, 0);
                }
            }
        }
    }
#pragma unroll
    for (int nf = 0; nf < 8; ++nf) {
        const int d = 16 * nf + 4 * c.fq;
        u32x2 w; w.x = pack_bf16(O[nf][0], O[nf][1]); w.y = pack_bf16(O[nf][2], O[nf][3]);
        *(u32x2*)(ob + qtok * 1024 + h * 128 + d) = w;
    }
}

__device__ __forceinline__ void phase_attn(const Params& p, const Ctx& c) {
    float d1 = 0.f, d2 = 0.f;
    if (c.lane < 64) { d1 = p.in[7][c.lane] * p.in[8][c.lane]; d2 = p.in[9][c.lane] * p.in[10][c.lane]; }
    d1 = wave_sum(d1); d2 = wave_sum(d2);
    const float lam = expf(d1) - expf(d2) + 0.2f;
    unsigned* ctr = (unsigned*)(p.ws + WS_CTL) + CW_Q;
    for (;;) {
        const int item = next_item(ctr, c);
        if (item >= 1024) break;
        const int qb = 15 - (item >> 6), rest = item & 63, kind = rest >> 5, bh = rest & 31;
        if (kind == 0) diff_attn_item(p, c, bh >> 3, bh & 7, qb, lam);
        else sb_attn_item(p, c, bh >> 3, bh & 7, qb);
    }
}

__device__ __forceinline__ void phase_merge(const Params& p, const Ctx& c) {
    const bf16_t* oa = (const bf16_t*)(p.ws + WS_OA); const bf16_t* ob = (const bf16_t*)(p.ws + WS_OB);
    const bf16_t* ga = (const bf16_t*)(p.ws + WS_GA); const bf16_t* gb = (const bf16_t*)(p.ws + WS_GB);
    bf16_t* mrg = (bf16_t*)(p.ws + WS_MRG);
    for (int item = c.bid; item < 32 * 16; item += c.nblk) {
        const int mt = item & 31, ntile = item >> 5;
        const int m0 = mt * 256, n0 = ntile * 128;
        f32x4 acc[8][2];
#pragma unroll 1
        for (int pass = 0; pass < 2; ++pass) {
            const bf16_t* A = pass ? ob : oa; const float* W = pass ? p.in[13] : p.in[12]; const bf16_t* G = pass ? gb : ga;
            const bf16_t* arow[4];
#pragma unroll
            for (int i = 0; i < 4; ++i) arow[i] = A + (size_t)(m0 + (c.tid >> 3) + 64 * i) * 1024 + (c.tid & 7) * 8;
            const float* bptr = W + (size_t)b_k0(c) * D + n0 + 4 * b_nq(c);
            zero_acc(acc);
            gemm_mainloop(acc, arow, bptr, D, 1024, c);
            float* tmp = (float*)(p.ws + WS_X1);
#pragma unroll
            for (int mi = 0; mi < 8; ++mi)
#pragma unroll
                for (int ni = 0; ni < 2; ++ni) {
                    const int row = m0 + 128 * c.wr + 16 * mi + c.fr;
                    const int col = n0 + 32 * c.wc + 16 * ni + 4 * c.fq;
                    const u32x2 gw = *(const u32x2*)(G + (size_t)row * D + col);
                    f32x4 g; g[0] = __uint_as_float(gw.x << 16); g[1] = __uint_as_float(gw.x & 0xffff0000u); g[2] = __uint_as_float(gw.y << 16); g[3] = __uint_as_float(gw.y & 0xffff0000u);
                    f32x4 v = acc[mi][ni] * g;
                    if (pass == 0) *(f32x4*)(tmp + (size_t)row * D + col) = v;
                    else {
                        v += *(const f32x4*)(tmp + (size_t)row * D + col);
                        u32x2 w; w.x = pack_bf16(v[0], v[1]); w.y = pack_bf16(v[2], v[3]);
                        *(u32x2*)(mrg + (size_t)row * D + col) = w;
                    }
                }
        }
    }
}

__device__ __forceinline__ void phase_out(const Params& p, const Ctx& c) {
    const bf16_t* mrg = (const bf16_t*)(p.ws + WS_MRG); const float* w_out = p.in[14]; const float* x = p.in[0];
    const float* mod = (const float*)(p.ws + WS_MOD);
    float* x1 = (float*)(p.ws + WS_X1);
    for (int item = c.bid; item < 32 * 16; item += c.nblk) {
        const int mt = item & 31, ntile = item >> 5;
        const int m0 = mt * 256, n0 = ntile * 128;
        const bf16_t* arow[4];
#pragma unroll
        for (int i = 0; i < 4; ++i) arow[i] = mrg + (size_t)(m0 + (c.tid >> 3) + 64 * i) * D + (c.tid & 7) * 8;
        const float* bptr = w_out + (size_t)b_k0(c) * D + n0 + 4 * b_nq(c);
        f32x4 acc[8][2]; zero_acc(acc);
        gemm_mainloop(acc, arow, bptr, D, D, c);
        const int b = m0 >> 11;
#pragma unroll
        for (int mi = 0; mi < 8; ++mi)
#pragma unroll
            for (int ni = 0; ni < 2; ++ni) {
                const int row = m0 + 128 * c.wr + 16 * mi + c.fr;
                const int col = n0 + 32 * c.wc + 16 * ni + 4 * c.fq;
                const f32x4 gm = *(const f32x4*)(mod + b * NMOD + 2 * D + col);
                const f32x4 xv = *(const f32x4*)(x + (size_t)row * D + col);
                *(f32x4*)(x1 + (size_t)row * D + col) = xv + gm * acc[mi][ni];
            }
    }
}

__device__ __forceinline__ void phase_norm2_route(const Params& p, const Ctx& c) {
    const float* x1 = (const float*)(p.ws + WS_X1); const float* g = p.in[15];
    const float* mod = (const float*)(p.ws + WS_MOD);
    const float* w_rg = p.in[16]; const float* b_rg = p.in[17]; const float* w_re = p.in[18]; const float* b_re = p.in[19];
    bf16_t* h2 = (bf16_t*)(p.ws + WS_H2);
    unsigned* cnt = (unsigned*)(p.ws + WS_CTL) + CW_CNT;
    int* ltok = (int*)(p.ws + WS_LTOK); float* lw = (float*)(p.ws + WS_LW);
    for (int row = c.bid * 8 + c.wid; row < NTOK; row += c.nblk * 8) {
        const int b = row >> 11;
        f32x4 v[8]; float ss = 0.f;
#pragma unroll
        for (int i = 0; i < 8; ++i) { v[i] = *(const f32x4*)(x1 + (size_t)row * D + i * 256 + c.lane * 4); ss += v[i][0] * v[i][0] + v[i][1] * v[i][1] + v[i][2] * v[i][2] + v[i][3] * v[i][3]; }
        ss = wave_sum(ss);
        const float rstd = rsqrtf(ss * (1.0f / D) + EPS);
        float gl[8];
#pragma unroll
        for (int j = 0; j < 8; ++j) gl[j] = 0.f;
#pragma unroll
        for (int i = 0; i < 8; ++i) {
            const int col = i * 256 + c.lane * 4;
            const f32x4 gg = *(const f32x4*)(g + col), sh = *(const f32x4*)(mod + b * NMOD + 3 * D + col), scl = *(const f32x4*)(mod + b * NMOD + 4 * D + col);
#pragma unroll
            for (int j = 0; j < 4; ++j) v[i][j] = (v[i][j] * rstd * gg[j]) * (1.0f + scl[j]) + sh[j];
            u32x2 w; w.x = pack_bf16(v[i][0], v[i][1]); w.y = pack_bf16(v[i][2], v[i][3]);
            *(u32x2*)(h2 + (size_t)row * D + col) = w;
#pragma unroll
            for (int j = 0; j < 4; ++j) {
                const f32x4 w0 = *(const f32x4*)(w_rg + (size_t)(col + j) * 8), w1 = *(const f32x4*)(w_rg + (size_t)(col + j) * 8 + 4);
#pragma unroll
                for (int e = 0; e < 4; ++e) { gl[e] += v[i][j] * w0[e]; gl[4 + e] += v[i][j] * w1[e]; }
            }
        }
#pragma unroll
        for (int j = 0; j < 8; ++j) gl[j] = wave_sum(gl[j]) + b_rg[j];
        int gi = 0; float gmax = gl[0];
#pragma unroll
        for (int j = 1; j < 8; ++j) if (gl[j] > gmax) { gmax = gl[j]; gi = j; }
        float gsum = 0.f;
#pragma unroll
        for (int j = 0; j < 8; ++j) gsum += __expf(gl[j] - gmax);
        const float pg = 1.0f / gsum;
        float el[8];
#pragma unroll
        for (int j = 0; j < 8; ++j) el[j] = 0.f;
#pragma unroll
        for (int i = 0; i < 8; ++i) {
            const int col = i * 256 + c.lane * 4;
#pragma unroll
            for (int j = 0; j < 4; ++j) {
                const f32x4 w0 = *(const f32x4*)(w_re + (size_t)(col + j) * 64 + gi * 8), w1 = *(const f32x4*)(w_re + (size_t)(col + j) * 64 + gi * 8 + 4);
#pragma unroll
                for (int e = 0; e < 4; ++e) { el[e] += v[i][j] * w0[e]; el[4 + e] += v[i][j] * w1[e]; }
            }
        }
#pragma unroll
        for (int j = 0; j < 8; ++j) el[j] = wave_sum(el[j]) + b_re[gi * 8 + j];
        int i1 = 0; float e1 = el[0];
#pragma unroll
        for (int j = 1; j < 8; ++j) if (el[j] > e1) { e1 = el[j]; i1 = j; }
        int i2 = -1; float e2 = -3.0e38f;
#pragma unroll
        for (int j = 0; j < 8; ++j) if (j != i1 && el[j] > e2) { e2 = el[j]; i2 = j; }
        const float r2 = __expf(e2 - e1);
        const float tp1 = 1.0f / (1.0f + r2), tp2 = r2 / (1.0f + r2);
        if (c.lane == 0) {
            const int ea = gi * 8 + i1, eb = gi * 8 + i2;
            const unsigned sa = atomicAdd(&cnt[ea], 1u), sb = atomicAdd(&cnt[eb], 1u);
            ltok[ea * NTOK + sa] = row * 2; lw[ea * NTOK + sa] = pg * tp1;
            ltok[eb * NTOK + sb] = row * 2 + 1; lw[eb * NTOK + sb] = pg * tp2;
        }
    }
}

constexpr int MOE_TAB = 100 * 1024;
__device__ __forceinline__ int moe_table(const Params& p, const Ctx& c) {
    const unsigned* cnt = (const unsigned*)(p.ws + WS_CTL) + CW_CNT;
    LAS int* tab = (LAS int*)(c.lds + MOE_TAB);
    __syncthreads();
    if (c.tid == 0) {
        int tp = 0, rp = 0;
        for (int e = 0; e < NE; ++e) { const int n = (int)cnt[e]; tab[e] = n; tab[64 + e] = tp; tab[192 + e] = rp; tp += (n + 255) >> 8; rp += n; }
        tab[64 + 64] = tp; tab[192 + 64] = rp;
    }
    __syncthreads();
    return tab[64 + 64];
}
__device__ __forceinline__ void moe_find(const Ctx& c, int ti, int& e, int& mt, int& cnt_e, int& rbase) {
    LAS int* tab = (LAS int*)(c.lds + MOE_TAB);
    int ee = 0;
    for (int k = 0; k < NE; ++k) if (tab[64 + k] <= ti) ee = k;
    while (ee > 0 && tab[ee] == 0) --ee;
    e = ee; mt = ti - tab[64 + ee]; cnt_e = tab[ee]; rbase = tab[192 + ee];
}

__device__ __forceinline__ void phase_moe1(const Params& p, const Ctx& c) {
    const bf16_t* h2 = (const bf16_t*)(p.ws + WS_H2);
    const int* ltok = (const int*)(p.ws + WS_LTOK);
    bf16_t* act = (bf16_t*)(p.ws + WS_ACT);
    const float* wg = p.in[20]; const float* wu = p.in[21];
    const int ntl = moe_table(p, c);
    unsigned* ctr = (unsigned*)(p.ws + WS_CTL) + CW_Q + 64;
    for (;;) {
        const int item = next_item(ctr, c);
        if (item >= ntl * 16) break;
        int e, mt, cnt_e, rbase; moe_find(c, item >> 4, e, mt, cnt_e, rbase);
        const int ntile = item & 15, n0 = ntile * 64;
        const bf16_t* arow[4];
#pragma unroll
        for (int i = 0; i < 4; ++i) {
            const int r = mt * 256 + (c.tid >> 3) + 64 * i;
            const int tok = r < cnt_e ? (ltok[e * NTOK + r] >> 1) : 0;
            arow[i] = h2 + (size_t)tok * D + (c.tid & 7) * 8;
        }
        const int nq = b_nq(c), blk = nq >> 2;
        const float* wsrc = ((blk & 1) ? wu : wg) + (size_t)e * D * DE;
        const float* bptr = wsrc + (size_t)b_k0(c) * DE + n0 + 16 * (blk >> 1) + 4 * (nq & 3);
        f32x4 acc[8][2]; zero_acc(acc);
        gemm_mainloop(acc, arow, bptr, DE, D, c);
#pragma unroll
        for (int mi = 0; mi < 8; ++mi) {
            const int r = mt * 256 + 128 * c.wr + 16 * mi + c.fr;
            if (r < cnt_e) {
                const int col = n0 + 16 * c.wc + 4 * c.fq;
                float o[4];
#pragma unroll
                for (int j = 0; j < 4; ++j) { const float a = acc[mi][0][j], u = acc[mi][1][j]; o[j] = a / (1.0f + __expf(-a)) * u; }
                u32x2 w; w.x = pack_bf16(o[0], o[1]); w.y = pack_bf16(o[2], o[3]);
                *(u32x2*)(act + (size_t)(rbase + r) * DE + col) = w;
            }
        }
    }
}
__device__ __forceinline__ void phase_moe2(const Params& p, const Ctx& c) {
    const int* ltok = (const int*)(p.ws + WS_LTOK); const float* lw = (const float*)(p.ws + WS_LW);
    const bf16_t* act = (const bf16_t*)(p.ws + WS_ACT);
    float* y = (float*)(p.ws + WS_Y);
    const float* wd = p.in[22];
    const int ntl = moe_table(p, c);
    unsigned* ctr = (unsigned*)(p.ws + WS_CTL) + CW_Q + 128;
    for (;;) {
        const int item = next_item(ctr, c);
        if (item >= ntl * 16) break;
        int e, mt, cnt_e, rbase; moe_find(c, item >> 4, e, mt, cnt_e, rbase);
        const int ntile = item & 15, n0 = ntile * 128;
        const bf16_t* arow[4];
#pragma unroll
        for (int i = 0; i < 4; ++i) arow[i] = act + (size_t)(rbase + mt * 256 + (c.tid >> 3) + 64 * i) * DE + (c.tid & 7) * 8;
        const float* bptr = wd + (size_t)e * DE * D + (size_t)b_k0(c) * D + n0 + 4 * b_nq(c);
        f32x4 acc[8][2]; zero_acc(acc);
        gemm_mainloop(acc, arow, bptr, D, DE, c);
#pragma unroll
        for (int mi = 0; mi < 8; ++mi) {
            const int r = mt * 256 + 128 * c.wr + 16 * mi + c.fr;
            if (r < cnt_e) {
                const int ent = ltok[e * NTOK + r]; const float w = lw[e * NTOK + r];
#pragma unroll
                for (int ni = 0; ni < 2; ++ni) {
                    const int col = n0 + 32 * c.wc + 16 * ni + 4 * c.fq;
                    *(f32x4*)(y + (size_t)ent * D + col) = acc[mi][ni] * w;
                }
            }
        }
    }
}

__device__ __forceinline__ void phase_final(const Params& p, const Ctx& c) {
    const float* x1 = (const float*)(p.ws + WS_X1); const float* y = (const float*)(p.ws + WS_Y);
    const float* mod = (const float*)(p.ws + WS_MOD); const float* g = p.in[23];
    for (int row = c.bid * 8 + c.wid; row < NTOK; row += c.nblk * 8) {
        const int b = row >> 11;
        f32x4 v[8]; float ss = 0.f;
#pragma unroll
        for (int i = 0; i < 8; ++i) {
            const int col = i * 256 + c.lane * 4;
            const f32x4 xv = *(const f32x4*)(x1 + (size_t)row * D + col);
            const f32x4 y0 = *(const f32x4*)(y + (size_t)(2 * row) * D + col), y1 = *(const f32x4*)(y + (size_t)(2 * row + 1) * D + col);
            const f32x4 gf = *(const f32x4*)(mod + b * NMOD + 5 * D + col);
            v[i] = xv + gf * (y0 + y1);
            ss += v[i][0] * v[i][0] + v[i][1] * v[i][1] + v[i][2] * v[i][2] + v[i][3] * v[i][3];
        }
        ss = wave_sum(ss);
        const float rstd = rsqrtf(ss * (1.0f / D) + EPS);
#pragma unroll
        for (int i = 0; i < 8; ++i) {
            const int col = i * 256 + c.lane * 4;
            const f32x4 gg = *(const f32x4*)(g + col);
            *(f32x4*)(p.out + (size_t)row * D + col) = v[i] * rstd * gg;
        }
    }
}

constexpr int LDS_BYTES = 160 * 1024;
__global__ void __launch_bounds__(512, 2) mk_fwd(Params p) {
    extern __shared__ __attribute__((aligned(16))) unsigned char smem[];
    Ctx c;
    c.lds = (LAS unsigned char*)smem;
    c.tid = threadIdx.x; c.lane = c.tid & 63; c.wid = __builtin_amdgcn_readfirstlane(c.tid >> 6);
    c.wr = c.wid >> 2; c.wc = c.wid & 3; c.fr = c.lane & 15; c.fq = c.lane >> 4;
    c.bid = blockIdx.x; c.nblk = gridDim.x;
    volatile LAS unsigned* bst = (volatile LAS unsigned*)(c.lds + LDS_BYTES - 32);
    if (c.tid == 0) { bst[0] = 0u; bst[1] = 0u; }
    __syncthreads();
    unsigned* barw = (unsigned*)(p.ws + WS_CTL);
    XcdBarrier bar; bar.bar = barw; bar.x = 0; bar.st = bst;
#if !MK_SPLIT
    bar = xcd_barrier_post(barw, bst);
#define GRID_BAR() xcd_barrier(bar)
#else
#define GRID_BAR() do {} while (0)
#endif
    const int lo = p.ph_lo, hi = p.ph_hi;
#define IN(k) (lo <= (k) && (k) < hi)
#define BOTH(k) (IN(k) && IN((k) + 1))
    if (IN(0)) { phase_mod(p, c); if (BOTH(0)) GRID_BAR(); }
    if (IN(1)) { phase_norm1(p, c); if (BOTH(1)) GRID_BAR(); }
    if (IN(2)) { phase_proj_in(p, c); if (BOTH(2)) GRID_BAR(); }
    if (IN(3)) { phase_attn(p, c); if (BOTH(3)) GRID_BAR(); }
    if (IN(4)) { phase_merge(p, c); if (BOTH(4)) GRID_BAR(); }
    if (IN(5)) { phase_out(p, c); if (BOTH(5)) GRID_BAR(); }
    if (IN(6)) { phase_norm2_route(p, c); if (BOTH(6)) GRID_BAR(); }
    if (IN(7)) { phase_moe1(p, c); if (BOTH(7)) GRID_BAR(); }
    if (IN(8)) { phase_moe2(p, c); if (BOTH(8)) GRID_BAR(); }
    if (IN(9)) { phase_final(p, c); }
}

extern "C" void kernel_launch(void* const* d_in, const int* in_sizes, int n_in, void* d_out, int out_size, void* d_ws, size_t ws_size, hipStream_t stream) {
    static int grid = 0;
    if (grid == 0) {
        if (n_in != 24 || out_size != NTOK * D || ws_size < WS_END) { fprintf(stderr, "kernel_launch: unexpected shapes (n_in %d out %d ws %zu need %zu)\n", n_in, out_size, ws_size, (size_t)WS_END); grid = -1; return; }
        int dev = 0, cus = 0, per_cu = 0;
        hipGetDevice(&dev); hipDeviceGetAttribute(&cus, hipDeviceAttributeMultiprocessorCount, dev);
        if (hipFuncSetAttribute((const void*)mk_fwd, hipFuncAttributeMaxDynamicSharedMemorySize, LDS_BYTES) != hipSuccess) { fprintf(stderr, "kernel_launch: hipFuncSetAttribute failed\n"); grid = -1; return; }
        if (hipOccupancyMaxActiveBlocksPerMultiprocessor(&per_cu, (const void*)mk_fwd, 512, LDS_BYTES) != hipSuccess || per_cu < 1) { fprintf(stderr, "kernel_launch: occupancy query says %d\n", per_cu); }
        (void)hipGetLastError();
        grid = cus > 0 ? cus : 256;
    }
    if (grid < 0) return;
    hipMemsetAsync((char*)d_ws + WS_CTL, 0, CTL_BYTES, stream);
    Params p{};
    for (int i = 0; i < 24; ++i) p.in[i] = (const float*)d_in[i];
    p.out = (float*)d_out; p.ws = (unsigned char*)d_ws;
#if MK_SPLIT
    for (int ph = 0; ph < NPHASE; ++ph) { p.ph_lo = ph; p.ph_hi = ph + 1; hipLaunchKernelGGL(mk_fwd, dim3(grid), dim3(512), LDS_BYTES, stream, p); }
#else
    p.ph_lo = 0; p.ph_hi = NPHASE;
    hipLaunchKernelGGL(mk_fwd, dim3(grid), dim3(512), LDS_BYTES, stream, p);
#endif
}
```

```cpp
#include <hip/hip_runtime.h>
#include <stdint.h>
#include <stdio.h>

#ifndef DUP_MASK
#define DUP_MASK 0
#endif
#ifndef MOE_NT
#define MOE_NT false
#endif
#ifndef MK_SPLIT
#define MK_SPLIT 0
#endif

typedef unsigned short bf16_t;
typedef short bf16x8 __attribute__((ext_vector_type(8)));
typedef short bf16x4 __attribute__((ext_vector_type(4)));
typedef float f32x4 __attribute__((ext_vector_type(4)));
typedef unsigned u32x4 __attribute__((ext_vector_type(4)));
typedef unsigned u32x2 __attribute__((ext_vector_type(2)));
#define LAS __attribute__((address_space(3)))

constexpr int D = 2048, NB = 4, SEQ = 2048, NTOK = NB * SEQ;
constexpr int INC = 10240, NMOD = 6 * D;
constexpr int NE = 64, DE = 1024;
constexpr float EPS = 1e-6f;
constexpr int NPHASE = 10;

constexpr size_t WS_CTL = 0;
constexpr size_t CTL_BYTES = 32768;
constexpr size_t CW_CNT = 4096;
constexpr size_t CW_Q = 4096 + 256;
constexpr size_t WS_MOD = WS_CTL + CTL_BYTES;
constexpr size_t WS_H = WS_MOD + (size_t)NB * NMOD * 4;
constexpr size_t WS_QA = WS_H + (size_t)NTOK * D * 2;
constexpr size_t WS_KA = WS_QA + (size_t)NTOK * 1024 * 2;
constexpr size_t WS_VAT = WS_KA + (size_t)NTOK * 1024 * 2;
constexpr size_t WS_QB = WS_VAT + (size_t)NTOK * 1024 * 2;
constexpr size_t WS_KB = WS_QB + (size_t)NTOK * 1024 * 2;
constexpr size_t WS_VBT = WS_KB + (size_t)NTOK * 1024 * 2;
constexpr size_t WS_GA = WS_VBT + (size_t)NTOK * 1024 * 2;
constexpr size_t WS_GB = WS_GA + (size_t)NTOK * D * 2;
constexpr size_t WS_OA = WS_GB + (size_t)NTOK * D * 2;
constexpr size_t WS_OB = WS_OA + (size_t)NTOK * 1024 * 2;
constexpr size_t WS_MRG = WS_OB + (size_t)NTOK * 1024 * 2;
constexpr size_t WS_X1 = WS_MRG + (size_t)NTOK * D * 2;
constexpr size_t WS_H2 = WS_X1 + (size_t)NTOK * D * 4;
constexpr size_t WS_LTOK = WS_H2 + (size_t)NTOK * D * 2;
constexpr size_t WS_LW = WS_LTOK + (size_t)NE * NTOK * 4;
constexpr size_t WS_ACT = WS_LW + (size_t)NE * NTOK * 4;
constexpr size_t WS_Y = WS_ACT + (size_t)(2 * NTOK + 512) * DE * 2;
constexpr size_t WS_WIN_T = WS_Y + (size_t)2 * NTOK * D * 4;
constexpr size_t WS_WPA_T = WS_WIN_T + (size_t)INC * D * 2;
constexpr size_t WS_WPB_T = WS_WPA_T + (size_t)D * 1024 * 2;
constexpr size_t WS_WOUT_T = WS_WPB_T + (size_t)D * 1024 * 2;
constexpr size_t WS_RW = WS_WOUT_T + (size_t)D * D * 2;
constexpr size_t WS_RC = WS_RW + (size_t)NB * 80 * D * 4;
constexpr size_t WS_TREC = WS_RC + 4096;
constexpr size_t WS_END = WS_TREC + (size_t)NTOK * 16;

#define XB_TMO      128
#define XB_XCNT(j)  (256  + 64 * (j))
#define XB_XSUB(j)  (1280 + 64 * (j))
#define XB_XGEN(j)  (2304 + 64 * (j))
#define XB_TOP      3328
#define XB_TOPGEN   3392
#define XCD_BAR_WORDS 3456
#define XB_SPIN_CAP (1u << 24)

__device__ __forceinline__ unsigned xb_ld(unsigned* p)              { return __hip_atomic_load(p, __ATOMIC_RELAXED, __HIP_MEMORY_SCOPE_AGENT); }
__device__ __forceinline__ unsigned xb_add(unsigned* p, unsigned v) { return __hip_atomic_fetch_add(p, v, __ATOMIC_RELAXED, __HIP_MEMORY_SCOPE_AGENT); }
__device__ __forceinline__ unsigned xb_xcc_id() { return (unsigned)__builtin_amdgcn_s_getreg((3 << 11) | 20) & 0xFu; }
#define XB_SPIN(cond, bar) do { unsigned _sp = 0; while (cond) { __builtin_amdgcn_s_sleep(1); \
    if ((++_sp & 255u) == 0u) { if (xb_ld(&(bar)[XB_TMO])) break; if (_sp > XB_SPIN_CAP) { atomicAdd(&(bar)[XB_TMO], 1u); break; } } } } while (0)

struct XcdBarrier { unsigned* bar; unsigned x; volatile LAS unsigned* st; };

__device__ __forceinline__ XcdBarrier xcd_barrier_post(unsigned* bar, volatile LAS unsigned* st, bool leader) {
    XcdBarrier b; b.bar = bar; b.x = xb_xcc_id(); b.st = st;
    if (leader) (void)xb_add(&bar[XB_XCNT(b.x)], 1u);
    return b;
}
__device__ __forceinline__ void xcd_barrier_complete(unsigned* bar, unsigned x, unsigned& nloc, unsigned& nx) {
    const unsigned G = gridDim.x * gridDim.y * gridDim.z;
    unsigned sum, cnt, mine, sp = 0u;
    for (;;) {
        sum = 0u; cnt = 0u; mine = 0u;
#pragma unroll
        for (unsigned j = 0; j < 16; ++j) { const unsigned c = xb_ld(&bar[XB_XCNT(j)]); sum += c; cnt += (c > 0u) ? 1u : 0u; mine = (j == x) ? c : mine; }
        if (sum == G) break;
        __builtin_amdgcn_s_sleep(1);
        if ((++sp & 255u) == 0u) { if (xb_ld(&bar[XB_TMO])) break; if (sp > XB_SPIN_CAP) { atomicAdd(&bar[XB_TMO], 1u); break; } }
    }
    nloc = mine > 0u ? mine : 1u; nx = cnt > 0u ? cnt : 1u;
}
__device__ __forceinline__ void xcd_barrier(const XcdBarrier& b, bool leader) {
    asm volatile("s_waitcnt vmcnt(0)" ::: "memory");
    __syncthreads();
    if (leader) {
        unsigned* bar = b.bar;
        __builtin_amdgcn_s_waitcnt(0);
        unsigned nloc = b.st[0], nx = b.st[1];
        if (nloc == 0u) { xcd_barrier_complete(bar, b.x, nloc, nx); b.st[0] = nloc; b.st[1] = nx; }
        const unsigned old = xb_add(&bar[XB_XSUB(b.x)], 1u);
        const unsigned gen = old / nloc;
        if (old + 1u == (gen + 1u) * nloc) {
            __builtin_amdgcn_fence(__ATOMIC_RELEASE, "agent");
            asm volatile("s_waitcnt vmcnt(0)" ::: "memory");
            const unsigned og = xb_add(&bar[XB_TOP], 1u);
            const unsigned tg = og / nx;
            if (og + 1u == (tg + 1u) * nx) xb_add(&bar[XB_TOPGEN], 1u);
            else XB_SPIN(xb_ld(&bar[XB_TOPGEN]) == tg, bar);
            __builtin_amdgcn_fence(__ATOMIC_ACQUIRE, "agent");
            xb_add(&bar[XB_XGEN(b.x)], 1u);
            asm volatile("s_waitcnt vmcnt(0)" ::: "memory");
        } else {
            XB_SPIN(xb_ld(&bar[XB_XGEN(b.x)]) == gen, bar);
            __builtin_amdgcn_fence(__ATOMIC_ACQUIRE, "agent");
            asm volatile("s_waitcnt vmcnt(0)" ::: "memory");
        }
    }
    __syncthreads();
}

typedef __bf16 bf16v2_t __attribute__((ext_vector_type(2)));
typedef float f32x2 __attribute__((ext_vector_type(2)));
__device__ __forceinline__ unsigned pack_bf16(float lo, float hi) {
    const f32x2 v = {lo, hi};
    return __builtin_bit_cast(unsigned, __builtin_convertvector(v, bf16v2_t));
}
__device__ __forceinline__ float wave_sum(float v) {
#pragma unroll
    for (int o = 32; o > 0; o >>= 1) v += __shfl_xor(v, o);
    return v;
}
__device__ __forceinline__ float xmax16(float v) { const auto r = __builtin_amdgcn_permlane16_swap(__float_as_uint(v), __float_as_uint(v), false, false); return fmaxf(__uint_as_float(r[0]), __uint_as_float(r[1])); }
__device__ __forceinline__ float xmax32(float v) { const auto r = __builtin_amdgcn_permlane32_swap(__float_as_uint(v), __float_as_uint(v), false, false); return fmaxf(__uint_as_float(r[0]), __uint_as_float(r[1])); }
__device__ __forceinline__ float xsum16(float v) { const auto r = __builtin_amdgcn_permlane16_swap(__float_as_uint(v), __float_as_uint(v), false, false); return __uint_as_float(r[0]) + __uint_as_float(r[1]); }
__device__ __forceinline__ float xsum32(float v) { const auto r = __builtin_amdgcn_permlane32_swap(__float_as_uint(v), __float_as_uint(v), false, false); return __uint_as_float(r[0]) + __uint_as_float(r[1]); }
__device__ __forceinline__ float sigmoidf_(float x) { return 1.0f / (1.0f + __expf(-x)); }

__device__ __forceinline__ int lane_id_fresh() { int l; asm volatile("v_mbcnt_lo_u32_b32 %0, -1, 0\n\tv_mbcnt_hi_u32_b32 %0, -1, %0" : "=v"(l)); return l; }
struct Params { const float* in[24]; float* out; unsigned char* ws; int ph_lo, ph_hi; };

struct Ctx {
    int tid, lane, wid, wr, wc, fr, fq, bid, nblk;
    LAS unsigned char* lds;
};

__device__ __forceinline__ int next_item(unsigned* ctr, const Ctx& c) {
    LAS int* slot = (LAS int*)(c.lds + 160 * 1024 - 64);
    __syncthreads();
    if (c.tid == 0) *slot = (int)__hip_atomic_fetch_add(ctr, 1u, __ATOMIC_RELAXED, __HIP_MEMORY_SCOPE_AGENT);
    __syncthreads();
    return *slot;
}

struct XQueue { unsigned* heads; int x, v; };
__device__ __forceinline__ XQueue xq_make(const Params& p, int qsel) { XQueue q; q.heads = (unsigned*)(p.ws + WS_CTL) + CW_Q + qsel * 512; q.x = (int)(xb_xcc_id() & 7u); q.v = 0; return q; }
__device__ __forceinline__ bool xq_next(XQueue& q, int per_tile, int ntiles, const Ctx& c, int& tile, int& sub) {
    while (q.v < 8) {
        const int qi = (q.x + q.v) & 7;
        const int L = next_item(q.heads + qi * 64, c);
        const int t = qi + 8 * (L / per_tile);
        if (t < ntiles) { tile = t; sub = L % per_tile; return true; }
        ++q.v;
    }
    return false;
}

namespace pg8 {
#define PG8_LAS __attribute__((address_space(3)))
typedef unsigned short bf16_t;
typedef short bf16x8 __attribute__((ext_vector_type(8)));
typedef float f32x4 __attribute__((ext_vector_type(4)));
typedef unsigned u32x4 __attribute__((ext_vector_type(4)));
constexpr int BM = 256, BK = 64, HALF = 128, HTB = HALF * BK * 2  , STAGE_BYTES = 8 * HTB, NXCD = 8, WGM = 8;

__host__ __device__ __forceinline__ int lds_byte(int r, int c) { const int st = (r >> 4) * 2 + (c >> 5), rr = r & 15, cc = c & 31, ob = rr * 64 + cc * 2; return st * 1024 + (ob ^ (((ob >> 9) & 1) << 5)); }
__host__ __device__ __forceinline__ void stage_rc(int b, int& R, int& C) { const int st = b / 1024, sb = b % 1024, swz = sb ^ (((sb >> 9) & 1) << 5); R = (st >> 1) * 16 + swz / 64; C = (st & 1) * 32 + (swz % 64) / 2; }
__host__ __device__ __forceinline__ int perm32(int rho) { const int n = rho >> 4, i = rho & 15; return 8 * (i >> 2) + 4 * n + (i & 3); }

struct Unit { int pm, pn; };
struct Gemm { const bf16_t* A; const bf16_t* Bt; int M, N, K; };

struct StaticOrder {
    int nM, nN, nwg, G, c;
    __host__ __device__ void init(int M, int N, int G_, int c_) { nM = M / BM; nN = N / BM; nwg = nM * nN; G = G_; c = c_; }
    __host__ __device__ bool next(int i, Unit& u) const {
        const long L = (long)i * G + c; if (L >= nwg) return false;
        int wgid = (int)L; { const int q = nwg / NXCD, r = nwg % NXCD, xcd = wgid % NXCD, off = wgid / NXCD; wgid = (xcd < r ? xcd * (q + 1) : r * (q + 1) + (xcd - r) * q) + off; }
        const int nig = WGM * nN, gid = wgid / nig, fm = gid * WGM, gsz = (nM - fm) < WGM ? (nM - fm) : WGM;
        u.pm = fm + ((wgid % nig) % gsz); u.pn = (wgid % nig) / gsz; return true;
    }
    __device__ __forceinline__ void a_ready(const Unit&) const {}
    __device__ __forceinline__ void done(const Unit&) const {}
};
struct NoMid { static constexpr int AT = -1; __device__ __forceinline__ void operator()(f32x4 (&)[2][2][4][2], const Unit&, int, int, int, int) const {} };
template <class Epi, class Sched, bool STAMP = false, class Mid = NoMid>
__device__ __forceinline__ void gemm_phase(PG8_LAS unsigned char* lds, const Gemm g, const Sched& S, const Epi& E, unsigned long long* stamps, const int wid_in, const Mid& MH = Mid()) {
    const int wid = __builtin_amdgcn_readfirstlane(wid_in), lane = lane_id_fresh(), tid = wid * 64 + lane, wr = wid >> 2, wc = wid & 3, fr = lane & 15, fq = lane >> 4;
    const int K = g.K, nt = K / BK;
    int ts_lo = 0, ts_hi = 0, nts = 0; const unsigned long long rt_entry = STAMP ? (unsigned long long)wall_clock64() : 0ull;
#define PG8_STAMP() do { if (STAMP && wid == 0 && nts < 64) { const unsigned long long _c = (unsigned long long)clock64(); \
        ts_lo = (lane == nts) ? (int)(unsigned)_c : ts_lo; ts_hi = (lane == nts) ? (int)(unsigned)(_c >> 32) : ts_hi; ++nts; } } while (0)
    PG8_STAMP();
    unsigned voffA[2], voffB[2];
#pragma unroll
    for (int i = 0; i < 2; ++i) { int R, C; stage_rc(tid * 16 + i * 8192, R, C); const int Rb = Epi::PERM ? ((R & ~31) + perm32(R & 31)) : R;
        voffA[i] = (unsigned)(R * K + C) * 2u; voffB[i] = (unsigned)(Rb * K + C) * 2u; }
    const size_t kstep = (size_t)(BK * 2);
    const size_t hstep = (size_t)HALF * K * 2;
    const size_t tstep = 2 * hstep;
    const unsigned ldsw = (unsigned)wid * 1024u;
    const int aoff = lds_byte(wr * 64 + fr, fq * 8), boff = lds_byte(wc * 32 + fr, fq * 8);
#define PG8_SA(b, h) (((b) * 2 + (h)) * HTB)
#define PG8_SB(b, h) ((4 + (b) * 2 + (h)) * HTB)
#define PG8_STAGE(bufoff, gbase, voff) do { _Pragma("unroll") for (int _i = 0; _i < 2; ++_i) \
        __builtin_amdgcn_global_load_lds((const unsigned*)((const char*)(gbase) + (voff)[_i]), (PG8_LAS unsigned*)(lds + (bufoff) + ldsw + _i * 8192), 16, 0, 0); } while (0)
#define PG8_LDA(dst, b, h) do { _Pragma("unroll") for (int m = 0; m < 4; ++m) _Pragma("unroll") for (int k = 0; k < 2; ++k) dst[m][k] = *(const PG8_LAS bf16x8*)(lds + PG8_SA(b, h) + aoff + m * 2048 + k * 1024); } while (0)
#define PG8_LDB(dst, b, h) do { _Pragma("unroll") for (int n = 0; n < 2; ++n) _Pragma("unroll") for (int k = 0; k < 2; ++k) dst[n][k] = *(const PG8_LAS bf16x8*)(lds + PG8_SB(b, h) + boff + n * 2048 + k * 1024); } while (0)
#define PG8_MMA(ai, bj, At, Bt) do { __builtin_amdgcn_s_setprio(1); _Pragma("unroll") for (int m = 0; m < 4; ++m) _Pragma("unroll") for (int n = 0; n < 2; ++n) _Pragma("unroll") for (int k = 0; k < 2; ++k) \
        acc[ai][bj][m][n] = __builtin_amdgcn_mfma_f32_16x16x32_bf16(Bt[n][k], At[m][k], acc[ai][bj][m][n], 0, 0, 0); __builtin_amdgcn_s_setprio(0); } while (0)
#define PG8_WAIT_V(n) asm volatile("s_waitcnt vmcnt(" #n ")" ::: "memory")
#define PG8_WAIT_L(n) asm volatile("s_waitcnt lgkmcnt(" #n ")" ::: "memory")
#define PG8_BAR __builtin_amdgcn_s_barrier()
#define PG8_SCHED __builtin_amdgcn_sched_barrier(0)
    Unit cur, nxt; int ui = 0;
    if (!S.next(0, cur)) return;
    f32x4 acc[2][2][4][2];
#pragma unroll
    for (int a = 0; a < 2; ++a)
#pragma unroll
        for (int b = 0; b < 2; ++b)
#pragma unroll
            for (int m = 0; m < 4; ++m)
#pragma unroll
                for (int n = 0; n < 2; ++n) acc[a][b][m][n] = (f32x4){0.f, 0.f, 0.f, 0.f};
    bf16x8 At[4][2], B0[2][2], B1[2][2];
    const char* cA = (const char*)g.A + (size_t)cur.pm * tstep; const char* cB = (const char*)g.Bt + (size_t)cur.pn * tstep;
    S.a_ready(cur);
    PG8_STAGE(PG8_SB(0, 0), cB, voffB); PG8_STAGE(PG8_SA(0, 0), cA, voffA); PG8_STAGE(PG8_SB(0, 1), cB + hstep, voffB); PG8_STAGE(PG8_SA(0, 1), cA + hstep, voffA);
    if (wr == 1) PG8_BAR;
    PG8_WAIT_V(4); PG8_BAR;
    PG8_STAGE(PG8_SB(1, 0), cB + kstep, voffB); PG8_STAGE(PG8_SA(1, 0), cA + kstep, voffA); PG8_STAGE(PG8_SB(1, 1), cB + hstep + kstep, voffB);
    PG8_WAIT_V(6); PG8_BAR;
    PG8_STAMP();
    for (;;) {
        const bool has_next = S.next(ui + 1, nxt);
        const char* nA = has_next ? (const char*)g.A + (size_t)nxt.pm * tstep : cA; const char* nB = has_next ? (const char*)g.Bt + (size_t)nxt.pn * tstep : cB;
        for (int t = 0; t < nt; t += 2) {
            if (Mid::AT >= 0 && t == Mid::AT) MH(acc, cur, wr, wc, fr, fq);
            const bool last = (t == nt - 2);
            const char* a1 = cA + (size_t)(t + 1) * kstep;
            const char* a2 = last ? nA : cA + (size_t)(t + 2) * kstep; const char* b2 = last ? nB : cB + (size_t)(t + 2) * kstep;
            const char* a3 = a2 + kstep; const char* b3 = b2 + kstep;
            if (last && has_next) S.a_ready(nxt);
            PG8_LDB(B0, 0, 0); PG8_SCHED; PG8_LDA(At, 0, 0); PG8_STAGE(PG8_SA(1, 1), a1 + hstep, voffA);
            PG8_WAIT_L(8); PG8_BAR; PG8_WAIT_L(0); PG8_MMA(0, 0, At, B0); PG8_BAR; PG8_SCHED;
            PG8_LDB(B1, 0, 1); PG8_STAGE(PG8_SB(0, 0), b2, voffB);
            PG8_BAR; PG8_WAIT_L(0); PG8_MMA(0, 1, At, B1); PG8_BAR;
            PG8_LDA(At, 0, 1); PG8_STAGE(PG8_SA(0, 0), a2, voffA);
            PG8_BAR; PG8_WAIT_L(0); PG8_MMA(1, 0, At, B0); PG8_BAR; PG8_SCHED;
            PG8_STAGE(PG8_SB(0, 1), b2 + hstep, voffB);
            PG8_WAIT_V(6); PG8_BAR; PG8_MMA(1, 1, At, B1); PG8_BAR;
            PG8_LDB(B0, 1, 0); PG8_SCHED; PG8_LDA(At, 1, 0); PG8_STAGE(PG8_SA(0, 1), a2 + hstep, voffA);
            PG8_WAIT_L(8); PG8_BAR; PG8_WAIT_L(0); PG8_MMA(0, 0, At, B0); PG8_BAR; PG8_SCHED;
            PG8_LDB(B1, 1, 1); PG8_STAGE(PG8_SB(1, 0), b3, voffB);
            PG8_BAR; PG8_WAIT_L(0); PG8_MMA(0, 1, At, B1); PG8_BAR;
            PG8_LDA(At, 1, 1); PG8_STAGE(PG8_SA(1, 0), a3, voffA);
            PG8_BAR; PG8_WAIT_L(0); PG8_MMA(1, 0, At, B0); PG8_BAR; PG8_SCHED;
            PG8_STAGE(PG8_SB(1, 1), b3 + hstep, voffB);
            PG8_WAIT_V(6); PG8_BAR; PG8_MMA(1, 1, At, B1); PG8_BAR;
        }
        PG8_STAMP();
        if constexpr (!Epi::AFTER_DRAIN) { E(acc, cur, wr, wc, fr, fq); S.done(cur); }
        PG8_STAMP();
        if (!has_next) break;
#pragma unroll
        for (int a = 0; a < 2; ++a)
#pragma unroll
            for (int b = 0; b < 2; ++b)
#pragma unroll
                for (int m = 0; m < 4; ++m)
#pragma unroll
                    for (int n = 0; n < 2; ++n) acc[a][b][m][n] = (f32x4){0.f, 0.f, 0.f, 0.f};
        cur = nxt; cA = nA; cB = nB; ++ui;
    }
    PG8_WAIT_V(0);
    if (wr == 0) PG8_BAR;
    PG8_BAR;
    if constexpr (Epi::AFTER_DRAIN) { E.fused(acc, cur, wr, wc, fr, fq, lds, wid, lane); S.done(cur); }
    PG8_STAMP();
    if (STAMP && wid == 0) { stamps[lane] = lane < nts ? (((unsigned long long)(unsigned)ts_hi << 32) | (unsigned)ts_lo) : 0ull;
        if (lane == 62) stamps[62] = rt_entry; if (lane == 63) stamps[63] = (unsigned long long)wall_clock64(); }
#undef PG8_STAMP
#undef PG8_SA
#undef PG8_SB
#undef PG8_STAGE
#undef PG8_LDA
#undef PG8_LDB
#undef PG8_MMA
#undef PG8_WAIT_V
#undef PG8_WAIT_L
#undef PG8_BAR
#undef PG8_SCHED
}
}

constexpr int G_STAGE = 49152, G_BOFF = 32768;
template <bool NTB, int K>
__device__ __forceinline__ void gemm_mainloop(f32x4 (&acc)[8][2], const bf16_t* const (&arow)[4], const float* bptr, const int ldb, const Ctx& c) {
    const int lane = c.lane, wid = c.wid;
    constexpr int nt = K >> 6;
    const int half = lane & 1, nq = ((lane >> 1) & 7) | ((lane >> 4) << 3);
    int b_wr[4];
#pragma unroll
    for (int j = 0; j < 4; ++j) { const int n = 4 * nq + j; b_wr[j] = G_BOFF + n * 128 + ((wid ^ ((n >> 1) & 7)) << 4) + half * 8; }
    const int a_wr = wid * 4096 + lane * 16;
    const int fr = c.fr, fq = c.fq;
    int a_rd[2], b_rd[2][2];
#pragma unroll
    for (int kb = 0; kb < 2; ++kb) {
        a_rd[kb] = (128 * c.wr + fr) * 128 + ((((4 * kb + fq) ^ (fr & 7))) << 4);
#pragma unroll
        for (int ni = 0; ni < 2; ++ni) { const int n = 32 * c.wc + 16 * ni + fr; b_rd[kb][ni] = G_BOFF + n * 128 + (((4 * kb + fq) ^ ((n >> 1) & 7)) << 4); }
    }
    u32x4 ra[4]; f32x4 rb0[4], rb1[4];
    bf16x8 A0[8], A1[8], B0[2], B1[2];
#define G_LOADA(T) do { _Pragma("unroll") for (int i = 0; i < 4; ++i) ra[i] = *(const u32x4*)(arow[i] + (T) * 64); } while (0)
#define G_LOADB(RB, T) do { _Pragma("unroll") for (int i = 0; i < 4; ++i) { \
        if (NTB) RB[i] = __builtin_nontemporal_load((const f32x4*)(bptr + (size_t)((T) * 64 + i) * ldb)); else RB[i] = *(const f32x4*)(bptr + (size_t)((T) * 64 + i) * ldb); } } while (0)
#define G_WRITE(ST, RB) do { _Pragma("unroll") for (int i = 0; i < 4; ++i) *(LAS u32x4*)((ST) + a_wr + i * 1024) = ra[i]; \
        _Pragma("unroll") for (int j = 0; j < 4; ++j) { u32x2 w; w.x = pack_bf16(RB[0][j], RB[1][j]); w.y = pack_bf16(RB[2][j], RB[3][j]); *(LAS u32x2*)((ST) + b_wr[j]) = w; } } while (0)
#define G_LDF(ST, kb, AF, BF) do { _Pragma("unroll") for (int ni = 0; ni < 2; ++ni) BF[ni] = *(const LAS bf16x8*)((ST) + b_rd[kb][ni]); \
        _Pragma("unroll") for (int mi = 0; mi < 8; ++mi) AF[mi] = *(const LAS bf16x8*)((ST) + a_rd[kb] + mi * 2048); } while (0)
#define G_MMA(AF, BF) do { _Pragma("unroll") for (int mi = 0; mi < 8; ++mi) _Pragma("unroll") for (int ni = 0; ni < 2; ++ni) \
        acc[mi][ni] = __builtin_amdgcn_mfma_f32_16x16x32_bf16(BF[ni], AF[mi], acc[mi][ni], 0, 0, 0); } while (0)
#define G_SB __builtin_amdgcn_sched_barrier(0)
    LAS unsigned char* st0 = c.lds; LAS unsigned char* st1 = c.lds + G_STAGE;
    constexpr int tl = nt - 1;
    G_LOADA(0); G_LOADB(rb0, 0); G_LOADB(rb1, 1);
    G_WRITE(st0, rb0);
    G_LOADA(1); G_LOADB(rb0, 2);
    __syncthreads();
#pragma unroll 1
    for (int t = 0; t < nt; t += 2) {
        const int t2 = (t + 2 < tl) ? t + 2 : tl, t3 = (t + 3 < tl) ? t + 3 : tl, t4 = (t + 4 < tl) ? t + 4 : tl;
        G_LDF(st0, 0, A0, B0); G_LDF(st0, 1, A1, B1); G_SB;
        G_MMA(A0, B0); G_SB;
        G_WRITE(st1, rb1); G_SB;
        G_MMA(A1, B1); G_SB;
        G_LOADA(t2); G_LOADB(rb1, t3);
        __syncthreads();
        G_LDF(st1, 0, A0, B0); G_LDF(st1, 1, A1, B1); G_SB;
        G_MMA(A0, B0); G_SB;
        G_WRITE(st0, rb0); G_SB;
        G_MMA(A1, B1); G_SB;
        G_LOADA(t3); G_LOADB(rb0, t4);
        __syncthreads();
    }
#undef G_LOADA
#undef G_LOADB
#undef G_WRITE
#undef G_LDF
#undef G_MMA
#undef G_SB
}
constexpr int W_STAGE = 65536, W_BOFF = 32768;
__device__ __forceinline__ int swzb(int n) { return ((n >> 2) & 1) | ((((n >> 1) ^ (n >> 3)) & 1) << 1) | ((((n >> 2) ^ (n >> 4)) & 1) << 2); }
template <int K>
__device__ __forceinline__ void gemm_mainloop256(f32x4 (&acc)[8][4], f32x4 (&rb)[8], const bf16_t* abase, const int (&aoff)[4], const float* bptr, const int ldb, const int nrows, const Ctx& c,
                                                 const bool staged, const int (&aoffn)[4], const float* bptrn, const int nrows_n, const bool hn) {
    const int lane = c.lane, wid = c.wid;
    constexpr int nt = K >> 6;
    int b_wr[2];
#pragma unroll
    for (int jh = 0; jh < 2; ++jh) { const int n = 4 * lane + 2 * jh; b_wr[jh] = W_BOFF + n * 128 + ((wid ^ swzb(n)) << 4); }
    const int a_dma = wid * 4096;
    const int fr = c.fr, fq = c.fq;
    int a_rd[2], b_rd[2][2];
#pragma unroll
    for (int kb = 0; kb < 2; ++kb) {
        a_rd[kb] = (128 * c.wr + fr) * 128 + ((((4 * kb + fq) ^ (fr & 7))) << 4);
#pragma unroll
        for (int ni = 0; ni < 2; ++ni) { const int n = 64 * c.wc + 16 * ni + fr; b_rd[kb][ni] = W_BOFF + n * 128 + (((4 * kb + fq) ^ swzb(n)) << 4); }
    }
    const int nfr = __builtin_amdgcn_readfirstlane(max(0, min(8, (nrows - 128 * c.wr + 15) >> 4)));
    const int npc = __builtin_amdgcn_readfirstlane(max(0, min(4, (nrows - 32 * wid + 7) >> 3)));
    const int npcn = __builtin_amdgcn_readfirstlane(max(0, min(4, (nrows_n - 32 * wid + 7) >> 3)));
    const int n1a = hn ? 64 : 0;
    const size_t n1b = hn ? (size_t)64 * ldb : 0;
#define W_FA(ST, T, NT1) do { const bool nx = ((T) >= nt); const int np = nx ? npcn : npc; \
        _Pragma("unroll") for (int i = 0; i < 4; ++i) if (i < np) \
            __builtin_amdgcn_global_load_lds((const unsigned*)(abase + (nx ? aoffn[i] + ((NT1) ? n1a : 0) : aoff[i] + (T) * 64)), (LAS unsigned*)((ST) + a_dma + i * 1024), 16, 0, 0); } while (0)
#define W_FB(T, NT1) do { const bool nx = ((T) >= nt); \
        const float* bq = nx ? bptrn + ((NT1) ? n1b : 0) : bptr + (size_t)((T) * 64) * ldb; \
        _Pragma("unroll") for (int i = 0; i < 8; ++i) rb[i] = *(const f32x4*)(bq + (size_t)i * ldb); } while (0)
#define W_CVT() do { _Pragma("unroll") for (int j = 0; j < 4; ++j) { wv[j].x = pack_bf16(rb[0][j], rb[1][j]); wv[j].y = pack_bf16(rb[2][j], rb[3][j]); \
            wv[j].z = pack_bf16(rb[4][j], rb[5][j]); wv[j].w = pack_bf16(rb[6][j], rb[7][j]); } } while (0)
#define W_ST(ST) do { _Pragma("unroll") for (int j = 0; j < 4; ++j) *(LAS u32x4*)((ST) + b_wr[j >> 1] + (j & 1) * 128) = wv[j]; } while (0)
#define W_SB __builtin_amdgcn_sched_barrier(0)
#define W_COMPUTE(ST) do { _Pragma("unroll") for (int kb = 0; kb < 2; ++kb) { bf16x8 bf[4]; \
        _Pragma("unroll") for (int ni = 0; ni < 4; ++ni) bf[ni] = *(const LAS bf16x8*)((ST) + b_rd[kb][ni & 1] + (ni >> 1) * 4096); \
        _Pragma("unroll") for (int mi = 0; mi < 8; ++mi) if (mi < nfr) { const bf16x8 af = *(const LAS bf16x8*)((ST) + a_rd[kb] + mi * 2048); \
            _Pragma("unroll") for (int ni = 0; ni < 4; ++ni) acc[mi][ni] = __builtin_amdgcn_mfma_f32_16x16x32_bf16(bf[ni], af, acc[mi][ni], 0, 0, 0); } } } while (0)
    LAS unsigned char* st0 = c.lds; LAS unsigned char* st1 = c.lds + W_STAGE;
    u32x4 wv[4];
    if (!staged) {
        W_FA(st0, 0, 0); W_FB(0, 0);
        W_CVT(); W_SB; W_FB(1, 0); W_SB; W_ST(st0);
        asm volatile("s_waitcnt vmcnt(8)" ::: "memory");
        __syncthreads();
        W_FA(st1, 1, 0);
    }
#pragma unroll 1
    for (int t = 0; t < nt; t += 2) {
        W_COMPUTE(st0);
        W_CVT(); W_SB; W_FB(t + 2, 0); W_SB; W_ST(st1);
        asm volatile("s_waitcnt vmcnt(8)" ::: "memory");
        __syncthreads();
        W_FA(st0, t + 2, 0);
        W_COMPUTE(st1);
        W_CVT(); W_SB; W_FB(t + 3, 1); W_SB; W_ST(st0);
        asm volatile("s_waitcnt vmcnt(8)" ::: "memory");
        __syncthreads();
        W_FA(st1, t + 3, 1);
    }
#undef W_FA
#undef W_FB
#undef W_CVT
#undef W_ST
#undef W_SB
#undef W_COMPUTE
}
__device__ __forceinline__ int a_piece_row(const Ctx& c, int i) { return 32 * c.wid + 8 * i + (c.lane >> 3); }
__device__ __forceinline__ int a_piece_col(const Ctx& c) { return 8 * ((c.lane & 7) ^ ((c.lane >> 3) & 7)); }
__device__ __forceinline__ void zero_acc(f32x4 (&acc)[8][2]) {
#pragma unroll
    for (int mi = 0; mi < 8; ++mi)
#pragma unroll
        for (int ni = 0; ni < 2; ++ni) acc[mi][ni] = (f32x4){0.f, 0.f, 0.f, 0.f};
}
__device__ __forceinline__ int b_nq(const Ctx& c) { return ((c.lane >> 1) & 7) | ((c.lane >> 4) << 3); }
__device__ __forceinline__ int b_k0(const Ctx& c) { return 8 * c.wid + 4 * (c.lane & 1); }

__device__ __forceinline__ void phase_mod(const Params& p, const Ctx& c) {
    const float* cc = p.in[1]; const float* w_ada = p.in[3]; const float* b_ada = p.in[4];
    float* mod = (float*)(p.ws + WS_MOD);
    LAS float* sc = (LAS float*)c.lds;
    LAS float* red = (LAS float*)(c.lds + 32768);
    for (int i = c.tid; i < NB * D; i += 512) { const float v = cc[i]; sc[i] = v / (1.0f + __expf(-v)); }
    __syncthreads();
    const int cq = c.tid % 12, kl = c.tid / 12;
    for (int item = c.bid; item < 256; item += c.nblk) {
        float acc[4][4];
#pragma unroll
        for (int b = 0; b < 4; ++b)
#pragma unroll
            for (int j = 0; j < 4; ++j) acc[b][j] = 0.f;
        if (kl < 42) {
            const float* wp = w_ada + item * 48 + cq * 4;
            for (int k = kl; k < D; k += 42) {
                const f32x4 w = *(const f32x4*)(wp + (size_t)k * NMOD);
#pragma unroll
                for (int b = 0; b < 4; ++b) { const float s = sc[b * D + k];
#pragma unroll
                    for (int j = 0; j < 4; ++j) acc[b][j] += s * w[j]; }
            }
#pragma unroll
            for (int b = 0; b < 4; ++b)
#pragma unroll
                for (int j = 0; j < 4; ++j) red[(kl * 12 + cq) * 16 + b * 4 + j] = acc[b][j];
        }
        __syncthreads();
        if (c.tid < 192) {
            const int b = c.tid / 48, col = c.tid % 48;
            float s = 0.f;
            for (int k2 = 0; k2 < 42; ++k2) s += red[(k2 * 12 + (col >> 2)) * 16 + b * 4 + (col & 3)];
            mod[b * NMOD + item * 48 + col] = s + b_ada[item * 48 + col];
        }
        __syncthreads();
    }
}

__device__ __forceinline__ void convert_tile(const float* W, int K, int N, bf16_t* Wt, int kt, int ntile, const Ctx& c, int ldt = 0, int koff = 0) {
    if (ldt == 0) ldt = K;
    const int half = c.lane & 1, nq = b_nq(c);
    const float* src = W + (size_t)(kt * 64 + 8 * c.wid + 4 * half) * N + ntile * 128 + 4 * nq;
    f32x4 rb_[4];
#pragma unroll
    for (int i = 0; i < 4; ++i) rb_[i] = *(const f32x4*)(src + (size_t)i * N);
    const int wo = (4 * nq) * 128 + ((c.wid ^ (nq & 7)) << 4) + half * 8;
#pragma unroll
    for (int j = 0; j < 4; ++j) { u32x2 w; w.x = pack_bf16(rb_[0][j], rb_[1][j]); w.y = pack_bf16(rb_[2][j], rb_[3][j]); *(LAS u32x2*)(c.lds + wo + j * 128) = w; }
    __syncthreads();
#pragma unroll
    for (int i = 0; i < 2; ++i) {
        const int idx = c.tid + 512 * i, n = idx >> 3, ch = idx & 7;
        const u32x4 v = *(const LAS u32x4*)(c.lds + n * 128 + ((ch ^ ((n >> 2) & 7)) << 4));
        *(u32x4*)(Wt + (size_t)(ntile * 128 + n) * ldt + koff + kt * 64 + ch * 8) = v;
    }
    __syncthreads();
}
__device__ __forceinline__ void phase_convert(const Params& p, const Ctx& c) {
    for (int t = c.bid; t < 3584; t += c.nblk) {
        if (t < 2560) convert_tile(p.in[6], D, INC, (bf16_t*)(p.ws + WS_WIN_T), t & 31, t >> 5, c);
        else if (t < 2816) { const int u = t - 2560; convert_tile(p.in[12], 1024, D, (bf16_t*)(p.ws + WS_WPA_T), u & 15, u >> 4, c, D, 0); }
        else if (t < 3072) { const int u = t - 2816; convert_tile(p.in[13], 1024, D, (bf16_t*)(p.ws + WS_WPA_T), u & 15, u >> 4, c, D, 1024); }
        else { const int u = t - 3072; convert_tile(p.in[14], D, D, (bf16_t*)(p.ws + WS_WOUT_T), u & 31, u >> 5, c); }
    }
}

__device__ __forceinline__ void phase_norm1(const Params& p, const Ctx& c) {
    const float* x = p.in[0]; const float* g = p.in[5];
    const float* mod = (const float*)(p.ws + WS_MOD);
    bf16_t* h = (bf16_t*)(p.ws + WS_H);
    for (int row = c.bid * 8 + c.wid; row < NTOK; row += c.nblk * 8) {
        const int b = row >> 11;
        f32x4 v[8]; float ss = 0.f;
#pragma unroll
        for (int i = 0; i < 8; ++i) { v[i] = *(const f32x4*)(x + (size_t)row * D + i * 256 + c.lane * 4); ss += v[i][0] * v[i][0] + v[i][1] * v[i][1] + v[i][2] * v[i][2] + v[i][3] * v[i][3]; }
        ss = wave_sum(ss);
        const float rstd = rsqrtf(ss * (1.0f / D) + EPS);
#pragma unroll
        for (int i = 0; i < 8; ++i) {
            const int col = i * 256 + c.lane * 4;
            const f32x4 gg = *(const f32x4*)(g + col), sh = *(const f32x4*)(mod + b * NMOD + col), scl = *(const f32x4*)(mod + b * NMOD + D + col);
            float o[4];
#pragma unroll
            for (int j = 0; j < 4; ++j) o[j] = (v[i][j] * rstd * gg[j]) * (1.0f + scl[j]) + sh[j];
            u32x2 w; w.x = pack_bf16(o[0], o[1]); w.y = pack_bf16(o[2], o[3]);
            *(u32x2*)(h + (size_t)row * D + col) = w;
        }
    }
}

__device__ __forceinline__ void phase_router_prep(const Params& p, const Ctx& c) {
    const float* mod = (const float*)(p.ws + WS_MOD); const float* g = p.in[15];
    const float* w_rg = p.in[16]; const float* b_rg = p.in[17]; const float* w_re = p.in[18]; const float* b_re = p.in[19];
    bf16_t* WtH = (bf16_t*)(p.ws + WS_RW); bf16_t* WtL = WtH + (size_t)NB * 80 * D; float* cb = (float*)(p.ws + WS_RC);
    for (int task = c.bid * 8 + c.wid; task < NB * 80; task += c.nblk * 8) {
        const int b = task / 80, j = task % 80;
        float cs = 0.f;
        for (int k = c.lane; k < D; k += 64) {
            float w = 0.f;
            if (j < 8) w = w_rg[(size_t)k * 8 + j]; else if (j < 72) w = w_re[(size_t)k * 64 + (j - 8)];
            const float wv = g[k] * (1.0f + mod[b * NMOD + 4 * D + k]) * w;
            const unsigned hi = pack_bf16(wv, 0.f) & 0xffffu; const float hif = __uint_as_float(hi << 16);
            WtH[((size_t)b * 80 + j) * D + k] = (bf16_t)hi; WtL[((size_t)b * 80 + j) * D + k] = (bf16_t)(pack_bf16(wv - hif, 0.f) & 0xffffu);
            cs += mod[b * NMOD + 3 * D + k] * w;
        }
        cs = wave_sum(cs);
        if (c.lane == 0) cb[b * 80 + j] = cs + (j < 8 ? b_rg[j] : (j < 72 ? b_re[j - 8] : 0.f));
    }
}

__device__ __forceinline__ void phase_proj_in(const Params& p, const Ctx& c) {
    const bf16_t* h = (const bf16_t*)(p.ws + WS_H); const float* w_in = p.in[6];
    for (int item = c.bid; item < 32 * 80; item += c.nblk) {
        const int mt = item & 31, ntile = item >> 5;
        const int m0 = mt * 256, n0 = ntile * 128;
        const bf16_t* arow[4];
#pragma unroll
        for (int i = 0; i < 4; ++i) arow[i] = h + (size_t)(m0 + a_piece_row(c, i)) * D + a_piece_col(c);
        const float* bptr = w_in + (size_t)b_k0(c) * INC + n0 + 4 * b_nq(c);
        f32x4 acc[8][2]; zero_acc(acc);
        gemm_mainloop<false, D>(acc, arow, bptr, INC, c);
        const int region = n0 >> 10;
#pragma unroll
        for (int mi = 0; mi < 8; ++mi)
#pragma unroll
            for (int ni = 0; ni < 2; ++ni) {
                const int row = m0 + 128 * c.wr + 16 * mi + c.fr;
                const int col = n0 + 32 * c.wc + 16 * ni + 4 * c.fq;
                const f32x4 a = acc[mi][ni];
                if (region < 6) {
                    const int cin = col & 1023;
                    if (region == 2 || region == 5) {
                        bf16_t* vt = (bf16_t*)(p.ws + (region == 2 ? WS_VAT : WS_VBT));
                        const int b = row >> 11, s = row & 2047, hh = cin >> 7, d = cin & 127;
                        const unsigned w0 = pack_bf16(a[0], a[1]), w1 = pack_bf16(a[2], a[3]);
                        bf16_t* base = vt + ((size_t)((b * 8 + hh) * 128 + d)) * SEQ + s;
                        base[0] = (bf16_t)(w0 & 0xffff); base[SEQ] = (bf16_t)(w0 >> 16); base[2 * SEQ] = (bf16_t)(w1 & 0xffff); base[3 * SEQ] = (bf16_t)(w1 >> 16);
                    } else {
                        const size_t off = region == 0 ? WS_QA : region == 1 ? WS_KA : region == 3 ? WS_QB : WS_KB;
                        bf16_t* dst = (bf16_t*)(p.ws + off);
                        u32x2 w; w.x = pack_bf16(a[0], a[1]); w.y = pack_bf16(a[2], a[3]);
                        *(u32x2*)(dst + (size_t)row * 1024 + cin) = w;
                    }
                } else {
                    bf16_t* dst = (bf16_t*)(p.ws + (region < 8 ? WS_GA : WS_GB));
                    const int cin = col - (region < 8 ? 6144 : 8192);
                    u32x2 w; w.x = pack_bf16(sigmoidf_(a[0]), sigmoidf_(a[1])); w.y = pack_bf16(sigmoidf_(a[2]), sigmoidf_(a[3]));
                    *(u32x2*)(dst + (size_t)row * D + cin) = w;
                }
            }
    }
}

constexpr int AT_STAGE = 32768, AT_VOFF = 16384, AT_BIAS = 98304;
__device__ __forceinline__ int rel_bucket_dev(int n) {
    if (n < 16) return n;
    int b = 16;
    b += (n >= 19) + (n >= 21) + (n >= 24) + (n >= 27) + (n >= 31) + (n >= 35) + (n >= 40) + (n >= 46) + (n >= 52) + (n >= 59) + (n >= 67) + (n >= 77) + (n >= 87) + (n >= 99) + (n >= 113);
    return b;
}
struct KVRegs { u32x4 k[2], v[2]; };
__device__ __forceinline__ void kv_load(KVRegs& r, const bf16_t* kbase, const bf16_t* vtbase, int kt, const Ctx& c) {
#pragma unroll
    for (int i = 0; i < 2; ++i) {
        const int key = (c.tid >> 4) + 32 * i, ck = c.tid & 15;
        r.k[i] = *(const u32x4*)(kbase + (size_t)(kt * 64 + key) * 1024 + ck * 8);
        const int d = (c.tid >> 3) + 64 * i, cv = c.tid & 7;
        r.v[i] = *(const u32x4*)(vtbase + (size_t)d * SEQ + kt * 64 + cv * 8);
    }
}
__device__ __forceinline__ void kv_store(const KVRegs& r, LAS unsigned char* st, const Ctx& c) {
#pragma unroll
    for (int i = 0; i < 2; ++i) {
        const int key = (c.tid >> 4) + 32 * i, ck = c.tid & 15;
        *(LAS u32x4*)(st + key * 256 + ((ck ^ (key & 15)) << 4)) = r.k[i];
        const int d = (c.tid >> 3) + 64 * i, cv = c.tid & 7;
        *(LAS u32x4*)(st + AT_VOFF + d * 128 + ((cv ^ ((d >> 1) & 7)) << 4)) = r.v[i];
    }
}
__device__ __forceinline__ bf16x8 v_frag(LAS unsigned char* st, int nf, int kb2, const Ctx& c) {
    const int d = 16 * nf + c.fr; const int sw = (c.fr >> 1) & 7;
    return *(const LAS bf16x8*)(st + AT_VOFF + d * 128 + (((4 * kb2 + c.fq) ^ sw) << 4));
}
__device__ __forceinline__ bf16x8 pack_p(const f32x4& a, const f32x4& b) {
    u32x4 w; w.x = pack_bf16(a[0], a[1]); w.y = pack_bf16(a[2], a[3]); w.z = pack_bf16(b[0], b[1]); w.w = pack_bf16(b[2], b[3]);
    return __builtin_bit_cast(bf16x8, w);
}

__device__ __forceinline__ void diff_attn_item(const Params& p, const Ctx& c, int b, int h, int qb, float lam) {
    const bf16_t* qa = (const bf16_t*)(p.ws + WS_QA); const bf16_t* ka = (const bf16_t*)(p.ws + WS_KA); const bf16_t* vat = (const bf16_t*)(p.ws + WS_VAT);
    bf16_t* oa = (bf16_t*)(p.ws + WS_OA);
    const float* rel = p.in[2]; const float* gsub = p.in[11];
    LAS float* bias = (LAS float*)(c.lds + AT_BIAS);
    __syncthreads();
    if (c.tid < 128) bias[c.tid] = rel[rel_bucket_dev(c.tid) * 8 + h] * 1.4426950408889634f;
    const int qpos = 128 * qb + 16 * c.wid + c.fr;
    const size_t qtok = (size_t)b * SEQ + qpos;
    bf16x8 qf[4];
#pragma unroll
    for (int kb = 0; kb < 4; ++kb) qf[kb] = *(const bf16x8*)(qa + qtok * 1024 + h * 128 + 32 * kb + 8 * c.fq);
    const bf16_t* kbase = ka + (size_t)b * SEQ * 1024 + h * 128;
    const bf16_t* vtbase = vat + (size_t)((b * 8 + h) * 128) * SEQ;
    f32x4 O1[8], O2[8];
#pragma unroll
    for (int nf = 0; nf < 8; ++nf) { O1[nf] = (f32x4){0.f, 0.f, 0.f, 0.f}; O2[nf] = (f32x4){0.f, 0.f, 0.f, 0.f}; }
    float m1 = -1e30f, m2 = -1e30f, l1 = 0.f, l2 = 0.f;
    const int ntiles = 2 * qb + 2;
    const int qmax_w = 128 * qb + 16 * c.wid + 15, qmin_w = 128 * qb + 16 * c.wid;
    const float L2E = 1.4426950408889634f;
    const bool defer = c.wid >= 4;
    bf16x8 pq1[2], pq2[2]; bool pend = false;
#pragma unroll
    for (int kb2 = 0; kb2 < 2; ++kb2) { pq1[kb2] = (bf16x8){0, 0, 0, 0, 0, 0, 0, 0}; pq2[kb2] = pq1[kb2]; }
    KVRegs kr; kv_load(kr, kbase, vtbase, 0, c);
    int sidx = 0, sprev = 2;
    for (int kt = 0; kt < ntiles; ++kt) {
        LAS unsigned char* st = c.lds + sidx * AT_STAGE;
        kv_store(kr, st, c);
        kv_load(kr, kbase, vtbase, (kt + 1 < ntiles) ? kt + 1 : kt, c);
        __syncthreads();
        if (pend) {
            LAS unsigned char* sp = c.lds + sprev * AT_STAGE;
#pragma unroll
            for (int kb2 = 0; kb2 < 2; ++kb2)
#pragma unroll
                for (int nf = 0; nf < 8; ++nf) {
                    const bf16x8 vf = v_frag(sp, nf, kb2, c);
                    O1[nf] = __builtin_amdgcn_mfma_f32_16x16x32_bf16(vf, pq1[kb2], O1[nf], 0, 0, 0);
                    O2[nf] = __builtin_amdgcn_mfma_f32_16x16x32_bf16(vf, pq2[kb2], O2[nf], 0, 0, 0);
                }
            pend = false;
        }
        if (64 * kt <= qmax_w) {
            f32x4 s1[4], s2[4];
#pragma unroll
            for (int f = 0; f < 4; ++f) {
                bf16x8 kf[4];
#pragma unroll
                for (int kb = 0; kb < 4; ++kb) kf[kb] = *(const LAS bf16x8*)(st + (16 * f + c.fr) * 256 + (((4 * kb + c.fq) ^ c.fr) << 4));
                f32x4 z = (f32x4){0.f, 0.f, 0.f, 0.f};
                z = __builtin_amdgcn_mfma_f32_16x16x32_bf16(kf[0], qf[0], z, 0, 0, 0);
                s1[f] = __builtin_amdgcn_mfma_f32_16x16x32_bf16(kf[1], qf[1], z, 0, 0, 0);
                z = (f32x4){0.f, 0.f, 0.f, 0.f};
                z = __builtin_amdgcn_mfma_f32_16x16x32_bf16(kf[2], qf[2], z, 0, 0, 0);
                s2[f] = __builtin_amdgcn_mfma_f32_16x16x32_bf16(kf[3], qf[3], z, 0, 0, 0);
            }
            const bool nearb = (qmin_w - (64 * kt + 63)) < 113;
            const float CS = 0.125f * L2E, THR = 8.0f;
            float mx1, mx2;
            if (!nearb) {
                const float bf_ = bias[127];
                float r1 = s1[0][0], r2 = s2[0][0];
#pragma unroll
                for (int f = 0; f < 4; ++f)
#pragma unroll
                    for (int r = 0; r < 4; ++r) { r1 = fmaxf(r1, s1[f][r]); r2 = fmaxf(r2, s2[f][r]); }
                mx1 = r1 * CS + bf_; mx2 = r2 * CS + bf_;
            } else {
                mx1 = -1e30f; mx2 = -1e30f;
#pragma unroll
                for (int f = 0; f < 4; ++f)
#pragma unroll
                    for (int r = 0; r < 4; ++r) {
                        const int n = qpos - (64 * kt + 16 * f + 4 * c.fq + r);
                        const float bv = bias[n < 0 ? 0 : (n > 127 ? 127 : n)];
                        float a1 = s1[f][r] * CS + bv, a2 = s2[f][r] * CS + bv;
                        if (n < 0) { a1 = -1e30f; a2 = -1e30f; }
                        s1[f][r] = a1; s2[f][r] = a2;
                        mx1 = fmaxf(mx1, a1); mx2 = fmaxf(mx2, a2);
                    }
            }
            mx1 = xmax32(xmax16(mx1)); mx2 = xmax32(xmax16(mx2));
            if (__any((mx1 - m1 > THR) || (mx2 - m2 > THR))) {
                const float mn1 = fmaxf(m1, mx1), mn2 = fmaxf(m2, mx2);
                const float al1 = __builtin_amdgcn_exp2f(m1 - mn1), al2 = __builtin_amdgcn_exp2f(m2 - mn2);
                m1 = mn1; m2 = mn2; l1 *= al1; l2 *= al2;
#pragma unroll
                for (int nf = 0; nf < 8; ++nf) { O1[nf] *= al1; O2[nf] *= al2; }
            }
            if (!nearb) {
                const float d1 = bias[127] - m1, d2 = bias[127] - m2;
#pragma unroll
                for (int f = 0; f < 4; ++f) { s1[f] = s1[f] * CS + d1; s2[f] = s2[f] * CS + d2; }
            } else {
#pragma unroll
                for (int f = 0; f < 4; ++f) { s1[f] = s1[f] - m1; s2[f] = s2[f] - m2; }
            }
            float ps1 = 0.f, ps2 = 0.f;
#pragma unroll
            for (int f = 0; f < 4; ++f)
#pragma unroll
                for (int r = 0; r < 4; ++r) {
                    const float e1 = __builtin_amdgcn_exp2f(s1[f][r]), e2 = __builtin_amdgcn_exp2f(s2[f][r]);
                    s1[f][r] = e1; s2[f][r] = e2; ps1 += e1; ps2 += e2;
                }
            l1 += ps1; l2 += ps2;
#pragma unroll
            for (int kb2 = 0; kb2 < 2; ++kb2) { pq1[kb2] = pack_p(s1[2 * kb2], s1[2 * kb2 + 1]); pq2[kb2] = pack_p(s2[2 * kb2], s2[2 * kb2 + 1]); }
            if (defer) pend = true;
            else {
#pragma unroll
                for (int kb2 = 0; kb2 < 2; ++kb2)
#pragma unroll
                    for (int nf = 0; nf < 8; ++nf) {
                        const bf16x8 vf = v_frag(st, nf, kb2, c);
                        O1[nf] = __builtin_amdgcn_mfma_f32_16x16x32_bf16(vf, pq1[kb2], O1[nf], 0, 0, 0);
                        O2[nf] = __builtin_amdgcn_mfma_f32_16x16x32_bf16(vf, pq2[kb2], O2[nf], 0, 0, 0);
                    }
            }
        }
        sprev = sidx; sidx = (sidx == 2) ? 0 : sidx + 1;
    }
    if (pend) {
        LAS unsigned char* sp = c.lds + sprev * AT_STAGE;
#pragma unroll
        for (int kb2 = 0; kb2 < 2; ++kb2)
#pragma unroll
            for (int nf = 0; nf < 8; ++nf) {
                const bf16x8 vf = v_frag(sp, nf, kb2, c);
                O1[nf] = __builtin_amdgcn_mfma_f32_16x16x32_bf16(vf, pq1[kb2], O1[nf], 0, 0, 0);
                O2[nf] = __builtin_amdgcn_mfma_f32_16x16x32_bf16(vf, pq2[kb2], O2[nf], 0, 0, 0);
            }
    }
    l1 = xsum32(xsum16(l1)); l2 = xsum32(xsum16(l2));
    const float i1 = 1.0f / l1, i2 = lam / l2;
    float ss = 0.f;
#pragma unroll
    for (int nf = 0; nf < 8; ++nf)
#pragma unroll
        for (int r = 0; r < 4; ++r) { const float o = O1[nf][r] * i1 - O2[nf][r] * i2; O1[nf][r] = o; ss += o * o; }
    ss += __shfl_xor(ss, 16); ss += __shfl_xor(ss, 32);
    const float rstd = rsqrtf(ss * (1.0f / 128.0f) + EPS) * 0.8f;
#pragma unroll
    for (int nf = 0; nf < 8; ++nf) {
        const int d = 16 * nf + 4 * c.fq;
        const f32x4 g = *(const f32x4*)(gsub + d);
        u32x2 w; w.x = pack_bf16(O1[nf][0] * rstd * g[0], O1[nf][1] * rstd * g[1]); w.y = pack_bf16(O1[nf][2] * rstd * g[2], O1[nf][3] * rstd * g[3]);
        *(u32x2*)(oa + qtok * 2048 + h * 128 + d) = w;
    }
}

__device__ __forceinline__ void sb_attn_item(const Params& p, const Ctx& c, int b, int h, int qb) {
    const bf16_t* qbuf = (const bf16_t*)(p.ws + WS_QB); const bf16_t* kbuf = (const bf16_t*)(p.ws + WS_KB); const bf16_t* vbt = (const bf16_t*)(p.ws + WS_VBT);
    bf16_t* ob = (bf16_t*)(p.ws + WS_OA) + 1024;
    __syncthreads();
    const int qpos = 128 * qb + 16 * c.wid + c.fr;
    const size_t qtok = (size_t)b * SEQ + qpos;
    bf16x8 qf[4];
#pragma unroll
    for (int kb = 0; kb < 4; ++kb) qf[kb] = *(const bf16x8*)(qbuf + qtok * 1024 + h * 128 + 32 * kb + 8 * c.fq);
    const bf16_t* kbase = kbuf + (size_t)b * SEQ * 1024 + h * 128;
    const bf16_t* vtbase = vbt + (size_t)((b * 8 + h) * 128) * SEQ;
    f32x4 O[8];
#pragma unroll
    for (int nf = 0; nf < 8; ++nf) O[nf] = (f32x4){0.f, 0.f, 0.f, 0.f};
    float carry = 0.f;
    const int ntiles = 2 * qb + 2;
    const int qmax_w = 128 * qb + 16 * c.wid + 15;
    const float scale = 0.08838834764831845f * 1.4426950408889634f;
    LAS int* dflag = (LAS int*)(c.lds + AT_BIAS + 1024);
    if (c.lane == 0) dflag[c.wid] = 0;
    bool wdone = false;
    KVRegs kr; kv_load(kr, kbase, vtbase, ntiles - 1, c);
    for (int it = 0; it < ntiles; ++it) {
        const int kt = ntiles - 1 - it;
        LAS unsigned char* st = c.lds + (it & 1) * AT_STAGE;
        kv_store(kr, st, c);
        kv_load(kr, kbase, vtbase, (kt > 0) ? kt - 1 : 0, c);
        __syncthreads();
        {
            int alld = 1;
#pragma unroll
            for (int w8 = 0; w8 < 8; ++w8) alld &= dflag[w8];
            if (alld) break;
        }
        if (!wdone && 64 * kt < qmax_w) {
            f32x4 z[4];
#pragma unroll
            for (int f = 0; f < 4; ++f) {
                f32x4 a = (f32x4){0.f, 0.f, 0.f, 0.f};
#pragma unroll
                for (int kb = 0; kb < 4; ++kb) {
                    const bf16x8 kf = *(const LAS bf16x8*)(st + (16 * f + c.fr) * 256 + (((4 * kb + c.fq) ^ c.fr) << 4));
                    a = __builtin_amdgcn_mfma_f32_16x16x32_bf16(kf, qf[kb], a, 0, 0, 0);
                }
                z[f] = a;
            }
            f32x4 lb[4], lk[4]; float T[4];
#pragma unroll
            for (int f = 0; f < 4; ++f) {
                float t = 0.f;
#pragma unroll
                for (int r = 0; r < 4; ++r) {
                    const int kpos = 64 * kt + 16 * f + 4 * c.fq + r;
                    const float zz = z[f][r] * scale;
                    const float sp = __builtin_amdgcn_logf(1.0f + __builtin_amdgcn_exp2f(-fabsf(zz)));
                    const float lbv = fminf(zz, 0.f) - sp;
                    const bool valid = kpos < qpos;
                    const float lkv = valid ? (lbv - zz) : 0.f;
                    lb[f][r] = valid ? lbv : -1e30f; lk[f][r] = lkv; t += lkv;
                }
                T[f] = t;
            }
            float tile_tot = 0.f; float Gl[4], Ft[4];
#pragma unroll
            for (int f = 0; f < 4; ++f) {
                const float A1 = __shfl_xor(T[f], 16), A2 = __shfl_xor(T[f], 32), A3 = __shfl_xor(T[f], 48);
                Gl[f] = ((c.fq & 1) == 0 ? A1 : 0.f) + ((c.fq & 2) == 0 ? (A2 + A3) : 0.f);
                Ft[f] = T[f] + A1 + A2 + A3; tile_tot += Ft[f];
            }
            float after = carry;
#pragma unroll
            for (int f = 3; f >= 0; --f) {
                float suf = 0.f;
#pragma unroll
                for (int r = 3; r >= 0; --r) {
                    const float later = after + Gl[f] + suf;
                    z[f][r] = __builtin_amdgcn_exp2f(lb[f][r] + later);
                    suf += lk[f][r];
                }
                after += Ft[f];
            }
            carry += tile_tot;
#pragma unroll
            for (int kb2 = 0; kb2 < 2; ++kb2) {
                const bf16x8 pp = pack_p(z[2 * kb2], z[2 * kb2 + 1]);
#pragma unroll
                for (int nf = 0; nf < 8; ++nf) {
                    const bf16x8 vf = v_frag(st, nf, kb2, c);
                    O[nf] = __builtin_amdgcn_mfma_f32_16x16x32_bf16(vf, pp, O[nf], 0, 0, 0);
                }
            }
            if (__all(carry < -159.0f)) { wdone = true; if (c.lane == 0) dflag[c.wid] = 1; }
        }
    }
#pragma unroll
    for (int nf = 0; nf < 8; ++nf) {
        const int d = 16 * nf + 4 * c.fq;
        u32x2 w; w.x = pack_bf16(O[nf][0], O[nf][1]); w.y = pack_bf16(O[nf][2], O[nf][3]);
        *(u32x2*)(ob + qtok * 2048 + h * 128 + d) = w;
    }
}

__device__ __forceinline__ void phase_attn(const Params& p, const Ctx& c, int qsel = 0) {
    float d1 = 0.f, d2 = 0.f;
    if (c.lane < 64) { d1 = p.in[7][c.lane] * p.in[8][c.lane]; d2 = p.in[9][c.lane] * p.in[10][c.lane]; }
    d1 = wave_sum(d1); d2 = wave_sum(d2);
    const float lam = expf(d1) - expf(d2) + 0.2f;
    (void)qsel;
#pragma unroll 1
    for (int sub = c.bid; sub < 1024 * 1; sub += c.nblk) {
        const int kh = sub >> 8, i2 = sub & 255, kind = kh >> 1, half = kh & 1, bh = i2 & 31, pr = i2 >> 5;
        const int qb = half ? pr : 15 - pr;
        if (kind == 0) diff_attn_item(p, c, bh >> 3, bh & 7, qb, lam);
        else sb_attn_item(p, c, bh >> 3, bh & 7, qb);
    }
}

__device__ __forceinline__ void phase_merge(const Params& p, const Ctx& c) {
    const bf16_t* oa = (const bf16_t*)(p.ws + WS_OA); const bf16_t* ob = (const bf16_t*)(p.ws + WS_OB);
    const bf16_t* ga = (const bf16_t*)(p.ws + WS_GA); const bf16_t* gb = (const bf16_t*)(p.ws + WS_GB);
    bf16_t* mrg = (bf16_t*)(p.ws + WS_MRG);
    for (int item = c.bid; item < 32 * 16; item += c.nblk) {
        const int mt = item & 31, ntile = item >> 5;
        const int m0 = mt * 256, n0 = ntile * 128;
        f32x4 acc[8][2];
#pragma unroll 1
        for (int pass = 0; pass < 2; ++pass) {
            const bf16_t* A = pass ? ob : oa; const float* W = pass ? p.in[13] : p.in[12]; const bf16_t* G = pass ? gb : ga;
            const bf16_t* arow[4];
#pragma unroll
            for (int i = 0; i < 4; ++i) arow[i] = A + (size_t)(m0 + a_piece_row(c, i)) * 1024 + a_piece_col(c);
            const float* bptr = W + (size_t)b_k0(c) * D + n0 + 4 * b_nq(c);
            zero_acc(acc);
            gemm_mainloop<false, 1024>(acc, arow, bptr, D, c);
            float* tmp = (float*)(p.ws + WS_X1);
#pragma unroll
            for (int mi = 0; mi < 8; ++mi)
#pragma unroll
                for (int ni = 0; ni < 2; ++ni) {
                    const int row = m0 + 128 * c.wr + 16 * mi + c.fr;
                    const int col = n0 + 32 * c.wc + 16 * ni + 4 * c.fq;
                    const u32x2 gw = *(const u32x2*)(G + (size_t)row * D + col);
                    f32x4 g; g[0] = __uint_as_float(gw.x << 16); g[1] = __uint_as_float(gw.x & 0xffff0000u); g[2] = __uint_as_float(gw.y << 16); g[3] = __uint_as_float(gw.y & 0xffff0000u);
                    f32x4 v = acc[mi][ni] * g;
                    if (pass == 0) *(f32x4*)(tmp + (size_t)row * D + col) = v;
                    else {
                        v += *(const f32x4*)(tmp + (size_t)row * D + col);
                        u32x2 w; w.x = pack_bf16(v[0], v[1]); w.y = pack_bf16(v[2], v[3]);
                        *(u32x2*)(mrg + (size_t)row * D + col) = w;
                    }
                }
        }
    }
}

__device__ __forceinline__ void phase_out(const Params& p, const Ctx& c) {
    const bf16_t* mrg = (const bf16_t*)(p.ws + WS_MRG); const float* w_out = p.in[14]; const float* x = p.in[0];
    const float* mod = (const float*)(p.ws + WS_MOD);
    float* x1 = (float*)(p.ws + WS_X1);
    for (int item = c.bid; item < 32 * 16; item += c.nblk) {
        const int mt = item & 31, ntile = item >> 5;
        const int m0 = mt * 256, n0 = ntile * 128;
        const bf16_t* arow[4];
#pragma unroll
        for (int i = 0; i < 4; ++i) arow[i] = mrg + (size_t)(m0 + a_piece_row(c, i)) * D + a_piece_col(c);
        const float* bptr = w_out + (size_t)b_k0(c) * D + n0 + 4 * b_nq(c);
        f32x4 acc[8][2]; zero_acc(acc);
        gemm_mainloop<false, D>(acc, arow, bptr, D, c);
        const int b = m0 >> 11;
#pragma unroll
        for (int mi = 0; mi < 8; ++mi)
#pragma unroll
            for (int ni = 0; ni < 2; ++ni) {
                const int row = m0 + 128 * c.wr + 16 * mi + c.fr;
                const int col = n0 + 32 * c.wc + 16 * ni + 4 * c.fq;
                const f32x4 gm = *(const f32x4*)(mod + b * NMOD + 2 * D + col);
                const f32x4 xv = *(const f32x4*)(x + (size_t)row * D + col);
                *(f32x4*)(x1 + (size_t)row * D + col) = xv + gm * acc[mi][ni];
            }
    }
}

__device__ __forceinline__ void phase_norm2_route(const Params& p, const Ctx& c) {
    const float* x1 = (const float*)(p.ws + WS_X1); const float* g = p.in[15];
    const float* mod = (const float*)(p.ws + WS_MOD);
    const float* w_rg = p.in[16]; const float* b_rg = p.in[17]; const float* w_re = p.in[18]; const float* b_re = p.in[19];
    bf16_t* h2 = (bf16_t*)(p.ws + WS_H2);
    unsigned* cnt = (unsigned*)(p.ws + WS_CTL) + CW_CNT;
    int* ltok = (int*)(p.ws + WS_LTOK); float* lw = (float*)(p.ws + WS_LW);
    for (int row = c.bid * 8 + c.wid; row < NTOK; row += c.nblk * 8) {
        const int b = row >> 11;
        f32x4 v[8]; float ss = 0.f;
#pragma unroll
        for (int i = 0; i < 8; ++i) { v[i] = *(const f32x4*)(x1 + (size_t)row * D + i * 256 + c.lane * 4); ss += v[i][0] * v[i][0] + v[i][1] * v[i][1] + v[i][2] * v[i][2] + v[i][3] * v[i][3]; }
        ss = wave_sum(ss);
        const float rstd = rsqrtf(ss * (1.0f / D) + EPS);
        float gl[8];
#pragma unroll
        for (int j = 0; j < 8; ++j) gl[j] = 0.f;
#pragma unroll
        for (int i = 0; i < 8; ++i) {
            const int col = i * 256 + c.lane * 4;
            const f32x4 gg = *(const f32x4*)(g + col), sh = *(const f32x4*)(mod + b * NMOD + 3 * D + col), scl = *(const f32x4*)(mod + b * NMOD + 4 * D + col);
#pragma unroll
            for (int j = 0; j < 4; ++j) v[i][j] = (v[i][j] * rstd * gg[j]) * (1.0f + scl[j]) + sh[j];
            u32x2 w; w.x = pack_bf16(v[i][0], v[i][1]); w.y = pack_bf16(v[i][2], v[i][3]);
            *(u32x2*)(h2 + (size_t)row * D + col) = w;
#pragma unroll
            for (int j = 0; j < 4; ++j) {
                const f32x4 w0 = *(const f32x4*)(w_rg + (size_t)(col + j) * 8), w1 = *(const f32x4*)(w_rg + (size_t)(col + j) * 8 + 4);
#pragma unroll
                for (int e = 0; e < 4; ++e) { gl[e] += v[i][j] * w0[e]; gl[4 + e] += v[i][j] * w1[e]; }
            }
        }
#pragma unroll
        for (int j = 0; j < 8; ++j) gl[j] = wave_sum(gl[j]) + b_rg[j];
        int gi = 0; float gmax = gl[0];
#pragma unroll
        for (int j = 1; j < 8; ++j) if (gl[j] > gmax) { gmax = gl[j]; gi = j; }
        float gsum = 0.f;
#pragma unroll
        for (int j = 0; j < 8; ++j) gsum += __expf(gl[j] - gmax);
        const float pg = 1.0f / gsum;
        float el[8];
#pragma unroll
        for (int j = 0; j < 8; ++j) el[j] = 0.f;
#pragma unroll
        for (int i = 0; i < 8; ++i) {
            const int col = i * 256 + c.lane * 4;
#pragma unroll
            for (int j = 0; j < 4; ++j) {
                const f32x4 w0 = *(const f32x4*)(w_re + (size_t)(col + j) * 64 + gi * 8), w1 = *(const f32x4*)(w_re + (size_t)(col + j) * 64 + gi * 8 + 4);
#pragma unroll
                for (int e = 0; e < 4; ++e) { el[e] += v[i][j] * w0[e]; el[4 + e] += v[i][j] * w1[e]; }
            }
        }
#pragma unroll
        for (int j = 0; j < 8; ++j) el[j] = wave_sum(el[j]) + b_re[gi * 8 + j];
        int i1 = 0; float e1 = el[0];
#pragma unroll
        for (int j = 1; j < 8; ++j) if (el[j] > e1) { e1 = el[j]; i1 = j; }
        int i2 = -1; float e2 = -3.0e38f;
#pragma unroll
        for (int j = 0; j < 8; ++j) if (j != i1 && el[j] > e2) { e2 = el[j]; i2 = j; }
        const float r2 = __expf(e2 - e1);
        const float tp1 = 1.0f / (1.0f + r2), tp2 = r2 / (1.0f + r2);
        if (c.lane == 0) {
            const int ea = gi * 8 + i1, eb = gi * 8 + i2;
            const unsigned sa = atomicAdd(&cnt[ea], 1u), sb = atomicAdd(&cnt[eb], 1u);
            ltok[ea * NTOK + sa] = row * 2; lw[ea * NTOK + sa] = pg * tp1;
            ltok[eb * NTOK + sb] = row * 2 + 1; lw[eb * NTOK + sb] = pg * tp2;
        }
    }
}

__device__ __forceinline__ void phase_norm2_route2(const Params& p, const Ctx& c, int dummy = 0) {
    const float* x1 = (const float*)(p.ws + WS_X1); const float* g = p.in[15];
    const float* mod = (const float*)(p.ws + WS_MOD);
    const bf16_t* WtH = (const bf16_t*)(p.ws + WS_RW); const bf16_t* WtL = WtH + (size_t)NB * 80 * D; const float* cb = (const float*)(p.ws + WS_RC);
    bf16_t* h2 = (bf16_t*)(p.ws + WS_H2);
    unsigned* cnt = (unsigned*)(p.ws + WS_CTL) + CW_CNT + (dummy ? 128 : 0);
    int* ltok = (int*)(p.ws + (dummy ? WS_ACT : WS_LTOK)); float* lw = (float*)(p.ws + (dummy ? WS_ACT + (size_t)NE * NTOK * 4 : WS_LW));
    LAS float* red = (LAS float*)c.lds;
    LAS float* ssr = (LAS float*)(c.lds + 81920);
    LAS float* rs = (LAS float*)(c.lds + 81920 + 1024);
    for (int it = c.bid; it < NTOK / 32; it += c.nblk) {
        const int tok0 = it * 32, b = tok0 >> 11;
        const int ks = c.wid, i16 = c.lane & 15, kk = c.lane >> 4;
        const float* ap0 = x1 + (size_t)(tok0 + i16) * D + 256 * ks + 8 * kk;
        const float* ap1 = ap0 + (size_t)16 * D;
        const bf16_t* bph = WtH + ((size_t)b * 80 + i16) * D + 256 * ks + 8 * kk;
        const bf16_t* bpl = WtL + ((size_t)b * 80 + i16) * D + 256 * ks + 8 * kk;
        f32x4 acc[2][5];
#pragma unroll
        for (int g2 = 0; g2 < 2; ++g2)
#pragma unroll
            for (int nb = 0; nb < 5; ++nb) acc[g2][nb] = (f32x4){0.f, 0.f, 0.f, 0.f};
        float ss0 = 0.f, ss1 = 0.f;
#pragma unroll 2
        for (int kb8 = 0; kb8 < 8; ++kb8) {
            bf16x8 ah[2], al[2];
#pragma unroll
            for (int g2 = 0; g2 < 2; ++g2) {
                const float* ap = (g2 ? ap1 : ap0) + 32 * kb8;
                const f32x4 v0 = *(const f32x4*)ap, v1 = *(const f32x4*)(ap + 4);
                const float sq = v0[0] * v0[0] + v0[1] * v0[1] + v0[2] * v0[2] + v0[3] * v0[3] + v1[0] * v1[0] + v1[1] * v1[1] + v1[2] * v1[2] + v1[3] * v1[3];
                if (g2) ss1 += sq; else ss0 += sq;
                u32x4 h, l;
                h.x = pack_bf16(v0[0], v0[1]); h.y = pack_bf16(v0[2], v0[3]); h.z = pack_bf16(v1[0], v1[1]); h.w = pack_bf16(v1[2], v1[3]);
                l.x = pack_bf16(v0[0] - __uint_as_float(h.x << 16), v0[1] - __uint_as_float(h.x & 0xffff0000u));
                l.y = pack_bf16(v0[2] - __uint_as_float(h.y << 16), v0[3] - __uint_as_float(h.y & 0xffff0000u));
                l.z = pack_bf16(v1[0] - __uint_as_float(h.z << 16), v1[1] - __uint_as_float(h.z & 0xffff0000u));
                l.w = pack_bf16(v1[2] - __uint_as_float(h.w << 16), v1[3] - __uint_as_float(h.w & 0xffff0000u));
                ah[g2] = __builtin_bit_cast(bf16x8, h); al[g2] = __builtin_bit_cast(bf16x8, l);
            }
#pragma unroll
            for (int nb = 0; nb < 5; ++nb) {
                const bf16x8 bh = *(const bf16x8*)(bph + (size_t)nb * 16 * D + 32 * kb8), bl = *(const bf16x8*)(bpl + (size_t)nb * 16 * D + 32 * kb8);
#pragma unroll
                for (int g2 = 0; g2 < 2; ++g2) {
                    acc[g2][nb] = __builtin_amdgcn_mfma_f32_16x16x32_bf16(ah[g2], bh, acc[g2][nb], 0, 0, 0);
                    acc[g2][nb] = __builtin_amdgcn_mfma_f32_16x16x32_bf16(ah[g2], bl, acc[g2][nb], 0, 0, 0);
                    acc[g2][nb] = __builtin_amdgcn_mfma_f32_16x16x32_bf16(al[g2], bh, acc[g2][nb], 0, 0, 0);
                }
            }
        }
        ss0 += __shfl_xor(ss0, 16); ss0 += __shfl_xor(ss0, 32);
        ss1 += __shfl_xor(ss1, 16); ss1 += __shfl_xor(ss1, 32);
        __syncthreads();
#pragma unroll
        for (int g2 = 0; g2 < 2; ++g2)
#pragma unroll
            for (int nb = 0; nb < 5; ++nb)
#pragma unroll
                for (int r = 0; r < 4; ++r) red[(c.wid * 32 + g2 * 16 + 4 * kk + r) * 80 + nb * 16 + i16] = acc[g2][nb][r];
        if (kk == 0) { ssr[c.wid * 32 + i16] = ss0; ssr[c.wid * 32 + 16 + i16] = ss1; }
        __syncthreads();
        if (c.tid < 32) {
            const int t = c.tid;
            float ssum = 0.f;
#pragma unroll
            for (int q = 0; q < 8; ++q) ssum += ssr[q * 32 + t];
            const float rstd = rsqrtf(ssum * (1.0f / D) + EPS);
            rs[t] = rstd;
            float gl[8];
#pragma unroll
            for (int j = 0; j < 8; ++j) {
                float a = 0.f;
#pragma unroll
                for (int q = 0; q < 8; ++q) a += red[(q * 32 + t) * 80 + j];
                gl[j] = a * rstd + cb[b * 80 + j];
            }
            int gi = 0; float gmax = gl[0];
#pragma unroll
            for (int j = 1; j < 8; ++j) if (gl[j] > gmax) { gmax = gl[j]; gi = j; }
            float gsum = 0.f;
#pragma unroll
            for (int j = 0; j < 8; ++j) gsum += __expf(gl[j] - gmax);
            const float pg = 1.0f / gsum;
            float el[8];
#pragma unroll
            for (int j = 0; j < 8; ++j) {
                float a = 0.f;
#pragma unroll
                for (int q = 0; q < 8; ++q) a += red[(q * 32 + t) * 80 + 8 + gi * 8 + j];
                el[j] = a * rstd + cb[b * 80 + 8 + gi * 8 + j];
            }
            int i1 = 0; float e1 = el[0];
#pragma unroll
            for (int j = 1; j < 8; ++j) if (el[j] > e1) { e1 = el[j]; i1 = j; }
            int i2 = -1; float e2 = -3.0e38f;
#pragma unroll
            for (int j = 0; j < 8; ++j) if (j != i1 && el[j] > e2) { e2 = el[j]; i2 = j; }
            const float r2 = __expf(e2 - e1);
            const float tp1 = 1.0f / (1.0f + r2), tp2 = r2 / (1.0f + r2);
            const int row = tok0 + t;
            const int ea = gi * 8 + i1, eb = gi * 8 + i2;
            const unsigned sa = atomicAdd(&cnt[ea], 1u), sb = atomicAdd(&cnt[eb], 1u);
            ltok[ea * NTOK + sa] = row * 2; lw[ea * NTOK + sa] = pg * tp1;
            ltok[eb * NTOK + sb] = row * 2 + 1; lw[eb * NTOK + sb] = pg * tp2;
            if (!dummy) { u32x4 rec; rec.x = ((unsigned)ea << 13) | sa; rec.y = __float_as_uint(pg * tp1); rec.z = ((unsigned)eb << 13) | sb; rec.w = __float_as_uint(pg * tp2);
                *(u32x4*)(p.ws + WS_TREC + (size_t)row * 16) = rec; }
        }
        __syncthreads();
#pragma unroll 1
        for (int q = 0; q < 4; ++q) {
            const int row = tok0 + c.wid * 4 + q;
            const float rstd = rs[c.wid * 4 + q];
#pragma unroll
            for (int i = 0; i < 8; ++i) {
                const int col = i * 256 + c.lane * 4;
                const f32x4 v = *(const f32x4*)(x1 + (size_t)row * D + col);
                const f32x4 gg = *(const f32x4*)(g + col), sh = *(const f32x4*)(mod + b * NMOD + 3 * D + col), scl = *(const f32x4*)(mod + b * NMOD + 4 * D + col);
                float o[4];
#pragma unroll
                for (int j = 0; j < 4; ++j) o[j] = (v[j] * rstd * gg[j]) * (1.0f + scl[j]) + sh[j];
                u32x2 w; w.x = pack_bf16(o[0], o[1]); w.y = pack_bf16(o[2], o[3]);
                *(u32x2*)(h2 + (size_t)row * D + col) = w;
            }
        }
    }
}

constexpr int MOE_TAB = 100 * 1024;
__device__ __forceinline__ void moe_table(const Params& p, const Ctx& c) {
    const unsigned* cnt = (const unsigned*)(p.ws + WS_CTL) + CW_CNT;
    LAS int* tab = (LAS int*)(c.lds + MOE_TAB);
    __syncthreads();
    if (c.tid == 0) {
        int rp = 0;
        for (int e = 0; e < NE; ++e) { const int n = (int)cnt[e]; tab[e] = n; tab[64 + e] = rp; rp += n; }
        tab[64 + 64] = rp;
        for (int q = 0; q < 8; ++q) { int ip = 0; for (int j = 0; j < 8; ++j) { tab[256 + 16 * q + j] = ip; ip += ((tab[q + 8 * j] + 255) >> 8) * 16; } tab[256 + 16 * q + 8] = ip; }
    }
    __syncthreads();
}
__device__ __forceinline__ bool moe_next(XQueue& q, const Ctx& c, int& e, int& mt, int& ntile, int& cnt_e, int& rbase) {
    LAS int* tab = (LAS int*)(c.lds + MOE_TAB);
    while (q.v < 8) {
        const int qi = (q.x + q.v) & 7;
        const int L = next_item(q.heads + qi * 64, c);
        if (L < tab[256 + 16 * qi + 8]) {
            int j = 0;
#pragma unroll
            for (int k = 1; k < 8; ++k) if (tab[256 + 16 * qi + k] <= L) j = k;
            e = qi + 8 * j;
            while (tab[e] == 0 && j > 0) { --j; e -= 8; }
            cnt_e = tab[e]; rbase = tab[64 + e];
            const int loc = L - tab[256 + 16 * qi + j], nmt = (cnt_e + 255) >> 8;
            ntile = loc / nmt; mt = loc - ntile * nmt;
            return true;
        }
        ++q.v;
    }
    return false;
}

__device__ __forceinline__ void phase_moe1(const Params& p, const Ctx& c, int qsel = 1) {
    const bf16_t* h2 = (const bf16_t*)(p.ws + WS_H2);
    const int* ltok = (const int*)(p.ws + WS_LTOK);
    bf16_t* act = (bf16_t*)(p.ws + WS_ACT);
    const float* wg = p.in[20]; const float* wu = p.in[21];
    moe_table(p, c);
    XQueue q = xq_make(p, qsel);
    for (;;) {
        int e, mt, ntile, cnt_e, rbase;
        if (!moe_next(q, c, e, mt, ntile, cnt_e, rbase)) break;
        const int n0 = ntile * 64;
        const bf16_t* arow[4];
#pragma unroll
        for (int i = 0; i < 4; ++i) {
            const int r = mt * 256 + a_piece_row(c, i);
            const int tok = r < cnt_e ? (ltok[e * NTOK + r] >> 1) : 0;
            arow[i] = h2 + (size_t)tok * D + a_piece_col(c);
        }
        const int nq = b_nq(c), blk = nq >> 2;
        const float* wsrc = ((blk & 1) ? wu : wg) + (size_t)e * D * DE;
        const float* bptr = wsrc + (size_t)b_k0(c) * DE + n0 + 16 * (blk >> 1) + 4 * (nq & 3);
        f32x4 acc[8][2]; zero_acc(acc);
        gemm_mainloop<MOE_NT, D>(acc, arow, bptr, DE, c);
#pragma unroll
        for (int mi = 0; mi < 8; ++mi) {
            const int r = mt * 256 + 128 * c.wr + 16 * mi + c.fr;
            if (r < cnt_e) {
                const int col = n0 + 16 * c.wc + 4 * c.fq;
                float o[4];
#pragma unroll
                for (int j = 0; j < 4; ++j) { const float a = acc[mi][0][j], u = acc[mi][1][j]; o[j] = a / (1.0f + __expf(-a)) * u; }
                u32x2 w; w.x = pack_bf16(o[0], o[1]); w.y = pack_bf16(o[2], o[3]);
                *(u32x2*)(act + (size_t)(rbase + r) * DE + col) = w;
            }
        }
    }
}
__device__ __forceinline__ void phase_moe2(const Params& p, const Ctx& c, int qsel = 2) {
    const int* ltok = (const int*)(p.ws + WS_LTOK); const float* lw = (const float*)(p.ws + WS_LW);
    const bf16_t* act = (const bf16_t*)(p.ws + WS_ACT);
    float* y = (float*)(p.ws + WS_Y);
    const float* wd = p.in[22];
    moe_table(p, c);
    XQueue q = xq_make(p, qsel);
    for (;;) {
        int e, mt, ntile, cnt_e, rbase;
        if (!moe_next(q, c, e, mt, ntile, cnt_e, rbase)) break;
        const int n0 = ntile * 128;
        const bf16_t* arow[4];
#pragma unroll
        for (int i = 0; i < 4; ++i) arow[i] = act + (size_t)(rbase + mt * 256 + a_piece_row(c, i)) * DE + a_piece_col(c);
        const float* bptr = wd + (size_t)e * DE * D + (size_t)b_k0(c) * D + n0 + 4 * b_nq(c);
        f32x4 acc[8][2]; zero_acc(acc);
        gemm_mainloop<MOE_NT, DE>(acc, arow, bptr, D, c);
#pragma unroll
        for (int mi = 0; mi < 8; ++mi) {
            const int r = mt * 256 + 128 * c.wr + 16 * mi + c.fr;
            if (r < cnt_e) {
                const int ent = ltok[e * NTOK + r]; const float w = lw[e * NTOK + r];
#pragma unroll
                for (int ni = 0; ni < 2; ++ni) {
                    const int col = n0 + 32 * c.wc + 16 * ni + 4 * c.fq;
                    *(f32x4*)(y + (size_t)ent * D + col) = acc[mi][ni] * w;
                }
            }
        }
    }
}

constexpr int MOE_TAB2 = 132 * 1024;
__device__ __forceinline__ void moe_table2(const Params& p, const Ctx& c) {
    const unsigned* cnt = (const unsigned*)(p.ws + WS_CTL) + CW_CNT;
    LAS int* tab = (LAS int*)(c.lds + MOE_TAB2);
    __syncthreads();
    if (c.tid == 0) {
        int rp = 0;
        for (int e = 0; e < NE; ++e) { const int n = (int)cnt[e]; tab[e] = n; tab[64 + e] = rp; rp += n; }
        tab[64 + 64] = rp;
        for (int q = 0; q < 8; ++q) { int ip = 0; for (int j = 0; j < 8; ++j) { tab[256 + 16 * q + j] = ip; ip += ((tab[q + 8 * j] + 255) >> 8) * 8; } tab[256 + 16 * q + 8] = ip; }
    }
    __syncthreads();
}
__device__ __forceinline__ bool moe_next2(XQueue& q, const Ctx& c, int& e, int& mt, int& ntile, int& cnt_e, int& rbase) {
    LAS int* tab = (LAS int*)(c.lds + MOE_TAB2);
    while (q.v < 8) {
        const int qi = (q.x + q.v) & 7;
        const int L = next_item(q.heads + qi * 64, c);
        if (L < tab[256 + 16 * qi + 8]) {
            int j = 0;
#pragma unroll
            for (int k = 1; k < 8; ++k) if (tab[256 + 16 * qi + k] <= L) j = k;
            e = qi + 8 * j;
            while (tab[e] == 0 && j > 0) { --j; e -= 8; }
            cnt_e = tab[e]; rbase = tab[64 + e];
            const int loc = L - tab[256 + 16 * qi + j], nmt = (cnt_e + 255) >> 8;
            ntile = loc / nmt; mt = loc - ntile * nmt;
            return true;
        }
        ++q.v;
    }
    return false;
}
__device__ __forceinline__ void zero_acc4(f32x4 (&acc)[8][4]) {
#pragma unroll
    for (int mi = 0; mi < 8; ++mi)
#pragma unroll
        for (int ni = 0; ni < 4; ++ni) acc[mi][ni] = (f32x4){0.f, 0.f, 0.f, 0.f};
}
__device__ __forceinline__ void phase_moe1w(const Params& p, const Ctx& c, int qsel = 1) {
    const bf16_t* h2 = (const bf16_t*)(p.ws + WS_H2);
    const int* ltok = (const int*)(p.ws + WS_LTOK);
    bf16_t* act = (bf16_t*)(p.ws + WS_ACT);
    const float* wg = p.in[20]; const float* wu = p.in[21];
    moe_table2(p, c);
    XQueue q = xq_make(p, qsel);
    const int blk = c.lane >> 2;
    const float* wsel = (blk & 1) ? wu : wg;
    const int bcol = 16 * (blk >> 1) + 4 * (c.lane & 3);
    int e, mt, ntile, cnt_e, rbase;
    if (!moe_next2(q, c, e, mt, ntile, cnt_e, rbase)) return;
    int aoff[4];
#pragma unroll
    for (int i = 0; i < 4; ++i) { const int r = mt * 256 + a_piece_row(c, i); const int tok = r < cnt_e ? (ltok[e * NTOK + r] >> 1) : 0; aoff[i] = tok * D + a_piece_col(c); }
    const float* bptr = wsel + (size_t)e * D * DE + (size_t)(8 * c.wid) * DE + ntile * 128 + bcol;
    bool staged = false;
    f32x4 rb[8];
    for (;;) {
        int en, mtn, ntilen, cntn, rbasen;
        const bool hn = moe_next2(q, c, en, mtn, ntilen, cntn, rbasen);
        int aoffn[4]; const float* bptrn; int nrn;
        if (hn) {
#pragma unroll
            for (int i = 0; i < 4; ++i) { const int r = mtn * 256 + a_piece_row(c, i); const int tok = r < cntn ? (ltok[en * NTOK + r] >> 1) : 0; aoffn[i] = tok * D + a_piece_col(c); }
            bptrn = wsel + (size_t)en * D * DE + (size_t)(8 * c.wid) * DE + ntilen * 128 + bcol; nrn = cntn - mtn * 256;
        } else {
#pragma unroll
            for (int i = 0; i < 4; ++i) aoffn[i] = aoff[i] + (D / 64 - 1) * 64;
            bptrn = bptr + (size_t)((D / 64 - 1) * 64) * DE; nrn = cnt_e - mt * 256;
        }
        const int n0 = ntile * 128;
        f32x4 acc[8][4]; zero_acc4(acc);
        gemm_mainloop256<D>(acc, rb, h2, aoff, bptr, DE, cnt_e - mt * 256, c, staged, aoffn, bptrn, nrn, hn);
#pragma unroll
        for (int mi = 0; mi < 8; ++mi) {
            const int r = mt * 256 + 128 * c.wr + 16 * mi + c.fr;
            if (r < cnt_e) {
#pragma unroll
                for (int hh = 0; hh < 2; ++hh) {
                    const int col = n0 + 16 * (2 * c.wc + hh) + 4 * c.fq;
                    float o[4];
#pragma unroll
                    for (int j = 0; j < 4; ++j) { const float a = acc[mi][2 * hh][j], u = acc[mi][2 * hh + 1][j]; o[j] = a / (1.0f + __expf(-a)) * u; }
                    u32x2 w; w.x = pack_bf16(o[0], o[1]); w.y = pack_bf16(o[2], o[3]);
                    *(u32x2*)(act + (size_t)(rbase + r) * DE + col) = w;
                }
            }
        }
        if (!hn) break;
        e = en; mt = mtn; ntile = ntilen; cnt_e = cntn; rbase = rbasen; bptr = bptrn; staged = true;
#pragma unroll
        for (int i = 0; i < 4; ++i) aoff[i] = aoffn[i];
    }
    asm volatile("s_waitcnt vmcnt(0)" ::: "memory");
}
__device__ __forceinline__ void phase_moe2w(const Params& p, const Ctx& c, int qsel = 2) {
    const bf16_t* act = (const bf16_t*)(p.ws + WS_ACT);
    bf16_t* yb = (bf16_t*)(p.ws + WS_Y);
    const float* wd = p.in[22];
    moe_table2(p, c);
    XQueue q = xq_make(p, qsel);
    int e, mt, ntile, cnt_e, rbase;
    if (!moe_next2(q, c, e, mt, ntile, cnt_e, rbase)) return;
    int aoff[4];
#pragma unroll
    for (int i = 0; i < 4; ++i) aoff[i] = (rbase + mt * 256 + a_piece_row(c, i)) * DE + a_piece_col(c);
    const float* bptr = wd + (size_t)e * DE * D + (size_t)(8 * c.wid) * D + ntile * 256 + 4 * c.lane;
    bool staged = false;
    f32x4 rb[8];
    for (;;) {
        int en, mtn, ntilen, cntn, rbasen;
        const bool hn = moe_next2(q, c, en, mtn, ntilen, cntn, rbasen);
        int aoffn[4]; const float* bptrn; int nrn;
        if (hn) {
#pragma unroll
            for (int i = 0; i < 4; ++i) aoffn[i] = (rbasen + mtn * 256 + a_piece_row(c, i)) * DE + a_piece_col(c);
            bptrn = wd + (size_t)en * DE * D + (size_t)(8 * c.wid) * D + ntilen * 256 + 4 * c.lane; nrn = cntn - mtn * 256;
        } else {
#pragma unroll
            for (int i = 0; i < 4; ++i) aoffn[i] = aoff[i] + (DE / 64 - 1) * 64;
            bptrn = bptr + (size_t)((DE / 64 - 1) * 64) * D; nrn = cnt_e - mt * 256;
        }
        const int n0 = ntile * 256;
        f32x4 acc[8][4]; zero_acc4(acc);
        gemm_mainloop256<DE>(acc, rb, act, aoff, bptr, D, cnt_e - mt * 256, c, staged, aoffn, bptrn, nrn, hn);
#pragma unroll
        for (int mi = 0; mi < 8; ++mi) {
            const int r = mt * 256 + 128 * c.wr + 16 * mi + c.fr;
            if (r < cnt_e) {
#pragma unroll
                for (int ni = 0; ni < 4; ++ni) {
                    const int col = n0 + 64 * c.wc + 16 * ni + 4 * c.fq;
                    const f32x4 v = acc[mi][ni];
                    u32x2 pk; pk.x = pack_bf16(v[0], v[1]); pk.y = pack_bf16(v[2], v[3]);
                    *(u32x2*)(yb + (size_t)(rbase + r) * D + col) = pk;
                }
            }
        }
        if (!hn) break;
        e = en; mt = mtn; ntile = ntilen; cnt_e = cntn; rbase = rbasen; bptr = bptrn; staged = true;
#pragma unroll
        for (int i = 0; i < 4; ++i) aoff[i] = aoffn[i];
    }
    asm volatile("s_waitcnt vmcnt(0)" ::: "memory");
}

__device__ __forceinline__ void phase_final(const Params& p, const Ctx& c) {
    const float* x1 = (const float*)(p.ws + WS_X1); const bf16_t* yb = (const bf16_t*)(p.ws + WS_Y);
    const float* mod = (const float*)(p.ws + WS_MOD); const float* g = p.in[23];
    const unsigned* cnt = (const unsigned*)(p.ws + WS_CTL) + CW_CNT;
    LAS int* rpre = (LAS int*)c.lds;
    __syncthreads();
    if (c.tid == 0) { int rp = 0; for (int e = 0; e < NE; ++e) { rpre[e] = rp; rp += (int)cnt[e]; } }
    __syncthreads();
    for (int row = c.bid * 8 + c.wid; row < NTOK; row += c.nblk * 8) {
        const int b = row >> 11;
        const u32x4 rec = *(const u32x4*)(p.ws + WS_TREC + (size_t)row * 16);
        const size_t r0 = (size_t)(rpre[rec.x >> 13] + (int)(rec.x & 8191u)), r1 = (size_t)(rpre[rec.z >> 13] + (int)(rec.z & 8191u));
        const float w0 = __uint_as_float(rec.y), w1 = __uint_as_float(rec.w);
        f32x4 v[8]; float ss = 0.f;
#pragma unroll
        for (int i = 0; i < 8; ++i) {
            const int col = i * 256 + c.lane * 4;
            const f32x4 xv = *(const f32x4*)(x1 + (size_t)row * D + col);
            const u32x2 a0 = *(const u32x2*)(yb + r0 * D + col), a1 = *(const u32x2*)(yb + r1 * D + col);
            f32x4 y0, y1;
            y0[0] = __uint_as_float(a0.x << 16); y0[1] = __uint_as_float(a0.x & 0xffff0000u); y0[2] = __uint_as_float(a0.y << 16); y0[3] = __uint_as_float(a0.y & 0xffff0000u);
            y1[0] = __uint_as_float(a1.x << 16); y1[1] = __uint_as_float(a1.x & 0xffff0000u); y1[2] = __uint_as_float(a1.y << 16); y1[3] = __uint_as_float(a1.y & 0xffff0000u);
            const f32x4 gf = *(const f32x4*)(mod + b * NMOD + 5 * D + col);
            v[i] = xv + gf * (y0 * w0 + y1 * w1);
            ss += v[i][0] * v[i][0] + v[i][1] * v[i][1] + v[i][2] * v[i][2] + v[i][3] * v[i][3];
        }
        ss = wave_sum(ss);
        const float rstd = rsqrtf(ss * (1.0f / D) + EPS);
#pragma unroll
        for (int i = 0; i < 8; ++i) {
            const int col = i * 256 + c.lane * 4;
            const f32x4 gg = *(const f32x4*)(g + col);
            *(f32x4*)(p.out + (size_t)row * D + col) = v[i] * rstd * gg;
        }
    }
}

struct EpiProjIn {
    static constexpr bool PERM = false, AFTER_DRAIN = false;
    unsigned char* ws;
    __device__ __forceinline__ void operator()(const pg8::f32x4 (&acc)[2][2][4][2], const pg8::Unit& u, int wr, int wc, int fr, int fq) const {
        const int region = (u.pn * 256) >> 10;
#pragma unroll
        for (int ai = 0; ai < 2; ++ai)
#pragma unroll
            for (int m = 0; m < 4; ++m) {
                const int row = u.pm * 256 + ai * 128 + wr * 64 + m * 16 + fr;
#pragma unroll
                for (int bj = 0; bj < 2; ++bj)
#pragma unroll
                    for (int n = 0; n < 2; ++n) {
                        const int col = u.pn * 256 + bj * 128 + wc * 32 + n * 16 + 4 * fq;
                        const f32x4 a = acc[ai][bj][m][n];
                        if (region < 6) {
                            const int cin = col & 1023;
                            if (region == 2 || region == 5) {
                                bf16_t* vt = (bf16_t*)(ws + (region == 2 ? WS_VAT : WS_VBT));
                                const int b = row >> 11, s0 = row & 2047, hh = cin >> 7, d = cin & 127;
                                const int s = (s0 & ~31) | ((s0 & 12) << 1) | ((s0 & 16) >> 2) | (s0 & 3);
                                const unsigned w0 = pack_bf16(a[0], a[1]), w1 = pack_bf16(a[2], a[3]);
                                bf16_t* base = vt + ((size_t)((b * 8 + hh) * 128 + d)) * SEQ + s;
                                base[0] = (bf16_t)(w0 & 0xffff); base[SEQ] = (bf16_t)(w0 >> 16); base[2 * SEQ] = (bf16_t)(w1 & 0xffff); base[3 * SEQ] = (bf16_t)(w1 >> 16);
                            } else {
                                const size_t off = region == 0 ? WS_QA : region == 1 ? WS_KA : region == 3 ? WS_QB : WS_KB;
                                bf16_t* dst = (bf16_t*)(ws + off);
                                u32x2 w; w.x = pack_bf16(a[0], a[1]); w.y = pack_bf16(a[2], a[3]);
                                *(u32x2*)(dst + (size_t)row * 1024 + cin) = w;
                            }
                        } else {
                            bf16_t* dst = (bf16_t*)(ws + (region < 8 ? WS_GA : WS_GB));
                            const int cin = col - (region < 8 ? 6144 : 8192);
                            u32x2 w; w.x = pack_bf16(sigmoidf_(a[0]), sigmoidf_(a[1])); w.y = pack_bf16(sigmoidf_(a[2]), sigmoidf_(a[3]));
                            *(u32x2*)(dst + (size_t)row * D + cin) = w;
                        }
                    }
            }
    }
};
template <int PASS> struct EpiGate {
    static constexpr bool PERM = false, AFTER_DRAIN = false;
    const bf16_t* G; float* tmp; bf16_t* out;
    __device__ __forceinline__ void operator()(const pg8::f32x4 (&acc)[2][2][4][2], const pg8::Unit& u, int wr, int wc, int fr, int fq) const {
#pragma unroll
        for (int ai = 0; ai < 2; ++ai)
#pragma unroll
            for (int m = 0; m < 4; ++m) {
                const int row = u.pm * 256 + ai * 128 + wr * 64 + m * 16 + fr;
#pragma unroll
                for (int bj = 0; bj < 2; ++bj)
#pragma unroll
                    for (int n = 0; n < 2; ++n) {
                        const int col = u.pn * 256 + bj * 128 + wc * 32 + n * 16 + 4 * fq;
                        const u32x2 gw = *(const u32x2*)(G + (size_t)row * D + col);
                        f32x4 g; g[0] = __uint_as_float(gw.x << 16); g[1] = __uint_as_float(gw.x & 0xffff0000u); g[2] = __uint_as_float(gw.y << 16); g[3] = __uint_as_float(gw.y & 0xffff0000u);
                        f32x4 v = acc[ai][bj][m][n] * g;
                        if (PASS == 0) *(f32x4*)(tmp + (size_t)row * D + col) = v;
                        else {
                            v += *(const f32x4*)(tmp + (size_t)row * D + col);
                            u32x2 w; w.x = pack_bf16(v[0], v[1]); w.y = pack_bf16(v[2], v[3]);
                            *(u32x2*)(out + (size_t)row * D + col) = w;
                        }
                    }
            }
    }
};
struct EpiX1 {
    static constexpr bool PERM = false, AFTER_DRAIN = false;
    const float* x; const float* mod; float* x1;
    __device__ __forceinline__ void operator()(const pg8::f32x4 (&acc)[2][2][4][2], const pg8::Unit& u, int wr, int wc, int fr, int fq) const {
        const int b = (u.pm * 256) >> 11;
#pragma unroll
        for (int ai = 0; ai < 2; ++ai)
#pragma unroll
            for (int m = 0; m < 4; ++m) {
                const int row = u.pm * 256 + ai * 128 + wr * 64 + m * 16 + fr;
#pragma unroll
                for (int bj = 0; bj < 2; ++bj)
#pragma unroll
                    for (int n = 0; n < 2; ++n) {
                        const int col = u.pn * 256 + bj * 128 + wc * 32 + n * 16 + 4 * fq;
                        const f32x4 gm = *(const f32x4*)(mod + b * NMOD + 2 * D + col);
                        const f32x4 xv = *(const f32x4*)(x + (size_t)row * D + col);
                        *(f32x4*)(x1 + (size_t)row * D + col) = xv + gm * acc[ai][bj][m][n];
                    }
            }
    }
};
__device__ __forceinline__ void phase_proj_in2(const Params& p, const Ctx& c) {
    pg8::Gemm g{(const bf16_t*)(p.ws + WS_H), (const bf16_t*)(p.ws + WS_WIN_T), NTOK, INC, D};
    pg8::StaticOrder S; S.init(NTOK, INC, c.nblk, c.bid);
    EpiProjIn E{p.ws};
    pg8::gemm_phase<EpiProjIn, pg8::StaticOrder>(c.lds, g, S, E, nullptr, c.wid);
}
__device__ __forceinline__ void phase_merge2(const Params& p, const Ctx& c) {
    float* tmp = (float*)(p.ws + WS_X1);
    {
        pg8::Gemm g{(const bf16_t*)(p.ws + WS_OA), (const bf16_t*)(p.ws + WS_WPA_T), NTOK, D, 1024};
        pg8::StaticOrder S; S.init(NTOK, D, c.nblk, c.bid);
        EpiGate<0> E{(const bf16_t*)(p.ws + WS_GA), tmp, nullptr};
        pg8::gemm_phase<EpiGate<0>, pg8::StaticOrder>(c.lds, g, S, E, nullptr, c.wid);
    }
    {
        pg8::Gemm g{(const bf16_t*)(p.ws + WS_OB), (const bf16_t*)(p.ws + WS_WPB_T), NTOK, D, 1024};
        pg8::StaticOrder S; S.init(NTOK, D, c.nblk, c.bid);
        EpiGate<1> E{(const bf16_t*)(p.ws + WS_GB), tmp, (bf16_t*)(p.ws + WS_MRG)};
        pg8::gemm_phase<EpiGate<1>, pg8::StaticOrder>(c.lds, g, S, E, nullptr, c.wid);
    }
}
struct MidGate {
    static constexpr int AT = 16;
    const bf16_t* GA; const bf16_t* GB;
    __device__ __forceinline__ void operator()(pg8::f32x4 (&acc)[2][2][4][2], const pg8::Unit& u, int wr, int wc, int fr, int fq) const {
        int off0 = (u.pm * 256 + wr * 64 + fr) * D + u.pn * 256 + wc * 32 + 4 * fq;
        asm volatile("" : "+v"(off0));
#pragma unroll
        for (int ai = 0; ai < 2; ++ai)
#pragma unroll
            for (int m = 0; m < 4; ++m) {
#pragma unroll
                for (int bj = 0; bj < 2; ++bj)
#pragma unroll
                    for (int n = 0; n < 2; ++n) {
                        const int off = off0 + (ai * 128 + m * 16) * D + bj * 128 + n * 16;
                        const u32x2 a = *(const u32x2*)(GA + off), b = *(const u32x2*)(GB + off);
                        f32x4 r;
                        r[0] = __uint_as_float(a.x << 16) * __builtin_amdgcn_rcpf(__uint_as_float(b.x << 16)); r[1] = __uint_as_float(a.x & 0xffff0000u) * __builtin_amdgcn_rcpf(__uint_as_float(b.x & 0xffff0000u));
                        r[2] = __uint_as_float(a.y << 16) * __builtin_amdgcn_rcpf(__uint_as_float(b.y << 16)); r[3] = __uint_as_float(a.y & 0xffff0000u) * __builtin_amdgcn_rcpf(__uint_as_float(b.y & 0xffff0000u));
                        acc[ai][bj][m][n] *= r;
                    }
                asm volatile("" ::: "memory");
            }
    }
};
struct EpiGateB {
    static constexpr bool PERM = false, AFTER_DRAIN = false;
    const bf16_t* GB; bf16_t* out;
    __device__ __forceinline__ void operator()(const pg8::f32x4 (&acc)[2][2][4][2], const pg8::Unit& u, int wr, int wc, int fr, int fq) const {
#pragma unroll
        for (int ai = 0; ai < 2; ++ai)
#pragma unroll
            for (int m = 0; m < 4; ++m) {
                const int row = u.pm * 256 + ai * 128 + wr * 64 + m * 16 + fr;
#pragma unroll
                for (int bj = 0; bj < 2; ++bj)
#pragma unroll
                    for (int n = 0; n < 2; ++n) {
                        const int col = u.pn * 256 + bj * 128 + wc * 32 + n * 16 + 4 * fq;
                        const u32x2 gw = *(const u32x2*)(GB + (size_t)row * D + col);
                        f32x4 g; g[0] = __uint_as_float(gw.x << 16); g[1] = __uint_as_float(gw.x & 0xffff0000u); g[2] = __uint_as_float(gw.y << 16); g[3] = __uint_as_float(gw.y & 0xffff0000u);
                        const f32x4 v = acc[ai][bj][m][n] * g;
                        u32x2 w; w.x = pack_bf16(v[0], v[1]); w.y = pack_bf16(v[2], v[3]);
                        *(u32x2*)(out + (size_t)row * D + col) = w;
                    }
            }
    }
};
__device__ __forceinline__ void phase_merge3(const Params& p, const Ctx& c) {
    pg8::Gemm g{(const bf16_t*)(p.ws + WS_OA), (const bf16_t*)(p.ws + WS_WPA_T), NTOK, D, D};
    pg8::StaticOrder S; S.init(NTOK, D, c.nblk, c.bid);
    EpiGateB E{(const bf16_t*)(p.ws + WS_GB), (bf16_t*)(p.ws + WS_MRG)};
    MidGate M{(const bf16_t*)(p.ws + WS_GA), (const bf16_t*)(p.ws + WS_GB)};
    pg8::gemm_phase<EpiGateB, pg8::StaticOrder, false, MidGate>(c.lds, g, S, E, nullptr, c.wid, M);
}
__device__ __forceinline__ void phase_out2(const Params& p, const Ctx& c) {
    pg8::Gemm g{(const bf16_t*)(p.ws + WS_MRG), (const bf16_t*)(p.ws + WS_WOUT_T), NTOK, D, D};
    pg8::StaticOrder S; S.init(NTOK, D, c.nblk, c.bid);
    EpiX1 E{p.in[0], (const float*)(p.ws + WS_MOD), (float*)(p.ws + WS_X1)};
    pg8::gemm_phase<EpiX1, pg8::StaticOrder>(c.lds, g, S, E, nullptr, c.wid);
}

constexpr int LDS_BYTES = 160 * 1024;
__global__ void __launch_bounds__(512, 2) mk_fwd(Params p) {
    extern __shared__ __attribute__((aligned(16))) unsigned char smem[];
    LAS unsigned char* ldsb = (LAS unsigned char*)smem;
    Ctx c; c.lds = ldsb; c.tid = threadIdx.x; c.lane = c.tid & 63; c.wid = __builtin_amdgcn_readfirstlane(c.tid >> 6); c.wr = c.wid >> 2; c.wc = c.wid & 3;
    c.fr = c.lane & 15; c.fq = c.lane >> 4; c.bid = blockIdx.x; c.nblk = gridDim.x;
#define MKCTX() do {} while (0)
#define LEADER() (c.tid == 0)
    volatile LAS unsigned* bst = (volatile LAS unsigned*)(ldsb + LDS_BYTES - 32);
    if (LEADER()) { bst[0] = 0u; bst[1] = 0u; }
    __syncthreads();
    unsigned* barw = (unsigned*)(p.ws + WS_CTL);
    XcdBarrier bar; bar.bar = barw; bar.x = 0; bar.st = bst;
#if !MK_SPLIT
    bar = xcd_barrier_post(barw, bst, LEADER());
#define GRID_BAR() xcd_barrier(bar, LEADER())
#else
#define GRID_BAR() do {} while (0)
#endif
    const int lo = p.ph_lo, hi = p.ph_hi;
#define IN(k) (lo <= (k) && (k) < hi)
#define BOTH(k) (IN(k) && IN((k) + 1))
#define DUP(k) ((DUP_MASK >> (k)) & 1)
    if (IN(0)) { MKCTX(); phase_mod(p, c); phase_convert(p, c); if (DUP(0)) { GRID_BAR(); phase_mod(p, c); phase_convert(p, c); } if (BOTH(0)) GRID_BAR(); }
    if (IN(1)) { MKCTX(); phase_norm1(p, c); phase_router_prep(p, c); if (DUP(1)) { GRID_BAR(); phase_norm1(p, c); } if (BOTH(1)) GRID_BAR(); }
    if (IN(2)) { MKCTX(); phase_proj_in2(p, c); if (DUP(2)) { GRID_BAR(); phase_proj_in2(p, c); } if (BOTH(2)) GRID_BAR(); }
    if (IN(3)) { MKCTX(); phase_attn(p, c, 0); if (DUP(3)) { GRID_BAR(); phase_attn(p, c, 3); } if (BOTH(3)) GRID_BAR(); }
    if (IN(4)) { MKCTX(); phase_merge3(p, c); if (DUP(4)) { GRID_BAR(); phase_merge3(p, c); } if (BOTH(4)) GRID_BAR(); }
    if (IN(5)) { MKCTX(); phase_out2(p, c); if (DUP(5)) { GRID_BAR(); phase_out2(p, c); } if (BOTH(5)) GRID_BAR(); }
    if (IN(6)) { MKCTX(); phase_norm2_route2(p, c); if (DUP(6)) { GRID_BAR(); phase_norm2_route2(p, c, 1); } if (BOTH(6)) GRID_BAR(); }
    if (IN(7)) { MKCTX(); phase_moe1w(p, c, 1); if (DUP(7)) { GRID_BAR(); phase_moe1w(p, c, 4); } if (BOTH(7)) GRID_BAR(); }
    if (IN(8)) { MKCTX(); phase_moe2w(p, c, 2); if (DUP(8)) { GRID_BAR(); phase_moe2w(p, c, 5); } if (BOTH(8)) GRID_BAR(); }
    if (IN(9)) { MKCTX(); phase_final(p, c); if (DUP(9)) { GRID_BAR(); phase_final(p, c); } }
}

extern "C" void kernel_launch(void* const* d_in, const int* in_sizes, int n_in, void* d_out, int out_size, void* d_ws, size_t ws_size, hipStream_t stream) {
    static int grid = 0;
    if (grid == 0) {
        if (n_in != 24 || out_size != NTOK * D || ws_size < WS_END) { fprintf(stderr, "kernel_launch: unexpected shapes (n_in %d out %d ws %zu need %zu)\n", n_in, out_size, ws_size, (size_t)WS_END); grid = -1; return; }
        int dev = 0, cus = 0, per_cu = 0;
        (void)hipGetDevice(&dev); (void)hipDeviceGetAttribute(&cus, hipDeviceAttributeMultiprocessorCount, dev);
        if (hipFuncSetAttribute((const void*)mk_fwd, hipFuncAttributeMaxDynamicSharedMemorySize, LDS_BYTES) != hipSuccess) { fprintf(stderr, "kernel_launch: hipFuncSetAttribute failed\n"); grid = -1; return; }
        if (hipOccupancyMaxActiveBlocksPerMultiprocessor(&per_cu, (const void*)mk_fwd, 512, LDS_BYTES) != hipSuccess || per_cu < 1) { fprintf(stderr, "kernel_launch: occupancy query says %d\n", per_cu); }
        (void)hipGetLastError();
        grid = cus > 0 ? cus : 256;
    }
    if (grid < 0) return;
    (void)hipMemsetAsync((char*)d_ws + WS_CTL, 0, CTL_BYTES, stream);
    Params p{};
    for (int i = 0; i < 24; ++i) p.in[i] = (const float*)d_in[i];
    p.out = (float*)d_out; p.ws = (unsigned char*)d_ws;
#if MK_SPLIT
    for (int ph = 0; ph < NPHASE; ++ph) { p.ph_lo = ph; p.ph_hi = ph + 1; hipLaunchKernelGGL(mk_fwd, dim3(grid), dim3(512), LDS_BYTES, stream, p); }
#else
    p.ph_lo = 0; p.ph_hi = NPHASE;
    hipLaunchKernelGGL(mk_fwd, dim3(grid), dim3(512), LDS_BYTES, stream, p);
#endif
}
```

```cpp
#include <hip/hip_runtime.h>
#include <stdint.h>
#include <stdio.h>

#ifndef DUP_MASK
#define DUP_MASK 0
#endif
#ifndef MOE_NT
#define MOE_NT false
#endif
#ifndef MK_SPLIT
#define MK_SPLIT 0
#endif

typedef unsigned short bf16_t;
typedef short bf16x8 __attribute__((ext_vector_type(8)));
typedef short bf16x4 __attribute__((ext_vector_type(4)));
typedef float f32x4 __attribute__((ext_vector_type(4)));
typedef unsigned u32x4 __attribute__((ext_vector_type(4)));
typedef unsigned u32x2 __attribute__((ext_vector_type(2)));
#define LAS __attribute__((address_space(3)))

constexpr int D = 2048, NB = 4, SEQ = 2048, NTOK = NB * SEQ;
constexpr int INC = 10240, NMOD = 6 * D;
constexpr int NE = 64, DE = 1024;
constexpr float EPS = 1e-6f;
constexpr int NPHASE = 10;

constexpr size_t WS_CTL = 0;
constexpr size_t CTL_BYTES = 32768;
constexpr size_t CW_CNT = 4096;
constexpr size_t CW_Q = 4096 + 256;
constexpr size_t WS_MOD = WS_CTL + CTL_BYTES;
constexpr size_t WS_H = WS_MOD + (size_t)NB * NMOD * 4;
constexpr size_t WS_QA = WS_H + (size_t)NTOK * D * 2;
constexpr size_t WS_KA = WS_QA + (size_t)NTOK * 1024 * 2;
constexpr size_t WS_VAT = WS_KA + (size_t)NTOK * 1024 * 2;
constexpr size_t WS_QB = WS_VAT + (size_t)NTOK * 1024 * 2;
constexpr size_t WS_KB = WS_QB + (size_t)NTOK * 1024 * 2;
constexpr size_t WS_VBT = WS_KB + (size_t)NTOK * 1024 * 2;
constexpr size_t WS_GA = WS_VBT + (size_t)NTOK * 1024 * 2;
constexpr size_t WS_GB = WS_GA + (size_t)NTOK * D * 2;
constexpr size_t WS_OA = WS_GB + (size_t)NTOK * D * 2;
constexpr size_t WS_OB = WS_OA + (size_t)NTOK * 1024 * 2;
constexpr size_t WS_MRG = WS_OB + (size_t)NTOK * 1024 * 2;
constexpr size_t WS_X1 = WS_MRG + (size_t)NTOK * D * 2;
constexpr size_t WS_H2 = WS_X1 + (size_t)NTOK * D * 4;
constexpr size_t WS_LTOK = WS_H2 + (size_t)NTOK * D * 2;
constexpr size_t WS_LW = WS_LTOK + (size_t)NE * NTOK * 4;
constexpr size_t WS_ACT = WS_LW + (size_t)NE * NTOK * 4;
constexpr size_t WS_Y = WS_ACT + (size_t)(2 * NTOK + 512) * DE * 2;
constexpr size_t WS_WIN_T = WS_Y + (size_t)2 * NTOK * D * 4;
constexpr size_t WS_WPA_T = WS_WIN_T + (size_t)INC * D * 2;
constexpr size_t WS_WPB_T = WS_WPA_T + (size_t)D * 1024 * 2;
constexpr size_t WS_WOUT_T = WS_WPB_T + (size_t)D * 1024 * 2;
constexpr size_t WS_RW = WS_WOUT_T + (size_t)D * D * 2;
constexpr size_t WS_RC = WS_RW + (size_t)NB * 80 * D * 4;
constexpr size_t WS_TREC = WS_RC + 4096;
constexpr size_t WS_END = WS_TREC + (size_t)NTOK * 16;

#define XB_TMO      128
#define XB_XCNT(j)  (256  + 64 * (j))
#define XB_XSUB(j)  (1280 + 64 * (j))
#define XB_XGEN(j)  (2304 + 64 * (j))
#define XB_TOP      3328
#define XB_TOPGEN   3392
#define XCD_BAR_WORDS 3456
#define XB_SPIN_CAP (1u << 24)

__device__ __forceinline__ unsigned xb_ld(unsigned* p)              { return __hip_atomic_load(p, __ATOMIC_RELAXED, __HIP_MEMORY_SCOPE_AGENT); }
__device__ __forceinline__ unsigned xb_add(unsigned* p, unsigned v) { return __hip_atomic_fetch_add(p, v, __ATOMIC_RELAXED, __HIP_MEMORY_SCOPE_AGENT); }
__device__ __forceinline__ unsigned xb_xcc_id() { return (unsigned)__builtin_amdgcn_s_getreg((3 << 11) | 20) & 0xFu; }
#define XB_SPIN(cond, bar) do { unsigned _sp = 0; while (cond) { __builtin_amdgcn_s_sleep(1); \
    if ((++_sp & 255u) == 0u) { if (xb_ld(&(bar)[XB_TMO])) break; if (_sp > XB_SPIN_CAP) { atomicAdd(&(bar)[XB_TMO], 1u); break; } } } } while (0)

struct XcdBarrier { unsigned* bar; unsigned x; volatile LAS unsigned* st; };

__device__ __forceinline__ XcdBarrier xcd_barrier_post(unsigned* bar, volatile LAS unsigned* st, bool leader) {
    XcdBarrier b; b.bar = bar; b.x = xb_xcc_id(); b.st = st;
    if (leader) (void)xb_add(&bar[XB_XCNT(b.x)], 1u);
    return b;
}
__device__ __forceinline__ void xcd_barrier_complete(unsigned* bar, unsigned x, unsigned& nloc, unsigned& nx) {
    const unsigned G = gridDim.x * gridDim.y * gridDim.z;
    unsigned sum, cnt, mine, sp = 0u;
    for (;;) {
        sum = 0u; cnt = 0u; mine = 0u;
#pragma unroll
        for (unsigned j = 0; j < 16; ++j) { const unsigned c = xb_ld(&bar[XB_XCNT(j)]); sum += c; cnt += (c > 0u) ? 1u : 0u; mine = (j == x) ? c : mine; }
        if (sum == G) break;
        __builtin_amdgcn_s_sleep(1);
        if ((++sp & 255u) == 0u) { if (xb_ld(&bar[XB_TMO])) break; if (sp > XB_SPIN_CAP) { atomicAdd(&bar[XB_TMO], 1u); break; } }
    }
    nloc = mine > 0u ? mine : 1u; nx = cnt > 0u ? cnt : 1u;
}
__device__ __forceinline__ void xcd_barrier(const XcdBarrier& b, bool leader) {
    asm volatile("s_waitcnt vmcnt(0)" ::: "memory");
    __syncthreads();
    if (leader) {
        unsigned* bar = b.bar;
        __builtin_amdgcn_s_waitcnt(0);
        unsigned nloc = b.st[0], nx = b.st[1];
        if (nloc == 0u) { xcd_barrier_complete(bar, b.x, nloc, nx); b.st[0] = nloc; b.st[1] = nx; }
        const unsigned old = xb_add(&bar[XB_XSUB(b.x)], 1u);
        const unsigned gen = old / nloc;
        if (old + 1u == (gen + 1u) * nloc) {
            __builtin_amdgcn_fence(__ATOMIC_RELEASE, "agent");
            asm volatile("s_waitcnt vmcnt(0)" ::: "memory");
            const unsigned og = xb_add(&bar[XB_TOP], 1u);
            const unsigned tg = og / nx;
            if (og + 1u == (tg + 1u) * nx) xb_add(&bar[XB_TOPGEN], 1u);
            else XB_SPIN(xb_ld(&bar[XB_TOPGEN]) == tg, bar);
            __builtin_amdgcn_fence(__ATOMIC_ACQUIRE, "agent");
            xb_add(&bar[XB_XGEN(b.x)], 1u);
            asm volatile("s_waitcnt vmcnt(0)" ::: "memory");
        } else {
            XB_SPIN(xb_ld(&bar[XB_XGEN(b.x)]) == gen, bar);
            __builtin_amdgcn_fence(__ATOMIC_ACQUIRE, "agent");
            asm volatile("s_waitcnt vmcnt(0)" ::: "memory");
        }
    }
    __syncthreads();
}

typedef __bf16 bf16v2_t __attribute__((ext_vector_type(2)));
typedef float f32x2 __attribute__((ext_vector_type(2)));
__device__ __forceinline__ unsigned pack_bf16(float lo, float hi) {
    const f32x2 v = {lo, hi};
    return __builtin_bit_cast(unsigned, __builtin_convertvector(v, bf16v2_t));
}
__device__ __forceinline__ float wave_sum(float v) {
#pragma unroll
    for (int o = 32; o > 0; o >>= 1) v += __shfl_xor(v, o);
    return v;
}
__device__ __forceinline__ float xmax16(float v) { const auto r = __builtin_amdgcn_permlane16_swap(__float_as_uint(v), __float_as_uint(v), false, false); return fmaxf(__uint_as_float(r[0]), __uint_as_float(r[1])); }
__device__ __forceinline__ float xmax32(float v) { const auto r = __builtin_amdgcn_permlane32_swap(__float_as_uint(v), __float_as_uint(v), false, false); return fmaxf(__uint_as_float(r[0]), __uint_as_float(r[1])); }
__device__ __forceinline__ float xsum16(float v) { const auto r = __builtin_amdgcn_permlane16_swap(__float_as_uint(v), __float_as_uint(v), false, false); return __uint_as_float(r[0]) + __uint_as_float(r[1]); }
__device__ __forceinline__ float xsum32(float v) { const auto r = __builtin_amdgcn_permlane32_swap(__float_as_uint(v), __float_as_uint(v), false, false); return __uint_as_float(r[0]) + __uint_as_float(r[1]); }
__device__ __forceinline__ float sigmoidf_(float x) { return 1.0f / (1.0f + __expf(-x)); }

__device__ __forceinline__ int lane_id_fresh() { int l; asm volatile("v_mbcnt_lo_u32_b32 %0, -1, 0\n\tv_mbcnt_hi_u32_b32 %0, -1, %0" : "=v"(l)); return l; }
struct Params { const float* in[24]; float* out; unsigned char* ws; int ph_lo, ph_hi; };

struct Ctx {
    int tid, lane, wid, wr, wc, fr, fq, bid, nblk;
    LAS unsigned char* lds;
};

__device__ __forceinline__ int next_item(unsigned* ctr, const Ctx& c) {
    LAS int* slot = (LAS int*)(c.lds + 160 * 1024 - 64);
    __syncthreads();
    if (c.tid == 0) *slot = (int)__hip_atomic_fetch_add(ctr, 1u, __ATOMIC_RELAXED, __HIP_MEMORY_SCOPE_AGENT);
    __syncthreads();
    return *slot;
}

struct XQueue { unsigned* heads; int x, v; };
__device__ __forceinline__ XQueue xq_make(const Params& p, int qsel) { XQueue q; q.heads = (unsigned*)(p.ws + WS_CTL) + CW_Q + qsel * 512; q.x = (int)(xb_xcc_id() & 7u); q.v = 0; return q; }
__device__ __forceinline__ bool xq_next(XQueue& q, int per_tile, int ntiles, const Ctx& c, int& tile, int& sub) {
    while (q.v < 8) {
        const int qi = (q.x + q.v) & 7;
        const int L = next_item(q.heads + qi * 64, c);
        const int t = qi + 8 * (L / per_tile);
        if (t < ntiles) { tile = t; sub = L % per_tile; return true; }
        ++q.v;
    }
    return false;
}

namespace pg8 {
#define PG8_LAS __attribute__((address_space(3)))
typedef unsigned short bf16_t;
typedef short bf16x8 __attribute__((ext_vector_type(8)));
typedef float f32x4 __attribute__((ext_vector_type(4)));
typedef unsigned u32x4 __attribute__((ext_vector_type(4)));
constexpr int BM = 256, BK = 64, HALF = 128, HTB = HALF * BK * 2  , STAGE_BYTES = 8 * HTB, NXCD = 8, WGM = 8;

__host__ __device__ __forceinline__ int lds_byte(int r, int c) { const int st = (r >> 4) * 2 + (c >> 5), rr = r & 15, cc = c & 31, ob = rr * 64 + cc * 2; return st * 1024 + (ob ^ (((ob >> 9) & 1) << 5)); }
__host__ __device__ __forceinline__ void stage_rc(int b, int& R, int& C) { const int st = b / 1024, sb = b % 1024, swz = sb ^ (((sb >> 9) & 1) << 5); R = (st >> 1) * 16 + swz / 64; C = (st & 1) * 32 + (swz % 64) / 2; }
__host__ __device__ __forceinline__ int perm32(int rho) { const int n = rho >> 4, i = rho & 15; return 8 * (i >> 2) + 4 * n + (i & 3); }

struct Unit { int pm, pn; };
struct Gemm { const bf16_t* A; const bf16_t* Bt; int M, N, K; };

struct StaticOrder {
    int nM, nN, nwg, G, c;
    __host__ __device__ void init(int M, int N, int G_, int c_) { nM = M / BM; nN = N / BM; nwg = nM * nN; G = G_; c = c_; }
    __host__ __device__ bool next(int i, Unit& u) const {
        const long L = (long)i * G + c; if (L >= nwg) return false;
        int wgid = (int)L; { const int q = nwg / NXCD, r = nwg % NXCD, xcd = wgid % NXCD, off = wgid / NXCD; wgid = (xcd < r ? xcd * (q + 1) : r * (q + 1) + (xcd - r) * q) + off; }
        const int nig = WGM * nN, gid = wgid / nig, fm = gid * WGM, gsz = (nM - fm) < WGM ? (nM - fm) : WGM;
        u.pm = fm + ((wgid % nig) % gsz); u.pn = (wgid % nig) / gsz; return true;
    }
    __device__ __forceinline__ void a_ready(const Unit&) const {}
    __device__ __forceinline__ void done(const Unit&) const {}
};
struct NoMid { static constexpr int AT = -1; __device__ __forceinline__ void operator()(f32x4 (&)[2][2][4][2], const Unit&, int, int, int, int) const {} };
template <class Epi, class Sched, bool STAMP = false, class Mid = NoMid>
__device__ __forceinline__ void gemm_phase(PG8_LAS unsigned char* lds, const Gemm g, const Sched& S, const Epi& E, unsigned long long* stamps, const int wid_in, const Mid& MH = Mid()) {
    const int wid = __builtin_amdgcn_readfirstlane(wid_in), lane = lane_id_fresh(), tid = wid * 64 + lane, wr = wid >> 2, wc = wid & 3, fr = lane & 15, fq = lane >> 4;
    const int K = g.K, nt = K / BK;
    int ts_lo = 0, ts_hi = 0, nts = 0; const unsigned long long rt_entry = STAMP ? (unsigned long long)wall_clock64() : 0ull;
#define PG8_STAMP() do { if (STAMP && wid == 0 && nts < 64) { const unsigned long long _c = (unsigned long long)clock64(); \
        ts_lo = (lane == nts) ? (int)(unsigned)_c : ts_lo; ts_hi = (lane == nts) ? (int)(unsigned)(_c >> 32) : ts_hi; ++nts; } } while (0)
    PG8_STAMP();
    unsigned voffA[2], voffB[2];
#pragma unroll
    for (int i = 0; i < 2; ++i) { int R, C; stage_rc(tid * 16 + i * 8192, R, C); const int Rb = Epi::PERM ? ((R & ~31) + perm32(R & 31)) : R;
        voffA[i] = (unsigned)(R * K + C) * 2u; voffB[i] = (unsigned)(Rb * K + C) * 2u; }
    const size_t kstep = (size_t)(BK * 2);
    const size_t hstep = (size_t)HALF * K * 2;
    const size_t tstep = 2 * hstep;
    const unsigned ldsw = (unsigned)wid * 1024u;
    const int aoff = lds_byte(wr * 64 + fr, fq * 8), boff = lds_byte(wc * 32 + fr, fq * 8);
#define PG8_SA(b, h) (((b) * 2 + (h)) * HTB)
#define PG8_SB(b, h) ((4 + (b) * 2 + (h)) * HTB)
#define PG8_STAGE(bufoff, gbase, voff) do { _Pragma("unroll") for (int _i = 0; _i < 2; ++_i) \
        __builtin_amdgcn_global_load_lds((const unsigned*)((const char*)(gbase) + (voff)[_i]), (PG8_LAS unsigned*)(lds + (bufoff) + ldsw + _i * 8192), 16, 0, 0); } while (0)
#define PG8_LDA(dst, b, h) do { _Pragma("unroll") for (int m = 0; m < 4; ++m) _Pragma("unroll") for (int k = 0; k < 2; ++k) dst[m][k] = *(const PG8_LAS bf16x8*)(lds + PG8_SA(b, h) + aoff + m * 2048 + k * 1024); } while (0)
#define PG8_LDB(dst, b, h) do { _Pragma("unroll") for (int n = 0; n < 2; ++n) _Pragma("unroll") for (int k = 0; k < 2; ++k) dst[n][k] = *(const PG8_LAS bf16x8*)(lds + PG8_SB(b, h) + boff + n * 2048 + k * 1024); } while (0)
#define PG8_MMA(ai, bj, At, Bt) do { __builtin_amdgcn_s_setprio(1); _Pragma("unroll") for (int m = 0; m < 4; ++m) _Pragma("unroll") for (int n = 0; n < 2; ++n) _Pragma("unroll") for (int k = 0; k < 2; ++k) \
        acc[ai][bj][m][n] = __builtin_amdgcn_mfma_f32_16x16x32_bf16(Bt[n][k], At[m][k], acc[ai][bj][m][n], 0, 0, 0); __builtin_amdgcn_s_setprio(0); } while (0)
#define PG8_WAIT_V(n) asm volatile("s_waitcnt vmcnt(" #n ")" ::: "memory")
#define PG8_WAIT_L(n) asm volatile("s_waitcnt lgkmcnt(" #n ")" ::: "memory")
#define PG8_BAR __builtin_amdgcn_s_barrier()
#define PG8_SCHED __builtin_amdgcn_sched_barrier(0)
    Unit cur, nxt; int ui = 0;
    if (!S.next(0, cur)) return;
    f32x4 acc[2][2][4][2];
#pragma unroll
    for (int a = 0; a < 2; ++a)
#pragma unroll
        for (int b = 0; b < 2; ++b)
#pragma unroll
            for (int m = 0; m < 4; ++m)
#pragma unroll
                for (int n = 0; n < 2; ++n) acc[a][b][m][n] = (f32x4){0.f, 0.f, 0.f, 0.f};
    bf16x8 At[4][2], B0[2][2], B1[2][2];
    const char* cA = (const char*)g.A + (size_t)cur.pm * tstep; const char* cB = (const char*)g.Bt + (size_t)cur.pn * tstep;
    S.a_ready(cur);
    PG8_STAGE(PG8_SB(0, 0), cB, voffB); PG8_STAGE(PG8_SA(0, 0), cA, voffA); PG8_STAGE(PG8_SB(0, 1), cB + hstep, voffB); PG8_STAGE(PG8_SA(0, 1), cA + hstep, voffA);
    if (wr == 1) PG8_BAR;
    PG8_WAIT_V(4); PG8_BAR;
    PG8_STAGE(PG8_SB(1, 0), cB + kstep, voffB); PG8_STAGE(PG8_SA(1, 0), cA + kstep, voffA); PG8_STAGE(PG8_SB(1, 1), cB + hstep + kstep, voffB);
    PG8_WAIT_V(6); PG8_BAR;
    PG8_STAMP();
    for (;;) {
        const bool has_next = S.next(ui + 1, nxt);
        const char* nA = has_next ? (const char*)g.A + (size_t)nxt.pm * tstep : cA; const char* nB = has_next ? (const char*)g.Bt + (size_t)nxt.pn * tstep : cB;
        for (int t = 0; t < nt; t += 2) {
            if (Mid::AT >= 0 && t == Mid::AT) MH(acc, cur, wr, wc, fr, fq);
            const bool last = (t == nt - 2);
            const char* a1 = cA + (size_t)(t + 1) * kstep;
            const char* a2 = last ? nA : cA + (size_t)(t + 2) * kstep; const char* b2 = last ? nB : cB + (size_t)(t + 2) * kstep;
            const char* a3 = a2 + kstep; const char* b3 = b2 + kstep;
            if (last && has_next) S.a_ready(nxt);
            PG8_LDB(B0, 0, 0); PG8_SCHED; PG8_LDA(At, 0, 0); PG8_STAGE(PG8_SA(1, 1), a1 + hstep, voffA);
            PG8_WAIT_L(8); PG8_BAR; PG8_WAIT_L(0); PG8_MMA(0, 0, At, B0); PG8_BAR; PG8_SCHED;
            PG8_LDB(B1, 0, 1); PG8_STAGE(PG8_SB(0, 0), b2, voffB);
            PG8_BAR; PG8_WAIT_L(0); PG8_MMA(0, 1, At, B1); PG8_BAR;
            PG8_LDA(At, 0, 1); PG8_STAGE(PG8_SA(0, 0), a2, voffA);
            PG8_BAR; PG8_WAIT_L(0); PG8_MMA(1, 0, At, B0); PG8_BAR; PG8_SCHED;
            PG8_STAGE(PG8_SB(0, 1), b2 + hstep, voffB);
            PG8_WAIT_V(6); PG8_BAR; PG8_MMA(1, 1, At, B1); PG8_BAR;
            PG8_LDB(B0, 1, 0); PG8_SCHED; PG8_LDA(At, 1, 0); PG8_STAGE(PG8_SA(0, 1), a2 + hstep, voffA);
            PG8_WAIT_L(8); PG8_BAR; PG8_WAIT_L(0); PG8_MMA(0, 0, At, B0); PG8_BAR; PG8_SCHED;
            PG8_LDB(B1, 1, 1); PG8_STAGE(PG8_SB(1, 0), b3, voffB);
            PG8_BAR; PG8_WAIT_L(0); PG8_MMA(0, 1, At, B1); PG8_BAR;
            PG8_LDA(At, 1, 1); PG8_STAGE(PG8_SA(1, 0), a3, voffA);
            PG8_BAR; PG8_WAIT_L(0); PG8_MMA(1, 0, At, B0); PG8_BAR; PG8_SCHED;
            PG8_STAGE(PG8_SB(1, 1), b3 + hstep, voffB);
            PG8_WAIT_V(6); PG8_BAR; PG8_MMA(1, 1, At, B1); PG8_BAR;
        }
        PG8_STAMP();
        if constexpr (!Epi::AFTER_DRAIN) { E(acc, cur, wr, wc, fr, fq); S.done(cur); }
        PG8_STAMP();
        if (!has_next) break;
#pragma unroll
        for (int a = 0; a < 2; ++a)
#pragma unroll
            for (int b = 0; b < 2; ++b)
#pragma unroll
                for (int m = 0; m < 4; ++m)
#pragma unroll
                    for (int n = 0; n < 2; ++n) acc[a][b][m][n] = (f32x4){0.f, 0.f, 0.f, 0.f};
        cur = nxt; cA = nA; cB = nB; ++ui;
    }
    PG8_WAIT_V(0);
    if (wr == 0) PG8_BAR;
    PG8_BAR;
    if constexpr (Epi::AFTER_DRAIN) { E.fused(acc, cur, wr, wc, fr, fq, lds, wid, lane); S.done(cur); }
    PG8_STAMP();
    if (STAMP && wid == 0) { stamps[lane] = lane < nts ? (((unsigned long long)(unsigned)ts_hi << 32) | (unsigned)ts_lo) : 0ull;
        if (lane == 62) stamps[62] = rt_entry; if (lane == 63) stamps[63] = (unsigned long long)wall_clock64(); }
#undef PG8_STAMP
#undef PG8_SA
#undef PG8_SB
#undef PG8_STAGE
#undef PG8_LDA
#undef PG8_LDB
#undef PG8_MMA
#undef PG8_WAIT_V
#undef PG8_WAIT_L
#undef PG8_BAR
#undef PG8_SCHED
}
}

constexpr int G_STAGE = 49152, G_BOFF = 32768;
template <bool NTB, int K>
__device__ __forceinline__ void gemm_mainloop(f32x4 (&acc)[8][2], const bf16_t* const (&arow)[4], const float* bptr, const int ldb, const Ctx& c) {
    const int lane = c.lane, wid = c.wid;
    constexpr int nt = K >> 6;
    const int half = lane & 1, nq = ((lane >> 1) & 7) | ((lane >> 4) << 3);
    int b_wr[4];
#pragma unroll
    for (int j = 0; j < 4; ++j) { const int n = 4 * nq + j; b_wr[j] = G_BOFF + n * 128 + ((wid ^ ((n >> 1) & 7)) << 4) + half * 8; }
    const int a_wr = wid * 4096 + lane * 16;
    const int fr = c.fr, fq = c.fq;
    int a_rd[2], b_rd[2][2];
#pragma unroll
    for (int kb = 0; kb < 2; ++kb) {
        a_rd[kb] = (128 * c.wr + fr) * 128 + ((((4 * kb + fq) ^ (fr & 7))) << 4);
#pragma unroll
        for (int ni = 0; ni < 2; ++ni) { const int n = 32 * c.wc + 16 * ni + fr; b_rd[kb][ni] = G_BOFF + n * 128 + (((4 * kb + fq) ^ ((n >> 1) & 7)) << 4); }
    }
    u32x4 ra[4]; f32x4 rb0[4], rb1[4];
    bf16x8 A0[8], A1[8], B0[2], B1[2];
#define G_LOADA(T) do { _Pragma("unroll") for (int i = 0; i < 4; ++i) ra[i] = *(const u32x4*)(arow[i] + (T) * 64); } while (0)
#define G_LOADB(RB, T) do { _Pragma("unroll") for (int i = 0; i < 4; ++i) { \
        if (NTB) RB[i] = __builtin_nontemporal_load((const f32x4*)(bptr + (size_t)((T) * 64 + i) * ldb)); else RB[i] = *(const f32x4*)(bptr + (size_t)((T) * 64 + i) * ldb); } } while (0)
#define G_WRITE(ST, RB) do { _Pragma("unroll") for (int i = 0; i < 4; ++i) *(LAS u32x4*)((ST) + a_wr + i * 1024) = ra[i]; \
        _Pragma("unroll") for (int j = 0; j < 4; ++j) { u32x2 w; w.x = pack_bf16(RB[0][j], RB[1][j]); w.y = pack_bf16(RB[2][j], RB[3][j]); *(LAS u32x2*)((ST) + b_wr[j]) = w; } } while (0)
#define G_LDF(ST, kb, AF, BF) do { _Pragma("unroll") for (int ni = 0; ni < 2; ++ni) BF[ni] = *(const LAS bf16x8*)((ST) + b_rd[kb][ni]); \
        _Pragma("unroll") for (int mi = 0; mi < 8; ++mi) AF[mi] = *(const LAS bf16x8*)((ST) + a_rd[kb] + mi * 2048); } while (0)
#define G_MMA(AF, BF) do { _Pragma("unroll") for (int mi = 0; mi < 8; ++mi) _Pragma("unroll") for (int ni = 0; ni < 2; ++ni) \
        acc[mi][ni] = __builtin_amdgcn_mfma_f32_16x16x32_bf16(BF[ni], AF[mi], acc[mi][ni], 0, 0, 0); } while (0)
#define G_SB __builtin_amdgcn_sched_barrier(0)
    LAS unsigned char* st0 = c.lds; LAS unsigned char* st1 = c.lds + G_STAGE;
    constexpr int tl = nt - 1;
    G_LOADA(0); G_LOADB(rb0, 0); G_LOADB(rb1, 1);
    G_WRITE(st0, rb0);
    G_LOADA(1); G_LOADB(rb0, 2);
    __syncthreads();
#pragma unroll 1
    for (int t = 0; t < nt; t += 2) {
        const int t2 = (t + 2 < tl) ? t + 2 : tl, t3 = (t + 3 < tl) ? t + 3 : tl, t4 = (t + 4 < tl) ? t + 4 : tl;
        G_LDF(st0, 0, A0, B0); G_LDF(st0, 1, A1, B1); G_SB;
        G_MMA(A0, B0); G_SB;
        G_WRITE(st1, rb1); G_SB;
        G_MMA(A1, B1); G_SB;
        G_LOADA(t2); G_LOADB(rb1, t3);
        __syncthreads();
        G_LDF(st1, 0, A0, B0); G_LDF(st1, 1, A1, B1); G_SB;
        G_MMA(A0, B0); G_SB;
        G_WRITE(st0, rb0); G_SB;
        G_MMA(A1, B1); G_SB;
        G_LOADA(t3); G_LOADB(rb0, t4);
        __syncthreads();
    }
#undef G_LOADA
#undef G_LOADB
#undef G_WRITE
#undef G_LDF
#undef G_MMA
#undef G_SB
}
constexpr int W_STAGE = 65536, W_BOFF = 32768;
__device__ __forceinline__ int swzb(int n) { return ((n >> 2) & 1) | ((((n >> 1) ^ (n >> 3)) & 1) << 1) | ((((n >> 2) ^ (n >> 4)) & 1) << 2); }
template <int K>
__device__ __forceinline__ void gemm_mainloop256(f32x4 (&acc)[8][4], f32x4 (&rb)[8], const bf16_t* abase, const int (&aoff)[4], const float* bptr, const int ldb, const int nrows, const Ctx& c,
                                                 const bool staged, const int (&aoffn)[4], const float* bptrn, const int nrows_n, const bool hn) {
    const int lane = c.lane, wid = c.wid;
    constexpr int nt = K >> 6;
    int b_wr[2];
#pragma unroll
    for (int jh = 0; jh < 2; ++jh) { const int n = 4 * lane + 2 * jh; b_wr[jh] = W_BOFF + n * 128 + ((wid ^ swzb(n)) << 4); }
    const int a_dma = wid * 4096;
    const int fr = c.fr, fq = c.fq;
    int a_rd[2], b_rd[2][2];
#pragma unroll
    for (int kb = 0; kb < 2; ++kb) {
        a_rd[kb] = (128 * c.wr + fr) * 128 + ((((4 * kb + fq) ^ (fr & 7))) << 4);
#pragma unroll
        for (int ni = 0; ni < 2; ++ni) { const int n = 64 * c.wc + 16 * ni + fr; b_rd[kb][ni] = W_BOFF + n * 128 + (((4 * kb + fq) ^ swzb(n)) << 4); }
    }
    const int nfr = __builtin_amdgcn_readfirstlane(max(0, min(8, (nrows - 128 * c.wr + 15) >> 4)));
    const int npc = __builtin_amdgcn_readfirstlane(max(0, min(4, (nrows - 32 * wid + 7) >> 3)));
    const int npcn = __builtin_amdgcn_readfirstlane(max(0, min(4, (nrows_n - 32 * wid + 7) >> 3)));
    const int n1a = hn ? 64 : 0;
    const size_t n1b = hn ? (size_t)64 * ldb : 0;
#define W_FA(ST, T, NT1) do { const bool nx = ((T) >= nt); const int np = nx ? npcn : npc; \
        _Pragma("unroll") for (int i = 0; i < 4; ++i) if (i < np) \
            __builtin_amdgcn_global_load_lds((const unsigned*)(abase + (nx ? aoffn[i] + ((NT1) ? n1a : 0) : aoff[i] + (T) * 64)), (LAS unsigned*)((ST) + a_dma + i * 1024), 16, 0, 0); } while (0)
#define W_FB(T, NT1) do { const bool nx = ((T) >= nt); \
        const float* bq = nx ? bptrn + ((NT1) ? n1b : 0) : bptr + (size_t)((T) * 64) * ldb; \
        _Pragma("unroll") for (int i = 0; i < 8; ++i) rb[i] = *(const f32x4*)(bq + (size_t)i * ldb); } while (0)
#define W_CVT() do { _Pragma("unroll") for (int j = 0; j < 4; ++j) { wv[j].x = pack_bf16(rb[0][j], rb[1][j]); wv[j].y = pack_bf16(rb[2][j], rb[3][j]); \
            wv[j].z = pack_bf16(rb[4][j], rb[5][j]); wv[j].w = pack_bf16(rb[6][j], rb[7][j]); } } while (0)
#define W_ST(ST) do { _Pragma("unroll") for (int j = 0; j < 4; ++j) *(LAS u32x4*)((ST) + b_wr[j >> 1] + (j & 1) * 128) = wv[j]; } while (0)
#define W_SB __builtin_amdgcn_sched_barrier(0)
#define W_COMPUTE(ST) do { _Pragma("unroll") for (int kb = 0; kb < 2; ++kb) { bf16x8 bf[4]; \
        _Pragma("unroll") for (int ni = 0; ni < 4; ++ni) bf[ni] = *(const LAS bf16x8*)((ST) + b_rd[kb][ni & 1] + (ni >> 1) * 4096); \
        _Pragma("unroll") for (int mi = 0; mi < 8; ++mi) if (mi < nfr) { const bf16x8 af = *(const LAS bf16x8*)((ST) + a_rd[kb] + mi * 2048); \
            _Pragma("unroll") for (int ni = 0; ni < 4; ++ni) acc[mi][ni] = __builtin_amdgcn_mfma_f32_16x16x32_bf16(bf[ni], af, acc[mi][ni], 0, 0, 0); } } } while (0)
    LAS unsigned char* st0 = c.lds; LAS unsigned char* st1 = c.lds + W_STAGE;
    u32x4 wv[4];
    if (!staged) {
        W_FA(st0, 0, 0); W_FB(0, 0);
        W_CVT(); W_SB; W_FB(1, 0); W_SB; W_ST(st0);
        asm volatile("s_waitcnt vmcnt(8)" ::: "memory");
        __syncthreads();
        W_FA(st1, 1, 0);
    }
#pragma unroll 1
    for (int t = 0; t < nt; t += 2) {
        W_COMPUTE(st0);
        W_CVT(); W_SB; W_FB(t + 2, 0); W_SB; W_ST(st1);
        asm volatile("s_waitcnt vmcnt(8)" ::: "memory");
        __syncthreads();
        W_FA(st0, t + 2, 0);
        W_COMPUTE(st1);
        W_CVT(); W_SB; W_FB(t + 3, 1); W_SB; W_ST(st0);
        asm volatile("s_waitcnt vmcnt(8)" ::: "memory");
        __syncthreads();
        W_FA(st1, t + 3, 1);
    }
#undef W_FA
#undef W_FB
#undef W_CVT
#undef W_ST
#undef W_SB
#undef W_COMPUTE
}
__device__ __forceinline__ int a_piece_row(const Ctx& c, int i) { return 32 * c.wid + 8 * i + (c.lane >> 3); }
__device__ __forceinline__ int a_piece_col(const Ctx& c) { return 8 * ((c.lane & 7) ^ ((c.lane >> 3) & 7)); }
__device__ __forceinline__ void zero_acc(f32x4 (&acc)[8][2]) {
#pragma unroll
    for (int mi = 0; mi < 8; ++mi)
#pragma unroll
        for (int ni = 0; ni < 2; ++ni) acc[mi][ni] = (f32x4){0.f, 0.f, 0.f, 0.f};
}
__device__ __forceinline__ int b_nq(const Ctx& c) { return ((c.lane >> 1) & 7) | ((c.lane >> 4) << 3); }
__device__ __forceinline__ int b_k0(const Ctx& c) { return 8 * c.wid + 4 * (c.lane & 1); }

__device__ __forceinline__ void phase_mod(const Params& p, const Ctx& c) {
    const float* cc = p.in[1]; const float* w_ada = p.in[3]; const float* b_ada = p.in[4];
    float* mod = (float*)(p.ws + WS_MOD);
    LAS float* sc = (LAS float*)c.lds;
    LAS float* red = (LAS float*)(c.lds + 32768);
    for (int i = c.tid; i < NB * D; i += 512) { const float v = cc[i]; sc[i] = v / (1.0f + __expf(-v)); }
    __syncthreads();
    const int cq = c.tid % 12, kl = c.tid / 12;
    for (int item = c.bid; item < 256; item += c.nblk) {
        float acc[4][4];
#pragma unroll
        for (int b = 0; b < 4; ++b)
#pragma unroll
            for (int j = 0; j < 4; ++j) acc[b][j] = 0.f;
        if (kl < 42) {
            const float* wp = w_ada + item * 48 + cq * 4;
            for (int k = kl; k < D; k += 42) {
                const f32x4 w = *(const f32x4*)(wp + (size_t)k * NMOD);
#pragma unroll
                for (int b = 0; b < 4; ++b) { const float s = sc[b * D + k];
#pragma unroll
                    for (int j = 0; j < 4; ++j) acc[b][j] += s * w[j]; }
            }
#pragma unroll
            for (int b = 0; b < 4; ++b)
#pragma unroll
                for (int j = 0; j < 4; ++j) red[(kl * 12 + cq) * 16 + b * 4 + j] = acc[b][j];
        }
        __syncthreads();
        if (c.tid < 192) {
            const int b = c.tid / 48, col = c.tid % 48;
            float s = 0.f;
            for (int k2 = 0; k2 < 42; ++k2) s += red[(k2 * 12 + (col >> 2)) * 16 + b * 4 + (col & 3)];
            mod[b * NMOD + item * 48 + col] = s + b_ada[item * 48 + col];
        }
        __syncthreads();
    }
}

__device__ __forceinline__ void convert_tile(const float* W, int K, int N, bf16_t* Wt, int kt, int ntile, const Ctx& c, int ldt = 0, int koff = 0) {
    if (ldt == 0) ldt = K;
    const int half = c.lane & 1, nq = b_nq(c);
    const float* src = W + (size_t)(kt * 64 + 8 * c.wid + 4 * half) * N + ntile * 128 + 4 * nq;
    f32x4 rb_[4];
#pragma unroll
    for (int i = 0; i < 4; ++i) rb_[i] = *(const f32x4*)(src + (size_t)i * N);
    const int wo = (4 * nq) * 128 + ((c.wid ^ (nq & 7)) << 4) + half * 8;
#pragma unroll
    for (int j = 0; j < 4; ++j) { u32x2 w; w.x = pack_bf16(rb_[0][j], rb_[1][j]); w.y = pack_bf16(rb_[2][j], rb_[3][j]); *(LAS u32x2*)(c.lds + wo + j * 128) = w; }
    __syncthreads();
#pragma unroll
    for (int i = 0; i < 2; ++i) {
        const int idx = c.tid + 512 * i, n = idx >> 3, ch = idx & 7;
        const u32x4 v = *(const LAS u32x4*)(c.lds + n * 128 + ((ch ^ ((n >> 2) & 7)) << 4));
        *(u32x4*)(Wt + (size_t)(ntile * 128 + n) * ldt + koff + kt * 64 + ch * 8) = v;
    }
    __syncthreads();
}
__device__ __forceinline__ void phase_convert(const Params& p, const Ctx& c) {
    for (int t = c.bid; t < 3584; t += c.nblk) {
        if (t < 2560) convert_tile(p.in[6], D, INC, (bf16_t*)(p.ws + WS_WIN_T), t & 31, t >> 5, c);
        else if (t < 2816) { const int u = t - 2560; convert_tile(p.in[12], 1024, D, (bf16_t*)(p.ws + WS_WPA_T), u & 15, u >> 4, c, D, 0); }
        else if (t < 3072) { const int u = t - 2816; convert_tile(p.in[13], 1024, D, (bf16_t*)(p.ws + WS_WPA_T), u & 15, u >> 4, c, D, 1024); }
        else { const int u = t - 3072; convert_tile(p.in[14], D, D, (bf16_t*)(p.ws + WS_WOUT_T), u & 31, u >> 5, c); }
    }
}

__device__ __forceinline__ void phase_norm1(const Params& p, const Ctx& c) {
    const float* x = p.in[0]; const float* g = p.in[5];
    const float* mod = (const float*)(p.ws + WS_MOD);
    bf16_t* h = (bf16_t*)(p.ws + WS_H);
    for (int row = c.bid * 8 + c.wid; row < NTOK; row += c.nblk * 8) {
        const int b = row >> 11;
        f32x4 v[8]; float ss = 0.f;
#pragma unroll
        for (int i = 0; i < 8; ++i) { v[i] = *(const f32x4*)(x + (size_t)row * D + i * 256 + c.lane * 4); ss += v[i][0] * v[i][0] + v[i][1] * v[i][1] + v[i][2] * v[i][2] + v[i][3] * v[i][3]; }
        ss = wave_sum(ss);
        const float rstd = rsqrtf(ss * (1.0f / D) + EPS);
#pragma unroll
        for (int i = 0; i < 8; ++i) {
            const int col = i * 256 + c.lane * 4;
            const f32x4 gg = *(const f32x4*)(g + col), sh = *(const f32x4*)(mod + b * NMOD + col), scl = *(const f32x4*)(mod + b * NMOD + D + col);
            float o[4];
#pragma unroll
            for (int j = 0; j < 4; ++j) o[j] = (v[i][j] * rstd * gg[j]) * (1.0f + scl[j]) + sh[j];
            u32x2 w; w.x = pack_bf16(o[0], o[1]); w.y = pack_bf16(o[2], o[3]);
            *(u32x2*)(h + (size_t)row * D + col) = w;
        }
    }
}

__device__ __forceinline__ void phase_router_prep(const Params& p, const Ctx& c) {
    const float* mod = (const float*)(p.ws + WS_MOD); const float* g = p.in[15];
    const float* w_rg = p.in[16]; const float* b_rg = p.in[17]; const float* w_re = p.in[18]; const float* b_re = p.in[19];
    bf16_t* WtH = (bf16_t*)(p.ws + WS_RW); bf16_t* WtL = WtH + (size_t)NB * 80 * D; float* cb = (float*)(p.ws + WS_RC);
    for (int task = c.bid * 8 + c.wid; task < NB * 80; task += c.nblk * 8) {
        const int b = task / 80, j = task % 80;
        float cs = 0.f;
        for (int k = c.lane; k < D; k += 64) {
            float w = 0.f;
            if (j < 8) w = w_rg[(size_t)k * 8 + j]; else if (j < 72) w = w_re[(size_t)k * 64 + (j - 8)];
            const float wv = g[k] * (1.0f + mod[b * NMOD + 4 * D + k]) * w;
            const unsigned hi = pack_bf16(wv, 0.f) & 0xffffu; const float hif = __uint_as_float(hi << 16);
            WtH[((size_t)b * 80 + j) * D + k] = (bf16_t)hi; WtL[((size_t)b * 80 + j) * D + k] = (bf16_t)(pack_bf16(wv - hif, 0.f) & 0xffffu);
            cs += mod[b * NMOD + 3 * D + k] * w;
        }
        cs = wave_sum(cs);
        if (c.lane == 0) cb[b * 80 + j] = cs + (j < 8 ? b_rg[j] : (j < 72 ? b_re[j - 8] : 0.f));
    }
}

__device__ __forceinline__ void phase_proj_in(const Params& p, const Ctx& c) {
    const bf16_t* h = (const bf16_t*)(p.ws + WS_H); const float* w_in = p.in[6];
    for (int item = c.bid; item < 32 * 80; item += c.nblk) {
        const int mt = item & 31, ntile = item >> 5;
        const int m0 = mt * 256, n0 = ntile * 128;
        const bf16_t* arow[4];
#pragma unroll
        for (int i = 0; i < 4; ++i) arow[i] = h + (size_t)(m0 + a_piece_row(c, i)) * D + a_piece_col(c);
        const float* bptr = w_in + (size_t)b_k0(c) * INC + n0 + 4 * b_nq(c);
        f32x4 acc[8][2]; zero_acc(acc);
        gemm_mainloop<false, D>(acc, arow, bptr, INC, c);
        const int region = n0 >> 10;
#pragma unroll
        for (int mi = 0; mi < 8; ++mi)
#pragma unroll
            for (int ni = 0; ni < 2; ++ni) {
                const int row = m0 + 128 * c.wr + 16 * mi + c.fr;
                const int col = n0 + 32 * c.wc + 16 * ni + 4 * c.fq;
                const f32x4 a = acc[mi][ni];
                if (region < 6) {
                    const int cin = col & 1023;
                    if (region == 2 || region == 5) {
                        bf16_t* vt = (bf16_t*)(p.ws + (region == 2 ? WS_VAT : WS_VBT));
                        const int b = row >> 11, s = row & 2047, hh = cin >> 7, d = cin & 127;
                        const unsigned w0 = pack_bf16(a[0], a[1]), w1 = pack_bf16(a[2], a[3]);
                        bf16_t* base = vt + ((size_t)((b * 8 + hh) * 128 + d)) * SEQ + s;
                        base[0] = (bf16_t)(w0 & 0xffff); base[SEQ] = (bf16_t)(w0 >> 16); base[2 * SEQ] = (bf16_t)(w1 & 0xffff); base[3 * SEQ] = (bf16_t)(w1 >> 16);
                    } else {
                        const size_t off = region == 0 ? WS_QA : region == 1 ? WS_KA : region == 3 ? WS_QB : WS_KB;
                        bf16_t* dst = (bf16_t*)(p.ws + off);
                        u32x2 w; w.x = pack_bf16(a[0], a[1]); w.y = pack_bf16(a[2], a[3]);
                        *(u32x2*)(dst + (size_t)row * 1024 + cin) = w;
                    }
                } else {
                    bf16_t* dst = (bf16_t*)(p.ws + (region < 8 ? WS_GA : WS_GB));
                    const int cin = col - (region < 8 ? 6144 : 8192);
                    u32x2 w; w.x = pack_bf16(sigmoidf_(a[0]), sigmoidf_(a[1])); w.y = pack_bf16(sigmoidf_(a[2]), sigmoidf_(a[3]));
                    *(u32x2*)(dst + (size_t)row * D + cin) = w;
                }
            }
    }
}

constexpr int AT_STAGE = 32768, AT_VOFF = 16384, AT_BIAS = 98304;
__device__ __forceinline__ int rel_bucket_dev(int n) {
    if (n < 16) return n;
    int b = 16;
    b += (n >= 19) + (n >= 21) + (n >= 24) + (n >= 27) + (n >= 31) + (n >= 35) + (n >= 40) + (n >= 46) + (n >= 52) + (n >= 59) + (n >= 67) + (n >= 77) + (n >= 87) + (n >= 99) + (n >= 113);
    return b;
}
struct KVRegs { u32x4 k[2], v[2]; };
__device__ __forceinline__ void kv_load(KVRegs& r, const bf16_t* kbase, const bf16_t* vtbase, int kt, const Ctx& c) {
#pragma unroll
    for (int i = 0; i < 2; ++i) {
        const int key = (c.tid >> 4) + 32 * i, ck = c.tid & 15;
        r.k[i] = *(const u32x4*)(kbase + (size_t)(kt * 64 + key) * 1024 + ck * 8);
        const int d = (c.tid >> 3) + 64 * i, cv = c.tid & 7;
        r.v[i] = *(const u32x4*)(vtbase + (size_t)d * SEQ + kt * 64 + cv * 8);
    }
}
__device__ __forceinline__ void kv_store(const KVRegs& r, LAS unsigned char* st, const Ctx& c) {
#pragma unroll
    for (int i = 0; i < 2; ++i) {
        const int key = (c.tid >> 4) + 32 * i, ck = c.tid & 15;
        *(LAS u32x4*)(st + key * 256 + ((ck ^ (key & 15)) << 4)) = r.k[i];
        const int d = (c.tid >> 3) + 64 * i, cv = c.tid & 7;
        *(LAS u32x4*)(st + AT_VOFF + d * 128 + ((cv ^ ((d >> 1) & 7)) << 4)) = r.v[i];
    }
}
__device__ __forceinline__ bf16x8 v_frag(LAS unsigned char* st, int nf, int kb2, const Ctx& c) {
    const int d = 16 * nf + c.fr; const int sw = (c.fr >> 1) & 7;
    return *(const LAS bf16x8*)(st + AT_VOFF + d * 128 + (((4 * kb2 + c.fq) ^ sw) << 4));
}
__device__ __forceinline__ bf16x8 pack_p(const f32x4& a, const f32x4& b) {
    u32x4 w; w.x = pack_bf16(a[0], a[1]); w.y = pack_bf16(a[2], a[3]); w.z = pack_bf16(b[0], b[1]); w.w = pack_bf16(b[2], b[3]);
    return __builtin_bit_cast(bf16x8, w);
}

__device__ __forceinline__ void diff_attn_item(const Params& p, const Ctx& c, int b, int h, int qb, float lam, bf16x8 (&qf)[4], KVRegs& kr,
                                               const bf16_t* qn, const bf16_t* kbn, const bf16_t* vtn, const int ktn) {
    const bf16_t* ka = (const bf16_t*)(p.ws + WS_KA); const bf16_t* vat = (const bf16_t*)(p.ws + WS_VAT);
    bf16_t* oa = (bf16_t*)(p.ws + WS_OA);
    const float* rel = p.in[2]; const float* gsub = p.in[11];
    LAS float* bias = (LAS float*)(c.lds + AT_BIAS);
    __syncthreads();
    if (c.tid < 128) bias[c.tid] = rel[rel_bucket_dev(c.tid) * 8 + h] * 1.4426950408889634f;
    const int qpos = 128 * qb + 16 * c.wid + c.fr;
    const size_t qtok = (size_t)b * SEQ + qpos;
    const bf16_t* kbase = ka + (size_t)b * SEQ * 1024 + h * 128;
    const bf16_t* vtbase = vat + (size_t)((b * 8 + h) * 128) * SEQ;
    f32x4 O1[8], O2[8];
#pragma unroll
    for (int nf = 0; nf < 8; ++nf) { O1[nf] = (f32x4){0.f, 0.f, 0.f, 0.f}; O2[nf] = (f32x4){0.f, 0.f, 0.f, 0.f}; }
    float m1 = -1e30f, m2 = -1e30f, l1 = 0.f, l2 = 0.f;
    const int ntiles = 2 * qb + 2;
    const int qmax_w = 128 * qb + 16 * c.wid + 15, qmin_w = 128 * qb + 16 * c.wid;
    const float L2E = 1.4426950408889634f;
    const bool defer = c.wid >= 4;
    bf16x8 pq1[2], pq2[2]; bool pend = false;
#pragma unroll
    for (int kb2 = 0; kb2 < 2; ++kb2) { pq1[kb2] = (bf16x8){0, 0, 0, 0, 0, 0, 0, 0}; pq2[kb2] = pq1[kb2]; }
    int sidx = 0, sprev = 2;
    for (int kt = 0; kt < ntiles; ++kt) {
        LAS unsigned char* st = c.lds + sidx * AT_STAGE;
        kv_store(kr, st, c);
        { const bool last = (kt + 1 >= ntiles);
          kv_load(kr, last ? kbn : kbase, last ? vtn : vtbase, last ? ktn : kt + 1, c); }
        __syncthreads();
        if (pend) {
            LAS unsigned char* sp = c.lds + sprev * AT_STAGE;
#pragma unroll
            for (int kb2 = 0; kb2 < 2; ++kb2)
#pragma unroll
                for (int nf = 0; nf < 8; ++nf) {
                    const bf16x8 vf = v_frag(sp, nf, kb2, c);
                    O1[nf] = __builtin_amdgcn_mfma_f32_16x16x32_bf16(vf, pq1[kb2], O1[nf], 0, 0, 0);
                    O2[nf] = __builtin_amdgcn_mfma_f32_16x16x32_bf16(vf, pq2[kb2], O2[nf], 0, 0, 0);
                }
            pend = false;
        }
        if (64 * kt <= qmax_w) {
            f32x4 s1[4], s2[4];
#pragma unroll
            for (int f = 0; f < 4; ++f) {
                bf16x8 kf[4];
#pragma unroll
                for (int kb = 0; kb < 4; ++kb) kf[kb] = *(const LAS bf16x8*)(st + (16 * f + c.fr) * 256 + (((4 * kb + c.fq) ^ c.fr) << 4));
                f32x4 z = (f32x4){0.f, 0.f, 0.f, 0.f};
                z = __builtin_amdgcn_mfma_f32_16x16x32_bf16(kf[0], qf[0], z, 0, 0, 0);
                s1[f] = __builtin_amdgcn_mfma_f32_16x16x32_bf16(kf[1], qf[1], z, 0, 0, 0);
                z = (f32x4){0.f, 0.f, 0.f, 0.f};
                z = __builtin_amdgcn_mfma_f32_16x16x32_bf16(kf[2], qf[2], z, 0, 0, 0);
                s2[f] = __builtin_amdgcn_mfma_f32_16x16x32_bf16(kf[3], qf[3], z, 0, 0, 0);
            }
            const bool nearb = (qmin_w - (64 * kt + 63)) < 113;
            const float CS = 0.125f * L2E, THR = 8.0f;
            float mx1, mx2;
            if (!nearb) {
                const float bf_ = bias[127];
                float r1 = s1[0][0], r2 = s2[0][0];
#pragma unroll
                for (int f = 0; f < 4; ++f)
#pragma unroll
                    for (int r = 0; r < 4; ++r) { r1 = fmaxf(r1, s1[f][r]); r2 = fmaxf(r2, s2[f][r]); }
                mx1 = r1 * CS + bf_; mx2 = r2 * CS + bf_;
            } else {
                mx1 = -1e30f; mx2 = -1e30f;
#pragma unroll
                for (int f = 0; f < 4; ++f)
#pragma unroll
                    for (int r = 0; r < 4; ++r) {
                        const int n = qpos - (64 * kt + 16 * f + 4 * c.fq + r);
                        const float bv = bias[n < 0 ? 0 : (n > 127 ? 127 : n)];
                        float a1 = s1[f][r] * CS + bv, a2 = s2[f][r] * CS + bv;
                        if (n < 0) { a1 = -1e30f; a2 = -1e30f; }
                        s1[f][r] = a1; s2[f][r] = a2;
                        mx1 = fmaxf(mx1, a1); mx2 = fmaxf(mx2, a2);
                    }
            }
            mx1 = xmax32(xmax16(mx1)); mx2 = xmax32(xmax16(mx2));
            if (__any((mx1 - m1 > THR) || (mx2 - m2 > THR))) {
                const float mn1 = fmaxf(m1, mx1), mn2 = fmaxf(m2, mx2);
                const float al1 = __builtin_amdgcn_exp2f(m1 - mn1), al2 = __builtin_amdgcn_exp2f(m2 - mn2);
                m1 = mn1; m2 = mn2; l1 *= al1; l2 *= al2;
#pragma unroll
                for (int nf = 0; nf < 8; ++nf) { O1[nf] *= al1; O2[nf] *= al2; }
            }
            if (!nearb) {
                const float d1 = bias[127] - m1, d2 = bias[127] - m2;
#pragma unroll
                for (int f = 0; f < 4; ++f) { s1[f] = s1[f] * CS + d1; s2[f] = s2[f] * CS + d2; }
            } else {
#pragma unroll
                for (int f = 0; f < 4; ++f) { s1[f] = s1[f] - m1; s2[f] = s2[f] - m2; }
            }
            float ps1 = 0.f, ps2 = 0.f;
#pragma unroll
            for (int f = 0; f < 4; ++f)
#pragma unroll
                for (int r = 0; r < 4; ++r) {
                    const float e1 = __builtin_amdgcn_exp2f(s1[f][r]), e2 = __builtin_amdgcn_exp2f(s2[f][r]);
                    s1[f][r] = e1; s2[f][r] = e2; ps1 += e1; ps2 += e2;
                }
            l1 += ps1; l2 += ps2;
#pragma unroll
            for (int kb2 = 0; kb2 < 2; ++kb2) { pq1[kb2] = pack_p(s1[2 * kb2], s1[2 * kb2 + 1]); pq2[kb2] = pack_p(s2[2 * kb2], s2[2 * kb2 + 1]); }
            if (defer) pend = true;
            else {
#pragma unroll
                for (int kb2 = 0; kb2 < 2; ++kb2)
#pragma unroll
                    for (int nf = 0; nf < 8; ++nf) {
                        const bf16x8 vf = v_frag(st, nf, kb2, c);
                        O1[nf] = __builtin_amdgcn_mfma_f32_16x16x32_bf16(vf, pq1[kb2], O1[nf], 0, 0, 0);
                        O2[nf] = __builtin_amdgcn_mfma_f32_16x16x32_bf16(vf, pq2[kb2], O2[nf], 0, 0, 0);
                    }
            }
        }
        sprev = sidx; sidx = (sidx == 2) ? 0 : sidx + 1;
    }
    if (pend) {
        LAS unsigned char* sp = c.lds + sprev * AT_STAGE;
#pragma unroll
        for (int kb2 = 0; kb2 < 2; ++kb2)
#pragma unroll
            for (int nf = 0; nf < 8; ++nf) {
                const bf16x8 vf = v_frag(sp, nf, kb2, c);
                O1[nf] = __builtin_amdgcn_mfma_f32_16x16x32_bf16(vf, pq1[kb2], O1[nf], 0, 0, 0);
                O2[nf] = __builtin_amdgcn_mfma_f32_16x16x32_bf16(vf, pq2[kb2], O2[nf], 0, 0, 0);
            }
    }
#pragma unroll
    for (int kb = 0; kb < 4; ++kb) qf[kb] = *(const bf16x8*)(qn + 32 * kb + 8 * c.fq);
    l1 = xsum32(xsum16(l1)); l2 = xsum32(xsum16(l2));
    const float i1 = 1.0f / l1, i2 = lam / l2;
    float ss = 0.f;
#pragma unroll
    for (int nf = 0; nf < 8; ++nf)
#pragma unroll
        for (int r = 0; r < 4; ++r) { const float o = O1[nf][r] * i1 - O2[nf][r] * i2; O1[nf][r] = o; ss += o * o; }
    ss += __shfl_xor(ss, 16); ss += __shfl_xor(ss, 32);
    const float rstd = rsqrtf(ss * (1.0f / 128.0f) + EPS) * 0.8f;
#pragma unroll
    for (int nf = 0; nf < 8; ++nf) {
        const int d = 16 * nf + 4 * c.fq;
        const f32x4 g = *(const f32x4*)(gsub + d);
        u32x2 w; w.x = pack_bf16(O1[nf][0] * rstd * g[0], O1[nf][1] * rstd * g[1]); w.y = pack_bf16(O1[nf][2] * rstd * g[2], O1[nf][3] * rstd * g[3]);
        *(u32x2*)(oa + qtok * 2048 + h * 128 + d) = w;
    }
}

__device__ __forceinline__ void sb_attn_item(const Params& p, const Ctx& c, int b, int h, int qb, bf16x8 (&qf)[4], KVRegs& kr,
                                             const bf16_t* qn, const bf16_t* kbn, const bf16_t* vtn, const int ktn) {
    const bf16_t* kbuf = (const bf16_t*)(p.ws + WS_KB); const bf16_t* vbt = (const bf16_t*)(p.ws + WS_VBT);
    bf16_t* ob = (bf16_t*)(p.ws + WS_OA) + 1024;
    __syncthreads();
    const int qpos = 128 * qb + 16 * c.wid + c.fr;
    const size_t qtok = (size_t)b * SEQ + qpos;
    const bf16_t* kbase = kbuf + (size_t)b * SEQ * 1024 + h * 128;
    const bf16_t* vtbase = vbt + (size_t)((b * 8 + h) * 128) * SEQ;
    f32x4 O[8];
#pragma unroll
    for (int nf = 0; nf < 8; ++nf) O[nf] = (f32x4){0.f, 0.f, 0.f, 0.f};
    float carry = 0.f;
    const int ntiles = 2 * qb + 2;
    const int qmax_w = 128 * qb + 16 * c.wid + 15;
    const float scale = 0.08838834764831845f * 1.4426950408889634f;
    LAS int* dflag = (LAS int*)(c.lds + AT_BIAS + 1024);
    if (c.lane == 0) dflag[c.wid] = 0;
    bool wdone = false, nxt = false;
    for (int it = 0; it < ntiles; ++it) {
        const int kt = ntiles - 1 - it;
        LAS unsigned char* st = c.lds + (it & 1) * AT_STAGE;
        kv_store(kr, st, c);
        __syncthreads();
        {
            int alld = 1;
#pragma unroll
            for (int w8 = 0; w8 < 8; ++w8) alld &= dflag[w8];
            if (alld) break;
        }
        { const bool last = (kt == 0);
          kv_load(kr, last ? kbn : kbase, last ? vtn : vtbase, last ? ktn : kt - 1, c); nxt = last; }
        if (!wdone && 64 * kt < qmax_w) {
            f32x4 z[4];
#pragma unroll
            for (int f = 0; f < 4; ++f) {
                f32x4 a = (f32x4){0.f, 0.f, 0.f, 0.f};
#pragma unroll
                for (int kb = 0; kb < 4; ++kb) {
                    const bf16x8 kf = *(const LAS bf16x8*)(st + (16 * f + c.fr) * 256 + (((4 * kb + c.fq) ^ c.fr) << 4));
                    a = __builtin_amdgcn_mfma_f32_16x16x32_bf16(kf, qf[kb], a, 0, 0, 0);
                }
                z[f] = a;
            }
            f32x4 lb[4], lk[4]; float T[4];
#pragma unroll
            for (int f = 0; f < 4; ++f) {
                float t = 0.f;
#pragma unroll
                for (int r = 0; r < 4; ++r) {
                    const int kpos = 64 * kt + 16 * f + 4 * c.fq + r;
                    const float zz = z[f][r] * scale;
                    const float sp = __builtin_amdgcn_logf(1.0f + __builtin_amdgcn_exp2f(-fabsf(zz)));
                    const float lbv = fminf(zz, 0.f) - sp;
                    const bool valid = kpos < qpos;
                    const float lkv = valid ? (lbv - zz) : 0.f;
                    lb[f][r] = valid ? lbv : -1e30f; lk[f][r] = lkv; t += lkv;
                }
                T[f] = t;
            }
            float tile_tot = 0.f; float Gl[4], Ft[4];
#pragma unroll
            for (int f = 0; f < 4; ++f) {
                const float A1 = __shfl_xor(T[f], 16), A2 = __shfl_xor(T[f], 32), A3 = __shfl_xor(T[f], 48);
                Gl[f] = ((c.fq & 1) == 0 ? A1 : 0.f) + ((c.fq & 2) == 0 ? (A2 + A3) : 0.f);
                Ft[f] = T[f] + A1 + A2 + A3; tile_tot += Ft[f];
            }
            float after = carry;
#pragma unroll
            for (int f = 3; f >= 0; --f) {
                float suf = 0.f;
#pragma unroll
                for (int r = 3; r >= 0; --r) {
                    const float later = after + Gl[f] + suf;
                    z[f][r] = __builtin_amdgcn_exp2f(lb[f][r] + later);
                    suf += lk[f][r];
                }
                after += Ft[f];
            }
            carry += tile_tot;
#pragma unroll
            for (int kb2 = 0; kb2 < 2; ++kb2) {
                const bf16x8 pp = pack_p(z[2 * kb2], z[2 * kb2 + 1]);
#pragma unroll
                for (int nf = 0; nf < 8; ++nf) {
                    const bf16x8 vf = v_frag(st, nf, kb2, c);
                    O[nf] = __builtin_amdgcn_mfma_f32_16x16x32_bf16(vf, pp, O[nf], 0, 0, 0);
                }
            }
            if (__all(carry < -64.0f)) { wdone = true; if (c.lane == 0) dflag[c.wid] = 1; }
        }
    }
    if (!nxt) kv_load(kr, kbn, vtn, ktn, c);
#pragma unroll
    for (int kb = 0; kb < 4; ++kb) qf[kb] = *(const bf16x8*)(qn + 32 * kb + 8 * c.fq);
#pragma unroll
    for (int nf = 0; nf < 8; ++nf) {
        const int d = 16 * nf + 4 * c.fq;
        u32x2 w; w.x = pack_bf16(O[nf][0], O[nf][1]); w.y = pack_bf16(O[nf][2], O[nf][3]);
        *(u32x2*)(ob + qtok * 2048 + h * 128 + d) = w;
    }
}

__device__ __forceinline__ void attn_sub(const Params& p, const Ctx& c, int sub, int& kind, int& bh, int& qb, const bf16_t*& qp, const bf16_t*& kb, const bf16_t*& vt, int& kt0) {
    const int kh = sub >> 8, i2 = sub & 255, half = kh & 1, pr = i2 >> 5;
    kind = kh >> 1; bh = i2 & 31; qb = half ? pr : 15 - pr;
    const int b = bh >> 3, h = bh & 7;
    const size_t qtok = (size_t)b * SEQ + 128 * qb + 16 * c.wid + c.fr;
    qp = (const bf16_t*)(p.ws + (kind ? WS_QB : WS_QA)) + qtok * 1024 + h * 128;
    kb = (const bf16_t*)(p.ws + (kind ? WS_KB : WS_KA)) + (size_t)b * SEQ * 1024 + h * 128;
    vt = (const bf16_t*)(p.ws + (kind ? WS_VBT : WS_VAT)) + (size_t)(bh * 128) * SEQ;
    kt0 = kind ? 2 * qb + 1 : 0;
}
__device__ __forceinline__ void phase_attn(const Params& p, const Ctx& c, int qsel = 0) {
    float d1 = 0.f, d2 = 0.f;
    if (c.lane < 64) { d1 = p.in[7][c.lane] * p.in[8][c.lane]; d2 = p.in[9][c.lane] * p.in[10][c.lane]; }
    d1 = wave_sum(d1); d2 = wave_sum(d2);
    const float lam = expf(d1) - expf(d2) + 0.2f;
    (void)qsel;
    if (c.bid >= 1024) return;
    int kind, bh, qb, kt0; const bf16_t* qp; const bf16_t* kb; const bf16_t* vt;
    attn_sub(p, c, c.bid, kind, bh, qb, qp, kb, vt, kt0);
    bf16x8 qf[4]; KVRegs kr;
#pragma unroll
    for (int k4 = 0; k4 < 4; ++k4) qf[k4] = *(const bf16x8*)(qp + 32 * k4 + 8 * c.fq);
    kv_load(kr, kb, vt, kt0, c);
#pragma unroll 1
    for (int sub = c.bid; sub < 1024; sub += c.nblk) {
        int kindn, bhn, qbn, kt0n; const bf16_t* qpn; const bf16_t* kbn; const bf16_t* vtn;
        attn_sub(p, c, (sub + c.nblk < 1024) ? sub + c.nblk : sub, kindn, bhn, qbn, qpn, kbn, vtn, kt0n);
        if (kind == 0) diff_attn_item(p, c, bh >> 3, bh & 7, qb, lam, qf, kr, qpn, kbn, vtn, kt0n);
        else sb_attn_item(p, c, bh >> 3, bh & 7, qb, qf, kr, qpn, kbn, vtn, kt0n);
        kind = kindn; bh = bhn; qb = qbn;
    }
}

__device__ __forceinline__ void phase_merge(const Params& p, const Ctx& c) {
    const bf16_t* oa = (const bf16_t*)(p.ws + WS_OA); const bf16_t* ob = (const bf16_t*)(p.ws + WS_OB);
    const bf16_t* ga = (const bf16_t*)(p.ws + WS_GA); const bf16_t* gb = (const bf16_t*)(p.ws + WS_GB);
    bf16_t* mrg = (bf16_t*)(p.ws + WS_MRG);
    for (int item = c.bid; item < 32 * 16; item += c.nblk) {
        const int mt = item & 31, ntile = item >> 5;
        const int m0 = mt * 256, n0 = ntile * 128;
        f32x4 acc[8][2];
#pragma unroll 1
        for (int pass = 0; pass < 2; ++pass) {
            const bf16_t* A = pass ? ob : oa; const float* W = pass ? p.in[13] : p.in[12]; const bf16_t* G = pass ? gb : ga;
            const bf16_t* arow[4];
#pragma unroll
            for (int i = 0; i < 4; ++i) arow[i] = A + (size_t)(m0 + a_piece_row(c, i)) * 1024 + a_piece_col(c);
            const float* bptr = W + (size_t)b_k0(c) * D + n0 + 4 * b_nq(c);
            zero_acc(acc);
            gemm_mainloop<false, 1024>(acc, arow, bptr, D, c);
            float* tmp = (float*)(p.ws + WS_X1);
#pragma unroll
            for (int mi = 0; mi < 8; ++mi)
#pragma unroll
                for (int ni = 0; ni < 2; ++ni) {
                    const int row = m0 + 128 * c.wr + 16 * mi + c.fr;
                    const int col = n0 + 32 * c.wc + 16 * ni + 4 * c.fq;
                    const u32x2 gw = *(const u32x2*)(G + (size_t)row * D + col);
                    f32x4 g; g[0] = __uint_as_float(gw.x << 16); g[1] = __uint_as_float(gw.x & 0xffff0000u); g[2] = __uint_as_float(gw.y << 16); g[3] = __uint_as_float(gw.y & 0xffff0000u);
                    f32x4 v = acc[mi][ni] * g;
                    if (pass == 0) *(f32x4*)(tmp + (size_t)row * D + col) = v;
                    else {
                        v += *(const f32x4*)(tmp + (size_t)row * D + col);
                        u32x2 w; w.x = pack_bf16(v[0], v[1]); w.y = pack_bf16(v[2], v[3]);
                        *(u32x2*)(mrg + (size_t)row * D + col) = w;
                    }
                }
        }
    }
}

__device__ __forceinline__ void phase_out(const Params& p, const Ctx& c) {
    const bf16_t* mrg = (const bf16_t*)(p.ws + WS_MRG); const float* w_out = p.in[14]; const float* x = p.in[0];
    const float* mod = (const float*)(p.ws + WS_MOD);
    float* x1 = (float*)(p.ws + WS_X1);
    for (int item = c.bid; item < 32 * 16; item += c.nblk) {
        const int mt = item & 31, ntile = item >> 5;
        const int m0 = mt * 256, n0 = ntile * 128;
        const bf16_t* arow[4];
#pragma unroll
        for (int i = 0; i < 4; ++i) arow[i] = mrg + (size_t)(m0 + a_piece_row(c, i)) * D + a_piece_col(c);
        const float* bptr = w_out + (size_t)b_k0(c) * D + n0 + 4 * b_nq(c);
        f32x4 acc[8][2]; zero_acc(acc);
        gemm_mainloop<false, D>(acc, arow, bptr, D, c);
        const int b = m0 >> 11;
#pragma unroll
        for (int mi = 0; mi < 8; ++mi)
#pragma unroll
            for (int ni = 0; ni < 2; ++ni) {
                const int row = m0 + 128 * c.wr + 16 * mi + c.fr;
                const int col = n0 + 32 * c.wc + 16 * ni + 4 * c.fq;
                const f32x4 gm = *(const f32x4*)(mod + b * NMOD + 2 * D + col);
                const f32x4 xv = *(const f32x4*)(x + (size_t)row * D + col);
                *(f32x4*)(x1 + (size_t)row * D + col) = xv + gm * acc[mi][ni];
            }
    }
}

__device__ __forceinline__ void phase_norm2_route(const Params& p, const Ctx& c) {
    const float* x1 = (const float*)(p.ws + WS_X1); const float* g = p.in[15];
    const float* mod = (const float*)(p.ws + WS_MOD);
    const float* w_rg = p.in[16]; const float* b_rg = p.in[17]; const float* w_re = p.in[18]; const float* b_re = p.in[19];
    bf16_t* h2 = (bf16_t*)(p.ws + WS_H2);
    unsigned* cnt = (unsigned*)(p.ws + WS_CTL) + CW_CNT;
    int* ltok = (int*)(p.ws + WS_LTOK); float* lw = (float*)(p.ws + WS_LW);
    for (int row = c.bid * 8 + c.wid; row < NTOK; row += c.nblk * 8) {
        const int b = row >> 11;
        f32x4 v[8]; float ss = 0.f;
#pragma unroll
        for (int i = 0; i < 8; ++i) { v[i] = *(const f32x4*)(x1 + (size_t)row * D + i * 256 + c.lane * 4); ss += v[i][0] * v[i][0] + v[i][1] * v[i][1] + v[i][2] * v[i][2] + v[i][3] * v[i][3]; }
        ss = wave_sum(ss);
        const float rstd = rsqrtf(ss * (1.0f / D) + EPS);
        float gl[8];
#pragma unroll
        for (int j = 0; j < 8; ++j) gl[j] = 0.f;
#pragma unroll
        for (int i = 0; i < 8; ++i) {
            const int col = i * 256 + c.lane * 4;
            const f32x4 gg = *(const f32x4*)(g + col), sh = *(const f32x4*)(mod + b * NMOD + 3 * D + col), scl = *(const f32x4*)(mod + b * NMOD + 4 * D + col);
#pragma unroll
            for (int j = 0; j < 4; ++j) v[i][j] = (v[i][j] * rstd * gg[j]) * (1.0f + scl[j]) + sh[j];
            u32x2 w; w.x = pack_bf16(v[i][0], v[i][1]); w.y = pack_bf16(v[i][2], v[i][3]);
            *(u32x2*)(h2 + (size_t)row * D + col) = w;
#pragma unroll
            for (int j = 0; j < 4; ++j) {
                const f32x4 w0 = *(const f32x4*)(w_rg + (size_t)(col + j) * 8), w1 = *(const f32x4*)(w_rg + (size_t)(col + j) * 8 + 4);
#pragma unroll
                for (int e = 0; e < 4; ++e) { gl[e] += v[i][j] * w0[e]; gl[4 + e] += v[i][j] * w1[e]; }
            }
        }
#pragma unroll
        for (int j = 0; j < 8; ++j) gl[j] = wave_sum(gl[j]) + b_rg[j];
        int gi = 0; float gmax = gl[0];
#pragma unroll
        for (int j = 1; j < 8; ++j) if (gl[j] > gmax) { gmax = gl[j]; gi = j; }
        float gsum = 0.f;
#pragma unroll
        for (int j = 0; j < 8; ++j) gsum += __expf(gl[j] - gmax);
        const float pg = 1.0f / gsum;
        float el[8];
#pragma unroll
        for (int j = 0; j < 8; ++j) el[j] = 0.f;
#pragma unroll
        for (int i = 0; i < 8; ++i) {
            const int col = i * 256 + c.lane * 4;
#pragma unroll
            for (int j = 0; j < 4; ++j) {
                const f32x4 w0 = *(const f32x4*)(w_re + (size_t)(col + j) * 64 + gi * 8), w1 = *(const f32x4*)(w_re + (size_t)(col + j) * 64 + gi * 8 + 4);
#pragma unroll
                for (int e = 0; e < 4; ++e) { el[e] += v[i][j] * w0[e]; el[4 + e] += v[i][j] * w1[e]; }
            }
        }
#pragma unroll
        for (int j = 0; j < 8; ++j) el[j] = wave_sum(el[j]) + b_re[gi * 8 + j];
        int i1 = 0; float e1 = el[0];
#pragma unroll
        for (int j = 1; j < 8; ++j) if (el[j] > e1) { e1 = el[j]; i1 = j; }
        int i2 = -1; float e2 = -3.0e38f;
#pragma unroll
        for (int j = 0; j < 8; ++j) if (j != i1 && el[j] > e2) { e2 = el[j]; i2 = j; }
        const float r2 = __expf(e2 - e1);
        const float tp1 = 1.0f / (1.0f + r2), tp2 = r2 / (1.0f + r2);
        if (c.lane == 0) {
            const int ea = gi * 8 + i1, eb = gi * 8 + i2;
            const unsigned sa = atomicAdd(&cnt[ea], 1u), sb = atomicAdd(&cnt[eb], 1u);
            ltok[ea * NTOK + sa] = row * 2; lw[ea * NTOK + sa] = pg * tp1;
            ltok[eb * NTOK + sb] = row * 2 + 1; lw[eb * NTOK + sb] = pg * tp2;
        }
    }
}

__device__ __forceinline__ void phase_norm2_route2(const Params& p, const Ctx& c, int dummy = 0) {
    const float* x1 = (const float*)(p.ws + WS_X1); const float* g = p.in[15];
    const float* mod = (const float*)(p.ws + WS_MOD);
    const bf16_t* WtH = (const bf16_t*)(p.ws + WS_RW); const bf16_t* WtL = WtH + (size_t)NB * 80 * D; const float* cb = (const float*)(p.ws + WS_RC);
    bf16_t* h2 = (bf16_t*)(p.ws + WS_H2);
    unsigned* cnt = (unsigned*)(p.ws + WS_CTL) + CW_CNT + (dummy ? 128 : 0);
    int* ltok = (int*)(p.ws + (dummy ? WS_ACT : WS_LTOK)); float* lw = (float*)(p.ws + (dummy ? WS_ACT + (size_t)NE * NTOK * 4 : WS_LW));
    LAS float* red = (LAS float*)c.lds;
    LAS float* ssr = (LAS float*)(c.lds + 81920);
    LAS float* rs = (LAS float*)(c.lds + 81920 + 1024);
    for (int it = c.bid; it < NTOK / 32; it += c.nblk) {
        const int tok0 = it * 32, b = tok0 >> 11;
        const int ks = c.wid, i16 = c.lane & 15, kk = c.lane >> 4;
        const float* ap0 = x1 + (size_t)(tok0 + i16) * D + 256 * ks + 8 * kk;
        const float* ap1 = ap0 + (size_t)16 * D;
        const bf16_t* bph = WtH + ((size_t)b * 80 + i16) * D + 256 * ks + 8 * kk;
        const bf16_t* bpl = WtL + ((size_t)b * 80 + i16) * D + 256 * ks + 8 * kk;
        f32x4 acc[2][5];
#pragma unroll
        for (int g2 = 0; g2 < 2; ++g2)
#pragma unroll
            for (int nb = 0; nb < 5; ++nb) acc[g2][nb] = (f32x4){0.f, 0.f, 0.f, 0.f};
        float ss0 = 0.f, ss1 = 0.f;
#pragma unroll 2
        for (int kb8 = 0; kb8 < 8; ++kb8) {
            bf16x8 ah[2], al[2];
#pragma unroll
            for (int g2 = 0; g2 < 2; ++g2) {
                const float* ap = (g2 ? ap1 : ap0) + 32 * kb8;
                const f32x4 v0 = *(const f32x4*)ap, v1 = *(const f32x4*)(ap + 4);
                const float sq = v0[0] * v0[0] + v0[1] * v0[1] + v0[2] * v0[2] + v0[3] * v0[3] + v1[0] * v1[0] + v1[1] * v1[1] + v1[2] * v1[2] + v1[3] * v1[3];
                if (g2) ss1 += sq; else ss0 += sq;
                u32x4 h, l;
                h.x = pack_bf16(v0[0], v0[1]); h.y = pack_bf16(v0[2], v0[3]); h.z = pack_bf16(v1[0], v1[1]); h.w = pack_bf16(v1[2], v1[3]);
                l.x = pack_bf16(v0[0] - __uint_as_float(h.x << 16), v0[1] - __uint_as_float(h.x & 0xffff0000u));
                l.y = pack_bf16(v0[2] - __uint_as_float(h.y << 16), v0[3] - __uint_as_float(h.y & 0xffff0000u));
                l.z = pack_bf16(v1[0] - __uint_as_float(h.z << 16), v1[1] - __uint_as_float(h.z & 0xffff0000u));
                l.w = pack_bf16(v1[2] - __uint_as_float(h.w << 16), v1[3] - __uint_as_float(h.w & 0xffff0000u));
                ah[g2] = __builtin_bit_cast(bf16x8, h); al[g2] = __builtin_bit_cast(bf16x8, l);
            }
#pragma unroll
            for (int nb = 0; nb < 5; ++nb) {
                const bf16x8 bh = *(const bf16x8*)(bph + (size_t)nb * 16 * D + 32 * kb8), bl = *(const bf16x8*)(bpl + (size_t)nb * 16 * D + 32 * kb8);
#pragma unroll
                for (int g2 = 0; g2 < 2; ++g2) {
                    acc[g2][nb] = __builtin_amdgcn_mfma_f32_16x16x32_bf16(ah[g2], bh, acc[g2][nb], 0, 0, 0);
                    acc[g2][nb] = __builtin_amdgcn_mfma_f32_16x16x32_bf16(ah[g2], bl, acc[g2][nb], 0, 0, 0);
                    acc[g2][nb] = __builtin_amdgcn_mfma_f32_16x16x32_bf16(al[g2], bh, acc[g2][nb], 0, 0, 0);
                }
            }
        }
        ss0 += __shfl_xor(ss0, 16); ss0 += __shfl_xor(ss0, 32);
        ss1 += __shfl_xor(ss1, 16); ss1 += __shfl_xor(ss1, 32);
        __syncthreads();
#pragma unroll
        for (int g2 = 0; g2 < 2; ++g2)
#pragma unroll
            for (int nb = 0; nb < 5; ++nb)
#pragma unroll
                for (int r = 0; r < 4; ++r) red[(c.wid * 32 + g2 * 16 + 4 * kk + r) * 80 + nb * 16 + i16] = acc[g2][nb][r];
        if (kk == 0) { ssr[c.wid * 32 + i16] = ss0; ssr[c.wid * 32 + 16 + i16] = ss1; }
        __syncthreads();
        if (c.tid < 32) {
            const int t = c.tid;
            float ssum = 0.f;
#pragma unroll
            for (int q = 0; q < 8; ++q) ssum += ssr[q * 32 + t];
            const float rstd = rsqrtf(ssum * (1.0f / D) + EPS);
            rs[t] = rstd;
            float gl[8];
#pragma unroll
            for (int j = 0; j < 8; ++j) {
                float a = 0.f;
#pragma unroll
                for (int q = 0; q < 8; ++q) a += red[(q * 32 + t) * 80 + j];
                gl[j] = a * rstd + cb[b * 80 + j];
            }
            int gi = 0; float gmax = gl[0];
#pragma unroll
            for (int j = 1; j < 8; ++j) if (gl[j] > gmax) { gmax = gl[j]; gi = j; }
            float gsum = 0.f;
#pragma unroll
            for (int j = 0; j < 8; ++j) gsum += __expf(gl[j] - gmax);
            const float pg = 1.0f / gsum;
            float el[8];
#pragma unroll
            for (int j = 0; j < 8; ++j) {
                float a = 0.f;
#pragma unroll
                for (int q = 0; q < 8; ++q) a += red[(q * 32 + t) * 80 + 8 + gi * 8 + j];
                el[j] = a * rstd + cb[b * 80 + 8 + gi * 8 + j];
            }
            int i1 = 0; float e1 = el[0];
#pragma unroll
            for (int j = 1; j < 8; ++j) if (el[j] > e1) { e1 = el[j]; i1 = j; }
            int i2 = -1; float e2 = -3.0e38f;
#pragma unroll
            for (int j = 0; j < 8; ++j) if (j != i1 && el[j] > e2) { e2 = el[j]; i2 = j; }
            const float r2 = __expf(e2 - e1);
            const float tp1 = 1.0f / (1.0f + r2), tp2 = r2 / (1.0f + r2);
            const int row = tok0 + t;
            const int ea = gi * 8 + i1, eb = gi * 8 + i2;
            const unsigned sa = atomicAdd(&cnt[ea], 1u), sb = atomicAdd(&cnt[eb], 1u);
            ltok[ea * NTOK + sa] = row * 2; lw[ea * NTOK + sa] = pg * tp1;
            ltok[eb * NTOK + sb] = row * 2 + 1; lw[eb * NTOK + sb] = pg * tp2;
            if (!dummy) { u32x4 rec; rec.x = ((unsigned)ea << 13) | sa; rec.y = __float_as_uint(pg * tp1); rec.z = ((unsigned)eb << 13) | sb; rec.w = __float_as_uint(pg * tp2);
                *(u32x4*)(p.ws + WS_TREC + (size_t)row * 16) = rec; }
        }
        __syncthreads();
#pragma unroll 1
        for (int q = 0; q < 4; ++q) {
            const int row = tok0 + c.wid * 4 + q;
            const float rstd = rs[c.wid * 4 + q];
#pragma unroll
            for (int i = 0; i < 8; ++i) {
                const int col = i * 256 + c.lane * 4;
                const f32x4 v = *(const f32x4*)(x1 + (size_t)row * D + col);
                const f32x4 gg = *(const f32x4*)(g + col), sh = *(const f32x4*)(mod + b * NMOD + 3 * D + col), scl = *(const f32x4*)(mod + b * NMOD + 4 * D + col);
                float o[4];
#pragma unroll
                for (int j = 0; j < 4; ++j) o[j] = (v[j] * rstd * gg[j]) * (1.0f + scl[j]) + sh[j];
                u32x2 w; w.x = pack_bf16(o[0], o[1]); w.y = pack_bf16(o[2], o[3]);
                *(u32x2*)(h2 + (size_t)row * D + col) = w;
            }
        }
    }
}

constexpr int MOE_TAB = 100 * 1024;
__device__ __forceinline__ void moe_table(const Params& p, const Ctx& c) {
    const unsigned* cnt = (const unsigned*)(p.ws + WS_CTL) + CW_CNT;
    LAS int* tab = (LAS int*)(c.lds + MOE_TAB);
    __syncthreads();
    if (c.tid == 0) {
        int rp = 0;
        for (int e = 0; e < NE; ++e) { const int n = (int)cnt[e]; tab[e] = n; tab[64 + e] = rp; rp += n; }
        tab[64 + 64] = rp;
        for (int q = 0; q < 8; ++q) { int ip = 0; for (int j = 0; j < 8; ++j) { tab[256 + 16 * q + j] = ip; ip += ((tab[q + 8 * j] + 255) >> 8) * 16; } tab[256 + 16 * q + 8] = ip; }
    }
    __syncthreads();
}
__device__ __forceinline__ bool moe_next(XQueue& q, const Ctx& c, int& e, int& mt, int& ntile, int& cnt_e, int& rbase) {
    LAS int* tab = (LAS int*)(c.lds + MOE_TAB);
    while (q.v < 8) {
        const int qi = (q.x + q.v) & 7;
        const int L = next_item(q.heads + qi * 64, c);
        if (L < tab[256 + 16 * qi + 8]) {
            int j = 0;
#pragma unroll
            for (int k = 1; k < 8; ++k) if (tab[256 + 16 * qi + k] <= L) j = k;
            e = qi + 8 * j;
            while (tab[e] == 0 && j > 0) { --j; e -= 8; }
            cnt_e = tab[e]; rbase = tab[64 + e];
            const int loc = L - tab[256 + 16 * qi + j], nmt = (cnt_e + 255) >> 8;
            ntile = loc / nmt; mt = loc - ntile * nmt;
            return true;
        }
        ++q.v;
    }
    return false;
}

__device__ __forceinline__ void phase_moe1(const Params& p, const Ctx& c, int qsel = 1) {
    const bf16_t* h2 = (const bf16_t*)(p.ws + WS_H2);
    const int* ltok = (const int*)(p.ws + WS_LTOK);
    bf16_t* act = (bf16_t*)(p.ws + WS_ACT);
    const float* wg = p.in[20]; const float* wu = p.in[21];
    moe_table(p, c);
    XQueue q = xq_make(p, qsel);
    for (;;) {
        int e, mt, ntile, cnt_e, rbase;
        if (!moe_next(q, c, e, mt, ntile, cnt_e, rbase)) break;
        const int n0 = ntile * 64;
        const bf16_t* arow[4];
#pragma unroll
        for (int i = 0; i < 4; ++i) {
            const int r = mt * 256 + a_piece_row(c, i);
            const int tok = r < cnt_e ? (ltok[e * NTOK + r] >> 1) : 0;
            arow[i] = h2 + (size_t)tok * D + a_piece_col(c);
        }
        const int nq = b_nq(c), blk = nq >> 2;
        const float* wsrc = ((blk & 1) ? wu : wg) + (size_t)e * D * DE;
        const float* bptr = wsrc + (size_t)b_k0(c) * DE + n0 + 16 * (blk >> 1) + 4 * (nq & 3);
        f32x4 acc[8][2]; zero_acc(acc);
        gemm_mainloop<MOE_NT, D>(acc, arow, bptr, DE, c);
#pragma unroll
        for (int mi = 0; mi < 8; ++mi) {
            const int r = mt * 256 + 128 * c.wr + 16 * mi + c.fr;
            if (r < cnt_e) {
                const int col = n0 + 16 * c.wc + 4 * c.fq;
                float o[4];
#pragma unroll
                for (int j = 0; j < 4; ++j) { const float a = acc[mi][0][j], u = acc[mi][1][j]; o[j] = a / (1.0f + __expf(-a)) * u; }
                u32x2 w; w.x = pack_bf16(o[0], o[1]); w.y = pack_bf16(o[2], o[3]);
                *(u32x2*)(act + (size_t)(rbase + r) * DE + col) = w;
            }
        }
    }
}
__device__ __forceinline__ void phase_moe2(const Params& p, const Ctx& c, int qsel = 2) {
    const int* ltok = (const int*)(p.ws + WS_LTOK); const float* lw = (const float*)(p.ws + WS_LW);
    const bf16_t* act = (const bf16_t*)(p.ws + WS_ACT);
    float* y = (float*)(p.ws + WS_Y);
    const float* wd = p.in[22];
    moe_table(p, c);
    XQueue q = xq_make(p, qsel);
    for (;;) {
        int e, mt, ntile, cnt_e, rbase;
        if (!moe_next(q, c, e, mt, ntile, cnt_e, rbase)) break;
        const int n0 = ntile * 128;
        const bf16_t* arow[4];
#pragma unroll
        for (int i = 0; i < 4; ++i) arow[i] = act + (size_t)(rbase + mt * 256 + a_piece_row(c, i)) * DE + a_piece_col(c);
        const float* bptr = wd + (size_t)e * DE * D + (size_t)b_k0(c) * D + n0 + 4 * b_nq(c);
        f32x4 acc[8][2]; zero_acc(acc);
        gemm_mainloop<MOE_NT, DE>(acc, arow, bptr, D, c);
#pragma unroll
        for (int mi = 0; mi < 8; ++mi) {
            const int r = mt * 256 + 128 * c.wr + 16 * mi + c.fr;
            if (r < cnt_e) {
                const int ent = ltok[e * NTOK + r]; const float w = lw[e * NTOK + r];
#pragma unroll
                for (int ni = 0; ni < 2; ++ni) {
                    const int col = n0 + 32 * c.wc + 16 * ni + 4 * c.fq;
                    *(f32x4*)(y + (size_t)ent * D + col) = acc[mi][ni] * w;
                }
            }
        }
    }
}

constexpr int MOE_TAB2 = 132 * 1024;
__device__ __forceinline__ void moe_table2(const Params& p, const Ctx& c) {
    const unsigned* cnt = (const unsigned*)(p.ws + WS_CTL) + CW_CNT;
    LAS int* tab = (LAS int*)(c.lds + MOE_TAB2);
    __syncthreads();
    if (c.tid == 0) {
        int rp = 0;
        for (int e = 0; e < NE; ++e) { const int n = (int)cnt[e]; tab[e] = n; tab[64 + e] = rp; rp += n; }
        tab[64 + 64] = rp;
        for (int q = 0; q < 8; ++q) { int ip = 0; for (int j = 0; j < 8; ++j) { tab[256 + 16 * q + j] = ip; ip += ((tab[q + 8 * j] + 255) >> 8) * 8; } tab[256 + 16 * q + 8] = ip; }
    }
    __syncthreads();
}
__device__ __forceinline__ bool moe_next2(XQueue& q, const Ctx& c, int& e, int& mt, int& ntile, int& cnt_e, int& rbase) {
    LAS int* tab = (LAS int*)(c.lds + MOE_TAB2);
    while (q.v < 8) {
        const int qi = (q.x + q.v) & 7;
        const int L = next_item(q.heads + qi * 64, c);
        if (L < tab[256 + 16 * qi + 8]) {
            int j = 0;
#pragma unroll
            for (int k = 1; k < 8; ++k) if (tab[256 + 16 * qi + k] <= L) j = k;
            e = qi + 8 * j;
            while (tab[e] == 0 && j > 0) { --j; e -= 8; }
            cnt_e = tab[e]; rbase = tab[64 + e];
            const int loc = L - tab[256 + 16 * qi + j], nmt = (cnt_e + 255) >> 8;
            ntile = loc / nmt; mt = loc - ntile * nmt;
            return true;
        }
        ++q.v;
    }
    return false;
}
__device__ __forceinline__ void zero_acc4(f32x4 (&acc)[8][4]) {
#pragma unroll
    for (int mi = 0; mi < 8; ++mi)
#pragma unroll
        for (int ni = 0; ni < 4; ++ni) acc[mi][ni] = (f32x4){0.f, 0.f, 0.f, 0.f};
}
__device__ __forceinline__ void phase_moe1w(const Params& p, const Ctx& c, int qsel = 1) {
    const bf16_t* h2 = (const bf16_t*)(p.ws + WS_H2);
    const int* ltok = (const int*)(p.ws + WS_LTOK);
    bf16_t* act = (bf16_t*)(p.ws + WS_ACT);
    const float* wg = p.in[20]; const float* wu = p.in[21];
    moe_table2(p, c);
    XQueue q = xq_make(p, qsel);
    const int blk = c.lane >> 2;
    const float* wsel = (blk & 1) ? wu : wg;
    const int bcol = 16 * (blk >> 1) + 4 * (c.lane & 3);
    int e, mt, ntile, cnt_e, rbase;
    if (!moe_next2(q, c, e, mt, ntile, cnt_e, rbase)) return;
    int aoff[4];
#pragma unroll
    for (int i = 0; i < 4; ++i) { const int r = mt * 256 + a_piece_row(c, i); const int tok = r < cnt_e ? (ltok[e * NTOK + r] >> 1) : 0; aoff[i] = tok * D + a_piece_col(c); }
    const float* bptr = wsel + (size_t)e * D * DE + (size_t)(8 * c.wid) * DE + ntile * 128 + bcol;
    bool staged = false;
    f32x4 rb[8];
    for (;;) {
        int en, mtn, ntilen, cntn, rbasen;
        const bool hn = moe_next2(q, c, en, mtn, ntilen, cntn, rbasen);
        int aoffn[4]; const float* bptrn; int nrn;
        if (hn) {
#pragma unroll
            for (int i = 0; i < 4; ++i) { const int r = mtn * 256 + a_piece_row(c, i); const int tok = r < cntn ? (ltok[en * NTOK + r] >> 1) : 0; aoffn[i] = tok * D + a_piece_col(c); }
            bptrn = wsel + (size_t)en * D * DE + (size_t)(8 * c.wid) * DE + ntilen * 128 + bcol; nrn = cntn - mtn * 256;
        } else {
#pragma unroll
            for (int i = 0; i < 4; ++i) aoffn[i] = aoff[i] + (D / 64 - 1) * 64;
            bptrn = bptr + (size_t)((D / 64 - 1) * 64) * DE; nrn = cnt_e - mt * 256;
        }
        const int n0 = ntile * 128;
        f32x4 acc[8][4]; zero_acc4(acc);
        gemm_mainloop256<D>(acc, rb, h2, aoff, bptr, DE, cnt_e - mt * 256, c, staged, aoffn, bptrn, nrn, hn);
#pragma unroll
        for (int mi = 0; mi < 8; ++mi) {
            const int r = mt * 256 + 128 * c.wr + 16 * mi + c.fr;
            if (r < cnt_e) {
#pragma unroll
                for (int hh = 0; hh < 2; ++hh) {
                    const int col = n0 + 16 * (2 * c.wc + hh) + 4 * c.fq;
                    float o[4];
#pragma unroll
                    for (int j = 0; j < 4; ++j) { const float a = acc[mi][2 * hh][j], u = acc[mi][2 * hh + 1][j]; o[j] = a / (1.0f + __expf(-a)) * u; }
                    u32x2 w; w.x = pack_bf16(o[0], o[1]); w.y = pack_bf16(o[2], o[3]);
                    *(u32x2*)(act + (size_t)(rbase + r) * DE + col) = w;
                }
            }
        }
        if (!hn) break;
        e = en; mt = mtn; ntile = ntilen; cnt_e = cntn; rbase = rbasen; bptr = bptrn; staged = true;
#pragma unroll
        for (int i = 0; i < 4; ++i) aoff[i] = aoffn[i];
    }
    asm volatile("s_waitcnt vmcnt(0)" ::: "memory");
}
__device__ __forceinline__ void phase_moe2w(const Params& p, const Ctx& c, int qsel = 2) {
    const bf16_t* act = (const bf16_t*)(p.ws + WS_ACT);
    bf16_t* yb = (bf16_t*)(p.ws + WS_Y);
    const float* wd = p.in[22];
    moe_table2(p, c);
    XQueue q = xq_make(p, qsel);
    int e, mt, ntile, cnt_e, rbase;
    if (!moe_next2(q, c, e, mt, ntile, cnt_e, rbase)) return;
    int aoff[4];
#pragma unroll
    for (int i = 0; i < 4; ++i) aoff[i] = (rbase + mt * 256 + a_piece_row(c, i)) * DE + a_piece_col(c);
    const float* bptr = wd + (size_t)e * DE * D + (size_t)(8 * c.wid) * D + ntile * 256 + 4 * c.lane;
    bool staged = false;
    f32x4 rb[8];
    for (;;) {
        int en, mtn, ntilen, cntn, rbasen;
        const bool hn = moe_next2(q, c, en, mtn, ntilen, cntn, rbasen);
        int aoffn[4]; const float* bptrn; int nrn;
        if (hn) {
#pragma unroll
            for (int i = 0; i < 4; ++i) aoffn[i] = (rbasen + mtn * 256 + a_piece_row(c, i)) * DE + a_piece_col(c);
            bptrn = wd + (size_t)en * DE * D + (size_t)(8 * c.wid) * D + ntilen * 256 + 4 * c.lane; nrn = cntn - mtn * 256;
        } else {
#pragma unroll
            for (int i = 0; i < 4; ++i) aoffn[i] = aoff[i] + (DE / 64 - 1) * 64;
            bptrn = bptr + (size_t)((DE / 64 - 1) * 64) * D; nrn = cnt_e - mt * 256;
        }
        const int n0 = ntile * 256;
        f32x4 acc[8][4]; zero_acc4(acc);
        gemm_mainloop256<DE>(acc, rb, act, aoff, bptr, D, cnt_e - mt * 256, c, staged, aoffn, bptrn, nrn, hn);
#pragma unroll
        for (int mi = 0; mi < 8; ++mi) {
            const int r = mt * 256 + 128 * c.wr + 16 * mi + c.fr;
            if (r < cnt_e) {
#pragma unroll
                for (int ni = 0; ni < 4; ++ni) {
                    const int col = n0 + 64 * c.wc + 16 * ni + 4 * c.fq;
                    const f32x4 v = acc[mi][ni];
                    u32x2 pk; pk.x = pack_bf16(v[0], v[1]); pk.y = pack_bf16(v[2], v[3]);
                    *(u32x2*)(yb + (size_t)(rbase + r) * D + col) = pk;
                }
            }
        }
        if (!hn) break;
        e = en; mt = mtn; ntile = ntilen; cnt_e = cntn; rbase = rbasen; bptr = bptrn; staged = true;
#pragma unroll
        for (int i = 0; i < 4; ++i) aoff[i] = aoffn[i];
    }
    asm volatile("s_waitcnt vmcnt(0)" ::: "memory");
}

__device__ __forceinline__ void phase_final(const Params& p, const Ctx& c) {
    const float* x1 = (const float*)(p.ws + WS_X1); const bf16_t* yb = (const bf16_t*)(p.ws + WS_Y);
    const float* mod = (const float*)(p.ws + WS_MOD); const float* g = p.in[23];
    const unsigned* cnt = (const unsigned*)(p.ws + WS_CTL) + CW_CNT;
    LAS int* rpre = (LAS int*)c.lds;
    __syncthreads();
    if (c.tid == 0) { int rp = 0; for (int e = 0; e < NE; ++e) { rpre[e] = rp; rp += (int)cnt[e]; } }
    __syncthreads();
    for (int row = c.bid * 8 + c.wid; row < NTOK; row += c.nblk * 8) {
        const int b = row >> 11;
        const u32x4 rec = *(const u32x4*)(p.ws + WS_TREC + (size_t)row * 16);
        const size_t r0 = (size_t)(rpre[rec.x >> 13] + (int)(rec.x & 8191u)), r1 = (size_t)(rpre[rec.z >> 13] + (int)(rec.z & 8191u));
        const float w0 = __uint_as_float(rec.y), w1 = __uint_as_float(rec.w);
        f32x4 v[8]; float ss = 0.f;
#pragma unroll
        for (int i = 0; i < 8; ++i) {
            const int col = i * 256 + c.lane * 4;
            const f32x4 xv = *(const f32x4*)(x1 + (size_t)row * D + col);
            const u32x2 a0 = *(const u32x2*)(yb + r0 * D + col), a1 = *(const u32x2*)(yb + r1 * D + col);
            f32x4 y0, y1;
            y0[0] = __uint_as_float(a0.x << 16); y0[1] = __uint_as_float(a0.x & 0xffff0000u); y0[2] = __uint_as_float(a0.y << 16); y0[3] = __uint_as_float(a0.y & 0xffff0000u);
            y1[0] = __uint_as_float(a1.x << 16); y1[1] = __uint_as_float(a1.x & 0xffff0000u); y1[2] = __uint_as_float(a1.y << 16); y1[3] = __uint_as_float(a1.y & 0xffff0000u);
            const f32x4 gf = *(const f32x4*)(mod + b * NMOD + 5 * D + col);
            v[i] = xv + gf * (y0 * w0 + y1 * w1);
            ss += v[i][0] * v[i][0] + v[i][1] * v[i][1] + v[i][2] * v[i][2] + v[i][3] * v[i][3];
        }
        ss = wave_sum(ss);
        const float rstd = rsqrtf(ss * (1.0f / D) + EPS);
#pragma unroll
        for (int i = 0; i < 8; ++i) {
            const int col = i * 256 + c.lane * 4;
            const f32x4 gg = *(const f32x4*)(g + col);
            *(f32x4*)(p.out + (size_t)row * D + col) = v[i] * rstd * gg;
        }
    }
}

struct EpiProjIn {
    static constexpr bool PERM = false, AFTER_DRAIN = false;
    unsigned char* ws;
    __device__ __forceinline__ void operator()(const pg8::f32x4 (&acc)[2][2][4][2], const pg8::Unit& u, int wr, int wc, int fr, int fq) const {
        const int region = (u.pn * 256) >> 10;
#pragma unroll
        for (int ai = 0; ai < 2; ++ai)
#pragma unroll
            for (int m = 0; m < 4; ++m) {
                const int row = u.pm * 256 + ai * 128 + wr * 64 + m * 16 + fr;
#pragma unroll
                for (int bj = 0; bj < 2; ++bj)
#pragma unroll
                    for (int n = 0; n < 2; ++n) {
                        const int col = u.pn * 256 + bj * 128 + wc * 32 + n * 16 + 4 * fq;
                        const f32x4 a = acc[ai][bj][m][n];
                        if (region < 6) {
                            const int cin = col & 1023;
                            if (region == 2 || region == 5) {
                                bf16_t* vt = (bf16_t*)(ws + (region == 2 ? WS_VAT : WS_VBT));
                                const int b = row >> 11, s0 = row & 2047, hh = cin >> 7, d = cin & 127;
                                const int s = (s0 & ~31) | ((s0 & 12) << 1) | ((s0 & 16) >> 2) | (s0 & 3);
                                const unsigned w0 = pack_bf16(a[0], a[1]), w1 = pack_bf16(a[2], a[3]);
                                bf16_t* base = vt + ((size_t)((b * 8 + hh) * 128 + d)) * SEQ + s;
                                base[0] = (bf16_t)(w0 & 0xffff); base[SEQ] = (bf16_t)(w0 >> 16); base[2 * SEQ] = (bf16_t)(w1 & 0xffff); base[3 * SEQ] = (bf16_t)(w1 >> 16);
                            } else {
                                const size_t off = region == 0 ? WS_QA : region == 1 ? WS_KA : region == 3 ? WS_QB : WS_KB;
                                bf16_t* dst = (bf16_t*)(ws + off);
                                u32x2 w; w.x = pack_bf16(a[0], a[1]); w.y = pack_bf16(a[2], a[3]);
                                *(u32x2*)(dst + (size_t)row * 1024 + cin) = w;
                            }
                        } else {
                            bf16_t* dst = (bf16_t*)(ws + (region < 8 ? WS_GA : WS_GB));
                            const int cin = col - (region < 8 ? 6144 : 8192);
                            u32x2 w; w.x = pack_bf16(sigmoidf_(a[0]), sigmoidf_(a[1])); w.y = pack_bf16(sigmoidf_(a[2]), sigmoidf_(a[3]));
                            *(u32x2*)(dst + (size_t)row * D + cin) = w;
                        }
                    }
            }
    }
};
template <int PASS> struct EpiGate {
    static constexpr bool PERM = false, AFTER_DRAIN = false;
    const bf16_t* G; float* tmp; bf16_t* out;
    __device__ __forceinline__ void operator()(const pg8::f32x4 (&acc)[2][2][4][2], const pg8::Unit& u, int wr, int wc, int fr, int fq) const {
#pragma unroll
        for (int ai = 0; ai < 2; ++ai)
#pragma unroll
            for (int m = 0; m < 4; ++m) {
                const int row = u.pm * 256 + ai * 128 + wr * 64 + m * 16 + fr;
#pragma unroll
                for (int bj = 0; bj < 2; ++bj)
#pragma unroll
                    for (int n = 0; n < 2; ++n) {
                        const int col = u.pn * 256 + bj * 128 + wc * 32 + n * 16 + 4 * fq;
                        const u32x2 gw = *(const u32x2*)(G + (size_t)row * D + col);
                        f32x4 g; g[0] = __uint_as_float(gw.x << 16); g[1] = __uint_as_float(gw.x & 0xffff0000u); g[2] = __uint_as_float(gw.y << 16); g[3] = __uint_as_float(gw.y & 0xffff0000u);
                        f32x4 v = acc[ai][bj][m][n] * g;
                        if (PASS == 0) *(f32x4*)(tmp + (size_t)row * D + col) = v;
                        else {
                            v += *(const f32x4*)(tmp + (size_t)row * D + col);
                            u32x2 w; w.x = pack_bf16(v[0], v[1]); w.y = pack_bf16(v[2], v[3]);
                            *(u32x2*)(out + (size_t)row * D + col) = w;
                        }
                    }
            }
    }
};
struct EpiX1 {
    static constexpr bool PERM = false, AFTER_DRAIN = false;
    const float* x; const float* mod; float* x1;
    __device__ __forceinline__ void operator()(const pg8::f32x4 (&acc)[2][2][4][2], const pg8::Unit& u, int wr, int wc, int fr, int fq) const {
        const int b = (u.pm * 256) >> 11;
#pragma unroll
        for (int ai = 0; ai < 2; ++ai)
#pragma unroll
            for (int m = 0; m < 4; ++m) {
                const int row = u.pm * 256 + ai * 128 + wr * 64 + m * 16 + fr;
#pragma unroll
                for (int bj = 0; bj < 2; ++bj)
#pragma unroll
                    for (int n = 0; n < 2; ++n) {
                        const int col = u.pn * 256 + bj * 128 + wc * 32 + n * 16 + 4 * fq;
                        const f32x4 gm = *(const f32x4*)(mod + b * NMOD + 2 * D + col);
                        const f32x4 xv = *(const f32x4*)(x + (size_t)row * D + col);
                        *(f32x4*)(x1 + (size_t)row * D + col) = xv + gm * acc[ai][bj][m][n];
                    }
            }
    }
};
__device__ __forceinline__ void phase_proj_in2(const Params& p, const Ctx& c) {
    pg8::Gemm g{(const bf16_t*)(p.ws + WS_H), (const bf16_t*)(p.ws + WS_WIN_T), NTOK, INC, D};
    pg8::StaticOrder S; S.init(NTOK, INC, c.nblk, c.bid);
    EpiProjIn E{p.ws};
    pg8::gemm_phase<EpiProjIn, pg8::StaticOrder>(c.lds, g, S, E, nullptr, c.wid);
}
__device__ __forceinline__ void phase_merge2(const Params& p, const Ctx& c) {
    float* tmp = (float*)(p.ws + WS_X1);
    {
        pg8::Gemm g{(const bf16_t*)(p.ws + WS_OA), (const bf16_t*)(p.ws + WS_WPA_T), NTOK, D, 1024};
        pg8::StaticOrder S; S.init(NTOK, D, c.nblk, c.bid);
        EpiGate<0> E{(const bf16_t*)(p.ws + WS_GA), tmp, nullptr};
        pg8::gemm_phase<EpiGate<0>, pg8::StaticOrder>(c.lds, g, S, E, nullptr, c.wid);
    }
    {
        pg8::Gemm g{(const bf16_t*)(p.ws + WS_OB), (const bf16_t*)(p.ws + WS_WPB_T), NTOK, D, 1024};
        pg8::StaticOrder S; S.init(NTOK, D, c.nblk, c.bid);
        EpiGate<1> E{(const bf16_t*)(p.ws + WS_GB), tmp, (bf16_t*)(p.ws + WS_MRG)};
        pg8::gemm_phase<EpiGate<1>, pg8::StaticOrder>(c.lds, g, S, E, nullptr, c.wid);
    }
}
struct MidGate {
    static constexpr int AT = 16;
    const bf16_t* GA; const bf16_t* GB;
    __device__ __forceinline__ void operator()(pg8::f32x4 (&acc)[2][2][4][2], const pg8::Unit& u, int wr, int wc, int fr, int fq) const {
        int off0 = (u.pm * 256 + wr * 64 + fr) * D + u.pn * 256 + wc * 32 + 4 * fq;
        asm volatile("" : "+v"(off0));
#pragma unroll
        for (int ai = 0; ai < 2; ++ai)
#pragma unroll
            for (int m = 0; m < 4; ++m) {
#pragma unroll
                for (int bj = 0; bj < 2; ++bj)
#pragma unroll
                    for (int n = 0; n < 2; ++n) {
                        const int off = off0 + (ai * 128 + m * 16) * D + bj * 128 + n * 16;
                        const u32x2 a = *(const u32x2*)(GA + off), b = *(const u32x2*)(GB + off);
                        f32x4 r;
                        r[0] = __uint_as_float(a.x << 16) * __builtin_amdgcn_rcpf(__uint_as_float(b.x << 16)); r[1] = __uint_as_float(a.x & 0xffff0000u) * __builtin_amdgcn_rcpf(__uint_as_float(b.x & 0xffff0000u));
                        r[2] = __uint_as_float(a.y << 16) * __builtin_amdgcn_rcpf(__uint_as_float(b.y << 16)); r[3] = __uint_as_float(a.y & 0xffff0000u) * __builtin_amdgcn_rcpf(__uint_as_float(b.y & 0xffff0000u));
                        acc[ai][bj][m][n] *= r;
                    }
                asm volatile("" ::: "memory");
            }
    }
};
struct EpiGateB {
    static constexpr bool PERM = false, AFTER_DRAIN = false;
    const bf16_t* GB; bf16_t* out;
    __device__ __forceinline__ void operator()(const pg8::f32x4 (&acc)[2][2][4][2], const pg8::Unit& u, int wr, int wc, int fr, int fq) const {
#pragma unroll
        for (int ai = 0; ai < 2; ++ai)
#pragma unroll
            for (int m = 0; m < 4; ++m) {
                const int row = u.pm * 256 + ai * 128 + wr * 64 + m * 16 + fr;
#pragma unroll
                for (int bj = 0; bj < 2; ++bj)
#pragma unroll
                    for (int n = 0; n < 2; ++n) {
                        const int col = u.pn * 256 + bj * 128 + wc * 32 + n * 16 + 4 * fq;
                        const u32x2 gw = *(const u32x2*)(GB + (size_t)row * D + col);
                        f32x4 g; g[0] = __uint_as_float(gw.x << 16); g[1] = __uint_as_float(gw.x & 0xffff0000u); g[2] = __uint_as_float(gw.y << 16); g[3] = __uint_as_float(gw.y & 0xffff0000u);
                        const f32x4 v = acc[ai][bj][m][n] * g;
                        u32x2 w; w.x = pack_bf16(v[0], v[1]); w.y = pack_bf16(v[2], v[3]);
                        *(u32x2*)(out + (size_t)row * D + col) = w;
                    }
            }
    }
};
__device__ __forceinline__ void phase_merge3(const Params& p, const Ctx& c) {
    pg8::Gemm g{(const bf16_t*)(p.ws + WS_OA), (const bf16_t*)(p.ws + WS_WPA_T), NTOK, D, D};
    pg8::StaticOrder S; S.init(NTOK, D, c.nblk, c.bid);
    EpiGateB E{(const bf16_t*)(p.ws + WS_GB), (bf16_t*)(p.ws + WS_MRG)};
    MidGate M{(const bf16_t*)(p.ws + WS_GA), (const bf16_t*)(p.ws + WS_GB)};
    pg8::gemm_phase<EpiGateB, pg8::StaticOrder, false, MidGate>(c.lds, g, S, E, nullptr, c.wid, M);
}
__device__ __forceinline__ void phase_out2(const Params& p, const Ctx& c) {
    pg8::Gemm g{(const bf16_t*)(p.ws + WS_MRG), (const bf16_t*)(p.ws + WS_WOUT_T), NTOK, D, D};
    pg8::StaticOrder S; S.init(NTOK, D, c.nblk, c.bid);
    EpiX1 E{p.in[0], (const float*)(p.ws + WS_MOD), (float*)(p.ws + WS_X1)};
    pg8::gemm_phase<EpiX1, pg8::StaticOrder>(c.lds, g, S, E, nullptr, c.wid);
}

constexpr int LDS_BYTES = 160 * 1024;
__global__ void __launch_bounds__(512, 2) mk_fwd(Params p) {
    extern __shared__ __attribute__((aligned(16))) unsigned char smem[];
    LAS unsigned char* ldsb = (LAS unsigned char*)smem;
    Ctx c; c.lds = ldsb; c.tid = threadIdx.x; c.lane = c.tid & 63; c.wid = __builtin_amdgcn_readfirstlane(c.tid >> 6); c.wr = c.wid >> 2; c.wc = c.wid & 3;
    c.fr = c.lane & 15; c.fq = c.lane >> 4; c.bid = blockIdx.x; c.nblk = gridDim.x;
#define MKCTX() do {} while (0)
#define LEADER() (c.tid == 0)
    volatile LAS unsigned* bst = (volatile LAS unsigned*)(ldsb + LDS_BYTES - 32);
    if (LEADER()) { bst[0] = 0u; bst[1] = 0u; }
    __syncthreads();
    unsigned* barw = (unsigned*)(p.ws + WS_CTL);
    XcdBarrier bar; bar.bar = barw; bar.x = 0; bar.st = bst;
#if !MK_SPLIT
    bar = xcd_barrier_post(barw, bst, LEADER());
#define GRID_BAR() xcd_barrier(bar, LEADER())
#else
#define GRID_BAR() do {} while (0)
#endif
    const int lo = p.ph_lo, hi = p.ph_hi;
#define IN(k) (lo <= (k) && (k) < hi)
#define BOTH(k) (IN(k) && IN((k) + 1))
#define DUP(k) ((DUP_MASK >> (k)) & 1)
    if (IN(0)) { MKCTX(); phase_mod(p, c); phase_convert(p, c); if (DUP(0)) { GRID_BAR(); phase_mod(p, c); phase_convert(p, c); } if (BOTH(0)) GRID_BAR(); }
    if (IN(1)) { MKCTX(); phase_norm1(p, c); phase_router_prep(p, c); if (DUP(1)) { GRID_BAR(); phase_norm1(p, c); } if (BOTH(1)) GRID_BAR(); }
    if (IN(2)) { MKCTX(); phase_proj_in2(p, c); if (DUP(2)) { GRID_BAR(); phase_proj_in2(p, c); } if (BOTH(2)) GRID_BAR(); }
    if (IN(3)) { MKCTX(); phase_attn(p, c, 0); if (DUP(3)) { GRID_BAR(); phase_attn(p, c, 3); } if (BOTH(3)) GRID_BAR(); }
    if (IN(4)) { MKCTX(); phase_merge3(p, c); if (DUP(4)) { GRID_BAR(); phase_merge3(p, c); } if (BOTH(4)) GRID_BAR(); }
    if (IN(5)) { MKCTX(); phase_out2(p, c); if (DUP(5)) { GRID_BAR(); phase_out2(p, c); } if (BOTH(5)) GRID_BAR(); }
    if (IN(6)) { MKCTX(); phase_norm2_route2(p, c); if (DUP(6)) { GRID_BAR(); phase_norm2_route2(p, c, 1); } if (BOTH(6)) GRID_BAR(); }
    if (IN(7)) { MKCTX(); phase_moe1w(p, c, 1); if (DUP(7)) { GRID_BAR(); phase_moe1w(p, c, 4); } if (BOTH(7)) GRID_BAR(); }
    if (IN(8)) { MKCTX(); phase_moe2w(p, c, 2); if (DUP(8)) { GRID_BAR(); phase_moe2w(p, c, 5); } if (BOTH(8)) GRID_BAR(); }
    if (IN(9)) { MKCTX(); phase_final(p, c); if (DUP(9)) { GRID_BAR(); phase_final(p, c); } }
}

extern "C" void kernel_launch(void* const* d_in, const int* in_sizes, int n_in, void* d_out, int out_size, void* d_ws, size_t ws_size, hipStream_t stream) {
    static int grid = 0;
    if (grid == 0) {
        if (n_in != 24 || out_size != NTOK * D || ws_size < WS_END) { fprintf(stderr, "kernel_launch: unexpected shapes (n_in %d out %d ws %zu need %zu)\n", n_in, out_size, ws_size, (size_t)WS_END); grid = -1; return; }
        int dev = 0, cus = 0, per_cu = 0;
        (void)hipGetDevice(&dev); (void)hipDeviceGetAttribute(&cus, hipDeviceAttributeMultiprocessorCount, dev);
        if (hipFuncSetAttribute((const void*)mk_fwd, hipFuncAttributeMaxDynamicSharedMemorySize, LDS_BYTES) != hipSuccess) { fprintf(stderr, "kernel_launch: hipFuncSetAttribute failed\n"); grid = -1; return; }
        if (hipOccupancyMaxActiveBlocksPerMultiprocessor(&per_cu, (const void*)mk_fwd, 512, LDS_BYTES) != hipSuccess || per_cu < 1) { fprintf(stderr, "kernel_launch: occupancy query says %d\n", per_cu); }
        (void)hipGetLastError();
        grid = cus > 0 ? cus : 256;
    }
    if (grid < 0) return;
    (void)hipMemsetAsync((char*)d_ws + WS_CTL, 0, CTL_BYTES, stream);
    Params p{};
    for (int i = 0; i < 24; ++i) p.in[i] = (const float*)d_in[i];
    p.out = (float*)d_out; p.ws = (unsigned char*)d_ws;
#if MK_SPLIT
    for (int ph = 0; ph < NPHASE; ++ph) { p.ph_lo = ph; p.ph_hi = ph + 1; hipLaunchKernelGGL(mk_fwd, dim3(grid), dim3(512), LDS_BYTES, stream, p); }
#else
    p.ph_lo = 0; p.ph_hi = NPHASE;
    hipLaunchKernelGGL(mk_fwd, dim3(grid), dim3(512), LDS_BYTES, stream, p);
#endif
}
```

```cpp
#include <hip/hip_runtime.h>
#include <stdint.h>
#include <stdio.h>

#ifndef DUP_MASK
#define DUP_MASK 0
#endif
#ifndef MOE_NT
#define MOE_NT false
#endif
#ifndef MK_SPLIT
#define MK_SPLIT 0
#endif

typedef unsigned short bf16_t;
typedef short bf16x8 __attribute__((ext_vector_type(8)));
typedef short bf16x4 __attribute__((ext_vector_type(4)));
typedef float f32x4 __attribute__((ext_vector_type(4)));
typedef unsigned u32x4 __attribute__((ext_vector_type(4)));
typedef unsigned u32x2 __attribute__((ext_vector_type(2)));
#define LAS __attribute__((address_space(3)))

constexpr int D = 2048, NB = 4, SEQ = 2048, NTOK = NB * SEQ;
constexpr int INC = 10240, NMOD = 6 * D;
constexpr int NE = 64, DE = 1024;
constexpr float EPS = 1e-6f;
constexpr int NPHASE = 10;

constexpr size_t WS_CTL = 0;
constexpr size_t CTL_BYTES = 32768;
constexpr size_t CW_CNT = 4096;
constexpr size_t CW_Q = 4096 + 256;
constexpr size_t WS_MOD = WS_CTL + CTL_BYTES;
constexpr size_t WS_H = WS_MOD + (size_t)NB * NMOD * 4;
constexpr size_t WS_QA = WS_H + (size_t)NTOK * D * 2;
constexpr size_t WS_KA = WS_QA + (size_t)NTOK * 1024 * 2;
constexpr size_t WS_VAT = WS_KA + (size_t)NTOK * 1024 * 2;
constexpr size_t WS_QB = WS_VAT + (size_t)NTOK * 1024 * 2;
constexpr size_t WS_KB = WS_QB + (size_t)NTOK * 1024 * 2;
constexpr size_t WS_VBT = WS_KB + (size_t)NTOK * 1024 * 2;
constexpr size_t WS_GA = WS_VBT + (size_t)NTOK * 1024 * 2;
constexpr size_t WS_GB = WS_GA + (size_t)NTOK * D * 2;
constexpr size_t WS_OA = WS_GB + (size_t)NTOK * D * 2;
constexpr size_t WS_OB = WS_OA + (size_t)NTOK * 1024 * 2;
constexpr size_t WS_MRG = WS_OB + (size_t)NTOK * 1024 * 2;
constexpr size_t WS_X1 = WS_MRG + (size_t)NTOK * D * 2;
constexpr size_t WS_H2 = WS_X1 + (size_t)NTOK * D * 4;
constexpr size_t WS_LTOK = WS_H2 + (size_t)NTOK * D * 2;
constexpr size_t WS_LW = WS_LTOK + (size_t)NE * NTOK * 4;
constexpr size_t WS_ACT = WS_LW + (size_t)NE * NTOK * 4;
constexpr size_t WS_Y = WS_ACT + (size_t)(2 * NTOK + 512) * DE * 2;
constexpr size_t WS_WIN_T = WS_Y + (size_t)2 * NTOK * D * 4;
constexpr size_t WS_WPA_T = WS_WIN_T + (size_t)INC * D * 2;
constexpr size_t WS_WPB_T = WS_WPA_T + (size_t)D * 1024 * 2;
constexpr size_t WS_WOUT_T = WS_WPB_T + (size_t)D * 1024 * 2;
constexpr size_t WS_RW = WS_WOUT_T + (size_t)D * D * 2;
constexpr size_t WS_RC = WS_RW + (size_t)NB * 80 * D * 4;
constexpr size_t WS_TREC = WS_RC + 4096;
constexpr size_t WS_END = WS_TREC + (size_t)NTOK * 16;

#define XB_TMO      128
#define XB_XCNT(j)  (256  + 64 * (j))
#define XB_XSUB(j)  (1280 + 64 * (j))
#define XB_XGEN(j)  (2304 + 64 * (j))
#define XB_TOP      3328
#define XB_TOPGEN   3392
#define XCD_BAR_WORDS 3456
#define XB_SPIN_CAP (1u << 24)

__device__ __forceinline__ unsigned xb_ld(unsigned* p)              { return __hip_atomic_load(p, __ATOMIC_RELAXED, __HIP_MEMORY_SCOPE_AGENT); }
__device__ __forceinline__ unsigned xb_add(unsigned* p, unsigned v) { return __hip_atomic_fetch_add(p, v, __ATOMIC_RELAXED, __HIP_MEMORY_SCOPE_AGENT); }
__device__ __forceinline__ unsigned xb_xcc_id() { return (unsigned)__builtin_amdgcn_s_getreg((3 << 11) | 20) & 0xFu; }
#define XB_SPIN(cond, bar) do { unsigned _sp = 0; while (cond) { __builtin_amdgcn_s_sleep(1); \
    if ((++_sp & 255u) == 0u) { if (xb_ld(&(bar)[XB_TMO])) break; if (_sp > XB_SPIN_CAP) { atomicAdd(&(bar)[XB_TMO], 1u); break; } } } } while (0)

struct XcdBarrier { unsigned* bar; unsigned x; volatile LAS unsigned* st; };

__device__ __forceinline__ XcdBarrier xcd_barrier_post(unsigned* bar, volatile LAS unsigned* st, bool leader) {
    XcdBarrier b; b.bar = bar; b.x = xb_xcc_id(); b.st = st;
    if (leader) (void)xb_add(&bar[XB_XCNT(b.x)], 1u);
    return b;
}
__device__ __forceinline__ void xcd_barrier_complete(unsigned* bar, unsigned x, unsigned& nloc, unsigned& nx) {
    const unsigned G = gridDim.x * gridDim.y * gridDim.z;
    unsigned sum, cnt, mine, sp = 0u;
    for (;;) {
        sum = 0u; cnt = 0u; mine = 0u;
#pragma unroll
        for (unsigned j = 0; j < 16; ++j) { const unsigned c = xb_ld(&bar[XB_XCNT(j)]); sum += c; cnt += (c > 0u) ? 1u : 0u; mine = (j == x) ? c : mine; }
        if (sum == G) break;
        __builtin_amdgcn_s_sleep(1);
        if ((++sp & 255u) == 0u) { if (xb_ld(&bar[XB_TMO])) break; if (sp > XB_SPIN_CAP) { atomicAdd(&bar[XB_TMO], 1u); break; } }
    }
    nloc = mine > 0u ? mine : 1u; nx = cnt > 0u ? cnt : 1u;
}
__device__ __forceinline__ void xcd_barrier(const XcdBarrier& b, bool leader) {
    asm volatile("s_waitcnt vmcnt(0)" ::: "memory");
    __syncthreads();
    if (leader) {
        unsigned* bar = b.bar;
        __builtin_amdgcn_s_waitcnt(0);
        unsigned nloc = b.st[0], nx = b.st[1];
        if (nloc == 0u) { xcd_barrier_complete(bar, b.x, nloc, nx); b.st[0] = nloc; b.st[1] = nx; }
        const unsigned old = xb_add(&bar[XB_XSUB(b.x)], 1u);
        const unsigned gen = old / nloc;
        if (old + 1u == (gen + 1u) * nloc) {
            __builtin_amdgcn_fence(__ATOMIC_RELEASE, "agent");
            asm volatile("s_waitcnt vmcnt(0)" ::: "memory");
            const unsigned og = xb_add(&bar[XB_TOP], 1u);
            const unsigned tg = og / nx;
            if (og + 1u == (tg + 1u) * nx) xb_add(&bar[XB_TOPGEN], 1u);
            else XB_SPIN(xb_ld(&bar[XB_TOPGEN]) == tg, bar);
            __builtin_amdgcn_fence(__ATOMIC_ACQUIRE, "agent");
            xb_add(&bar[XB_XGEN(b.x)], 1u);
            asm volatile("s_waitcnt vmcnt(0)" ::: "memory");
        } else {
            XB_SPIN(xb_ld(&bar[XB_XGEN(b.x)]) == gen, bar);
            __builtin_amdgcn_fence(__ATOMIC_ACQUIRE, "agent");
            asm volatile("s_waitcnt vmcnt(0)" ::: "memory");
        }
    }
    __syncthreads();
}

typedef __bf16 bf16v2_t __attribute__((ext_vector_type(2)));
typedef float f32x2 __attribute__((ext_vector_type(2)));
__device__ __forceinline__ unsigned pack_bf16(float lo, float hi) {
    const f32x2 v = {lo, hi};
    return __builtin_bit_cast(unsigned, __builtin_convertvector(v, bf16v2_t));
}
__device__ __forceinline__ float wave_sum(float v) {
#pragma unroll
    for (int o = 32; o > 0; o >>= 1) v += __shfl_xor(v, o);
    return v;
}
__device__ __forceinline__ float xmax16(float v) { const auto r = __builtin_amdgcn_permlane16_swap(__float_as_uint(v), __float_as_uint(v), false, false); return fmaxf(__uint_as_float(r[0]), __uint_as_float(r[1])); }
__device__ __forceinline__ float xmax32(float v) { const auto r = __builtin_amdgcn_permlane32_swap(__float_as_uint(v), __float_as_uint(v), false, false); return fmaxf(__uint_as_float(r[0]), __uint_as_float(r[1])); }
__device__ __forceinline__ float xsum16(float v) { const auto r = __builtin_amdgcn_permlane16_swap(__float_as_uint(v), __float_as_uint(v), false, false); return __uint_as_float(r[0]) + __uint_as_float(r[1]); }
__device__ __forceinline__ float xsum32(float v) { const auto r = __builtin_amdgcn_permlane32_swap(__float_as_uint(v), __float_as_uint(v), false, false); return __uint_as_float(r[0]) + __uint_as_float(r[1]); }
__device__ __forceinline__ float sigmoidf_(float x) { return 1.0f / (1.0f + __expf(-x)); }

__device__ __forceinline__ int lane_id_fresh() { int l; asm volatile("v_mbcnt_lo_u32_b32 %0, -1, 0\n\tv_mbcnt_hi_u32_b32 %0, -1, %0" : "=v"(l)); return l; }
struct Params { const float* in[24]; float* out; unsigned char* ws; int ph_lo, ph_hi; };

struct Ctx {
    int tid, lane, wid, wr, wc, fr, fq, bid, nblk;
    LAS unsigned char* lds;
};

__device__ __forceinline__ int next_item(unsigned* ctr, const Ctx& c) {
    LAS int* slot = (LAS int*)(c.lds + 160 * 1024 - 64);
    __syncthreads();
    if (c.tid == 0) *slot = (int)__hip_atomic_fetch_add(ctr, 1u, __ATOMIC_RELAXED, __HIP_MEMORY_SCOPE_AGENT);
    __syncthreads();
    return *slot;
}

struct XQueue { unsigned* heads; int x, v; };
__device__ __forceinline__ XQueue xq_make(const Params& p, int qsel) { XQueue q; q.heads = (unsigned*)(p.ws + WS_CTL) + CW_Q + qsel * 512; q.x = (int)(xb_xcc_id() & 7u); q.v = 0; return q; }
__device__ __forceinline__ bool xq_next(XQueue& q, int per_tile, int ntiles, const Ctx& c, int& tile, int& sub) {
    while (q.v < 8) {
        const int qi = (q.x + q.v) & 7;
        const int L = next_item(q.heads + qi * 64, c);
        const int t = qi + 8 * (L / per_tile);
        if (t < ntiles) { tile = t; sub = L % per_tile; return true; }
        ++q.v;
    }
    return false;
}

namespace pg8 {
#define PG8_LAS __attribute__((address_space(3)))
typedef unsigned short bf16_t;
typedef short bf16x8 __attribute__((ext_vector_type(8)));
typedef float f32x4 __attribute__((ext_vector_type(4)));
typedef unsigned u32x4 __attribute__((ext_vector_type(4)));
constexpr int BM = 256, BK = 64, HALF = 128, HTB = HALF * BK * 2  , STAGE_BYTES = 8 * HTB, NXCD = 8, WGM = 8;

__host__ __device__ __forceinline__ int lds_byte(int r, int c) { const int st = (r >> 4) * 2 + (c >> 5), rr = r & 15, cc = c & 31, ob = rr * 64 + cc * 2; return st * 1024 + (ob ^ (((ob >> 9) & 1) << 5)); }
__host__ __device__ __forceinline__ void stage_rc(int b, int& R, int& C) { const int st = b / 1024, sb = b % 1024, swz = sb ^ (((sb >> 9) & 1) << 5); R = (st >> 1) * 16 + swz / 64; C = (st & 1) * 32 + (swz % 64) / 2; }
__host__ __device__ __forceinline__ int perm32(int rho) { const int n = rho >> 4, i = rho & 15; return 8 * (i >> 2) + 4 * n + (i & 3); }

struct Unit { int pm, pn; };
struct Gemm { const bf16_t* A; const bf16_t* Bt; int M, N, K; };

struct StaticOrder {
    int nM, nN, nwg, G, c;
    __host__ __device__ void init(int M, int N, int G_, int c_) { nM = M / BM; nN = N / BM; nwg = nM * nN; G = G_; c = c_; }
    __host__ __device__ bool next(int i, Unit& u) const {
        const long L = (long)i * G + c; if (L >= nwg) return false;
        int wgid = (int)L; { const int q = nwg / NXCD, r = nwg % NXCD, xcd = wgid % NXCD, off = wgid / NXCD; wgid = (xcd < r ? xcd * (q + 1) : r * (q + 1) + (xcd - r) * q) + off; }
        const int nig = WGM * nN, gid = wgid / nig, fm = gid * WGM, gsz = (nM - fm) < WGM ? (nM - fm) : WGM;
        u.pm = fm + ((wgid % nig) % gsz); u.pn = (wgid % nig) / gsz; return true;
    }
    __device__ __forceinline__ void a_ready(const Unit&) const {}
    __device__ __forceinline__ void done(const Unit&) const {}
};
struct NoMid { static constexpr int AT = -1; __device__ __forceinline__ void operator()(f32x4 (&)[2][2][4][2], const Unit&, int, int, int, int) const {} };
template <class Epi, class Sched, bool STAMP = false, class Mid = NoMid>
__device__ __forceinline__ void gemm_phase(PG8_LAS unsigned char* lds, const Gemm g, const Sched& S, const Epi& E, unsigned long long* stamps, const int wid_in, const Mid& MH = Mid()) {
    const int wid = __builtin_amdgcn_readfirstlane(wid_in), lane = lane_id_fresh(), tid = wid * 64 + lane, wr = wid >> 2, wc = wid & 3, fr = lane & 15, fq = lane >> 4;
    const int K = g.K, nt = K / BK;
    int ts_lo = 0, ts_hi = 0, nts = 0; const unsigned long long rt_entry = STAMP ? (unsigned long long)wall_clock64() : 0ull;
#define PG8_STAMP() do { if (STAMP && wid == 0 && nts < 64) { const unsigned long long _c = (unsigned long long)clock64(); \
        ts_lo = (lane == nts) ? (int)(unsigned)_c : ts_lo; ts_hi = (lane == nts) ? (int)(unsigned)(_c >> 32) : ts_hi; ++nts; } } while (0)
    PG8_STAMP();
    unsigned voffA[2], voffB[2];
#pragma unroll
    for (int i = 0; i < 2; ++i) { int R, C; stage_rc(tid * 16 + i * 8192, R, C); const int Rb = Epi::PERM ? ((R & ~31) + perm32(R & 31)) : R;
        voffA[i] = (unsigned)(R * K + C) * 2u; voffB[i] = (unsigned)(Rb * K + C) * 2u; }
    const size_t kstep = (size_t)(BK * 2);
    const size_t hstep = (size_t)HALF * K * 2;
    const size_t tstep = 2 * hstep;
    const unsigned ldsw = (unsigned)wid * 1024u;
    const int aoff = lds_byte(wr * 64 + fr, fq * 8), boff = lds_byte(wc * 32 + fr, fq * 8);
#define PG8_SA(b, h) (((b) * 2 + (h)) * HTB)
#define PG8_SB(b, h) ((4 + (b) * 2 + (h)) * HTB)
#define PG8_STAGE(bufoff, gbase, voff) do { _Pragma("unroll") for (int _i = 0; _i < 2; ++_i) \
        __builtin_amdgcn_global_load_lds((const unsigned*)((const char*)(gbase) + (voff)[_i]), (PG8_LAS unsigned*)(lds + (bufoff) + ldsw + _i * 8192), 16, 0, 0); } while (0)
#define PG8_LDA(dst, b, h) do { _Pragma("unroll") for (int m = 0; m < 4; ++m) _Pragma("unroll") for (int k = 0; k < 2; ++k) dst[m][k] = *(const PG8_LAS bf16x8*)(lds + PG8_SA(b, h) + aoff + m * 2048 + k * 1024); } while (0)
#define PG8_LDB(dst, b, h) do { _Pragma("unroll") for (int n = 0; n < 2; ++n) _Pragma("unroll") for (int k = 0; k < 2; ++k) dst[n][k] = *(const PG8_LAS bf16x8*)(lds + PG8_SB(b, h) + boff + n * 2048 + k * 1024); } while (0)
#define PG8_MMA(ai, bj, At, Bt) do { __builtin_amdgcn_s_setprio(1); _Pragma("unroll") for (int m = 0; m < 4; ++m) _Pragma("unroll") for (int n = 0; n < 2; ++n) _Pragma("unroll") for (int k = 0; k < 2; ++k) \
        acc[ai][bj][m][n] = __builtin_amdgcn_mfma_f32_16x16x32_bf16(Bt[n][k], At[m][k], acc[ai][bj][m][n], 0, 0, 0); __builtin_amdgcn_s_setprio(0); } while (0)
#define PG8_WAIT_V(n) asm volatile("s_waitcnt vmcnt(" #n ")" ::: "memory")
#define PG8_WAIT_L(n) asm volatile("s_waitcnt lgkmcnt(" #n ")" ::: "memory")
#define PG8_BAR __builtin_amdgcn_s_barrier()
#define PG8_SCHED __builtin_amdgcn_sched_barrier(0)
    Unit cur, nxt; int ui = 0;
    if (!S.next(0, cur)) return;
    f32x4 acc[2][2][4][2];
#pragma unroll
    for (int a = 0; a < 2; ++a)
#pragma unroll
        for (int b = 0; b < 2; ++b)
#pragma unroll
            for (int m = 0; m < 4; ++m)
#pragma unroll
                for (int n = 0; n < 2; ++n) acc[a][b][m][n] = (f32x4){0.f, 0.f, 0.f, 0.f};
    bf16x8 At[4][2], B0[2][2], B1[2][2];
    const char* cA = (const char*)g.A + (size_t)cur.pm * tstep; const char* cB = (const char*)g.Bt + (size_t)cur.pn * tstep;
    S.a_ready(cur);
    PG8_STAGE(PG8_SB(0, 0), cB, voffB); PG8_STAGE(PG8_SA(0, 0), cA, voffA); PG8_STAGE(PG8_SB(0, 1), cB + hstep, voffB); PG8_STAGE(PG8_SA(0, 1), cA + hstep, voffA);
    if (wr == 1) PG8_BAR;
    PG8_WAIT_V(4); PG8_BAR;
    PG8_STAGE(PG8_SB(1, 0), cB + kstep, voffB); PG8_STAGE(PG8_SA(1, 0), cA + kstep, voffA); PG8_STAGE(PG8_SB(1, 1), cB + hstep + kstep, voffB);
    PG8_WAIT_V(6); PG8_BAR;
    PG8_STAMP();
    for (;;) {
        const bool has_next = S.next(ui + 1, nxt);
        const char* nA = has_next ? (const char*)g.A + (size_t)nxt.pm * tstep : cA; const char* nB = has_next ? (const char*)g.Bt + (size_t)nxt.pn * tstep : cB;
        for (int t = 0; t < nt; t += 2) {
            if (Mid::AT >= 0 && t == Mid::AT) MH(acc, cur, wr, wc, fr, fq);
            const bool last = (t == nt - 2);
            const char* a1 = cA + (size_t)(t + 1) * kstep;
            const char* a2 = last ? nA : cA + (size_t)(t + 2) * kstep; const char* b2 = last ? nB : cB + (size_t)(t + 2) * kstep;
            const char* a3 = a2 + kstep; const char* b3 = b2 + kstep;
            if (last && has_next) S.a_ready(nxt);
            PG8_LDB(B0, 0, 0); PG8_SCHED; PG8_LDA(At, 0, 0); PG8_STAGE(PG8_SA(1, 1), a1 + hstep, voffA);
            PG8_WAIT_L(8); PG8_BAR; PG8_WAIT_L(0); PG8_MMA(0, 0, At, B0); PG8_BAR; PG8_SCHED;
            PG8_LDB(B1, 0, 1); PG8_STAGE(PG8_SB(0, 0), b2, voffB);
            PG8_BAR; PG8_WAIT_L(0); PG8_MMA(0, 1, At, B1); PG8_BAR;
            PG8_LDA(At, 0, 1); PG8_STAGE(PG8_SA(0, 0), a2, voffA);
            PG8_BAR; PG8_WAIT_L(0); PG8_MMA(1, 0, At, B0); PG8_BAR; PG8_SCHED;
            PG8_STAGE(PG8_SB(0, 1), b2 + hstep, voffB);
            PG8_WAIT_V(6); PG8_BAR; PG8_MMA(1, 1, At, B1); PG8_BAR;
            PG8_LDB(B0, 1, 0); PG8_SCHED; PG8_LDA(At, 1, 0); PG8_STAGE(PG8_SA(0, 1), a2 + hstep, voffA);
            PG8_WAIT_L(8); PG8_BAR; PG8_WAIT_L(0); PG8_MMA(0, 0, At, B0); PG8_BAR; PG8_SCHED;
            PG8_LDB(B1, 1, 1); PG8_STAGE(PG8_SB(1, 0), b3, voffB);
            PG8_BAR; PG8_WAIT_L(0); PG8_MMA(0, 1, At, B1); PG8_BAR;
            PG8_LDA(At, 1, 1); PG8_STAGE(PG8_SA(1, 0), a3, voffA);
            PG8_BAR; PG8_WAIT_L(0); PG8_MMA(1, 0, At, B0); PG8_BAR; PG8_SCHED;
            PG8_STAGE(PG8_SB(1, 1), b3 + hstep, voffB);
            PG8_WAIT_V(6); PG8_BAR; PG8_MMA(1, 1, At, B1); PG8_BAR;
        }
        PG8_STAMP();
        if constexpr (!Epi::AFTER_DRAIN) { E(acc, cur, wr, wc, fr, fq); S.done(cur); }
        PG8_STAMP();
        if (!has_next) break;
#pragma unroll
        for (int a = 0; a < 2; ++a)
#pragma unroll
            for (int b = 0; b < 2; ++b)
#pragma unroll
                for (int m = 0; m < 4; ++m)
#pragma unroll
                    for (int n = 0; n < 2; ++n) acc[a][b][m][n] = (f32x4){0.f, 0.f, 0.f, 0.f};
        cur = nxt; cA = nA; cB = nB; ++ui;
    }
    PG8_WAIT_V(0);
    if (wr == 0) PG8_BAR;
    PG8_BAR;
    if constexpr (Epi::AFTER_DRAIN) { E.fused(acc, cur, wr, wc, fr, fq, lds, wid, lane); S.done(cur); }
    PG8_STAMP();
    if (STAMP && wid == 0) { stamps[lane] = lane < nts ? (((unsigned long long)(unsigned)ts_hi << 32) | (unsigned)ts_lo) : 0ull;
        if (lane == 62) stamps[62] = rt_entry; if (lane == 63) stamps[63] = (unsigned long long)wall_clock64(); }
#undef PG8_STAMP
#undef PG8_SA
#undef PG8_SB
#undef PG8_STAGE
#undef PG8_LDA
#undef PG8_LDB
#undef PG8_MMA
#undef PG8_WAIT_V
#undef PG8_WAIT_L
#undef PG8_BAR
#undef PG8_SCHED
}
}

constexpr int G_STAGE = 49152, G_BOFF = 32768;
template <bool NTB, int K>
__device__ __forceinline__ void gemm_mainloop(f32x4 (&acc)[8][2], const bf16_t* const (&arow)[4], const float* bptr, const int ldb, const Ctx& c) {
    const int lane = c.lane, wid = c.wid;
    constexpr int nt = K >> 6;
    const int half = lane & 1, nq = ((lane >> 1) & 7) | ((lane >> 4) << 3);
    int b_wr[4];
#pragma unroll
    for (int j = 0; j < 4; ++j) { const int n = 4 * nq + j; b_wr[j] = G_BOFF + n * 128 + ((wid ^ ((n >> 1) & 7)) << 4) + half * 8; }
    const int a_wr = wid * 4096 + lane * 16;
    const int fr = c.fr, fq = c.fq;
    int a_rd[2], b_rd[2][2];
#pragma unroll
    for (int kb = 0; kb < 2; ++kb) {
        a_rd[kb] = (128 * c.wr + fr) * 128 + ((((4 * kb + fq) ^ (fr & 7))) << 4);
#pragma unroll
        for (int ni = 0; ni < 2; ++ni) { const int n = 32 * c.wc + 16 * ni + fr; b_rd[kb][ni] = G_BOFF + n * 128 + (((4 * kb + fq) ^ ((n >> 1) & 7)) << 4); }
    }
    u32x4 ra[4]; f32x4 rb0[4], rb1[4];
    bf16x8 A0[8], A1[8], B0[2], B1[2];
#define G_LOADA(T) do { _Pragma("unroll") for (int i = 0; i < 4; ++i) ra[i] = *(const u32x4*)(arow[i] + (T) * 64); } while (0)
#define G_LOADB(RB, T) do { _Pragma("unroll") for (int i = 0; i < 4; ++i) { \
        if (NTB) RB[i] = __builtin_nontemporal_load((const f32x4*)(bptr + (size_t)((T) * 64 + i) * ldb)); else RB[i] = *(const f32x4*)(bptr + (size_t)((T) * 64 + i) * ldb); } } while (0)
#define G_WRITE(ST, RB) do { _Pragma("unroll") for (int i = 0; i < 4; ++i) *(LAS u32x4*)((ST) + a_wr + i * 1024) = ra[i]; \
        _Pragma("unroll") for (int j = 0; j < 4; ++j) { u32x2 w; w.x = pack_bf16(RB[0][j], RB[1][j]); w.y = pack_bf16(RB[2][j], RB[3][j]); *(LAS u32x2*)((ST) + b_wr[j]) = w; } } while (0)
#define G_LDF(ST, kb, AF, BF) do { _Pragma("unroll") for (int ni = 0; ni < 2; ++ni) BF[ni] = *(const LAS bf16x8*)((ST) + b_rd[kb][ni]); \
        _Pragma("unroll") for (int mi = 0; mi < 8; ++mi) AF[mi] = *(const LAS bf16x8*)((ST) + a_rd[kb] + mi * 2048); } while (0)
#define G_MMA(AF, BF) do { _Pragma("unroll") for (int mi = 0; mi < 8; ++mi) _Pragma("unroll") for (int ni = 0; ni < 2; ++ni) \
        acc[mi][ni] = __builtin_amdgcn_mfma_f32_16x16x32_bf16(BF[ni], AF[mi], acc[mi][ni], 0, 0, 0); } while (0)
#define G_SB __builtin_amdgcn_sched_barrier(0)
    LAS unsigned char* st0 = c.lds; LAS unsigned char* st1 = c.lds + G_STAGE;
    constexpr int tl = nt - 1;
    G_LOADA(0); G_LOADB(rb0, 0); G_LOADB(rb1, 1);
    G_WRITE(st0, rb0);
    G_LOADA(1); G_LOADB(rb0, 2);
    __syncthreads();
#pragma unroll 1
    for (int t = 0; t < nt; t += 2) {
        const int t2 = (t + 2 < tl) ? t + 2 : tl, t3 = (t + 3 < tl) ? t + 3 : tl, t4 = (t + 4 < tl) ? t + 4 : tl;
        G_LDF(st0, 0, A0, B0); G_LDF(st0, 1, A1, B1); G_SB;
        G_MMA(A0, B0); G_SB;
        G_WRITE(st1, rb1); G_SB;
        G_MMA(A1, B1); G_SB;
        G_LOADA(t2); G_LOADB(rb1, t3);
        __syncthreads();
        G_LDF(st1, 0, A0, B0); G_LDF(st1, 1, A1, B1); G_SB;
        G_MMA(A0, B0); G_SB;
        G_WRITE(st0, rb0); G_SB;
        G_MMA(A1, B1); G_SB;
        G_LOADA(t3); G_LOADB(rb0, t4);
        __syncthreads();
    }
#undef G_LOADA
#undef G_LOADB
#undef G_WRITE
#undef G_LDF
#undef G_MMA
#undef G_SB
}
constexpr int W_STAGE = 65536, W_BOFF = 32768;
__device__ __forceinline__ int swzb(int n) { return ((n >> 2) & 1) | ((((n >> 1) ^ (n >> 3)) & 1) << 1) | ((((n >> 2) ^ (n >> 4)) & 1) << 2); }
template <int K>
__device__ __forceinline__ void gemm_mainloop256(f32x4 (&acc)[8][4], f32x4 (&rb)[8], const bf16_t* abase, const int (&aoff)[4], const float* bptr, const int ldb, const int nrows, const Ctx& c,
                                                 const bool staged, const int (&aoffn)[4], const float* bptrn, const int nrows_n, const bool hn) {
    const int lane = c.lane, wid = c.wid;
    constexpr int nt = K >> 6;
    int b_wr[2];
#pragma unroll
    for (int jh = 0; jh < 2; ++jh) { const int n = 4 * lane + 2 * jh; b_wr[jh] = W_BOFF + n * 128 + ((wid ^ swzb(n)) << 4); }
    const int a_dma = wid * 4096;
    const int fr = c.fr, fq = c.fq;
    int a_rd[2], b_rd[2][2];
#pragma unroll
    for (int kb = 0; kb < 2; ++kb) {
        a_rd[kb] = (128 * c.wr + fr) * 128 + ((((4 * kb + fq) ^ (fr & 7))) << 4);
#pragma unroll
        for (int ni = 0; ni < 2; ++ni) { const int n = 64 * c.wc + 16 * ni + fr; b_rd[kb][ni] = W_BOFF + n * 128 + (((4 * kb + fq) ^ swzb(n)) << 4); }
    }
    const int nfr = __builtin_amdgcn_readfirstlane(max(0, min(8, (nrows - 128 * c.wr + 15) >> 4)));
    const int npc = __builtin_amdgcn_readfirstlane(max(0, min(4, (nrows - 32 * wid + 7) >> 3)));
    const int npcn = __builtin_amdgcn_readfirstlane(max(0, min(4, (nrows_n - 32 * wid + 7) >> 3)));
    const int n1a = hn ? 64 : 0;
    const size_t n1b = hn ? (size_t)64 * ldb : 0;
#define W_FA(ST, T, NT1) do { const bool nx = ((T) >= nt); const int np = nx ? npcn : npc; \
        _Pragma("unroll") for (int i = 0; i < 4; ++i) if (i < np) \
            __builtin_amdgcn_global_load_lds((const unsigned*)(abase + (nx ? aoffn[i] + ((NT1) ? n1a : 0) : aoff[i] + (T) * 64)), (LAS unsigned*)((ST) + a_dma + i * 1024), 16, 0, 0); } while (0)
#define W_FB(T, NT1) do { const bool nx = ((T) >= nt); \
        const float* bq = nx ? bptrn + ((NT1) ? n1b : 0) : bptr + (size_t)((T) * 64) * ldb; \
        _Pragma("unroll") for (int i = 0; i < 8; ++i) rb[i] = *(const f32x4*)(bq + (size_t)i * ldb); } while (0)
#define W_CVT() do { _Pragma("unroll") for (int j = 0; j < 4; ++j) { wv[j].x = pack_bf16(rb[0][j], rb[1][j]); wv[j].y = pack_bf16(rb[2][j], rb[3][j]); \
            wv[j].z = pack_bf16(rb[4][j], rb[5][j]); wv[j].w = pack_bf16(rb[6][j], rb[7][j]); } } while (0)
#define W_ST(ST) do { _Pragma("unroll") for (int j = 0; j < 4; ++j) *(LAS u32x4*)((ST) + b_wr[j >> 1] + (j & 1) * 128) = wv[j]; } while (0)
#define W_SB __builtin_amdgcn_sched_barrier(0)
#define W_DSR(dst, addr, off) asm volatile("ds_read_b128 %0, %1 offset:%2" : "=v"(dst) : "v"(addr), "i"(off))
#define W_COMPUTE(ST) do { const unsigned stb = (unsigned)(unsigned long)(ST); \
    _Pragma("unroll") for (int kb = 0; kb < 2; ++kb) { bf16x8 bf0, bf1, bf2, bf3, afc, afn; \
        const unsigned ba0 = stb + b_rd[kb][0], ba1 = stb + b_rd[kb][1], aa = stb + a_rd[kb]; \
        W_DSR(bf0, ba0, 0); W_DSR(bf1, ba1, 0); W_DSR(bf2, ba0, 4096); W_DSR(bf3, ba1, 4096); W_DSR(afc, aa, 0); \
        _Pragma("unroll") for (int mi = 0; mi < 8; ++mi) { \
            if (mi < 7) { W_DSR(afn, aa, (mi + 1) * 2048); } \
            if (mi == 0) asm volatile("s_waitcnt lgkmcnt(1)" : "+v"(afc), "+v"(bf0), "+v"(bf1), "+v"(bf2), "+v"(bf3)); \
            else if (mi < 7) asm volatile("s_waitcnt lgkmcnt(1)" : "+v"(afc)); \
            else asm volatile("s_waitcnt lgkmcnt(0)" : "+v"(afc)); \
            if (mi < nfr) { \
                acc[mi][0] = __builtin_amdgcn_mfma_f32_16x16x32_bf16(bf0, afc, acc[mi][0], 0, 0, 0); acc[mi][1] = __builtin_amdgcn_mfma_f32_16x16x32_bf16(bf1, afc, acc[mi][1], 0, 0, 0); \
                acc[mi][2] = __builtin_amdgcn_mfma_f32_16x16x32_bf16(bf2, afc, acc[mi][2], 0, 0, 0); acc[mi][3] = __builtin_amdgcn_mfma_f32_16x16x32_bf16(bf3, afc, acc[mi][3], 0, 0, 0); } \
            afc = afn; } } } while (0)
    LAS unsigned char* st0 = c.lds; LAS unsigned char* st1 = c.lds + W_STAGE;
    u32x4 wv[4];
    if (!staged) {
        W_FA(st0, 0, 0); W_FB(0, 0);
        W_CVT(); W_SB; W_FB(1, 0); W_SB; W_ST(st0);
        asm volatile("s_waitcnt vmcnt(8)" ::: "memory");
        __syncthreads();
        W_FA(st1, 1, 0);
    }
#pragma unroll 1
    for (int t = 0; t < nt; t += 2) {
        W_COMPUTE(st0);
        W_CVT(); W_SB; W_FB(t + 2, 0); W_SB; W_ST(st1);
        asm volatile("s_waitcnt vmcnt(8)" ::: "memory");
        __syncthreads();
        W_FA(st0, t + 2, 0);
        W_COMPUTE(st1);
        W_CVT(); W_SB; W_FB(t + 3, 1); W_SB; W_ST(st0);
        asm volatile("s_waitcnt vmcnt(8)" ::: "memory");
        __syncthreads();
        W_FA(st1, t + 3, 1);
    }
#undef W_FA
#undef W_FB
#undef W_CVT
#undef W_ST
#undef W_SB
#undef W_COMPUTE
#undef W_DSR
}
__device__ __forceinline__ int a_piece_row(const Ctx& c, int i) { return 32 * c.wid + 8 * i + (c.lane >> 3); }
__device__ __forceinline__ int a_piece_col(const Ctx& c) { return 8 * ((c.lane & 7) ^ ((c.lane >> 3) & 7)); }
__device__ __forceinline__ void zero_acc(f32x4 (&acc)[8][2]) {
#pragma unroll
    for (int mi = 0; mi < 8; ++mi)
#pragma unroll
        for (int ni = 0; ni < 2; ++ni) acc[mi][ni] = (f32x4){0.f, 0.f, 0.f, 0.f};
}
__device__ __forceinline__ int b_nq(const Ctx& c) { return ((c.lane >> 1) & 7) | ((c.lane >> 4) << 3); }
__device__ __forceinline__ int b_k0(const Ctx& c) { return 8 * c.wid + 4 * (c.lane & 1); }

__device__ __forceinline__ void phase_mod(const Params& p, const Ctx& c) {
    const float* cc = p.in[1]; const float* w_ada = p.in[3]; const float* b_ada = p.in[4];
    float* mod = (float*)(p.ws + WS_MOD);
    LAS float* sc = (LAS float*)c.lds;
    LAS float* red = (LAS float*)(c.lds + 32768);
    for (int i = c.tid; i < NB * D; i += 512) { const float v = cc[i]; sc[i] = v / (1.0f + __expf(-v)); }
    __syncthreads();
    const int cq = c.tid % 12, kl = c.tid / 12;
    for (int item = c.bid; item < 256; item += c.nblk) {
        float acc[4][4];
#pragma unroll
        for (int b = 0; b < 4; ++b)
#pragma unroll
            for (int j = 0; j < 4; ++j) acc[b][j] = 0.f;
        if (kl < 42) {
            const float* wp = w_ada + item * 48 + cq * 4;
            for (int k = kl; k < D; k += 42) {
                const f32x4 w = *(const f32x4*)(wp + (size_t)k * NMOD);
#pragma unroll
                for (int b = 0; b < 4; ++b) { const float s = sc[b * D + k];
#pragma unroll
                    for (int j = 0; j < 4; ++j) acc[b][j] += s * w[j]; }
            }
#pragma unroll
            for (int b = 0; b < 4; ++b)
#pragma unroll
                for (int j = 0; j < 4; ++j) red[(kl * 12 + cq) * 16 + b * 4 + j] = acc[b][j];
        }
        __syncthreads();
        if (c.tid < 192) {
            const int b = c.tid / 48, col = c.tid % 48;
            float s = 0.f;
            for (int k2 = 0; k2 < 42; ++k2) s += red[(k2 * 12 + (col >> 2)) * 16 + b * 4 + (col & 3)];
            mod[b * NMOD + item * 48 + col] = s + b_ada[item * 48 + col];
        }
        __syncthreads();
    }
}

__device__ __forceinline__ void convert_tile(const float* W, int K, int N, bf16_t* Wt, int kt, int ntile, const Ctx& c, int ldt = 0, int koff = 0) {
    if (ldt == 0) ldt = K;
    const int half = c.lane & 1, nq = b_nq(c);
    const float* src = W + (size_t)(kt * 64 + 8 * c.wid + 4 * half) * N + ntile * 128 + 4 * nq;
    f32x4 rb_[4];
#pragma unroll
    for (int i = 0; i < 4; ++i) rb_[i] = *(const f32x4*)(src + (size_t)i * N);
    const int wo = (4 * nq) * 128 + ((c.wid ^ (nq & 7)) << 4) + half * 8;
#pragma unroll
    for (int j = 0; j < 4; ++j) { u32x2 w; w.x = pack_bf16(rb_[0][j], rb_[1][j]); w.y = pack_bf16(rb_[2][j], rb_[3][j]); *(LAS u32x2*)(c.lds + wo + j * 128) = w; }
    __syncthreads();
#pragma unroll
    for (int i = 0; i < 2; ++i) {
        const int idx = c.tid + 512 * i, n = idx >> 3, ch = idx & 7;
        const u32x4 v = *(const LAS u32x4*)(c.lds + n * 128 + ((ch ^ ((n >> 2) & 7)) << 4));
        *(u32x4*)(Wt + (size_t)(ntile * 128 + n) * ldt + koff + kt * 64 + ch * 8) = v;
    }
    __syncthreads();
}
__device__ __forceinline__ void phase_convert(const Params& p, const Ctx& c) {
    for (int t = c.bid; t < 3584; t += c.nblk) {
        if (t < 2560) convert_tile(p.in[6], D, INC, (bf16_t*)(p.ws + WS_WIN_T), t & 31, t >> 5, c);
        else if (t < 2816) { const int u = t - 2560; convert_tile(p.in[12], 1024, D, (bf16_t*)(p.ws + WS_WPA_T), u & 15, u >> 4, c, D, 0); }
        else if (t < 3072) { const int u = t - 2816; convert_tile(p.in[13], 1024, D, (bf16_t*)(p.ws + WS_WPA_T), u & 15, u >> 4, c, D, 1024); }
        else { const int u = t - 3072; convert_tile(p.in[14], D, D, (bf16_t*)(p.ws + WS_WOUT_T), u & 31, u >> 5, c); }
    }
}

__device__ __forceinline__ void phase_norm1(const Params& p, const Ctx& c) {
    const float* x = p.in[0]; const float* g = p.in[5];
    const float* mod = (const float*)(p.ws + WS_MOD);
    bf16_t* h = (bf16_t*)(p.ws + WS_H);
    for (int row = c.bid * 8 + c.wid; row < NTOK; row += c.nblk * 8) {
        const int b = row >> 11;
        f32x4 v[8]; float ss = 0.f;
#pragma unroll
        for (int i = 0; i < 8; ++i) { v[i] = *(const f32x4*)(x + (size_t)row * D + i * 256 + c.lane * 4); ss += v[i][0] * v[i][0] + v[i][1] * v[i][1] + v[i][2] * v[i][2] + v[i][3] * v[i][3]; }
        ss = wave_sum(ss);
        const float rstd = rsqrtf(ss * (1.0f / D) + EPS);
#pragma unroll
        for (int i = 0; i < 8; ++i) {
            const int col = i * 256 + c.lane * 4;
            const f32x4 gg = *(const f32x4*)(g + col), sh = *(const f32x4*)(mod + b * NMOD + col), scl = *(const f32x4*)(mod + b * NMOD + D + col);
            float o[4];
#pragma unroll
            for (int j = 0; j < 4; ++j) o[j] = (v[i][j] * rstd * gg[j]) * (1.0f + scl[j]) + sh[j];
            u32x2 w; w.x = pack_bf16(o[0], o[1]); w.y = pack_bf16(o[2], o[3]);
            *(u32x2*)(h + (size_t)row * D + col) = w;
        }
    }
}

__device__ __forceinline__ void phase_router_prep(const Params& p, const Ctx& c) {
    const float* mod = (const float*)(p.ws + WS_MOD); const float* g = p.in[15];
    const float* w_rg = p.in[16]; const float* b_rg = p.in[17]; const float* w_re = p.in[18]; const float* b_re = p.in[19];
    bf16_t* WtH = (bf16_t*)(p.ws + WS_RW); bf16_t* WtL = WtH + (size_t)NB * 80 * D; float* cb = (float*)(p.ws + WS_RC);
    for (int task = c.bid * 8 + c.wid; task < NB * 80; task += c.nblk * 8) {
        const int b = task / 80, j = task % 80;
        float cs = 0.f;
        for (int k = c.lane; k < D; k += 64) {
            float w = 0.f;
            if (j < 8) w = w_rg[(size_t)k * 8 + j]; else if (j < 72) w = w_re[(size_t)k * 64 + (j - 8)];
            const float wv = g[k] * (1.0f + mod[b * NMOD + 4 * D + k]) * w;
            const unsigned hi = pack_bf16(wv, 0.f) & 0xffffu; const float hif = __uint_as_float(hi << 16);
            WtH[((size_t)b * 80 + j) * D + k] = (bf16_t)hi; WtL[((size_t)b * 80 + j) * D + k] = (bf16_t)(pack_bf16(wv - hif, 0.f) & 0xffffu);
            cs += mod[b * NMOD + 3 * D + k] * w;
        }
        cs = wave_sum(cs);
        if (c.lane == 0) cb[b * 80 + j] = cs + (j < 8 ? b_rg[j] : (j < 72 ? b_re[j - 8] : 0.f));
    }
}

__device__ __forceinline__ void phase_proj_in(const Params& p, const Ctx& c) {
    const bf16_t* h = (const bf16_t*)(p.ws + WS_H); const float* w_in = p.in[6];
    for (int item = c.bid; item < 32 * 80; item += c.nblk) {
        const int mt = item & 31, ntile = item >> 5;
        const int m0 = mt * 256, n0 = ntile * 128;
        const bf16_t* arow[4];
#pragma unroll
        for (int i = 0; i < 4; ++i) arow[i] = h + (size_t)(m0 + a_piece_row(c, i)) * D + a_piece_col(c);
        const float* bptr = w_in + (size_t)b_k0(c) * INC + n0 + 4 * b_nq(c);
        f32x4 acc[8][2]; zero_acc(acc);
        gemm_mainloop<false, D>(acc, arow, bptr, INC, c);
        const int region = n0 >> 10;
#pragma unroll
        for (int mi = 0; mi < 8; ++mi)
#pragma unroll
            for (int ni = 0; ni < 2; ++ni) {
                const int row = m0 + 128 * c.wr + 16 * mi + c.fr;
                const int col = n0 + 32 * c.wc + 16 * ni + 4 * c.fq;
                const f32x4 a = acc[mi][ni];
                if (region < 6) {
                    const int cin = col & 1023;
                    if (region == 2 || region == 5) {
                        bf16_t* vt = (bf16_t*)(p.ws + (region == 2 ? WS_VAT : WS_VBT));
                        const int b = row >> 11, s = row & 2047, hh = cin >> 7, d = cin & 127;
                        const unsigned w0 = pack_bf16(a[0], a[1]), w1 = pack_bf16(a[2], a[3]);
                        bf16_t* base = vt + ((size_t)((b * 8 + hh) * 128 + d)) * SEQ + s;
                        base[0] = (bf16_t)(w0 & 0xffff); base[SEQ] = (bf16_t)(w0 >> 16); base[2 * SEQ] = (bf16_t)(w1 & 0xffff); base[3 * SEQ] = (bf16_t)(w1 >> 16);
                    } else {
                        const size_t off = region == 0 ? WS_QA : region == 1 ? WS_KA : region == 3 ? WS_QB : WS_KB;
                        bf16_t* dst = (bf16_t*)(p.ws + off);
                        u32x2 w; w.x = pack_bf16(a[0], a[1]); w.y = pack_bf16(a[2], a[3]);
                        *(u32x2*)(dst + (size_t)row * 1024 + cin) = w;
                    }
                } else {
                    bf16_t* dst = (bf16_t*)(p.ws + (region < 8 ? WS_GA : WS_GB));
                    const int cin = col - (region < 8 ? 6144 : 8192);
                    u32x2 w; w.x = pack_bf16(sigmoidf_(a[0]), sigmoidf_(a[1])); w.y = pack_bf16(sigmoidf_(a[2]), sigmoidf_(a[3]));
                    *(u32x2*)(dst + (size_t)row * D + cin) = w;
                }
            }
    }
}

constexpr int AT_STAGE = 32768, AT_VOFF = 16384, AT_BIAS = 98304;
__device__ __forceinline__ int rel_bucket_dev(int n) {
    if (n < 16) return n;
    int b = 16;
    b += (n >= 19) + (n >= 21) + (n >= 24) + (n >= 27) + (n >= 31) + (n >= 35) + (n >= 40) + (n >= 46) + (n >= 52) + (n >= 59) + (n >= 67) + (n >= 77) + (n >= 87) + (n >= 99) + (n >= 113);
    return b;
}
struct KVRegs { u32x4 k[2], v[2]; };
__device__ __forceinline__ void kv_load(KVRegs& r, const bf16_t* kbase, const bf16_t* vtbase, int kt, const Ctx& c) {
#pragma unroll
    for (int i = 0; i < 2; ++i) {
        const int key = (c.tid >> 4) + 32 * i, ck = c.tid & 15;
        r.k[i] = *(const u32x4*)(kbase + (size_t)(kt * 64 + key) * 1024 + ck * 8);
        const int d = (c.tid >> 3) + 64 * i, cv = c.tid & 7;
        r.v[i] = *(const u32x4*)(vtbase + (size_t)d * SEQ + kt * 64 + cv * 8);
    }
}
__device__ __forceinline__ void kv_store(const KVRegs& r, LAS unsigned char* st, const Ctx& c) {
#pragma unroll
    for (int i = 0; i < 2; ++i) {
        const int key = (c.tid >> 4) + 32 * i, ck = c.tid & 15;
        *(LAS u32x4*)(st + key * 256 + ((ck ^ (key & 15)) << 4)) = r.k[i];
        const int d = (c.tid >> 3) + 64 * i, cv = c.tid & 7;
        *(LAS u32x4*)(st + AT_VOFF + d * 128 + ((cv ^ ((d >> 1) & 7)) << 4)) = r.v[i];
    }
}
__device__ __forceinline__ bf16x8 v_frag(LAS unsigned char* st, int nf, int kb2, const Ctx& c) {
    const int d = 16 * nf + c.fr; const int sw = (c.fr >> 1) & 7;
    return *(const LAS bf16x8*)(st + AT_VOFF + d * 128 + (((4 * kb2 + c.fq) ^ sw) << 4));
}
__device__ __forceinline__ bf16x8 pack_p(const f32x4& a, const f32x4& b) {
    u32x4 w; w.x = pack_bf16(a[0], a[1]); w.y = pack_bf16(a[2], a[3]); w.z = pack_bf16(b[0], b[1]); w.w = pack_bf16(b[2], b[3]);
    return __builtin_bit_cast(bf16x8, w);
}

__device__ __forceinline__ void diff_attn_item(const Params& p, const Ctx& c, int b, int h, int qb, float lam, bf16x8 (&qf)[4], KVRegs& kr,
                                               const bf16_t* qn, const bf16_t* kbn, const bf16_t* vtn, const int ktn) {
    const bf16_t* ka = (const bf16_t*)(p.ws + WS_KA); const bf16_t* vat = (const bf16_t*)(p.ws + WS_VAT);
    bf16_t* oa = (bf16_t*)(p.ws + WS_OA);
    const float* rel = p.in[2]; const float* gsub = p.in[11];
    LAS float* bias = (LAS float*)(c.lds + AT_BIAS);
    __syncthreads();
    if (c.tid < 128) bias[c.tid] = rel[rel_bucket_dev(c.tid) * 8 + h] * 1.4426950408889634f;
    const int qpos = 128 * qb + 16 * c.wid + c.fr;
    const size_t qtok = (size_t)b * SEQ + qpos;
    const bf16_t* kbase = ka + (size_t)b * SEQ * 1024 + h * 128;
    const bf16_t* vtbase = vat + (size_t)((b * 8 + h) * 128) * SEQ;
    f32x4 O1[8], O2[8];
#pragma unroll
    for (int nf = 0; nf < 8; ++nf) { O1[nf] = (f32x4){0.f, 0.f, 0.f, 0.f}; O2[nf] = (f32x4){0.f, 0.f, 0.f, 0.f}; }
    float m1 = -1e30f, m2 = -1e30f, l1 = 0.f, l2 = 0.f;
    const int ntiles = 2 * qb + 2;
    const int qmax_w = 128 * qb + 16 * c.wid + 15, qmin_w = 128 * qb + 16 * c.wid;
    const float L2E = 1.4426950408889634f;
    const bool defer = c.wid >= 4;
    bf16x8 pq1[2], pq2[2]; bool pend = false;
#pragma unroll
    for (int kb2 = 0; kb2 < 2; ++kb2) { pq1[kb2] = (bf16x8){0, 0, 0, 0, 0, 0, 0, 0}; pq2[kb2] = pq1[kb2]; }
    int sidx = 0, sprev = 2;
    for (int kt = 0; kt < ntiles; ++kt) {
        LAS unsigned char* st = c.lds + sidx * AT_STAGE;
        kv_store(kr, st, c);
        { const bool last = (kt + 1 >= ntiles);
          kv_load(kr, last ? kbn : kbase, last ? vtn : vtbase, last ? ktn : kt + 1, c); }
        __syncthreads();
        if (pend) {
            LAS unsigned char* sp = c.lds + sprev * AT_STAGE;
#pragma unroll
            for (int kb2 = 0; kb2 < 2; ++kb2)
#pragma unroll
                for (int nf = 0; nf < 8; ++nf) {
                    const bf16x8 vf = v_frag(sp, nf, kb2, c);
                    O1[nf] = __builtin_amdgcn_mfma_f32_16x16x32_bf16(vf, pq1[kb2], O1[nf], 0, 0, 0);
                    O2[nf] = __builtin_amdgcn_mfma_f32_16x16x32_bf16(vf, pq2[kb2], O2[nf], 0, 0, 0);
                }
            pend = false;
        }
        if (64 * kt <= qmax_w) {
            f32x4 s1[4], s2[4];
#pragma unroll
            for (int f = 0; f < 4; ++f) {
                bf16x8 kf[4];
#pragma unroll
                for (int kb = 0; kb < 4; ++kb) kf[kb] = *(const LAS bf16x8*)(st + (16 * f + c.fr) * 256 + (((4 * kb + c.fq) ^ c.fr) << 4));
                f32x4 z = (f32x4){0.f, 0.f, 0.f, 0.f};
                z = __builtin_amdgcn_mfma_f32_16x16x32_bf16(kf[0], qf[0], z, 0, 0, 0);
                s1[f] = __builtin_amdgcn_mfma_f32_16x16x32_bf16(kf[1], qf[1], z, 0, 0, 0);
                z = (f32x4){0.f, 0.f, 0.f, 0.f};
                z = __builtin_amdgcn_mfma_f32_16x16x32_bf16(kf[2], qf[2], z, 0, 0, 0);
                s2[f] = __builtin_amdgcn_mfma_f32_16x16x32_bf16(kf[3], qf[3], z, 0, 0, 0);
            }
            const bool nearb = (qmin_w - (64 * kt + 63)) < 113;
            const float CS = 0.125f * L2E, THR = 8.0f;
            float mx1, mx2;
            if (!nearb) {
                const float bf_ = bias[127];
                float r1 = s1[0][0], r2 = s2[0][0];
#pragma unroll
                for (int f = 0; f < 4; ++f)
#pragma unroll
                    for (int r = 0; r < 4; ++r) { r1 = fmaxf(r1, s1[f][r]); r2 = fmaxf(r2, s2[f][r]); }
                mx1 = r1 * CS + bf_; mx2 = r2 * CS + bf_;
            } else {
                mx1 = -1e30f; mx2 = -1e30f;
#pragma unroll
                for (int f = 0; f < 4; ++f)
#pragma unroll
                    for (int r = 0; r < 4; ++r) {
                        const int n = qpos - (64 * kt + 16 * f + 4 * c.fq + r);
                        const float bv = bias[n < 0 ? 0 : (n > 127 ? 127 : n)];
                        float a1 = s1[f][r] * CS + bv, a2 = s2[f][r] * CS + bv;
                        if (n < 0) { a1 = -1e30f; a2 = -1e30f; }
                        s1[f][r] = a1; s2[f][r] = a2;
                        mx1 = fmaxf(mx1, a1); mx2 = fmaxf(mx2, a2);
                    }
            }
            mx1 = xmax32(xmax16(mx1)); mx2 = xmax32(xmax16(mx2));
            if (__any((mx1 - m1 > THR) || (mx2 - m2 > THR))) {
                const float mn1 = fmaxf(m1, mx1), mn2 = fmaxf(m2, mx2);
                const float al1 = __builtin_amdgcn_exp2f(m1 - mn1), al2 = __builtin_amdgcn_exp2f(m2 - mn2);
                m1 = mn1; m2 = mn2; l1 *= al1; l2 *= al2;
#pragma unroll
                for (int nf = 0; nf < 8; ++nf) { O1[nf] *= al1; O2[nf] *= al2; }
            }
            if (!nearb) {
                const float d1 = bias[127] - m1, d2 = bias[127] - m2;
#pragma unroll
                for (int f = 0; f < 4; ++f) { s1[f] = s1[f] * CS + d1; s2[f] = s2[f] * CS + d2; }
            } else {
#pragma unroll
                for (int f = 0; f < 4; ++f) { s1[f] = s1[f] - m1; s2[f] = s2[f] - m2; }
            }
            float ps1 = 0.f, ps2 = 0.f;
#pragma unroll
            for (int f = 0; f < 4; ++f)
#pragma unroll
                for (int r = 0; r < 4; ++r) {
                    const float e1 = __builtin_amdgcn_exp2f(s1[f][r]), e2 = __builtin_amdgcn_exp2f(s2[f][r]);
                    s1[f][r] = e1; s2[f][r] = e2; ps1 += e1; ps2 += e2;
                }
            l1 += ps1; l2 += ps2;
#pragma unroll
            for (int kb2 = 0; kb2 < 2; ++kb2) { pq1[kb2] = pack_p(s1[2 * kb2], s1[2 * kb2 + 1]); pq2[kb2] = pack_p(s2[2 * kb2], s2[2 * kb2 + 1]); }
            if (defer) pend = true;
            else {
#pragma unroll
                for (int kb2 = 0; kb2 < 2; ++kb2)
#pragma unroll
                    for (int nf = 0; nf < 8; ++nf) {
                        const bf16x8 vf = v_frag(st, nf, kb2, c);
                        O1[nf] = __builtin_amdgcn_mfma_f32_16x16x32_bf16(vf, pq1[kb2], O1[nf], 0, 0, 0);
                        O2[nf] = __builtin_amdgcn_mfma_f32_16x16x32_bf16(vf, pq2[kb2], O2[nf], 0, 0, 0);
                    }
            }
        }
        sprev = sidx; sidx = (sidx == 2) ? 0 : sidx + 1;
    }
    if (pend) {
        LAS unsigned char* sp = c.lds + sprev * AT_STAGE;
#pragma unroll
        for (int kb2 = 0; kb2 < 2; ++kb2)
#pragma unroll
            for (int nf = 0; nf < 8; ++nf) {
                const bf16x8 vf = v_frag(sp, nf, kb2, c);
                O1[nf] = __builtin_amdgcn_mfma_f32_16x16x32_bf16(vf, pq1[kb2], O1[nf], 0, 0, 0);
                O2[nf] = __builtin_amdgcn_mfma_f32_16x16x32_bf16(vf, pq2[kb2], O2[nf], 0, 0, 0);
            }
    }
#pragma unroll
    for (int kb = 0; kb < 4; ++kb) qf[kb] = *(const bf16x8*)(qn + 32 * kb + 8 * c.fq);
    l1 = xsum32(xsum16(l1)); l2 = xsum32(xsum16(l2));
    const float i1 = 1.0f / l1, i2 = lam / l2;
    float ss = 0.f;
#pragma unroll
    for (int nf = 0; nf < 8; ++nf)
#pragma unroll
        for (int r = 0; r < 4; ++r) { const float o = O1[nf][r] * i1 - O2[nf][r] * i2; O1[nf][r] = o; ss += o * o; }
    ss += __shfl_xor(ss, 16); ss += __shfl_xor(ss, 32);
    const float rstd = rsqrtf(ss * (1.0f / 128.0f) + EPS) * 0.8f;
#pragma unroll
    for (int nf = 0; nf < 8; ++nf) {
        const int d = 16 * nf + 4 * c.fq;
        const f32x4 g = *(const f32x4*)(gsub + d);
        u32x2 w; w.x = pack_bf16(O1[nf][0] * rstd * g[0], O1[nf][1] * rstd * g[1]); w.y = pack_bf16(O1[nf][2] * rstd * g[2], O1[nf][3] * rstd * g[3]);
        *(u32x2*)(oa + qtok * 2048 + h * 128 + d) = w;
    }
}

__device__ __forceinline__ void sb_attn_item(const Params& p, const Ctx& c, int b, int h, int qb, bf16x8 (&qf)[4], KVRegs& kr,
                                             const bf16_t* qn, const bf16_t* kbn, const bf16_t* vtn, const int ktn) {
    const bf16_t* kbuf = (const bf16_t*)(p.ws + WS_KB); const bf16_t* vbt = (const bf16_t*)(p.ws + WS_VBT);
    bf16_t* ob = (bf16_t*)(p.ws + WS_OA) + 1024;
    __syncthreads();
    const int qpos = 128 * qb + 16 * c.wid + c.fr;
    const size_t qtok = (size_t)b * SEQ + qpos;
    const bf16_t* kbase = kbuf + (size_t)b * SEQ * 1024 + h * 128;
    const bf16_t* vtbase = vbt + (size_t)((b * 8 + h) * 128) * SEQ;
    f32x4 O[8];
#pragma unroll
    for (int nf = 0; nf < 8; ++nf) O[nf] = (f32x4){0.f, 0.f, 0.f, 0.f};
    float carry = 0.f;
    const int ntiles = 2 * qb + 2;
    const int qmax_w = 128 * qb + 16 * c.wid + 15;
    const float scale = 0.08838834764831845f * 1.4426950408889634f;
    LAS int* dflag = (LAS int*)(c.lds + AT_BIAS + 1024);
    if (c.lane == 0) dflag[c.wid] = 0;
    bool wdone = false, nxt = false;
    for (int it = 0; it < ntiles; ++it) {
        const int kt = ntiles - 1 - it;
        LAS unsigned char* st = c.lds + (it & 1) * AT_STAGE;
        kv_store(kr, st, c);
        __syncthreads();
        {
            int alld = 1;
#pragma unroll
            for (int w8 = 0; w8 < 8; ++w8) alld &= dflag[w8];
            if (alld) break;
        }
        { const bool last = (kt == 0);
          kv_load(kr, last ? kbn : kbase, last ? vtn : vtbase, last ? ktn : kt - 1, c); nxt = last; }
        if (!wdone && 64 * kt < qmax_w) {
            f32x4 z[4];
#pragma unroll
            for (int f = 0; f < 4; ++f) {
                f32x4 a = (f32x4){0.f, 0.f, 0.f, 0.f};
#pragma unroll
                for (int kb = 0; kb < 4; ++kb) {
                    const bf16x8 kf = *(const LAS bf16x8*)(st + (16 * f + c.fr) * 256 + (((4 * kb + c.fq) ^ c.fr) << 4));
                    a = __builtin_amdgcn_mfma_f32_16x16x32_bf16(kf, qf[kb], a, 0, 0, 0);
                }
                z[f] = a;
            }
            f32x4 lb[4], lk[4]; float T[4];
#pragma unroll
            for (int f = 0; f < 4; ++f) {
                float t = 0.f;
#pragma unroll
                for (int r = 0; r < 4; ++r) {
                    const int kpos = 64 * kt + 16 * f + 4 * c.fq + r;
                    const float zz = z[f][r] * scale;
                    const float sp = __builtin_amdgcn_logf(1.0f + __builtin_amdgcn_exp2f(-fabsf(zz)));
                    const float lbv = fminf(zz, 0.f) - sp;
                    const bool valid = kpos < qpos;
                    const float lkv = valid ? (lbv - zz) : 0.f;
                    lb[f][r] = valid ? lbv : -1e30f; lk[f][r] = lkv; t += lkv;
                }
                T[f] = t;
            }
            float tile_tot = 0.f; float Gl[4], Ft[4];
#pragma unroll
            for (int f = 0; f < 4; ++f) {
                const float A1 = __shfl_xor(T[f], 16), A2 = __shfl_xor(T[f], 32), A3 = __shfl_xor(T[f], 48);
                Gl[f] = ((c.fq & 1) == 0 ? A1 : 0.f) + ((c.fq & 2) == 0 ? (A2 + A3) : 0.f);
                Ft[f] = T[f] + A1 + A2 + A3; tile_tot += Ft[f];
            }
            float after = carry;
#pragma unroll
            for (int f = 3; f >= 0; --f) {
                float suf = 0.f;
#pragma unroll
                for (int r = 3; r >= 0; --r) {
                    const float later = after + Gl[f] + suf;
                    z[f][r] = __builtin_amdgcn_exp2f(lb[f][r] + later);
                    suf += lk[f][r];
                }
                after += Ft[f];
            }
            carry += tile_tot;
#pragma unroll
            for (int kb2 = 0; kb2 < 2; ++kb2) {
                const bf16x8 pp = pack_p(z[2 * kb2], z[2 * kb2 + 1]);
#pragma unroll
                for (int nf = 0; nf < 8; ++nf) {
                    const bf16x8 vf = v_frag(st, nf, kb2, c);
                    O[nf] = __builtin_amdgcn_mfma_f32_16x16x32_bf16(vf, pp, O[nf], 0, 0, 0);
                }
            }
            if (__all(carry < -64.0f)) { wdone = true; if (c.lane == 0) dflag[c.wid] = 1; }
        }
    }
    if (!nxt) kv_load(kr, kbn, vtn, ktn, c);
#pragma unroll
    for (int kb = 0; kb < 4; ++kb) qf[kb] = *(const bf16x8*)(qn + 32 * kb + 8 * c.fq);
#pragma unroll
    for (int nf = 0; nf < 8; ++nf) {
        const int d = 16 * nf + 4 * c.fq;
        u32x2 w; w.x = pack_bf16(O[nf][0], O[nf][1]); w.y = pack_bf16(O[nf][2], O[nf][3]);
        *(u32x2*)(ob + qtok * 2048 + h * 128 + d) = w;
    }
}

__device__ __forceinline__ void attn_sub(const Params& p, const Ctx& c, int sub, int& kind, int& bh, int& qb, const bf16_t*& qp, const bf16_t*& kb, const bf16_t*& vt, int& kt0) {
    const int kh = sub >> 8, i2 = sub & 255, half = kh & 1, pr = i2 >> 5;
    kind = kh >> 1; bh = i2 & 31; qb = half ? pr : 15 - pr;
    const int b = bh >> 3, h = bh & 7;
    const size_t qtok = (size_t)b * SEQ + 128 * qb + 16 * c.wid + c.fr;
    qp = (const bf16_t*)(p.ws + (kind ? WS_QB : WS_QA)) + qtok * 1024 + h * 128;
    kb = (const bf16_t*)(p.ws + (kind ? WS_KB : WS_KA)) + (size_t)b * SEQ * 1024 + h * 128;
    vt = (const bf16_t*)(p.ws + (kind ? WS_VBT : WS_VAT)) + (size_t)(bh * 128) * SEQ;
    kt0 = kind ? 2 * qb + 1 : 0;
}
__device__ __forceinline__ void phase_attn(const Params& p, const Ctx& c, int qsel = 0) {
    float d1 = 0.f, d2 = 0.f;
    if (c.lane < 64) { d1 = p.in[7][c.lane] * p.in[8][c.lane]; d2 = p.in[9][c.lane] * p.in[10][c.lane]; }
    d1 = wave_sum(d1); d2 = wave_sum(d2);
    const float lam = expf(d1) - expf(d2) + 0.2f;
    (void)qsel;
    if (c.bid >= 1024) return;
    int kind, bh, qb, kt0; const bf16_t* qp; const bf16_t* kb; const bf16_t* vt;
    attn_sub(p, c, c.bid, kind, bh, qb, qp, kb, vt, kt0);
    bf16x8 qf[4]; KVRegs kr;
#pragma unroll
    for (int k4 = 0; k4 < 4; ++k4) qf[k4] = *(const bf16x8*)(qp + 32 * k4 + 8 * c.fq);
    kv_load(kr, kb, vt, kt0, c);
#pragma unroll 1
    for (int sub = c.bid; sub < 1024; sub += c.nblk) {
        int kindn, bhn, qbn, kt0n; const bf16_t* qpn; const bf16_t* kbn; const bf16_t* vtn;
        attn_sub(p, c, (sub + c.nblk < 1024) ? sub + c.nblk : sub, kindn, bhn, qbn, qpn, kbn, vtn, kt0n);
        if (kind == 0) diff_attn_item(p, c, bh >> 3, bh & 7, qb, lam, qf, kr, qpn, kbn, vtn, kt0n);
        else sb_attn_item(p, c, bh >> 3, bh & 7, qb, qf, kr, qpn, kbn, vtn, kt0n);
        kind = kindn; bh = bhn; qb = qbn;
    }
}

__device__ __forceinline__ void phase_merge(const Params& p, const Ctx& c) {
    const bf16_t* oa = (const bf16_t*)(p.ws + WS_OA); const bf16_t* ob = (const bf16_t*)(p.ws + WS_OB);
    const bf16_t* ga = (const bf16_t*)(p.ws + WS_GA); const bf16_t* gb = (const bf16_t*)(p.ws + WS_GB);
    bf16_t* mrg = (bf16_t*)(p.ws + WS_MRG);
    for (int item = c.bid; item < 32 * 16; item += c.nblk) {
        const int mt = item & 31, ntile = item >> 5;
        const int m0 = mt * 256, n0 = ntile * 128;
        f32x4 acc[8][2];
#pragma unroll 1
        for (int pass = 0; pass < 2; ++pass) {
            const bf16_t* A = pass ? ob : oa; const float* W = pass ? p.in[13] : p.in[12]; const bf16_t* G = pass ? gb : ga;
            const bf16_t* arow[4];
#pragma unroll
            for (int i = 0; i < 4; ++i) arow[i] = A + (size_t)(m0 + a_piece_row(c, i)) * 1024 + a_piece_col(c);
            const float* bptr = W + (size_t)b_k0(c) * D + n0 + 4 * b_nq(c);
            zero_acc(acc);
            gemm_mainloop<false, 1024>(acc, arow, bptr, D, c);
            float* tmp = (float*)(p.ws + WS_X1);
#pragma unroll
            for (int mi = 0; mi < 8; ++mi)
#pragma unroll
                for (int ni = 0; ni < 2; ++ni) {
                    const int row = m0 + 128 * c.wr + 16 * mi + c.fr;
                    const int col = n0 + 32 * c.wc + 16 * ni + 4 * c.fq;
                    const u32x2 gw = *(const u32x2*)(G + (size_t)row * D + col);
                    f32x4 g; g[0] = __uint_as_float(gw.x << 16); g[1] = __uint_as_float(gw.x & 0xffff0000u); g[2] = __uint_as_float(gw.y << 16); g[3] = __uint_as_float(gw.y & 0xffff0000u);
                    f32x4 v = acc[mi][ni] * g;
                    if (pass == 0) *(f32x4*)(tmp + (size_t)row * D + col) = v;
                    else {
                        v += *(const f32x4*)(tmp + (size_t)row * D + col);
                        u32x2 w; w.x = pack_bf16(v[0], v[1]); w.y = pack_bf16(v[2], v[3]);
                        *(u32x2*)(mrg + (size_t)row * D + col) = w;
                    }
                }
        }
    }
}

__device__ __forceinline__ void phase_out(const Params& p, const Ctx& c) {
    const bf16_t* mrg = (const bf16_t*)(p.ws + WS_MRG); const float* w_out = p.in[14]; const float* x = p.in[0];
    const float* mod = (const float*)(p.ws + WS_MOD);
    float* x1 = (float*)(p.ws + WS_X1);
    for (int item = c.bid; item < 32 * 16; item += c.nblk) {
        const int mt = item & 31, ntile = item >> 5;
        const int m0 = mt * 256, n0 = ntile * 128;
        const bf16_t* arow[4];
#pragma unroll
        for (int i = 0; i < 4; ++i) arow[i] = mrg + (size_t)(m0 + a_piece_row(c, i)) * D + a_piece_col(c);
        const float* bptr = w_out + (size_t)b_k0(c) * D + n0 + 4 * b_nq(c);
        f32x4 acc[8][2]; zero_acc(acc);
        gemm_mainloop<false, D>(acc, arow, bptr, D, c);
        const int b = m0 >> 11;
#pragma unroll
        for (int mi = 0; mi < 8; ++mi)
#pragma unroll
            for (int ni = 0; ni < 2; ++ni) {
                const int row = m0 + 128 * c.wr + 16 * mi + c.fr;
                const int col = n0 + 32 * c.wc + 16 * ni + 4 * c.fq;
                const f32x4 gm = *(const f32x4*)(mod + b * NMOD + 2 * D + col);
                const f32x4 xv = *(const f32x4*)(x + (size_t)row * D + col);
                *(f32x4*)(x1 + (size_t)row * D + col) = xv + gm * acc[mi][ni];
            }
    }
}

__device__ __forceinline__ void phase_norm2_route(const Params& p, const Ctx& c) {
    const float* x1 = (const float*)(p.ws + WS_X1); const float* g = p.in[15];
    const float* mod = (const float*)(p.ws + WS_MOD);
    const float* w_rg = p.in[16]; const float* b_rg = p.in[17]; const float* w_re = p.in[18]; const float* b_re = p.in[19];
    bf16_t* h2 = (bf16_t*)(p.ws + WS_H2);
    unsigned* cnt = (unsigned*)(p.ws + WS_CTL) + CW_CNT;
    int* ltok = (int*)(p.ws + WS_LTOK); float* lw = (float*)(p.ws + WS_LW);
    for (int row = c.bid * 8 + c.wid; row < NTOK; row += c.nblk * 8) {
        const int b = row >> 11;
        f32x4 v[8]; float ss = 0.f;
#pragma unroll
        for (int i = 0; i < 8; ++i) { v[i] = *(const f32x4*)(x1 + (size_t)row * D + i * 256 + c.lane * 4); ss += v[i][0] * v[i][0] + v[i][1] * v[i][1] + v[i][2] * v[i][2] + v[i][3] * v[i][3]; }
        ss = wave_sum(ss);
        const float rstd = rsqrtf(ss * (1.0f / D) + EPS);
        float gl[8];
#pragma unroll
        for (int j = 0; j < 8; ++j) gl[j] = 0.f;
#pragma unroll
        for (int i = 0; i < 8; ++i) {
            const int col = i * 256 + c.lane * 4;
            const f32x4 gg = *(const f32x4*)(g + col), sh = *(const f32x4*)(mod + b * NMOD + 3 * D + col), scl = *(const f32x4*)(mod + b * NMOD + 4 * D + col);
#pragma unroll
            for (int j = 0; j < 4; ++j) v[i][j] = (v[i][j] * rstd * gg[j]) * (1.0f + scl[j]) + sh[j];
            u32x2 w; w.x = pack_bf16(v[i][0], v[i][1]); w.y = pack_bf16(v[i][2], v[i][3]);
            *(u32x2*)(h2 + (size_t)row * D + col) = w;
#pragma unroll
            for (int j = 0; j < 4; ++j) {
                const f32x4 w0 = *(const f32x4*)(w_rg + (size_t)(col + j) * 8), w1 = *(const f32x4*)(w_rg + (size_t)(col + j) * 8 + 4);
#pragma unroll
                for (int e = 0; e < 4; ++e) { gl[e] += v[i][j] * w0[e]; gl[4 + e] += v[i][j] * w1[e]; }
            }
        }
#pragma unroll
        for (int j = 0; j < 8; ++j) gl[j] = wave_sum(gl[j]) + b_rg[j];
        int gi = 0; float gmax = gl[0];
#pragma unroll
        for (int j = 1; j < 8; ++j) if (gl[j] > gmax) { gmax = gl[j]; gi = j; }
        float gsum = 0.f;
#pragma unroll
        for (int j = 0; j < 8; ++j) gsum += __expf(gl[j] - gmax);
        const float pg = 1.0f / gsum;
        float el[8];
#pragma unroll
        for (int j = 0; j < 8; ++j) el[j] = 0.f;
#pragma unroll
        for (int i = 0; i < 8; ++i) {
            const int col = i * 256 + c.lane * 4;
#pragma unroll
            for (int j = 0; j < 4; ++j) {
                const f32x4 w0 = *(const f32x4*)(w_re + (size_t)(col + j) * 64 + gi * 8), w1 = *(const f32x4*)(w_re + (size_t)(col + j) * 64 + gi * 8 + 4);
#pragma unroll
                for (int e = 0; e < 4; ++e) { el[e] += v[i][j] * w0[e]; el[4 + e] += v[i][j] * w1[e]; }
            }
        }
#pragma unroll
        for (int j = 0; j < 8; ++j) el[j] = wave_sum(el[j]) + b_re[gi * 8 + j];
        int i1 = 0; float e1 = el[0];
#pragma unroll
        for (int j = 1; j < 8; ++j) if (el[j] > e1) { e1 = el[j]; i1 = j; }
        int i2 = -1; float e2 = -3.0e38f;
#pragma unroll
        for (int j = 0; j < 8; ++j) if (j != i1 && el[j] > e2) { e2 = el[j]; i2 = j; }
        const float r2 = __expf(e2 - e1);
        const float tp1 = 1.0f / (1.0f + r2), tp2 = r2 / (1.0f + r2);
        if (c.lane == 0) {
            const int ea = gi * 8 + i1, eb = gi * 8 + i2;
            const unsigned sa = atomicAdd(&cnt[ea], 1u), sb = atomicAdd(&cnt[eb], 1u);
            ltok[ea * NTOK + sa] = row * 2; lw[ea * NTOK + sa] = pg * tp1;
            ltok[eb * NTOK + sb] = row * 2 + 1; lw[eb * NTOK + sb] = pg * tp2;
        }
    }
}

__device__ __forceinline__ void phase_norm2_route2(const Params& p, const Ctx& c, int dummy = 0) {
    const float* x1 = (const float*)(p.ws + WS_X1); const float* g = p.in[15];
    const float* mod = (const float*)(p.ws + WS_MOD);
    const bf16_t* WtH = (const bf16_t*)(p.ws + WS_RW); const bf16_t* WtL = WtH + (size_t)NB * 80 * D; const float* cb = (const float*)(p.ws + WS_RC);
    bf16_t* h2 = (bf16_t*)(p.ws + WS_H2);
    unsigned* cnt = (unsigned*)(p.ws + WS_CTL) + CW_CNT + (dummy ? 128 : 0);
    int* ltok = (int*)(p.ws + (dummy ? WS_ACT : WS_LTOK)); float* lw = (float*)(p.ws + (dummy ? WS_ACT + (size_t)NE * NTOK * 4 : WS_LW));
    LAS float* red = (LAS float*)c.lds;
    LAS float* ssr = (LAS float*)(c.lds + 81920);
    LAS float* rs = (LAS float*)(c.lds + 81920 + 1024);
    for (int it = c.bid; it < NTOK / 32; it += c.nblk) {
        const int tok0 = it * 32, b = tok0 >> 11;
        const int ks = c.wid, i16 = c.lane & 15, kk = c.lane >> 4;
        const float* ap0 = x1 + (size_t)(tok0 + i16) * D + 256 * ks + 8 * kk;
        const float* ap1 = ap0 + (size_t)16 * D;
        const bf16_t* bph = WtH + ((size_t)b * 80 + i16) * D + 256 * ks + 8 * kk;
        const bf16_t* bpl = WtL + ((size_t)b * 80 + i16) * D + 256 * ks + 8 * kk;
        f32x4 acc[2][5];
#pragma unroll
        for (int g2 = 0; g2 < 2; ++g2)
#pragma unroll
            for (int nb = 0; nb < 5; ++nb) acc[g2][nb] = (f32x4){0.f, 0.f, 0.f, 0.f};
        float ss0 = 0.f, ss1 = 0.f;
#pragma unroll 2
        for (int kb8 = 0; kb8 < 8; ++kb8) {
            bf16x8 ah[2], al[2];
#pragma unroll
            for (int g2 = 0; g2 < 2; ++g2) {
                const float* ap = (g2 ? ap1 : ap0) + 32 * kb8;
                const f32x4 v0 = *(const f32x4*)ap, v1 = *(const f32x4*)(ap + 4);
                const float sq = v0[0] * v0[0] + v0[1] * v0[1] + v0[2] * v0[2] + v0[3] * v0[3] + v1[0] * v1[0] + v1[1] * v1[1] + v1[2] * v1[2] + v1[3] * v1[3];
                if (g2) ss1 += sq; else ss0 += sq;
                u32x4 h, l;
                h.x = pack_bf16(v0[0], v0[1]); h.y = pack_bf16(v0[2], v0[3]); h.z = pack_bf16(v1[0], v1[1]); h.w = pack_bf16(v1[2], v1[3]);
                l.x = pack_bf16(v0[0] - __uint_as_float(h.x << 16), v0[1] - __uint_as_float(h.x & 0xffff0000u));
                l.y = pack_bf16(v0[2] - __uint_as_float(h.y << 16), v0[3] - __uint_as_float(h.y & 0xffff0000u));
                l.z = pack_bf16(v1[0] - __uint_as_float(h.z << 16), v1[1] - __uint_as_float(h.z & 0xffff0000u));
                l.w = pack_bf16(v1[2] - __uint_as_float(h.w << 16), v1[3] - __uint_as_float(h.w & 0xffff0000u));
                ah[g2] = __builtin_bit_cast(bf16x8, h); al[g2] = __builtin_bit_cast(bf16x8, l);
            }
#pragma unroll
            for (int nb = 0; nb < 5; ++nb) {
                const bf16x8 bh = *(const bf16x8*)(bph + (size_t)nb * 16 * D + 32 * kb8), bl = *(const bf16x8*)(bpl + (size_t)nb * 16 * D + 32 * kb8);
#pragma unroll
                for (int g2 = 0; g2 < 2; ++g2) {
                    acc[g2][nb] = __builtin_amdgcn_mfma_f32_16x16x32_bf16(ah[g2], bh, acc[g2][nb], 0, 0, 0);
                    acc[g2][nb] = __builtin_amdgcn_mfma_f32_16x16x32_bf16(ah[g2], bl, acc[g2][nb], 0, 0, 0);
                    acc[g2][nb] = __builtin_amdgcn_mfma_f32_16x16x32_bf16(al[g2], bh, acc[g2][nb], 0, 0, 0);
                }
            }
        }
        ss0 += __shfl_xor(ss0, 16); ss0 += __shfl_xor(ss0, 32);
        ss1 += __shfl_xor(ss1, 16); ss1 += __shfl_xor(ss1, 32);
        __syncthreads();
#pragma unroll
        for (int g2 = 0; g2 < 2; ++g2)
#pragma unroll
            for (int nb = 0; nb < 5; ++nb)
#pragma unroll
                for (int r = 0; r < 4; ++r) red[(c.wid * 32 + g2 * 16 + 4 * kk + r) * 80 + nb * 16 + i16] = acc[g2][nb][r];
        if (kk == 0) { ssr[c.wid * 32 + i16] = ss0; ssr[c.wid * 32 + 16 + i16] = ss1; }
        __syncthreads();
        if (c.tid < 32) {
            const int t = c.tid;
            float ssum = 0.f;
#pragma unroll
            for (int q = 0; q < 8; ++q) ssum += ssr[q * 32 + t];
            const float rstd = rsqrtf(ssum * (1.0f / D) + EPS);
            rs[t] = rstd;
            float gl[8];
#pragma unroll
            for (int j = 0; j < 8; ++j) {
                float a = 0.f;
#pragma unroll
                for (int q = 0; q < 8; ++q) a += red[(q * 32 + t) * 80 + j];
                gl[j] = a * rstd + cb[b * 80 + j];
            }
            int gi = 0; float gmax = gl[0];
#pragma unroll
            for (int j = 1; j < 8; ++j) if (gl[j] > gmax) { gmax = gl[j]; gi = j; }
            float gsum = 0.f;
#pragma unroll
            for (int j = 0; j < 8; ++j) gsum += __expf(gl[j] - gmax);
            const float pg = 1.0f / gsum;
            float el[8];
#pragma unroll
            for (int j = 0; j < 8; ++j) {
                float a = 0.f;
#pragma unroll
                for (int q = 0; q < 8; ++q) a += red[(q * 32 + t) * 80 + 8 + gi * 8 + j];
                el[j] = a * rstd + cb[b * 80 + 8 + gi * 8 + j];
            }
            int i1 = 0; float e1 = el[0];
#pragma unroll
            for (int j = 1; j < 8; ++j) if (el[j] > e1) { e1 = el[j]; i1 = j; }
            int i2 = -1; float e2 = -3.0e38f;
#pragma unroll
            for (int j = 0; j < 8; ++j) if (j != i1 && el[j] > e2) { e2 = el[j]; i2 = j; }
            const float r2 = __expf(e2 - e1);
            const float tp1 = 1.0f / (1.0f + r2), tp2 = r2 / (1.0f + r2);
            const int row = tok0 + t;
            const int ea = gi * 8 + i1, eb = gi * 8 + i2;
            const unsigned sa = atomicAdd(&cnt[ea], 1u), sb = atomicAdd(&cnt[eb], 1u);
            ltok[ea * NTOK + sa] = row * 2; lw[ea * NTOK + sa] = pg * tp1;
            ltok[eb * NTOK + sb] = row * 2 + 1; lw[eb * NTOK + sb] = pg * tp2;
            if (!dummy) { u32x4 rec; rec.x = ((unsigned)ea << 13) | sa; rec.y = __float_as_uint(pg * tp1); rec.z = ((unsigned)eb << 13) | sb; rec.w = __float_as_uint(pg * tp2);
                *(u32x4*)(p.ws + WS_TREC + (size_t)row * 16) = rec; }
        }
        __syncthreads();
#pragma unroll 1
        for (int q = 0; q < 4; ++q) {
            const int row = tok0 + c.wid * 4 + q;
            const float rstd = rs[c.wid * 4 + q];
#pragma unroll
            for (int i = 0; i < 8; ++i) {
                const int col = i * 256 + c.lane * 4;
                const f32x4 v = *(const f32x4*)(x1 + (size_t)row * D + col);
                const f32x4 gg = *(const f32x4*)(g + col), sh = *(const f32x4*)(mod + b * NMOD + 3 * D + col), scl = *(const f32x4*)(mod + b * NMOD + 4 * D + col);
                float o[4];
#pragma unroll
                for (int j = 0; j < 4; ++j) o[j] = (v[j] * rstd * gg[j]) * (1.0f + scl[j]) + sh[j];
                u32x2 w; w.x = pack_bf16(o[0], o[1]); w.y = pack_bf16(o[2], o[3]);
                *(u32x2*)(h2 + (size_t)row * D + col) = w;
            }
        }
    }
}

constexpr int MOE_TAB = 100 * 1024;
__device__ __forceinline__ void moe_table(const Params& p, const Ctx& c) {
    const unsigned* cnt = (const unsigned*)(p.ws + WS_CTL) + CW_CNT;
    LAS int* tab = (LAS int*)(c.lds + MOE_TAB);
    __syncthreads();
    if (c.tid == 0) {
        int rp = 0;
        for (int e = 0; e < NE; ++e) { const int n = (int)cnt[e]; tab[e] = n; tab[64 + e] = rp; rp += n; }
        tab[64 + 64] = rp;
        for (int q = 0; q < 8; ++q) { int ip = 0; for (int j = 0; j < 8; ++j) { tab[256 + 16 * q + j] = ip; ip += ((tab[q + 8 * j] + 255) >> 8) * 16; } tab[256 + 16 * q + 8] = ip; }
    }
    __syncthreads();
}
__device__ __forceinline__ bool moe_next(XQueue& q, const Ctx& c, int& e, int& mt, int& ntile, int& cnt_e, int& rbase) {
    LAS int* tab = (LAS int*)(c.lds + MOE_TAB);
    while (q.v < 8) {
        const int qi = (q.x + q.v) & 7;
        const int L = next_item(q.heads + qi * 64, c);
        if (L < tab[256 + 16 * qi + 8]) {
            int j = 0;
#pragma unroll
            for (int k = 1; k < 8; ++k) if (tab[256 + 16 * qi + k] <= L) j = k;
            e = qi + 8 * j;
            while (tab[e] == 0 && j > 0) { --j; e -= 8; }
            cnt_e = tab[e]; rbase = tab[64 + e];
            const int loc = L - tab[256 + 16 * qi + j], nmt = (cnt_e + 255) >> 8;
            ntile = loc / nmt; mt = loc - ntile * nmt;
            return true;
        }
        ++q.v;
    }
    return false;
}

__device__ __forceinline__ void phase_moe1(const Params& p, const Ctx& c, int qsel = 1) {
    const bf16_t* h2 = (const bf16_t*)(p.ws + WS_H2);
    const int* ltok = (const int*)(p.ws + WS_LTOK);
    bf16_t* act = (bf16_t*)(p.ws + WS_ACT);
    const float* wg = p.in[20]; const float* wu = p.in[21];
    moe_table(p, c);
    XQueue q = xq_make(p, qsel);
    for (;;) {
        int e, mt, ntile, cnt_e, rbase;
        if (!moe_next(q, c, e, mt, ntile, cnt_e, rbase)) break;
        const int n0 = ntile * 64;
        const bf16_t* arow[4];
#pragma unroll
        for (int i = 0; i < 4; ++i) {
            const int r = mt * 256 + a_piece_row(c, i);
            const int tok = r < cnt_e ? (ltok[e * NTOK + r] >> 1) : 0;
            arow[i] = h2 + (size_t)tok * D + a_piece_col(c);
        }
        const int nq = b_nq(c), blk = nq >> 2;
        const float* wsrc = ((blk & 1) ? wu : wg) + (size_t)e * D * DE;
        const float* bptr = wsrc + (size_t)b_k0(c) * DE + n0 + 16 * (blk >> 1) + 4 * (nq & 3);
        f32x4 acc[8][2]; zero_acc(acc);
        gemm_mainloop<MOE_NT, D>(acc, arow, bptr, DE, c);
#pragma unroll
        for (int mi = 0; mi < 8; ++mi) {
            const int r = mt * 256 + 128 * c.wr + 16 * mi + c.fr;
            if (r < cnt_e) {
                const int col = n0 + 16 * c.wc + 4 * c.fq;
                float o[4];
#pragma unroll
                for (int j = 0; j < 4; ++j) { const float a = acc[mi][0][j], u = acc[mi][1][j]; o[j] = a / (1.0f + __expf(-a)) * u; }
                u32x2 w; w.x = pack_bf16(o[0], o[1]); w.y = pack_bf16(o[2], o[3]);
                *(u32x2*)(act + (size_t)(rbase + r) * DE + col) = w;
            }
        }
    }
}
__device__ __forceinline__ void phase_moe2(const Params& p, const Ctx& c, int qsel = 2) {
    const int* ltok = (const int*)(p.ws + WS_LTOK); const float* lw = (const float*)(p.ws + WS_LW);
    const bf16_t* act = (const bf16_t*)(p.ws + WS_ACT);
    float* y = (float*)(p.ws + WS_Y);
    const float* wd = p.in[22];
    moe_table(p, c);
    XQueue q = xq_make(p, qsel);
    for (;;) {
        int e, mt, ntile, cnt_e, rbase;
        if (!moe_next(q, c, e, mt, ntile, cnt_e, rbase)) break;
        const int n0 = ntile * 128;
        const bf16_t* arow[4];
#pragma unroll
        for (int i = 0; i < 4; ++i) arow[i] = act + (size_t)(rbase + mt * 256 + a_piece_row(c, i)) * DE + a_piece_col(c);
        const float* bptr = wd + (size_t)e * DE * D + (size_t)b_k0(c) * D + n0 + 4 * b_nq(c);
        f32x4 acc[8][2]; zero_acc(acc);
        gemm_mainloop<MOE_NT, DE>(acc, arow, bptr, D, c);
#pragma unroll
        for (int mi = 0; mi < 8; ++mi) {
            const int r = mt * 256 + 128 * c.wr + 16 * mi + c.fr;
            if (r < cnt_e) {
                const int ent = ltok[e * NTOK + r]; const float w = lw[e * NTOK + r];
#pragma unroll
                for (int ni = 0; ni < 2; ++ni) {
                    const int col = n0 + 32 * c.wc + 16 * ni + 4 * c.fq;
                    *(f32x4*)(y + (size_t)ent * D + col) = acc[mi][ni] * w;
                }
            }
        }
    }
}

constexpr int MOE_TAB2 = 132 * 1024;
__device__ __forceinline__ void moe_table2(const Params& p, const Ctx& c) {
    const unsigned* cnt = (const unsigned*)(p.ws + WS_CTL) + CW_CNT;
    LAS int* tab = (LAS int*)(c.lds + MOE_TAB2);
    __syncthreads();
    if (c.tid == 0) {
        int rp = 0;
        for (int e = 0; e < NE; ++e) { const int n = (int)cnt[e]; tab[e] = n; tab[64 + e] = rp; rp += n; }
        tab[64 + 64] = rp;
        for (int q = 0; q < 8; ++q) { int ip = 0; for (int j = 0; j < 8; ++j) { tab[256 + 16 * q + j] = ip; ip += ((tab[q + 8 * j] + 255) >> 8) * 8; } tab[256 + 16 * q + 8] = ip; }
    }
    __syncthreads();
}
__device__ __forceinline__ bool moe_next2(XQueue& q, const Ctx& c, int& e, int& mt, int& ntile, int& cnt_e, int& rbase) {
    LAS int* tab = (LAS int*)(c.lds + MOE_TAB2);
    while (q.v < 8) {
        const int qi = (q.x + q.v) & 7;
        const int L = next_item(q.heads + qi * 64, c);
        if (L < tab[256 + 16 * qi + 8]) {
            int j = 0;
#pragma unroll
            for (int k = 1; k < 8; ++k) if (tab[256 + 16 * qi + k] <= L) j = k;
            e = qi + 8 * j;
            while (tab[e] == 0 && j > 0) { --j; e -= 8; }
            cnt_e = tab[e]; rbase = tab[64 + e];
            const int loc = L - tab[256 + 16 * qi + j], nmt = (cnt_e + 255) >> 8;
            ntile = loc / nmt; mt = loc - ntile * nmt;
            return true;
        }
        ++q.v;
    }
    return false;
}
__device__ __forceinline__ void zero_acc4(f32x4 (&acc)[8][4]) {
#pragma unroll
    for (int mi = 0; mi < 8; ++mi)
#pragma unroll
        for (int ni = 0; ni < 4; ++ni) acc[mi][ni] = (f32x4){0.f, 0.f, 0.f, 0.f};
}
__device__ __forceinline__ void phase_moe1w(const Params& p, const Ctx& c, int qsel = 1) {
    const bf16_t* h2 = (const bf16_t*)(p.ws + WS_H2);
    const int* ltok = (const int*)(p.ws + WS_LTOK);
    bf16_t* act = (bf16_t*)(p.ws + WS_ACT);
    const float* wg = p.in[20]; const float* wu = p.in[21];
    moe_table2(p, c);
    XQueue q = xq_make(p, qsel);
    const int blk = c.lane >> 2;
    const float* wsel = (blk & 1) ? wu : wg;
    const int bcol = 16 * (blk >> 1) + 4 * (c.lane & 3);
    int e, mt, ntile, cnt_e, rbase;
    if (!moe_next2(q, c, e, mt, ntile, cnt_e, rbase)) return;
    int aoff[4];
#pragma unroll
    for (int i = 0; i < 4; ++i) { const int r = mt * 256 + a_piece_row(c, i); const int tok = r < cnt_e ? (ltok[e * NTOK + r] >> 1) : 0; aoff[i] = tok * D + a_piece_col(c); }
    const float* bptr = wsel + (size_t)e * D * DE + (size_t)(8 * c.wid) * DE + ntile * 128 + bcol;
    bool staged = false;
    f32x4 rb[8];
    for (;;) {
        int en, mtn, ntilen, cntn, rbasen;
        const bool hn = moe_next2(q, c, en, mtn, ntilen, cntn, rbasen);
        int aoffn[4]; const float* bptrn; int nrn;
        if (hn) {
#pragma unroll
            for (int i = 0; i < 4; ++i) { const int r = mtn * 256 + a_piece_row(c, i); const int tok = r < cntn ? (ltok[en * NTOK + r] >> 1) : 0; aoffn[i] = tok * D + a_piece_col(c); }
            bptrn = wsel + (size_t)en * D * DE + (size_t)(8 * c.wid) * DE + ntilen * 128 + bcol; nrn = cntn - mtn * 256;
        } else {
#pragma unroll
            for (int i = 0; i < 4; ++i) aoffn[i] = aoff[i] + (D / 64 - 1) * 64;
            bptrn = bptr + (size_t)((D / 64 - 1) * 64) * DE; nrn = cnt_e - mt * 256;
        }
        const int n0 = ntile * 128;
        f32x4 acc[8][4]; zero_acc4(acc);
        gemm_mainloop256<D>(acc, rb, h2, aoff, bptr, DE, cnt_e - mt * 256, c, staged, aoffn, bptrn, nrn, hn);
#pragma unroll
        for (int mi = 0; mi < 8; ++mi) {
            const int r = mt * 256 + 128 * c.wr + 16 * mi + c.fr;
            if (r < cnt_e) {
#pragma unroll
                for (int hh = 0; hh < 2; ++hh) {
                    const int col = n0 + 16 * (2 * c.wc + hh) + 4 * c.fq;
                    float o[4];
#pragma unroll
                    for (int j = 0; j < 4; ++j) { const float a = acc[mi][2 * hh][j], u = acc[mi][2 * hh + 1][j]; o[j] = a / (1.0f + __expf(-a)) * u; }
                    u32x2 w; w.x = pack_bf16(o[0], o[1]); w.y = pack_bf16(o[2], o[3]);
                    *(u32x2*)(act + (size_t)(rbase + r) * DE + col) = w;
                }
            }
        }
        if (!hn) break;
        e = en; mt = mtn; ntile = ntilen; cnt_e = cntn; rbase = rbasen; bptr = bptrn; staged = true;
#pragma unroll
        for (int i = 0; i < 4; ++i) aoff[i] = aoffn[i];
    }
    asm volatile("s_waitcnt vmcnt(0)" ::: "memory");
}
__device__ __forceinline__ void phase_moe2w(const Params& p, const Ctx& c, int qsel = 2) {
    const bf16_t* act = (const bf16_t*)(p.ws + WS_ACT);
    bf16_t* yb = (bf16_t*)(p.ws + WS_Y);
    const float* wd = p.in[22];
    moe_table2(p, c);
    XQueue q = xq_make(p, qsel);
    int e, mt, ntile, cnt_e, rbase;
    if (!moe_next2(q, c, e, mt, ntile, cnt_e, rbase)) return;
    int aoff[4];
#pragma unroll
    for (int i = 0; i < 4; ++i) aoff[i] = (rbase + mt * 256 + a_piece_row(c, i)) * DE + a_piece_col(c);
    const float* bptr = wd + (size_t)e * DE * D + (size_t)(8 * c.wid) * D + ntile * 256 + 4 * c.lane;
    bool staged = false;
    f32x4 rb[8];
    for (;;) {
        int en, mtn, ntilen, cntn, rbasen;
        const bool hn = moe_next2(q, c, en, mtn, ntilen, cntn, rbasen);
        int aoffn[4]; const float* bptrn; int nrn;
        if (hn) {
#pragma unroll
            for (int i = 0; i < 4; ++i) aoffn[i] = (rbasen + mtn * 256 + a_piece_row(c, i)) * DE + a_piece_col(c);
            bptrn = wd + (size_t)en * DE * D + (size_t)(8 * c.wid) * D + ntilen * 256 + 4 * c.lane; nrn = cntn - mtn * 256;
        } else {
#pragma unroll
            for (int i = 0; i < 4; ++i) aoffn[i] = aoff[i] + (DE / 64 - 1) * 64;
            bptrn = bptr + (size_t)((DE / 64 - 1) * 64) * D; nrn = cnt_e - mt * 256;
        }
        const int n0 = ntile * 256;
        f32x4 acc[8][4]; zero_acc4(acc);
        gemm_mainloop256<DE>(acc, rb, act, aoff, bptr, D, cnt_e - mt * 256, c, staged, aoffn, bptrn, nrn, hn);
#pragma unroll
        for (int mi = 0; mi < 8; ++mi) {
            const int r = mt * 256 + 128 * c.wr + 16 * mi + c.fr;
            if (r < cnt_e) {
#pragma unroll
                for (int ni = 0; ni < 4; ++ni) {
                    const int col = n0 + 64 * c.wc + 16 * ni + 4 * c.fq;
                    const f32x4 v = acc[mi][ni];
                    u32x2 pk; pk.x = pack_bf16(v[0], v[1]); pk.y = pack_bf16(v[2], v[3]);
                    *(u32x2*)(yb + (size_t)(rbase + r) * D + col) = pk;
                }
            }
        }
        if (!hn) break;
        e = en; mt = mtn; ntile = ntilen; cnt_e = cntn; rbase = rbasen; bptr = bptrn; staged = true;
#pragma unroll
        for (int i = 0; i < 4; ++i) aoff[i] = aoffn[i];
    }
    asm volatile("s_waitcnt vmcnt(0)" ::: "memory");
}

__device__ __forceinline__ void phase_final(const Params& p, const Ctx& c) {
    const float* x1 = (const float*)(p.ws + WS_X1); const bf16_t* yb = (const bf16_t*)(p.ws + WS_Y);
    const float* mod = (const float*)(p.ws + WS_MOD); const float* g = p.in[23];
    const unsigned* cnt = (const unsigned*)(p.ws + WS_CTL) + CW_CNT;
    LAS int* rpre = (LAS int*)c.lds;
    __syncthreads();
    if (c.tid == 0) { int rp = 0; for (int e = 0; e < NE; ++e) { rpre[e] = rp; rp += (int)cnt[e]; } }
    __syncthreads();
    for (int row = c.bid * 8 + c.wid; row < NTOK; row += c.nblk * 8) {
        const int b = row >> 11;
        const u32x4 rec = *(const u32x4*)(p.ws + WS_TREC + (size_t)row * 16);
        const size_t r0 = (size_t)(rpre[rec.x >> 13] + (int)(rec.x & 8191u)), r1 = (size_t)(rpre[rec.z >> 13] + (int)(rec.z & 8191u));
        const float w0 = __uint_as_float(rec.y), w1 = __uint_as_float(rec.w);
        f32x4 v[8]; float ss = 0.f;
#pragma unroll
        for (int i = 0; i < 8; ++i) {
            const int col = i * 256 + c.lane * 4;
            const f32x4 xv = *(const f32x4*)(x1 + (size_t)row * D + col);
            const u32x2 a0 = *(const u32x2*)(yb + r0 * D + col), a1 = *(const u32x2*)(yb + r1 * D + col);
            f32x4 y0, y1;
            y0[0] = __uint_as_float(a0.x << 16); y0[1] = __uint_as_float(a0.x & 0xffff0000u); y0[2] = __uint_as_float(a0.y << 16); y0[3] = __uint_as_float(a0.y & 0xffff0000u);
            y1[0] = __uint_as_float(a1.x << 16); y1[1] = __uint_as_float(a1.x & 0xffff0000u); y1[2] = __uint_as_float(a1.y << 16); y1[3] = __uint_as_float(a1.y & 0xffff0000u);
            const f32x4 gf = *(const f32x4*)(mod + b * NMOD + 5 * D + col);
            v[i] = xv + gf * (y0 * w0 + y1 * w1);
            ss += v[i][0] * v[i][0] + v[i][1] * v[i][1] + v[i][2] * v[i][2] + v[i][3] * v[i][3];
        }
        ss = wave_sum(ss);
        const float rstd = rsqrtf(ss * (1.0f / D) + EPS);
#pragma unroll
        for (int i = 0; i < 8; ++i) {
            const int col = i * 256 + c.lane * 4;
            const f32x4 gg = *(const f32x4*)(g + col);
            *(f32x4*)(p.out + (size_t)row * D + col) = v[i] * rstd * gg;
        }
    }
}

struct EpiProjIn {
    static constexpr bool PERM = false, AFTER_DRAIN = false;
    unsigned char* ws;
    __device__ __forceinline__ void operator()(const pg8::f32x4 (&acc)[2][2][4][2], const pg8::Unit& u, int wr, int wc, int fr, int fq) const {
        const int region = (u.pn * 256) >> 10;
#pragma unroll
        for (int ai = 0; ai < 2; ++ai)
#pragma unroll
            for (int m = 0; m < 4; ++m) {
                const int row = u.pm * 256 + ai * 128 + wr * 64 + m * 16 + fr;
#pragma unroll
                for (int bj = 0; bj < 2; ++bj)
#pragma unroll
                    for (int n = 0; n < 2; ++n) {
                        const int col = u.pn * 256 + bj * 128 + wc * 32 + n * 16 + 4 * fq;
                        const f32x4 a = acc[ai][bj][m][n];
                        if (region < 6) {
                            const int cin = col & 1023;
                            if (region == 2 || region == 5) {
                                bf16_t* vt = (bf16_t*)(ws + (region == 2 ? WS_VAT : WS_VBT));
                                const int b = row >> 11, s0 = row & 2047, hh = cin >> 7, d = cin & 127;
                                const int s = (s0 & ~31) | ((s0 & 12) << 1) | ((s0 & 16) >> 2) | (s0 & 3);
                                const unsigned w0 = pack_bf16(a[0], a[1]), w1 = pack_bf16(a[2], a[3]);
                                bf16_t* base = vt + ((size_t)((b * 8 + hh) * 128 + d)) * SEQ + s;
                                base[0] = (bf16_t)(w0 & 0xffff); base[SEQ] = (bf16_t)(w0 >> 16); base[2 * SEQ] = (bf16_t)(w1 & 0xffff); base[3 * SEQ] = (bf16_t)(w1 >> 16);
                            } else {
                                const size_t off = region == 0 ? WS_QA : region == 1 ? WS_KA : region == 3 ? WS_QB : WS_KB;
                                bf16_t* dst = (bf16_t*)(ws + off);
                                u32x2 w; w.x = pack_bf16(a[0], a[1]); w.y = pack_bf16(a[2], a[3]);
                                *(u32x2*)(dst + (size_t)row * 1024 + cin) = w;
                            }
                        } else {
                            bf16_t* dst = (bf16_t*)(ws + (region < 8 ? WS_GA : WS_GB));
                            const int cin = col - (region < 8 ? 6144 : 8192);
                            u32x2 w; w.x = pack_bf16(sigmoidf_(a[0]), sigmoidf_(a[1])); w.y = pack_bf16(sigmoidf_(a[2]), sigmoidf_(a[3]));
                            *(u32x2*)(dst + (size_t)row * D + cin) = w;
                        }
                    }
            }
    }
};
template <int PASS> struct EpiGate {
    static constexpr bool PERM = false, AFTER_DRAIN = false;
    const bf16_t* G; float* tmp; bf16_t* out;
    __device__ __forceinline__ void operator()(const pg8::f32x4 (&acc)[2][2][4][2], const pg8::Unit& u, int wr, int wc, int fr, int fq) const {
#pragma unroll
        for (int ai = 0; ai < 2; ++ai)
#pragma unroll
            for (int m = 0; m < 4; ++m) {
                const int row = u.pm * 256 + ai * 128 + wr * 64 + m * 16 + fr;
#pragma unroll
                for (int bj = 0; bj < 2; ++bj)
#pragma unroll
                    for (int n = 0; n < 2; ++n) {
                        const int col = u.pn * 256 + bj * 128 + wc * 32 + n * 16 + 4 * fq;
                        const u32x2 gw = *(const u32x2*)(G + (size_t)row * D + col);
                        f32x4 g; g[0] = __uint_as_float(gw.x << 16); g[1] = __uint_as_float(gw.x & 0xffff0000u); g[2] = __uint_as_float(gw.y << 16); g[3] = __uint_as_float(gw.y & 0xffff0000u);
                        f32x4 v = acc[ai][bj][m][n] * g;
                        if (PASS == 0) *(f32x4*)(tmp + (size_t)row * D + col) = v;
                        else {
                            v += *(const f32x4*)(tmp + (size_t)row * D + col);
                            u32x2 w; w.x = pack_bf16(v[0], v[1]); w.y = pack_bf16(v[2], v[3]);
                            *(u32x2*)(out + (size_t)row * D + col) = w;
                        }
                    }
            }
    }
};
struct EpiX1 {
    static constexpr bool PERM = false, AFTER_DRAIN = false;
    const float* x; const float* mod; float* x1;
    __device__ __forceinline__ void operator()(const pg8::f32x4 (&acc)[2][2][4][2], const pg8::Unit& u, int wr, int wc, int fr, int fq) const {
        const int b = (u.pm * 256) >> 11;
#pragma unroll
        for (int ai = 0; ai < 2; ++ai)
#pragma unroll
            for (int m = 0; m < 4; ++m) {
                const int row = u.pm * 256 + ai * 128 + wr * 64 + m * 16 + fr;
#pragma unroll
                for (int bj = 0; bj < 2; ++bj)
#pragma unroll
                    for (int n = 0; n < 2; ++n) {
                        const int col = u.pn * 256 + bj * 128 + wc * 32 + n * 16 + 4 * fq;
                        const f32x4 gm = *(const f32x4*)(mod + b * NMOD + 2 * D + col);
                        const f32x4 xv = *(const f32x4*)(x + (size_t)row * D + col);
                        *(f32x4*)(x1 + (size_t)row * D + col) = xv + gm * acc[ai][bj][m][n];
                    }
            }
    }
};
__device__ __forceinline__ void phase_proj_in2(const Params& p, const Ctx& c) {
    pg8::Gemm g{(const bf16_t*)(p.ws + WS_H), (const bf16_t*)(p.ws + WS_WIN_T), NTOK, INC, D};
    pg8::StaticOrder S; S.init(NTOK, INC, c.nblk, c.bid);
    EpiProjIn E{p.ws};
    pg8::gemm_phase<EpiProjIn, pg8::StaticOrder>(c.lds, g, S, E, nullptr, c.wid);
}
__device__ __forceinline__ void phase_merge2(const Params& p, const Ctx& c) {
    float* tmp = (float*)(p.ws + WS_X1);
    {
        pg8::Gemm g{(const bf16_t*)(p.ws + WS_OA), (const bf16_t*)(p.ws + WS_WPA_T), NTOK, D, 1024};
        pg8::StaticOrder S; S.init(NTOK, D, c.nblk, c.bid);
        EpiGate<0> E{(const bf16_t*)(p.ws + WS_GA), tmp, nullptr};
        pg8::gemm_phase<EpiGate<0>, pg8::StaticOrder>(c.lds, g, S, E, nullptr, c.wid);
    }
    {
        pg8::Gemm g{(const bf16_t*)(p.ws + WS_OB), (const bf16_t*)(p.ws + WS_WPB_T), NTOK, D, 1024};
        pg8::StaticOrder S; S.init(NTOK, D, c.nblk, c.bid);
        EpiGate<1> E{(const bf16_t*)(p.ws + WS_GB), tmp, (bf16_t*)(p.ws + WS_MRG)};
        pg8::gemm_phase<EpiGate<1>, pg8::StaticOrder>(c.lds, g, S, E, nullptr, c.wid);
    }
}
struct MidGate {
    static constexpr int AT = 16;
    const bf16_t* GA; const bf16_t* GB;
    __device__ __forceinline__ void operator()(pg8::f32x4 (&acc)[2][2][4][2], const pg8::Unit& u, int wr, int wc, int fr, int fq) const {
        int off0 = (u.pm * 256 + wr * 64 + fr) * D + u.pn * 256 + wc * 32 + 4 * fq;
        asm volatile("" : "+v"(off0));
#pragma unroll
        for (int ai = 0; ai < 2; ++ai)
#pragma unroll
            for (int m = 0; m < 4; ++m) {
#pragma unroll
                for (int bj = 0; bj < 2; ++bj)
#pragma unroll
                    for (int n = 0; n < 2; ++n) {
                        const int off = off0 + (ai * 128 + m * 16) * D + bj * 128 + n * 16;
                        const u32x2 a = *(const u32x2*)(GA + off), b = *(const u32x2*)(GB + off);
                        f32x4 r;
                        r[0] = __uint_as_float(a.x << 16) * __builtin_amdgcn_rcpf(__uint_as_float(b.x << 16)); r[1] = __uint_as_float(a.x & 0xffff0000u) * __builtin_amdgcn_rcpf(__uint_as_float(b.x & 0xffff0000u));
                        r[2] = __uint_as_float(a.y << 16) * __builtin_amdgcn_rcpf(__uint_as_float(b.y << 16)); r[3] = __uint_as_float(a.y & 0xffff0000u) * __builtin_amdgcn_rcpf(__uint_as_float(b.y & 0xffff0000u));
                        acc[ai][bj][m][n] *= r;
                    }
                asm volatile("" ::: "memory");
            }
    }
};
struct EpiGateB {
    static constexpr bool PERM = false, AFTER_DRAIN = false;
    const bf16_t* GB; bf16_t* out;
    __device__ __forceinline__ void operator()(const pg8::f32x4 (&acc)[2][2][4][2], const pg8::Unit& u, int wr, int wc, int fr, int fq) const {
#pragma unroll
        for (int ai = 0; ai < 2; ++ai)
#pragma unroll
            for (int m = 0; m < 4; ++m) {
                const int row = u.pm * 256 + ai * 128 + wr * 64 + m * 16 + fr;
#pragma unroll
                for (int bj = 0; bj < 2; ++bj)
#pragma unroll
                    for (int n = 0; n < 2; ++n) {
                        const int col = u.pn * 256 + bj * 128 + wc * 32 + n * 16 + 4 * fq;
                        const u32x2 gw = *(const u32x2*)(GB + (size_t)row * D + col);
                        f32x4 g; g[0] = __uint_as_float(gw.x << 16); g[1] = __uint_as_float(gw.x & 0xffff0000u); g[2] = __uint_as_float(gw.y << 16); g[3] = __uint_as_float(gw.y & 0xffff0000u);
                        const f32x4 v = acc[ai][bj][m][n] * g;
                        u32x2 w; w.x = pack_bf16(v[0], v[1]); w.y = pack_bf16(v[2], v[3]);
                        *(u32x2*)(out + (size_t)row * D + col) = w;
                    }
            }
    }
};
__device__ __forceinline__ void phase_merge3(const Params& p, const Ctx& c) {
    pg8::Gemm g{(const bf16_t*)(p.ws + WS_OA), (const bf16_t*)(p.ws + WS_WPA_T), NTOK, D, D};
    pg8::StaticOrder S; S.init(NTOK, D, c.nblk, c.bid);
    EpiGateB E{(const bf16_t*)(p.ws + WS_GB), (bf16_t*)(p.ws + WS_MRG)};
    MidGate M{(const bf16_t*)(p.ws + WS_GA), (const bf16_t*)(p.ws + WS_GB)};
    pg8::gemm_phase<EpiGateB, pg8::StaticOrder, false, MidGate>(c.lds, g, S, E, nullptr, c.wid, M);
}
__device__ __forceinline__ void phase_out2(const Params& p, const Ctx& c) {
    pg8::Gemm g{(const bf16_t*)(p.ws + WS_MRG), (const bf16_t*)(p.ws + WS_WOUT_T), NTOK, D, D};
    pg8::StaticOrder S; S.init(NTOK, D, c.nblk, c.bid);
    EpiX1 E{p.in[0], (const float*)(p.ws + WS_MOD), (float*)(p.ws + WS_X1)};
    pg8::gemm_phase<EpiX1, pg8::StaticOrder>(c.lds, g, S, E, nullptr, c.wid);
}

constexpr int LDS_BYTES = 160 * 1024;
__global__ void __launch_bounds__(512, 2) mk_fwd(Params p) {
    extern __shared__ __attribute__((aligned(16))) unsigned char smem[];
    LAS unsigned char* ldsb = (LAS unsigned char*)smem;
    Ctx c; c.lds = ldsb; c.tid = threadIdx.x; c.lane = c.tid & 63; c.wid = __builtin_amdgcn_readfirstlane(c.tid >> 6); c.wr = c.wid >> 2; c.wc = c.wid & 3;
    c.fr = c.lane & 15; c.fq = c.lane >> 4; c.bid = blockIdx.x; c.nblk = gridDim.x;
#define MKCTX() do {} while (0)
#define LEADER() (c.tid == 0)
    volatile LAS unsigned* bst = (volatile LAS unsigned*)(ldsb + LDS_BYTES - 32);
    if (LEADER()) { bst[0] = 0u; bst[1] = 0u; }
    __syncthreads();
    unsigned* barw = (unsigned*)(p.ws + WS_CTL);
    XcdBarrier bar; bar.bar = barw; bar.x = 0; bar.st = bst;
#if !MK_SPLIT
    bar = xcd_barrier_post(barw, bst, LEADER());
#define GRID_BAR() xcd_barrier(bar, LEADER())
#else
#define GRID_BAR() do {} while (0)
#endif
    const int lo = p.ph_lo, hi = p.ph_hi;
#define IN(k) (lo <= (k) && (k) < hi)
#define BOTH(k) (IN(k) && IN((k) + 1))
#define DUP(k) ((DUP_MASK >> (k)) & 1)
    if (IN(0)) { MKCTX(); phase_mod(p, c); phase_convert(p, c); if (DUP(0)) { GRID_BAR(); phase_mod(p, c); phase_convert(p, c); } if (BOTH(0)) GRID_BAR(); }
    if (IN(1)) { MKCTX(); phase_norm1(p, c); phase_router_prep(p, c); if (DUP(1)) { GRID_BAR(); phase_norm1(p, c); } if (BOTH(1)) GRID_BAR(); }
    if (IN(2)) { MKCTX(); phase_proj_in2(p, c); if (DUP(2)) { GRID_BAR(); phase_proj_in2(p, c); } if (BOTH(2)) GRID_BAR(); }
    if (IN(3)) { MKCTX(); phase_attn(p, c, 0); if (DUP(3)) { GRID_BAR(); phase_attn(p, c, 3); } if (BOTH(3)) GRID_BAR(); }
    if (IN(4)) { MKCTX(); phase_merge3(p, c); if (DUP(4)) { GRID_BAR(); phase_merge3(p, c); } if (BOTH(4)) GRID_BAR(); }
    if (IN(5)) { MKCTX(); phase_out2(p, c); if (DUP(5)) { GRID_BAR(); phase_out2(p, c); } if (BOTH(5)) GRID_BAR(); }
    if (IN(6)) { MKCTX(); phase_norm2_route2(p, c); if (DUP(6)) { GRID_BAR(); phase_norm2_route2(p, c, 1); } if (BOTH(6)) GRID_BAR(); }
    if (IN(7)) { MKCTX(); phase_moe1w(p, c, 1); if (DUP(7)) { GRID_BAR(); phase_moe1w(p, c, 4); } if (BOTH(7)) GRID_BAR(); }
    if (IN(8)) { MKCTX(); phase_moe2w(p, c, 2); if (DUP(8)) { GRID_BAR(); phase_moe2w(p, c, 5); } if (BOTH(8)) GRID_BAR(); }
    if (IN(9)) { MKCTX(); phase_final(p, c); if (DUP(9)) { GRID_BAR(); phase_final(p, c); } }
}

extern "C" void kernel_launch(void* const* d_in, const int* in_sizes, int n_in, void* d_out, int out_size, void* d_ws, size_t ws_size, hipStream_t stream) {
    static int grid = 0;
    if (grid == 0) {
        if (n_in != 24 || out_size != NTOK * D || ws_size < WS_END) { fprintf(stderr, "kernel_launch: unexpected shapes (n_in %d out %d ws %zu need %zu)\n", n_in, out_size, ws_size, (size_t)WS_END); grid = -1; return; }
        int dev = 0, cus = 0, per_cu = 0;
        (void)hipGetDevice(&dev); (void)hipDeviceGetAttribute(&cus, hipDeviceAttributeMultiprocessorCount, dev);
        if (hipFuncSetAttribute((const void*)mk_fwd, hipFuncAttributeMaxDynamicSharedMemorySize, LDS_BYTES) != hipSuccess) { fprintf(stderr, "kernel_launch: hipFuncSetAttribute failed\n"); grid = -1; return; }
        if (hipOccupancyMaxActiveBlocksPerMultiprocessor(&per_cu, (const void*)mk_fwd, 512, LDS_BYTES) != hipSuccess || per_cu < 1) { fprintf(stderr, "kernel_launch: occupancy query says %d\n", per_cu); }
        (void)hipGetLastError();
        grid = cus > 0 ? cus : 256;
    }
    if (grid < 0) return;
    (void)hipMemsetAsync((char*)d_ws + WS_CTL, 0, CTL_BYTES, stream);
    Params p{};
    for (int i = 0; i < 24; ++i) p.in[i] = (const float*)d_in[i];
    p.out = (float*)d_out; p.ws = (unsigned char*)d_ws;
#if MK_SPLIT
    for (int ph = 0; ph < NPHASE; ++ph) { p.ph_lo = ph; p.ph_hi = ph + 1; hipLaunchKernelGGL(mk_fwd, dim3(grid), dim3(512), LDS_BYTES, stream, p); }
#else
    p.ph_lo = 0; p.ph_hi = NPHASE;
    hipLaunchKernelGGL(mk_fwd, dim3(grid), dim3(512), LDS_BYTES, stream, p);
#endif
}
```

```cpp
#include <hip/hip_runtime.h>
#include <stdint.h>
#include <stdio.h>

#ifndef DUP_MASK
#define DUP_MASK 0
#endif
#ifndef MOE_NT
#define MOE_NT false
#endif
#ifndef MK_SPLIT
#define MK_SPLIT 0
#endif

typedef unsigned short bf16_t;
typedef short bf16x8 __attribute__((ext_vector_type(8)));
typedef short bf16x4 __attribute__((ext_vector_type(4)));
typedef float f32x4 __attribute__((ext_vector_type(4)));
typedef unsigned u32x4 __attribute__((ext_vector_type(4)));
typedef unsigned u32x2 __attribute__((ext_vector_type(2)));
#define LAS __attribute__((address_space(3)))

constexpr int D = 2048, NB = 4, SEQ = 2048, NTOK = NB * SEQ;
constexpr int INC = 10240, NMOD = 6 * D;
constexpr int NE = 64, DE = 1024;
constexpr float EPS = 1e-6f;
constexpr int NPHASE = 10;

constexpr size_t WS_CTL = 0;
constexpr size_t CTL_BYTES = 32768;
constexpr size_t CW_CNT = 4096;
constexpr size_t CW_Q = 4096 + 256;
constexpr size_t WS_MOD = WS_CTL + CTL_BYTES;
constexpr size_t WS_H = WS_MOD + (size_t)NB * NMOD * 4;
constexpr size_t WS_QA = WS_H + (size_t)NTOK * D * 2;
constexpr size_t WS_KA = WS_QA + (size_t)NTOK * 1024 * 2;
constexpr size_t WS_VAT = WS_KA + (size_t)NTOK * 1024 * 2;
constexpr size_t WS_QB = WS_VAT + (size_t)NTOK * 1024 * 2;
constexpr size_t WS_KB = WS_QB + (size_t)NTOK * 1024 * 2;
constexpr size_t WS_VBT = WS_KB + (size_t)NTOK * 1024 * 2;
constexpr size_t WS_GA = WS_VBT + (size_t)NTOK * 1024 * 2;
constexpr size_t WS_GB = WS_GA + (size_t)NTOK * D * 2;
constexpr size_t WS_OA = WS_GB + (size_t)NTOK * D * 2;
constexpr size_t WS_OB = WS_OA + (size_t)NTOK * 1024 * 2;
constexpr size_t WS_MRG = WS_OB + (size_t)NTOK * 1024 * 2;
constexpr size_t WS_X1 = WS_MRG + (size_t)NTOK * D * 2;
constexpr size_t WS_H2 = WS_X1 + (size_t)NTOK * D * 4;
constexpr size_t WS_LTOK = WS_H2 + (size_t)NTOK * D * 2;
constexpr size_t WS_LW = WS_LTOK + (size_t)NE * NTOK * 4;
constexpr size_t WS_ACT = WS_LW + (size_t)NE * NTOK * 4;
constexpr size_t WS_Y = WS_ACT + (size_t)(2 * NTOK + 512) * DE * 2;
constexpr size_t WS_WIN_T = WS_Y + (size_t)2 * NTOK * D * 4;
constexpr size_t WS_WPA_T = WS_WIN_T + (size_t)INC * D * 2;
constexpr size_t WS_WPB_T = WS_WPA_T + (size_t)D * 1024 * 2;
constexpr size_t WS_WOUT_T = WS_WPB_T + (size_t)D * 1024 * 2;
constexpr size_t WS_RW = WS_WOUT_T + (size_t)D * D * 2;
constexpr size_t WS_RC = WS_RW + (size_t)NB * 80 * D * 4;
constexpr size_t WS_TREC = WS_RC + 4096;
constexpr size_t WS_END = WS_TREC + (size_t)NTOK * 16;

#define XB_TMO      128
#define XB_XCNT(j)  (256  + 64 * (j))
#define XB_XSUB(j)  (1280 + 64 * (j))
#define XB_XGEN(j)  (2304 + 64 * (j))
#define XB_TOP      3328
#define XB_TOPGEN   3392
#define XCD_BAR_WORDS 3456
#define XB_SPIN_CAP (1u << 24)

__device__ __forceinline__ unsigned xb_ld(unsigned* p)              { return __hip_atomic_load(p, __ATOMIC_RELAXED, __HIP_MEMORY_SCOPE_AGENT); }
__device__ __forceinline__ unsigned xb_add(unsigned* p, unsigned v) { return __hip_atomic_fetch_add(p, v, __ATOMIC_RELAXED, __HIP_MEMORY_SCOPE_AGENT); }
__device__ __forceinline__ unsigned xb_xcc_id() { return (unsigned)__builtin_amdgcn_s_getreg((3 << 11) | 20) & 0xFu; }
#define XB_SPIN(cond, bar) do { unsigned _sp = 0; while (cond) { __builtin_amdgcn_s_sleep(1); \
    if ((++_sp & 255u) == 0u) { if (xb_ld(&(bar)[XB_TMO])) break; if (_sp > XB_SPIN_CAP) { atomicAdd(&(bar)[XB_TMO], 1u); break; } } } } while (0)

struct XcdBarrier { unsigned* bar; unsigned x; volatile LAS unsigned* st; };

__device__ __forceinline__ XcdBarrier xcd_barrier_post(unsigned* bar, volatile LAS unsigned* st, bool leader) {
    XcdBarrier b; b.bar = bar; b.x = xb_xcc_id(); b.st = st;
    if (leader) (void)xb_add(&bar[XB_XCNT(b.x)], 1u);
    return b;
}
__device__ __forceinline__ void xcd_barrier_complete(unsigned* bar, unsigned x, unsigned& nloc, unsigned& nx) {
    const unsigned G = gridDim.x * gridDim.y * gridDim.z;
    unsigned sum, cnt, mine, sp = 0u;
    for (;;) {
        sum = 0u; cnt = 0u; mine = 0u;
#pragma unroll
        for (unsigned j = 0; j < 16; ++j) { const unsigned c = xb_ld(&bar[XB_XCNT(j)]); sum += c; cnt += (c > 0u) ? 1u : 0u; mine = (j == x) ? c : mine; }
        if (sum == G) break;
        __builtin_amdgcn_s_sleep(1);
        if ((++sp & 255u) == 0u) { if (xb_ld(&bar[XB_TMO])) break; if (sp > XB_SPIN_CAP) { atomicAdd(&bar[XB_TMO], 1u); break; } }
    }
    nloc = mine > 0u ? mine : 1u; nx = cnt > 0u ? cnt : 1u;
}
__device__ __forceinline__ void xcd_barrier(const XcdBarrier& b, bool leader) {
    asm volatile("s_waitcnt vmcnt(0)" ::: "memory");
    __syncthreads();
    if (leader) {
        unsigned* bar = b.bar;
        __builtin_amdgcn_s_waitcnt(0);
        unsigned nloc = b.st[0], nx = b.st[1];
        if (nloc == 0u) { xcd_barrier_complete(bar, b.x, nloc, nx); b.st[0] = nloc; b.st[1] = nx; }
        const unsigned old = xb_add(&bar[XB_XSUB(b.x)], 1u);
        const unsigned gen = old / nloc;
        if (old + 1u == (gen + 1u) * nloc) {
            __builtin_amdgcn_fence(__ATOMIC_RELEASE, "agent");
            asm volatile("s_waitcnt vmcnt(0)" ::: "memory");
            const unsigned og = xb_add(&bar[XB_TOP], 1u);
            const unsigned tg = og / nx;
            if (og + 1u == (tg + 1u) * nx) xb_add(&bar[XB_TOPGEN], 1u);
            else XB_SPIN(xb_ld(&bar[XB_TOPGEN]) == tg, bar);
            __builtin_amdgcn_fence(__ATOMIC_ACQUIRE, "agent");
            xb_add(&bar[XB_XGEN(b.x)], 1u);
            asm volatile("s_waitcnt vmcnt(0)" ::: "memory");
        } else {
            XB_SPIN(xb_ld(&bar[XB_XGEN(b.x)]) == gen, bar);
            __builtin_amdgcn_fence(__ATOMIC_ACQUIRE, "agent");
            asm volatile("s_waitcnt vmcnt(0)" ::: "memory");
        }
    }
    __syncthreads();
}

typedef __bf16 bf16v2_t __attribute__((ext_vector_type(2)));
typedef float f32x2 __attribute__((ext_vector_type(2)));
__device__ __forceinline__ unsigned pack_bf16(float lo, float hi) {
    const f32x2 v = {lo, hi};
    return __builtin_bit_cast(unsigned, __builtin_convertvector(v, bf16v2_t));
}
__device__ __forceinline__ float wave_sum(float v) {
#pragma unroll
    for (int o = 32; o > 0; o >>= 1) v += __shfl_xor(v, o);
    return v;
}
__device__ __forceinline__ float xmax16(float v) { const auto r = __builtin_amdgcn_permlane16_swap(__float_as_uint(v), __float_as_uint(v), false, false); return fmaxf(__uint_as_float(r[0]), __uint_as_float(r[1])); }
__device__ __forceinline__ float xmax32(float v) { const auto r = __builtin_amdgcn_permlane32_swap(__float_as_uint(v), __float_as_uint(v), false, false); return fmaxf(__uint_as_float(r[0]), __uint_as_float(r[1])); }
__device__ __forceinline__ float xsum16(float v) { const auto r = __builtin_amdgcn_permlane16_swap(__float_as_uint(v), __float_as_uint(v), false, false); return __uint_as_float(r[0]) + __uint_as_float(r[1]); }
__device__ __forceinline__ float xsum32(float v) { const auto r = __builtin_amdgcn_permlane32_swap(__float_as_uint(v), __float_as_uint(v), false, false); return __uint_as_float(r[0]) + __uint_as_float(r[1]); }
__device__ __forceinline__ float sigmoidf_(float x) { return __builtin_amdgcn_rcpf(1.0f + __builtin_amdgcn_exp2f(-1.4426950408889634f * x)); }

__device__ __forceinline__ int lane_id_fresh() { int l; asm volatile("v_mbcnt_lo_u32_b32 %0, -1, 0\n\tv_mbcnt_hi_u32_b32 %0, -1, %0" : "=v"(l)); return l; }
struct Params { const float* in[24]; float* out; unsigned char* ws; int ph_lo, ph_hi; };

struct Ctx {
    int tid, lane, wid, wr, wc, fr, fq, bid, nblk;
    LAS unsigned char* lds;
};

__device__ __forceinline__ int next_item(unsigned* ctr, const Ctx& c) {
    LAS int* slot = (LAS int*)(c.lds + 160 * 1024 - 64);
    __syncthreads();
    if (c.tid == 0) *slot = (int)__hip_atomic_fetch_add(ctr, 1u, __ATOMIC_RELAXED, __HIP_MEMORY_SCOPE_AGENT);
    __syncthreads();
    return *slot;
}

struct XQueue { unsigned* heads; int x, v; };
__device__ __forceinline__ XQueue xq_make(const Params& p, int qsel) { XQueue q; q.heads = (unsigned*)(p.ws + WS_CTL) + CW_Q + qsel * 512; q.x = (int)(xb_xcc_id() & 7u); q.v = 0; return q; }
__device__ __forceinline__ bool xq_next(XQueue& q, int per_tile, int ntiles, const Ctx& c, int& tile, int& sub) {
    while (q.v < 8) {
        const int qi = (q.x + q.v) & 7;
        const int L = next_item(q.heads + qi * 64, c);
        const int t = qi + 8 * (L / per_tile);
        if (t < ntiles) { tile = t; sub = L % per_tile; return true; }
        ++q.v;
    }
    return false;
}

namespace pg8 {
#define PG8_LAS __attribute__((address_space(3)))
typedef unsigned short bf16_t;
typedef short bf16x8 __attribute__((ext_vector_type(8)));
typedef float f32x4 __attribute__((ext_vector_type(4)));
typedef unsigned u32x4 __attribute__((ext_vector_type(4)));
constexpr int BM = 256, BK = 64, HALF = 128, HTB = HALF * BK * 2  , STAGE_BYTES = 8 * HTB, NXCD = 8, WGM = 8;

__host__ __device__ __forceinline__ int lds_byte(int r, int c) { const int st = (r >> 4) * 2 + (c >> 5), rr = r & 15, cc = c & 31, ob = rr * 64 + cc * 2; return st * 1024 + (ob ^ (((ob >> 9) & 1) << 5)); }
__host__ __device__ __forceinline__ void stage_rc(int b, int& R, int& C) { const int st = b / 1024, sb = b % 1024, swz = sb ^ (((sb >> 9) & 1) << 5); R = (st >> 1) * 16 + swz / 64; C = (st & 1) * 32 + (swz % 64) / 2; }
__host__ __device__ __forceinline__ int perm32(int rho) { const int n = rho >> 4, i = rho & 15; return 8 * (i >> 2) + 4 * n + (i & 3); }

struct Unit { int pm, pn; };
struct Gemm { const bf16_t* A; const bf16_t* Bt; int M, N, K; };

struct StaticOrder {
    int nM, nN, nwg, G, c;
    __host__ __device__ void init(int M, int N, int G_, int c_) { nM = M / BM; nN = N / BM; nwg = nM * nN; G = G_; c = c_; }
    __host__ __device__ bool next(int i, Unit& u) const {
        const long L = (long)i * G + c; if (L >= nwg) return false;
        int wgid = (int)L; { const int q = nwg / NXCD, r = nwg % NXCD, xcd = wgid % NXCD, off = wgid / NXCD; wgid = (xcd < r ? xcd * (q + 1) : r * (q + 1) + (xcd - r) * q) + off; }
        const int nig = WGM * nN, gid = wgid / nig, fm = gid * WGM, gsz = (nM - fm) < WGM ? (nM - fm) : WGM;
        u.pm = fm + ((wgid % nig) % gsz); u.pn = (wgid % nig) / gsz; return true;
    }
    __device__ __forceinline__ void a_ready(const Unit&) const {}
    __device__ __forceinline__ void done(const Unit&) const {}
};
struct NoMid { static constexpr int AT = -1; __device__ __forceinline__ void operator()(f32x4 (&)[2][2][4][2], const Unit&, int, int, int, int) const {} };
template <class Epi, class Sched, bool STAMP = false, class Mid = NoMid>
__device__ __forceinline__ void gemm_phase(PG8_LAS unsigned char* lds, const Gemm g, const Sched& S, const Epi& E, unsigned long long* stamps, const int wid_in, const Mid& MH = Mid()) {
    const int wid = __builtin_amdgcn_readfirstlane(wid_in), lane = lane_id_fresh(), tid = wid * 64 + lane, wr = wid >> 2, wc = wid & 3, fr = lane & 15, fq = lane >> 4;
    const int K = g.K, nt = K / BK;
    int ts_lo = 0, ts_hi = 0, nts = 0; const unsigned long long rt_entry = STAMP ? (unsigned long long)wall_clock64() : 0ull;
#define PG8_STAMP() do { if (STAMP && wid == 0 && nts < 64) { const unsigned long long _c = (unsigned long long)clock64(); \
        ts_lo = (lane == nts) ? (int)(unsigned)_c : ts_lo; ts_hi = (lane == nts) ? (int)(unsigned)(_c >> 32) : ts_hi; ++nts; } } while (0)
    PG8_STAMP();
    unsigned voffA[2], voffB[2];
#pragma unroll
    for (int i = 0; i < 2; ++i) { int R, C; stage_rc(tid * 16 + i * 8192, R, C); const int Rb = Epi::PERM ? ((R & ~31) + perm32(R & 31)) : R;
        voffA[i] = (unsigned)(R * K + C) * 2u; voffB[i] = (unsigned)(Rb * K + C) * 2u; }
    const size_t kstep = (size_t)(BK * 2);
    const size_t hstep = (size_t)HALF * K * 2;
    const size_t tstep = 2 * hstep;
    const unsigned ldsw = (unsigned)wid * 1024u;
    const int aoff = lds_byte(wr * 64 + fr, fq * 8), boff = lds_byte(wc * 32 + fr, fq * 8);
#define PG8_SA(b, h) (((b) * 2 + (h)) * HTB)
#define PG8_SB(b, h) ((4 + (b) * 2 + (h)) * HTB)
#define PG8_STAGE(bufoff, gbase, voff) do { _Pragma("unroll") for (int _i = 0; _i < 2; ++_i) \
        __builtin_amdgcn_global_load_lds((const unsigned*)((const char*)(gbase) + (voff)[_i]), (PG8_LAS unsigned*)(lds + (bufoff) + ldsw + _i * 8192), 16, 0, 0); } while (0)
#define PG8_LDA(dst, b, h) do { _Pragma("unroll") for (int m = 0; m < 4; ++m) _Pragma("unroll") for (int k = 0; k < 2; ++k) dst[m][k] = *(const PG8_LAS bf16x8*)(lds + PG8_SA(b, h) + aoff + m * 2048 + k * 1024); } while (0)
#define PG8_LDB(dst, b, h) do { _Pragma("unroll") for (int n = 0; n < 2; ++n) _Pragma("unroll") for (int k = 0; k < 2; ++k) dst[n][k] = *(const PG8_LAS bf16x8*)(lds + PG8_SB(b, h) + boff + n * 2048 + k * 1024); } while (0)
#define PG8_MMA(ai, bj, At, Bt) do { __builtin_amdgcn_s_setprio(1); _Pragma("unroll") for (int m = 0; m < 4; ++m) _Pragma("unroll") for (int n = 0; n < 2; ++n) _Pragma("unroll") for (int k = 0; k < 2; ++k) \
        acc[ai][bj][m][n] = __builtin_amdgcn_mfma_f32_16x16x32_bf16(Bt[n][k], At[m][k], acc[ai][bj][m][n], 0, 0, 0); __builtin_amdgcn_s_setprio(0); } while (0)
#define PG8_WAIT_V(n) asm volatile("s_waitcnt vmcnt(" #n ")" ::: "memory")
#define PG8_WAIT_L(n) asm volatile("s_waitcnt lgkmcnt(" #n ")" ::: "memory")
#define PG8_BAR __builtin_amdgcn_s_barrier()
#define PG8_SCHED __builtin_amdgcn_sched_barrier(0)
    Unit cur, nxt; int ui = 0;
    if (!S.next(0, cur)) return;
    f32x4 acc[2][2][4][2];
#pragma unroll
    for (int a = 0; a < 2; ++a)
#pragma unroll
        for (int b = 0; b < 2; ++b)
#pragma unroll
            for (int m = 0; m < 4; ++m)
#pragma unroll
                for (int n = 0; n < 2; ++n) acc[a][b][m][n] = (f32x4){0.f, 0.f, 0.f, 0.f};
    bf16x8 At[4][2], B0[2][2], B1[2][2];
    const char* cA = (const char*)g.A + (size_t)cur.pm * tstep; const char* cB = (const char*)g.Bt + (size_t)cur.pn * tstep;
    S.a_ready(cur);
    PG8_STAGE(PG8_SB(0, 0), cB, voffB); PG8_STAGE(PG8_SA(0, 0), cA, voffA); PG8_STAGE(PG8_SB(0, 1), cB + hstep, voffB); PG8_STAGE(PG8_SA(0, 1), cA + hstep, voffA);
    if (wr == 1) PG8_BAR;
    PG8_WAIT_V(4); PG8_BAR;
    PG8_STAGE(PG8_SB(1, 0), cB + kstep, voffB); PG8_STAGE(PG8_SA(1, 0), cA + kstep, voffA); PG8_STAGE(PG8_SB(1, 1), cB + hstep + kstep, voffB);
    PG8_WAIT_V(6); PG8_BAR;
    PG8_STAMP();
    for (;;) {
        const bool has_next = S.next(ui + 1, nxt);
        const char* nA = has_next ? (const char*)g.A + (size_t)nxt.pm * tstep : cA; const char* nB = has_next ? (const char*)g.Bt + (size_t)nxt.pn * tstep : cB;
        for (int t = 0; t < nt; t += 2) {
            if (Mid::AT >= 0 && t == Mid::AT) MH(acc, cur, wr, wc, fr, fq);
            const bool last = (t == nt - 2);
            const char* a1 = cA + (size_t)(t + 1) * kstep;
            const char* a2 = last ? nA : cA + (size_t)(t + 2) * kstep; const char* b2 = last ? nB : cB + (size_t)(t + 2) * kstep;
            const char* a3 = a2 + kstep; const char* b3 = b2 + kstep;
            if (last && has_next) S.a_ready(nxt);
            PG8_LDB(B0, 0, 0); PG8_SCHED; PG8_LDA(At, 0, 0); PG8_STAGE(PG8_SA(1, 1), a1 + hstep, voffA);
            PG8_WAIT_L(8); PG8_BAR; PG8_WAIT_L(0); PG8_MMA(0, 0, At, B0); PG8_BAR; PG8_SCHED;
            PG8_LDB(B1, 0, 1); PG8_STAGE(PG8_SB(0, 0), b2, voffB);
            PG8_BAR; PG8_WAIT_L(0); PG8_MMA(0, 1, At, B1); PG8_BAR;
            PG8_LDA(At, 0, 1); PG8_STAGE(PG8_SA(0, 0), a2, voffA);
            PG8_BAR; PG8_WAIT_L(0); PG8_MMA(1, 0, At, B0); PG8_BAR; PG8_SCHED;
            PG8_STAGE(PG8_SB(0, 1), b2 + hstep, voffB);
            PG8_WAIT_V(6); PG8_BAR; PG8_MMA(1, 1, At, B1); PG8_BAR;
            PG8_LDB(B0, 1, 0); PG8_SCHED; PG8_LDA(At, 1, 0); PG8_STAGE(PG8_SA(0, 1), a2 + hstep, voffA);
            PG8_WAIT_L(8); PG8_BAR; PG8_WAIT_L(0); PG8_MMA(0, 0, At, B0); PG8_BAR; PG8_SCHED;
            PG8_LDB(B1, 1, 1); PG8_STAGE(PG8_SB(1, 0), b3, voffB);
            PG8_BAR; PG8_WAIT_L(0); PG8_MMA(0, 1, At, B1); PG8_BAR;
            PG8_LDA(At, 1, 1); PG8_STAGE(PG8_SA(1, 0), a3, voffA);
            PG8_BAR; PG8_WAIT_L(0); PG8_MMA(1, 0, At, B0); PG8_BAR; PG8_SCHED;
            PG8_STAGE(PG8_SB(1, 1), b3 + hstep, voffB);
            PG8_WAIT_V(6); PG8_BAR; PG8_MMA(1, 1, At, B1); PG8_BAR;
        }
        PG8_STAMP();
        if constexpr (!Epi::AFTER_DRAIN) { E(acc, cur, wr, wc, fr, fq); S.done(cur); }
        PG8_STAMP();
        if (!has_next) break;
#pragma unroll
        for (int a = 0; a < 2; ++a)
#pragma unroll
            for (int b = 0; b < 2; ++b)
#pragma unroll
                for (int m = 0; m < 4; ++m)
#pragma unroll
                    for (int n = 0; n < 2; ++n) acc[a][b][m][n] = (f32x4){0.f, 0.f, 0.f, 0.f};
        cur = nxt; cA = nA; cB = nB; ++ui;
    }
    PG8_WAIT_V(0);
    if (wr == 0) PG8_BAR;
    PG8_BAR;
    if constexpr (Epi::AFTER_DRAIN) { E.fused(acc, cur, wr, wc, fr, fq, lds, wid, lane); S.done(cur); }
    PG8_STAMP();
    if (STAMP && wid == 0) { stamps[lane] = lane < nts ? (((unsigned long long)(unsigned)ts_hi << 32) | (unsigned)ts_lo) : 0ull;
        if (lane == 62) stamps[62] = rt_entry; if (lane == 63) stamps[63] = (unsigned long long)wall_clock64(); }
#undef PG8_STAMP
#undef PG8_SA
#undef PG8_SB
#undef PG8_STAGE
#undef PG8_LDA
#undef PG8_LDB
#undef PG8_MMA
#undef PG8_WAIT_V
#undef PG8_WAIT_L
#undef PG8_BAR
#undef PG8_SCHED
}
}

constexpr int G_STAGE = 49152, G_BOFF = 32768;
template <bool NTB, int K>
__device__ __forceinline__ void gemm_mainloop(f32x4 (&acc)[8][2], const bf16_t* const (&arow)[4], const float* bptr, const int ldb, const Ctx& c) {
    const int lane = c.lane, wid = c.wid;
    constexpr int nt = K >> 6;
    const int half = lane & 1, nq = ((lane >> 1) & 7) | ((lane >> 4) << 3);
    int b_wr[4];
#pragma unroll
    for (int j = 0; j < 4; ++j) { const int n = 4 * nq + j; b_wr[j] = G_BOFF + n * 128 + ((wid ^ ((n >> 1) & 7)) << 4) + half * 8; }
    const int a_wr = wid * 4096 + lane * 16;
    const int fr = c.fr, fq = c.fq;
    int a_rd[2], b_rd[2][2];
#pragma unroll
    for (int kb = 0; kb < 2; ++kb) {
        a_rd[kb] = (128 * c.wr + fr) * 128 + ((((4 * kb + fq) ^ (fr & 7))) << 4);
#pragma unroll
        for (int ni = 0; ni < 2; ++ni) { const int n = 32 * c.wc + 16 * ni + fr; b_rd[kb][ni] = G_BOFF + n * 128 + (((4 * kb + fq) ^ ((n >> 1) & 7)) << 4); }
    }
    u32x4 ra[4]; f32x4 rb0[4], rb1[4];
    bf16x8 A0[8], A1[8], B0[2], B1[2];
#define G_LOADA(T) do { _Pragma("unroll") for (int i = 0; i < 4; ++i) ra[i] = *(const u32x4*)(arow[i] + (T) * 64); } while (0)
#define G_LOADB(RB, T) do { _Pragma("unroll") for (int i = 0; i < 4; ++i) { \
        if (NTB) RB[i] = __builtin_nontemporal_load((const f32x4*)(bptr + (size_t)((T) * 64 + i) * ldb)); else RB[i] = *(const f32x4*)(bptr + (size_t)((T) * 64 + i) * ldb); } } while (0)
#define G_WRITE(ST, RB) do { _Pragma("unroll") for (int i = 0; i < 4; ++i) *(LAS u32x4*)((ST) + a_wr + i * 1024) = ra[i]; \
        _Pragma("unroll") for (int j = 0; j < 4; ++j) { u32x2 w; w.x = pack_bf16(RB[0][j], RB[1][j]); w.y = pack_bf16(RB[2][j], RB[3][j]); *(LAS u32x2*)((ST) + b_wr[j]) = w; } } while (0)
#define G_LDF(ST, kb, AF, BF) do { _Pragma("unroll") for (int ni = 0; ni < 2; ++ni) BF[ni] = *(const LAS bf16x8*)((ST) + b_rd[kb][ni]); \
        _Pragma("unroll") for (int mi = 0; mi < 8; ++mi) AF[mi] = *(const LAS bf16x8*)((ST) + a_rd[kb] + mi * 2048); } while (0)
#define G_MMA(AF, BF) do { _Pragma("unroll") for (int mi = 0; mi < 8; ++mi) _Pragma("unroll") for (int ni = 0; ni < 2; ++ni) \
        acc[mi][ni] = __builtin_amdgcn_mfma_f32_16x16x32_bf16(BF[ni], AF[mi], acc[mi][ni], 0, 0, 0); } while (0)
#define G_SB __builtin_amdgcn_sched_barrier(0)
    LAS unsigned char* st0 = c.lds; LAS unsigned char* st1 = c.lds + G_STAGE;
    constexpr int tl = nt - 1;
    G_LOADA(0); G_LOADB(rb0, 0); G_LOADB(rb1, 1);
    G_WRITE(st0, rb0);
    G_LOADA(1); G_LOADB(rb0, 2);
    __syncthreads();
#pragma unroll 1
    for (int t = 0; t < nt; t += 2) {
        const int t2 = (t + 2 < tl) ? t + 2 : tl, t3 = (t + 3 < tl) ? t + 3 : tl, t4 = (t + 4 < tl) ? t + 4 : tl;
        G_LDF(st0, 0, A0, B0); G_LDF(st0, 1, A1, B1); G_SB;
        G_MMA(A0, B0); G_SB;
        G_WRITE(st1, rb1); G_SB;
        G_MMA(A1, B1); G_SB;
        G_LOADA(t2); G_LOADB(rb1, t3);
        __syncthreads();
        G_LDF(st1, 0, A0, B0); G_LDF(st1, 1, A1, B1); G_SB;
        G_MMA(A0, B0); G_SB;
        G_WRITE(st0, rb0); G_SB;
        G_MMA(A1, B1); G_SB;
        G_LOADA(t3); G_LOADB(rb0, t4);
        __syncthreads();
    }
#undef G_LOADA
#undef G_LOADB
#undef G_WRITE
#undef G_LDF
#undef G_MMA
#undef G_SB
}
constexpr int W_STAGE = 65536, W_BOFF = 32768;
__device__ __forceinline__ int swzb(int n) { return ((n >> 2) & 1) | ((((n >> 1) ^ (n >> 3)) & 1) << 1) | ((((n >> 2) ^ (n >> 4)) & 1) << 2); }
template <int K>
__device__ __forceinline__ void gemm_mainloop256(f32x4 (&acc)[8][4], f32x4 (&rb)[8], const bf16_t* abase, const int (&aoff)[4], const float* bptr, const int ldb, const int nrows, const Ctx& c,
                                                 const bool staged, const int (&aoffn)[4], const float* bptrn, const int nrows_n, const bool hn) {
    const int lane = c.lane, wid = c.wid;
    constexpr int nt = K >> 6;
    int b_wr[2];
#pragma unroll
    for (int jh = 0; jh < 2; ++jh) { const int n = 4 * lane + 2 * jh; b_wr[jh] = W_BOFF + n * 128 + ((wid ^ swzb(n)) << 4); }
    const int a_dma = wid * 4096;
    const int fr = c.fr, fq = c.fq;
    int a_rd[2], b_rd[2][2];
#pragma unroll
    for (int kb = 0; kb < 2; ++kb) {
        a_rd[kb] = (128 * c.wr + fr) * 128 + ((((4 * kb + fq) ^ (fr & 7))) << 4);
#pragma unroll
        for (int ni = 0; ni < 2; ++ni) { const int n = 64 * c.wc + 16 * ni + fr; b_rd[kb][ni] = W_BOFF + n * 128 + (((4 * kb + fq) ^ swzb(n)) << 4); }
    }
    const int nfr = __builtin_amdgcn_readfirstlane(max(0, min(8, (nrows - 128 * c.wr + 15) >> 4)));
    const int npc = __builtin_amdgcn_readfirstlane(max(0, min(4, (nrows - 32 * wid + 7) >> 3)));
    const int npcn = __builtin_amdgcn_readfirstlane(max(0, min(4, (nrows_n - 32 * wid + 7) >> 3)));
    const int n1a = hn ? 64 : 0;
    const size_t n1b = hn ? (size_t)64 * ldb : 0;
#define W_FA(ST, T, NT1) do { const bool nx = ((T) >= nt); const int np = nx ? npcn : npc; \
        _Pragma("unroll") for (int i = 0; i < 4; ++i) if (i < np) \
            __builtin_amdgcn_global_load_lds((const unsigned*)(abase + (nx ? aoffn[i] + ((NT1) ? n1a : 0) : aoff[i] + (T) * 64)), (LAS unsigned*)((ST) + a_dma + i * 1024), 16, 0, 0); } while (0)
#define W_FB(T, NT1) do { const bool nx = ((T) >= nt); \
        const float* bq = nx ? bptrn + ((NT1) ? n1b : 0) : bptr + (size_t)((T) * 64) * ldb; \
        _Pragma("unroll") for (int i = 0; i < 8; ++i) rb[i] = *(const f32x4*)(bq + (size_t)i * ldb); } while (0)
#define W_CVT() do { _Pragma("unroll") for (int j = 0; j < 4; ++j) { wv[j].x = pack_bf16(rb[0][j], rb[1][j]); wv[j].y = pack_bf16(rb[2][j], rb[3][j]); \
            wv[j].z = pack_bf16(rb[4][j], rb[5][j]); wv[j].w = pack_bf16(rb[6][j], rb[7][j]); } } while (0)
#define W_ST(ST) do { _Pragma("unroll") for (int j = 0; j < 4; ++j) *(LAS u32x4*)((ST) + b_wr[j >> 1] + (j & 1) * 128) = wv[j]; } while (0)
#define W_SB __builtin_amdgcn_sched_barrier(0)
#define W_DSR(dst, addr, off) asm volatile("ds_read_b128 %0, %1 offset:%2" : "=v"(dst) : "v"(addr), "i"(off))
#define W_COMPUTE(ST) do { const unsigned stb = (unsigned)(unsigned long)(ST); \
    _Pragma("unroll") for (int kb = 0; kb < 2; ++kb) { bf16x8 bf0, bf1, bf2, bf3, afc, afn; \
        const unsigned ba0 = stb + b_rd[kb][0], ba1 = stb + b_rd[kb][1], aa = stb + a_rd[kb]; \
        W_DSR(bf0, ba0, 0); W_DSR(bf1, ba1, 0); W_DSR(bf2, ba0, 4096); W_DSR(bf3, ba1, 4096); W_DSR(afc, aa, 0); \
        _Pragma("unroll") for (int mi = 0; mi < 8; ++mi) { \
            if (mi < 7) { W_DSR(afn, aa, (mi + 1) * 2048); } \
            if (mi == 0) asm volatile("s_waitcnt lgkmcnt(1)" : "+v"(afc), "+v"(bf0), "+v"(bf1), "+v"(bf2), "+v"(bf3)); \
            else if (mi < 7) asm volatile("s_waitcnt lgkmcnt(1)" : "+v"(afc)); \
            else asm volatile("s_waitcnt lgkmcnt(0)" : "+v"(afc)); \
            if (mi < nfr) { \
                acc[mi][0] = __builtin_amdgcn_mfma_f32_16x16x32_bf16(bf0, afc, acc[mi][0], 0, 0, 0); acc[mi][1] = __builtin_amdgcn_mfma_f32_16x16x32_bf16(bf1, afc, acc[mi][1], 0, 0, 0); \
                acc[mi][2] = __builtin_amdgcn_mfma_f32_16x16x32_bf16(bf2, afc, acc[mi][2], 0, 0, 0); acc[mi][3] = __builtin_amdgcn_mfma_f32_16x16x32_bf16(bf3, afc, acc[mi][3], 0, 0, 0); } \
            afc = afn; } } } while (0)
    LAS unsigned char* st0 = c.lds; LAS unsigned char* st1 = c.lds + W_STAGE;
    u32x4 wv[4];
    if (!staged) {
        W_FA(st0, 0, 0); W_FB(0, 0);
        W_CVT(); W_SB; W_FB(1, 0); W_SB; W_ST(st0);
        asm volatile("s_waitcnt vmcnt(8)" ::: "memory");
        __syncthreads();
        W_FA(st1, 1, 0);
    }
#pragma unroll 1
    for (int t = 0; t < nt; t += 2) {
        W_COMPUTE(st0);
        W_CVT(); W_SB; W_FB(t + 2, 0); W_SB; W_ST(st1);
        asm volatile("s_waitcnt vmcnt(8)" ::: "memory");
        __syncthreads();
        W_FA(st0, t + 2, 0);
        W_COMPUTE(st1);
        W_CVT(); W_SB; W_FB(t + 3, 1); W_SB; W_ST(st0);
        asm volatile("s_waitcnt vmcnt(8)" ::: "memory");
        __syncthreads();
        W_FA(st1, t + 3, 1);
    }
#undef W_FA
#undef W_FB
#undef W_CVT
#undef W_ST
#undef W_SB
#undef W_COMPUTE
#undef W_DSR
}
__device__ __forceinline__ int a_piece_row(const Ctx& c, int i) { return 32 * c.wid + 8 * i + (c.lane >> 3); }
__device__ __forceinline__ int a_piece_col(const Ctx& c) { return 8 * ((c.lane & 7) ^ ((c.lane >> 3) & 7)); }
__device__ __forceinline__ void zero_acc(f32x4 (&acc)[8][2]) {
#pragma unroll
    for (int mi = 0; mi < 8; ++mi)
#pragma unroll
        for (int ni = 0; ni < 2; ++ni) acc[mi][ni] = (f32x4){0.f, 0.f, 0.f, 0.f};
}
__device__ __forceinline__ int b_nq(const Ctx& c) { return ((c.lane >> 1) & 7) | ((c.lane >> 4) << 3); }
__device__ __forceinline__ int b_k0(const Ctx& c) { return 8 * c.wid + 4 * (c.lane & 1); }

__device__ __forceinline__ void phase_mod(const Params& p, const Ctx& c) {
    const float* cc = p.in[1]; const float* w_ada = p.in[3]; const float* b_ada = p.in[4];
    float* mod = (float*)(p.ws + WS_MOD);
    LAS float* sc = (LAS float*)c.lds;
    LAS float* red = (LAS float*)(c.lds + 32768);
    for (int i = c.tid; i < NB * D; i += 512) { const float v = cc[i]; sc[i] = v / (1.0f + __expf(-v)); }
    __syncthreads();
    const int cq = c.tid % 12, kl = c.tid / 12;
    for (int item = c.bid; item < 256; item += c.nblk) {
        float acc[4][4];
#pragma unroll
        for (int b = 0; b < 4; ++b)
#pragma unroll
            for (int j = 0; j < 4; ++j) acc[b][j] = 0.f;
        if (kl < 42) {
            const float* wp = w_ada + item * 48 + cq * 4;
            for (int k = kl; k < D; k += 42) {
                const f32x4 w = *(const f32x4*)(wp + (size_t)k * NMOD);
#pragma unroll
                for (int b = 0; b < 4; ++b) { const float s = sc[b * D + k];
#pragma unroll
                    for (int j = 0; j < 4; ++j) acc[b][j] += s * w[j]; }
            }
#pragma unroll
            for (int b = 0; b < 4; ++b)
#pragma unroll
                for (int j = 0; j < 4; ++j) red[(kl * 12 + cq) * 16 + b * 4 + j] = acc[b][j];
        }
        __syncthreads();
        if (c.tid < 192) {
            const int b = c.tid / 48, col = c.tid % 48;
            float s = 0.f;
            for (int k2 = 0; k2 < 42; ++k2) s += red[(k2 * 12 + (col >> 2)) * 16 + b * 4 + (col & 3)];
            mod[b * NMOD + item * 48 + col] = s + b_ada[item * 48 + col];
        }
        __syncthreads();
    }
}

__device__ __forceinline__ void convert_tile(const float* W, int K, int N, bf16_t* Wt, int kt, int ntile, const Ctx& c, int ldt = 0, int koff = 0) {
    if (ldt == 0) ldt = K;
    const int half = c.lane & 1, nq = b_nq(c);
    const float* src = W + (size_t)(kt * 64 + 8 * c.wid + 4 * half) * N + ntile * 128 + 4 * nq;
    f32x4 rb_[4];
#pragma unroll
    for (int i = 0; i < 4; ++i) rb_[i] = *(const f32x4*)(src + (size_t)i * N);
    const int wo = (4 * nq) * 128 + ((c.wid ^ (nq & 7)) << 4) + half * 8;
#pragma unroll
    for (int j = 0; j < 4; ++j) { u32x2 w; w.x = pack_bf16(rb_[0][j], rb_[1][j]); w.y = pack_bf16(rb_[2][j], rb_[3][j]); *(LAS u32x2*)(c.lds + wo + j * 128) = w; }
    __syncthreads();
#pragma unroll
    for (int i = 0; i < 2; ++i) {
        const int idx = c.tid + 512 * i, n = idx >> 3, ch = idx & 7;
        const u32x4 v = *(const LAS u32x4*)(c.lds + n * 128 + ((ch ^ ((n >> 2) & 7)) << 4));
        *(u32x4*)(Wt + (size_t)(ntile * 128 + n) * ldt + koff + kt * 64 + ch * 8) = v;
    }
    __syncthreads();
}
__device__ __forceinline__ void phase_convert(const Params& p, const Ctx& c) {
    for (int t = c.bid; t < 3584; t += c.nblk) {
        if (t < 2560) convert_tile(p.in[6], D, INC, (bf16_t*)(p.ws + WS_WIN_T), t & 31, t >> 5, c);
        else if (t < 2816) { const int u = t - 2560; convert_tile(p.in[12], 1024, D, (bf16_t*)(p.ws + WS_WPA_T), u & 15, u >> 4, c, D, 0); }
        else if (t < 3072) { const int u = t - 2816; convert_tile(p.in[13], 1024, D, (bf16_t*)(p.ws + WS_WPA_T), u & 15, u >> 4, c, D, 1024); }
        else { const int u = t - 3072; convert_tile(p.in[14], D, D, (bf16_t*)(p.ws + WS_WOUT_T), u & 31, u >> 5, c); }
    }
}

__device__ __forceinline__ void phase_norm1(const Params& p, const Ctx& c) {
    const float* x = p.in[0]; const float* g = p.in[5];
    const float* mod = (const float*)(p.ws + WS_MOD);
    bf16_t* h = (bf16_t*)(p.ws + WS_H);
    for (int row = c.bid * 8 + c.wid; row < NTOK; row += c.nblk * 8) {
        const int b = row >> 11;
        f32x4 v[8]; float ss = 0.f;
#pragma unroll
        for (int i = 0; i < 8; ++i) { v[i] = *(const f32x4*)(x + (size_t)row * D + i * 256 + c.lane * 4); ss += v[i][0] * v[i][0] + v[i][1] * v[i][1] + v[i][2] * v[i][2] + v[i][3] * v[i][3]; }
        ss = wave_sum(ss);
        const float rstd = rsqrtf(ss * (1.0f / D) + EPS);
#pragma unroll
        for (int i = 0; i < 8; ++i) {
            const int col = i * 256 + c.lane * 4;
            const f32x4 gg = *(const f32x4*)(g + col), sh = *(const f32x4*)(mod + b * NMOD + col), scl = *(const f32x4*)(mod + b * NMOD + D + col);
            float o[4];
#pragma unroll
            for (int j = 0; j < 4; ++j) o[j] = (v[i][j] * rstd * gg[j]) * (1.0f + scl[j]) + sh[j];
            u32x2 w; w.x = pack_bf16(o[0], o[1]); w.y = pack_bf16(o[2], o[3]);
            *(u32x2*)(h + (size_t)row * D + col) = w;
        }
    }
}

__device__ __forceinline__ void phase_router_prep(const Params& p, const Ctx& c) {
    const float* mod = (const float*)(p.ws + WS_MOD); const float* g = p.in[15];
    const float* w_rg = p.in[16]; const float* b_rg = p.in[17]; const float* w_re = p.in[18]; const float* b_re = p.in[19];
    bf16_t* WtH = (bf16_t*)(p.ws + WS_RW); bf16_t* WtL = WtH + (size_t)NB * 80 * D; float* cb = (float*)(p.ws + WS_RC);
    for (int task = c.bid * 8 + c.wid; task < NB * 80; task += c.nblk * 8) {
        const int b = task / 80, j = task % 80;
        float cs = 0.f;
        for (int k = c.lane; k < D; k += 64) {
            float w = 0.f;
            if (j < 8) w = w_rg[(size_t)k * 8 + j]; else if (j < 72) w = w_re[(size_t)k * 64 + (j - 8)];
            const float wv = g[k] * (1.0f + mod[b * NMOD + 4 * D + k]) * w;
            const unsigned hi = pack_bf16(wv, 0.f) & 0xffffu; const float hif = __uint_as_float(hi << 16);
            WtH[((size_t)b * 80 + j) * D + k] = (bf16_t)hi; WtL[((size_t)b * 80 + j) * D + k] = (bf16_t)(pack_bf16(wv - hif, 0.f) & 0xffffu);
            cs += mod[b * NMOD + 3 * D + k] * w;
        }
        cs = wave_sum(cs);
        if (c.lane == 0) cb[b * 80 + j] = cs + (j < 8 ? b_rg[j] : (j < 72 ? b_re[j - 8] : 0.f));
    }
}

__device__ __forceinline__ void phase_proj_in(const Params& p, const Ctx& c) {
    const bf16_t* h = (const bf16_t*)(p.ws + WS_H); const float* w_in = p.in[6];
    for (int item = c.bid; item < 32 * 80; item += c.nblk) {
        const int mt = item & 31, ntile = item >> 5;
        const int m0 = mt * 256, n0 = ntile * 128;
        const bf16_t* arow[4];
#pragma unroll
        for (int i = 0; i < 4; ++i) arow[i] = h + (size_t)(m0 + a_piece_row(c, i)) * D + a_piece_col(c);
        const float* bptr = w_in + (size_t)b_k0(c) * INC + n0 + 4 * b_nq(c);
        f32x4 acc[8][2]; zero_acc(acc);
        gemm_mainloop<false, D>(acc, arow, bptr, INC, c);
        const int region = n0 >> 10;
#pragma unroll
        for (int mi = 0; mi < 8; ++mi)
#pragma unroll
            for (int ni = 0; ni < 2; ++ni) {
                const int row = m0 + 128 * c.wr + 16 * mi + c.fr;
                const int col = n0 + 32 * c.wc + 16 * ni + 4 * c.fq;
                const f32x4 a = acc[mi][ni];
                if (region < 6) {
                    const int cin = col & 1023;
                    if (region == 2 || region == 5) {
                        bf16_t* vt = (bf16_t*)(p.ws + (region == 2 ? WS_VAT : WS_VBT));
                        const int b = row >> 11, s = row & 2047, hh = cin >> 7, d = cin & 127;
                        const unsigned w0 = pack_bf16(a[0], a[1]), w1 = pack_bf16(a[2], a[3]);
                        bf16_t* base = vt + ((size_t)((b * 8 + hh) * 128 + d)) * SEQ + s;
                        base[0] = (bf16_t)(w0 & 0xffff); base[SEQ] = (bf16_t)(w0 >> 16); base[2 * SEQ] = (bf16_t)(w1 & 0xffff); base[3 * SEQ] = (bf16_t)(w1 >> 16);
                    } else {
                        const size_t off = region == 0 ? WS_QA : region == 1 ? WS_KA : region == 3 ? WS_QB : WS_KB;
                        bf16_t* dst = (bf16_t*)(p.ws + off);
                        u32x2 w; w.x = pack_bf16(a[0], a[1]); w.y = pack_bf16(a[2], a[3]);
                        *(u32x2*)(dst + (size_t)row * 1024 + cin) = w;
                    }
                } else {
                    bf16_t* dst = (bf16_t*)(p.ws + (region < 8 ? WS_GA : WS_GB));
                    const int cin = col - (region < 8 ? 6144 : 8192);
                    u32x2 w; w.x = pack_bf16(sigmoidf_(a[0]), sigmoidf_(a[1])); w.y = pack_bf16(sigmoidf_(a[2]), sigmoidf_(a[3]));
                    *(u32x2*)(dst + (size_t)row * D + cin) = w;
                }
            }
    }
}

constexpr int AT_STAGE = 32768, AT_VOFF = 16384, AT_BIAS = 98304;
__device__ __forceinline__ int rel_bucket_dev(int n) {
    if (n < 16) return n;
    int b = 16;
    b += (n >= 19) + (n >= 21) + (n >= 24) + (n >= 27) + (n >= 31) + (n >= 35) + (n >= 40) + (n >= 46) + (n >= 52) + (n >= 59) + (n >= 67) + (n >= 77) + (n >= 87) + (n >= 99) + (n >= 113);
    return b;
}
struct KVRegs { u32x4 k[2], v[2]; };
__device__ __forceinline__ void kv_load(KVRegs& r, const bf16_t* kbase, const bf16_t* vtbase, int kt, const Ctx& c) {
#pragma unroll
    for (int i = 0; i < 2; ++i) {
        const int key = (c.tid >> 4) + 32 * i, ck = c.tid & 15;
        r.k[i] = *(const u32x4*)(kbase + (size_t)(kt * 64 + key) * 1024 + ck * 8);
        const int d = (c.tid >> 3) + 64 * i, cv = c.tid & 7;
        r.v[i] = *(const u32x4*)(vtbase + (size_t)d * SEQ + kt * 64 + cv * 8);
    }
}
__device__ __forceinline__ void kv_store(const KVRegs& r, LAS unsigned char* st, const Ctx& c) {
#pragma unroll
    for (int i = 0; i < 2; ++i) {
        const int key = (c.tid >> 4) + 32 * i, ck = c.tid & 15;
        *(LAS u32x4*)(st + key * 256 + ((ck ^ (key & 15)) << 4)) = r.k[i];
        const int d = (c.tid >> 3) + 64 * i, cv = c.tid & 7;
        *(LAS u32x4*)(st + AT_VOFF + d * 128 + ((cv ^ ((d >> 1) & 7)) << 4)) = r.v[i];
    }
}
__device__ __forceinline__ bf16x8 v_frag(LAS unsigned char* st, int nf, int kb2, const Ctx& c) {
    const int d = 16 * nf + c.fr; const int sw = (c.fr >> 1) & 7;
    return *(const LAS bf16x8*)(st + AT_VOFF + d * 128 + (((4 * kb2 + c.fq) ^ sw) << 4));
}
__device__ __forceinline__ bf16x8 pack_p(const f32x4& a, const f32x4& b) {
    u32x4 w; w.x = pack_bf16(a[0], a[1]); w.y = pack_bf16(a[2], a[3]); w.z = pack_bf16(b[0], b[1]); w.w = pack_bf16(b[2], b[3]);
    return __builtin_bit_cast(bf16x8, w);
}

__device__ __forceinline__ void diff_attn_item(const Params& p, const Ctx& c, int b, int h, int qb, float lam, bf16x8 (&qf)[4], KVRegs& kr,
                                               const bf16_t* qn, const bf16_t* kbn, const bf16_t* vtn, const int ktn) {
    const bf16_t* ka = (const bf16_t*)(p.ws + WS_KA); const bf16_t* vat = (const bf16_t*)(p.ws + WS_VAT);
    bf16_t* oa = (bf16_t*)(p.ws + WS_OA);
    const float* rel = p.in[2]; const float* gsub = p.in[11];
    LAS float* bias = (LAS float*)(c.lds + AT_BIAS);
    __syncthreads();
    if (c.tid < 128) bias[c.tid] = rel[rel_bucket_dev(c.tid) * 8 + h] * 1.4426950408889634f;
    const int qpos = 128 * qb + 16 * c.wid + c.fr;
    const size_t qtok = (size_t)b * SEQ + qpos;
    const bf16_t* kbase = ka + (size_t)b * SEQ * 1024 + h * 128;
    const bf16_t* vtbase = vat + (size_t)((b * 8 + h) * 128) * SEQ;
    f32x4 O1[8], O2[8];
#pragma unroll
    for (int nf = 0; nf < 8; ++nf) { O1[nf] = (f32x4){0.f, 0.f, 0.f, 0.f}; O2[nf] = (f32x4){0.f, 0.f, 0.f, 0.f}; }
    float m1 = -1e30f, m2 = -1e30f, l1 = 0.f, l2 = 0.f;
    const int ntiles = 2 * qb + 2;
    const int qmax_w = 128 * qb + 16 * c.wid + 15, qmin_w = 128 * qb + 16 * c.wid;
    const float L2E = 1.4426950408889634f;
    const bool defer = c.wid >= 4;
    bf16x8 pq1[2], pq2[2]; bool pend = false;
#pragma unroll
    for (int kb2 = 0; kb2 < 2; ++kb2) { pq1[kb2] = (bf16x8){0, 0, 0, 0, 0, 0, 0, 0}; pq2[kb2] = pq1[kb2]; }
    int sidx = 0, sprev = 2;
    for (int kt = 0; kt < ntiles; ++kt) {
        LAS unsigned char* st = c.lds + sidx * AT_STAGE;
        kv_store(kr, st, c);
        { const bool last = (kt + 1 >= ntiles);
          kv_load(kr, last ? kbn : kbase, last ? vtn : vtbase, last ? ktn : kt + 1, c); }
        __syncthreads();
        if (pend) {
            LAS unsigned char* sp = c.lds + sprev * AT_STAGE;
#pragma unroll
            for (int kb2 = 0; kb2 < 2; ++kb2)
#pragma unroll
                for (int nf = 0; nf < 8; ++nf) {
                    const bf16x8 vf = v_frag(sp, nf, kb2, c);
                    O1[nf] = __builtin_amdgcn_mfma_f32_16x16x32_bf16(vf, pq1[kb2], O1[nf], 0, 0, 0);
                    O2[nf] = __builtin_amdgcn_mfma_f32_16x16x32_bf16(vf, pq2[kb2], O2[nf], 0, 0, 0);
                }
            pend = false;
        }
        if (64 * kt <= qmax_w) {
            f32x4 s1[4], s2[4];
#pragma unroll
            for (int f = 0; f < 4; ++f) {
                bf16x8 kf[4];
#pragma unroll
                for (int kb = 0; kb < 4; ++kb) kf[kb] = *(const LAS bf16x8*)(st + (16 * f + c.fr) * 256 + (((4 * kb + c.fq) ^ c.fr) << 4));
                f32x4 z = (f32x4){0.f, 0.f, 0.f, 0.f};
                z = __builtin_amdgcn_mfma_f32_16x16x32_bf16(kf[0], qf[0], z, 0, 0, 0);
                s1[f] = __builtin_amdgcn_mfma_f32_16x16x32_bf16(kf[1], qf[1], z, 0, 0, 0);
                z = (f32x4){0.f, 0.f, 0.f, 0.f};
                z = __builtin_amdgcn_mfma_f32_16x16x32_bf16(kf[2], qf[2], z, 0, 0, 0);
                s2[f] = __builtin_amdgcn_mfma_f32_16x16x32_bf16(kf[3], qf[3], z, 0, 0, 0);
            }
            const bool nearb = (qmin_w - (64 * kt + 63)) < 113;
            const float CS = 0.125f * L2E, THR = 8.0f;
            float mx1, mx2;
            if (!nearb) {
                const float bf_ = bias[127];
                float r1 = s1[0][0], r2 = s2[0][0];
#pragma unroll
                for (int f = 0; f < 4; ++f)
#pragma unroll
                    for (int r = 0; r < 4; ++r) { r1 = fmaxf(r1, s1[f][r]); r2 = fmaxf(r2, s2[f][r]); }
                mx1 = r1 * CS + bf_; mx2 = r2 * CS + bf_;
            } else {
                mx1 = -1e30f; mx2 = -1e30f;
#pragma unroll
                for (int f = 0; f < 4; ++f)
#pragma unroll
                    for (int r = 0; r < 4; ++r) {
                        const int n = qpos - (64 * kt + 16 * f + 4 * c.fq + r);
                        const float bv = bias[n < 0 ? 0 : (n > 127 ? 127 : n)];
                        float a1 = s1[f][r] * CS + bv, a2 = s2[f][r] * CS + bv;
                        if (n < 0) { a1 = -1e30f; a2 = -1e30f; }
                        s1[f][r] = a1; s2[f][r] = a2;
                        mx1 = fmaxf(mx1, a1); mx2 = fmaxf(mx2, a2);
                    }
            }
            mx1 = xmax32(xmax16(mx1)); mx2 = xmax32(xmax16(mx2));
            if (__any((mx1 - m1 > THR) || (mx2 - m2 > THR))) {
                const float mn1 = fmaxf(m1, mx1), mn2 = fmaxf(m2, mx2);
                const float al1 = __builtin_amdgcn_exp2f(m1 - mn1), al2 = __builtin_amdgcn_exp2f(m2 - mn2);
                m1 = mn1; m2 = mn2; l1 *= al1; l2 *= al2;
#pragma unroll
                for (int nf = 0; nf < 8; ++nf) { O1[nf] *= al1; O2[nf] *= al2; }
            }
            if (!nearb) {
                const float d1 = bias[127] - m1, d2 = bias[127] - m2;
#pragma unroll
                for (int f = 0; f < 4; ++f) { s1[f] = s1[f] * CS + d1; s2[f] = s2[f] * CS + d2; }
            } else {
#pragma unroll
                for (int f = 0; f < 4; ++f) { s1[f] = s1[f] - m1; s2[f] = s2[f] - m2; }
            }
            float ps1 = 0.f, ps2 = 0.f;
#pragma unroll
            for (int f = 0; f < 4; ++f)
#pragma unroll
                for (int r = 0; r < 4; ++r) {
                    const float e1 = __builtin_amdgcn_exp2f(s1[f][r]), e2 = __builtin_amdgcn_exp2f(s2[f][r]);
                    s1[f][r] = e1; s2[f][r] = e2; ps1 += e1; ps2 += e2;
                }
            l1 += ps1; l2 += ps2;
#pragma unroll
            for (int kb2 = 0; kb2 < 2; ++kb2) { pq1[kb2] = pack_p(s1[2 * kb2], s1[2 * kb2 + 1]); pq2[kb2] = pack_p(s2[2 * kb2], s2[2 * kb2 + 1]); }
            if (defer) pend = true;
            else {
#pragma unroll
                for (int kb2 = 0; kb2 < 2; ++kb2)
#pragma unroll
                    for (int nf = 0; nf < 8; ++nf) {
                        const bf16x8 vf = v_frag(st, nf, kb2, c);
                        O1[nf] = __builtin_amdgcn_mfma_f32_16x16x32_bf16(vf, pq1[kb2], O1[nf], 0, 0, 0);
                        O2[nf] = __builtin_amdgcn_mfma_f32_16x16x32_bf16(vf, pq2[kb2], O2[nf], 0, 0, 0);
                    }
            }
        }
        sprev = sidx; sidx = (sidx == 2) ? 0 : sidx + 1;
    }
    if (pend) {
        LAS unsigned char* sp = c.lds + sprev * AT_STAGE;
#pragma unroll
        for (int kb2 = 0; kb2 < 2; ++kb2)
#pragma unroll
            for (int nf = 0; nf < 8; ++nf) {
                const bf16x8 vf = v_frag(sp, nf, kb2, c);
                O1[nf] = __builtin_amdgcn_mfma_f32_16x16x32_bf16(vf, pq1[kb2], O1[nf], 0, 0, 0);
                O2[nf] = __builtin_amdgcn_mfma_f32_16x16x32_bf16(vf, pq2[kb2], O2[nf], 0, 0, 0);
            }
    }
#pragma unroll
    for (int kb = 0; kb < 4; ++kb) qf[kb] = *(const bf16x8*)(qn + 32 * kb + 8 * c.fq);
    l1 = xsum32(xsum16(l1)); l2 = xsum32(xsum16(l2));
    const float i1 = 1.0f / l1, i2 = lam / l2;
    float ss = 0.f;
#pragma unroll
    for (int nf = 0; nf < 8; ++nf)
#pragma unroll
        for (int r = 0; r < 4; ++r) { const float o = O1[nf][r] * i1 - O2[nf][r] * i2; O1[nf][r] = o; ss += o * o; }
    ss += __shfl_xor(ss, 16); ss += __shfl_xor(ss, 32);
    const float rstd = rsqrtf(ss * (1.0f / 128.0f) + EPS) * 0.8f;
#pragma unroll
    for (int nf = 0; nf < 8; ++nf) {
        const int d = 16 * nf + 4 * c.fq;
        const f32x4 g = *(const f32x4*)(gsub + d);
        u32x2 w; w.x = pack_bf16(O1[nf][0] * rstd * g[0], O1[nf][1] * rstd * g[1]); w.y = pack_bf16(O1[nf][2] * rstd * g[2], O1[nf][3] * rstd * g[3]);
        *(u32x2*)(oa + qtok * 2048 + h * 128 + d) = w;
    }
}

__device__ __forceinline__ void sb_attn_item(const Params& p, const Ctx& c, int b, int h, int qb, bf16x8 (&qf)[4], KVRegs& kr,
                                             const bf16_t* qn, const bf16_t* kbn, const bf16_t* vtn, const int ktn) {
    const bf16_t* kbuf = (const bf16_t*)(p.ws + WS_KB); const bf16_t* vbt = (const bf16_t*)(p.ws + WS_VBT);
    bf16_t* ob = (bf16_t*)(p.ws + WS_OA) + 1024;
    __syncthreads();
    const int qpos = 128 * qb + 16 * c.wid + c.fr;
    const size_t qtok = (size_t)b * SEQ + qpos;
    const bf16_t* kbase = kbuf + (size_t)b * SEQ * 1024 + h * 128;
    const bf16_t* vtbase = vbt + (size_t)((b * 8 + h) * 128) * SEQ;
    f32x4 O[8];
#pragma unroll
    for (int nf = 0; nf < 8; ++nf) O[nf] = (f32x4){0.f, 0.f, 0.f, 0.f};
    float carry = 0.f;
    const int ntiles = 2 * qb + 2;
    const int qmax_w = 128 * qb + 16 * c.wid + 15;
    const float scale = 0.08838834764831845f * 1.4426950408889634f;
    LAS int* dflag = (LAS int*)(c.lds + AT_BIAS + 1024);
    if (c.lane == 0) dflag[c.wid] = 0;
    bool wdone = false, nxt = false;
    for (int it = 0; it < ntiles; ++it) {
        const int kt = ntiles - 1 - it;
        LAS unsigned char* st = c.lds + (it & 1) * AT_STAGE;
        kv_store(kr, st, c);
        __syncthreads();
        {
            int alld = 1;
#pragma unroll
            for (int w8 = 0; w8 < 8; ++w8) alld &= dflag[w8];
            if (alld) break;
        }
        { const bool last = (kt == 0);
          kv_load(kr, last ? kbn : kbase, last ? vtn : vtbase, last ? ktn : kt - 1, c); nxt = last; }
        if (!wdone && 64 * kt < qmax_w) {
            f32x4 z[4];
#pragma unroll
            for (int f = 0; f < 4; ++f) {
                f32x4 a = (f32x4){0.f, 0.f, 0.f, 0.f};
#pragma unroll
                for (int kb = 0; kb < 4; ++kb) {
                    const bf16x8 kf = *(const LAS bf16x8*)(st + (16 * f + c.fr) * 256 + (((4 * kb + c.fq) ^ c.fr) << 4));
                    a = __builtin_amdgcn_mfma_f32_16x16x32_bf16(kf, qf[kb], a, 0, 0, 0);
                }
                z[f] = a;
            }
            f32x4 lb[4], lk[4]; float T[4];
#pragma unroll
            for (int f = 0; f < 4; ++f) {
                float t = 0.f;
#pragma unroll
                for (int r = 0; r < 4; ++r) {
                    const int kpos = 64 * kt + 16 * f + 4 * c.fq + r;
                    const float zz = z[f][r] * scale;
                    const float sp = __builtin_amdgcn_logf(1.0f + __builtin_amdgcn_exp2f(-fabsf(zz)));
                    const float lbv = fminf(zz, 0.f) - sp;
                    const bool valid = kpos < qpos;
                    const float lkv = valid ? (lbv - zz) : 0.f;
                    lb[f][r] = valid ? lbv : -1e30f; lk[f][r] = lkv; t += lkv;
                }
                T[f] = t;
            }
            float tile_tot = 0.f; float Gl[4], Ft[4];
#pragma unroll
            for (int f = 0; f < 4; ++f) {
                const float A1 = __shfl_xor(T[f], 16), A2 = __shfl_xor(T[f], 32), A3 = __shfl_xor(T[f], 48);
                Gl[f] = ((c.fq & 1) == 0 ? A1 : 0.f) + ((c.fq & 2) == 0 ? (A2 + A3) : 0.f);
                Ft[f] = T[f] + A1 + A2 + A3; tile_tot += Ft[f];
            }
            float after = carry;
#pragma unroll
            for (int f = 3; f >= 0; --f) {
                float suf = 0.f;
#pragma unroll
                for (int r = 3; r >= 0; --r) {
                    const float later = after + Gl[f] + suf;
                    z[f][r] = __builtin_amdgcn_exp2f(lb[f][r] + later);
                    suf += lk[f][r];
                }
                after += Ft[f];
            }
            carry += tile_tot;
#pragma unroll
            for (int kb2 = 0; kb2 < 2; ++kb2) {
                const bf16x8 pp = pack_p(z[2 * kb2], z[2 * kb2 + 1]);
#pragma unroll
                for (int nf = 0; nf < 8; ++nf) {
                    const bf16x8 vf = v_frag(st, nf, kb2, c);
                    O[nf] = __builtin_amdgcn_mfma_f32_16x16x32_bf16(vf, pp, O[nf], 0, 0, 0);
                }
            }
            if (__all(carry < -64.0f)) { wdone = true; if (c.lane == 0) dflag[c.wid] = 1; }
        }
    }
    if (!nxt) kv_load(kr, kbn, vtn, ktn, c);
#pragma unroll
    for (int kb = 0; kb < 4; ++kb) qf[kb] = *(const bf16x8*)(qn + 32 * kb + 8 * c.fq);
#pragma unroll
    for (int nf = 0; nf < 8; ++nf) {
        const int d = 16 * nf + 4 * c.fq;
        u32x2 w; w.x = pack_bf16(O[nf][0], O[nf][1]); w.y = pack_bf16(O[nf][2], O[nf][3]);
        *(u32x2*)(ob + qtok * 2048 + h * 128 + d) = w;
    }
}

__device__ __forceinline__ void attn_sub(const Params& p, const Ctx& c, int sub, int& kind, int& bh, int& qb, const bf16_t*& qp, const bf16_t*& kb, const bf16_t*& vt, int& kt0) {
    const int kh = sub >> 8, i2 = sub & 255, half = kh & 1, pr = i2 >> 5;
    kind = kh >> 1; bh = i2 & 31; qb = half ? pr : 15 - pr;
    const int b = bh >> 3, h = bh & 7;
    const size_t qtok = (size_t)b * SEQ + 128 * qb + 16 * c.wid + c.fr;
    qp = (const bf16_t*)(p.ws + (kind ? WS_QB : WS_QA)) + qtok * 1024 + h * 128;
    kb = (const bf16_t*)(p.ws + (kind ? WS_KB : WS_KA)) + (size_t)b * SEQ * 1024 + h * 128;
    vt = (const bf16_t*)(p.ws + (kind ? WS_VBT : WS_VAT)) + (size_t)(bh * 128) * SEQ;
    kt0 = kind ? 2 * qb + 1 : 0;
}
__device__ __forceinline__ void phase_attn(const Params& p, const Ctx& c, int qsel = 0) {
    float d1 = 0.f, d2 = 0.f;
    if (c.lane < 64) { d1 = p.in[7][c.lane] * p.in[8][c.lane]; d2 = p.in[9][c.lane] * p.in[10][c.lane]; }
    d1 = wave_sum(d1); d2 = wave_sum(d2);
    const float lam = expf(d1) - expf(d2) + 0.2f;
    (void)qsel;
    if (c.bid >= 1024) return;
    int kind, bh, qb, kt0; const bf16_t* qp; const bf16_t* kb; const bf16_t* vt;
    attn_sub(p, c, c.bid, kind, bh, qb, qp, kb, vt, kt0);
    bf16x8 qf[4]; KVRegs kr;
#pragma unroll
    for (int k4 = 0; k4 < 4; ++k4) qf[k4] = *(const bf16x8*)(qp + 32 * k4 + 8 * c.fq);
    kv_load(kr, kb, vt, kt0, c);
#pragma unroll 1
    for (int sub = c.bid; sub < 1024; sub += c.nblk) {
        int kindn, bhn, qbn, kt0n; const bf16_t* qpn; const bf16_t* kbn; const bf16_t* vtn;
        attn_sub(p, c, (sub + c.nblk < 1024) ? sub + c.nblk : sub, kindn, bhn, qbn, qpn, kbn, vtn, kt0n);
        if (kind == 0) diff_attn_item(p, c, bh >> 3, bh & 7, qb, lam, qf, kr, qpn, kbn, vtn, kt0n);
        else sb_attn_item(p, c, bh >> 3, bh & 7, qb, qf, kr, qpn, kbn, vtn, kt0n);
        kind = kindn; bh = bhn; qb = qbn;
    }
}

__device__ __forceinline__ void phase_merge(const Params& p, const Ctx& c) {
    const bf16_t* oa = (const bf16_t*)(p.ws + WS_OA); const bf16_t* ob = (const bf16_t*)(p.ws + WS_OB);
    const bf16_t* ga = (const bf16_t*)(p.ws + WS_GA); const bf16_t* gb = (const bf16_t*)(p.ws + WS_GB);
    bf16_t* mrg = (bf16_t*)(p.ws + WS_MRG);
    for (int item = c.bid; item < 32 * 16; item += c.nblk) {
        const int mt = item & 31, ntile = item >> 5;
        const int m0 = mt * 256, n0 = ntile * 128;
        f32x4 acc[8][2];
#pragma unroll 1
        for (int pass = 0; pass < 2; ++pass) {
            const bf16_t* A = pass ? ob : oa; const float* W = pass ? p.in[13] : p.in[12]; const bf16_t* G = pass ? gb : ga;
            const bf16_t* arow[4];
#pragma unroll
            for (int i = 0; i < 4; ++i) arow[i] = A + (size_t)(m0 + a_piece_row(c, i)) * 1024 + a_piece_col(c);
            const float* bptr = W + (size_t)b_k0(c) * D + n0 + 4 * b_nq(c);
            zero_acc(acc);
            gemm_mainloop<false, 1024>(acc, arow, bptr, D, c);
            float* tmp = (float*)(p.ws + WS_X1);
#pragma unroll
            for (int mi = 0; mi < 8; ++mi)
#pragma unroll
                for (int ni = 0; ni < 2; ++ni) {
                    const int row = m0 + 128 * c.wr + 16 * mi + c.fr;
                    const int col = n0 + 32 * c.wc + 16 * ni + 4 * c.fq;
                    const u32x2 gw = *(const u32x2*)(G + (size_t)row * D + col);
                    f32x4 g; g[0] = __uint_as_float(gw.x << 16); g[1] = __uint_as_float(gw.x & 0xffff0000u); g[2] = __uint_as_float(gw.y << 16); g[3] = __uint_as_float(gw.y & 0xffff0000u);
                    f32x4 v = acc[mi][ni] * g;
                    if (pass == 0) *(f32x4*)(tmp + (size_t)row * D + col) = v;
                    else {
                        v += *(const f32x4*)(tmp + (size_t)row * D + col);
                        u32x2 w; w.x = pack_bf16(v[0], v[1]); w.y = pack_bf16(v[2], v[3]);
                        *(u32x2*)(mrg + (size_t)row * D + col) = w;
                    }
                }
        }
    }
}

__device__ __forceinline__ void phase_out(const Params& p, const Ctx& c) {
    const bf16_t* mrg = (const bf16_t*)(p.ws + WS_MRG); const float* w_out = p.in[14]; const float* x = p.in[0];
    const float* mod = (const float*)(p.ws + WS_MOD);
    float* x1 = (float*)(p.ws + WS_X1);
    for (int item = c.bid; item < 32 * 16; item += c.nblk) {
        const int mt = item & 31, ntile = item >> 5;
        const int m0 = mt * 256, n0 = ntile * 128;
        const bf16_t* arow[4];
#pragma unroll
        for (int i = 0; i < 4; ++i) arow[i] = mrg + (size_t)(m0 + a_piece_row(c, i)) * D + a_piece_col(c);
        const float* bptr = w_out + (size_t)b_k0(c) * D + n0 + 4 * b_nq(c);
        f32x4 acc[8][2]; zero_acc(acc);
        gemm_mainloop<false, D>(acc, arow, bptr, D, c);
        const int b = m0 >> 11;
#pragma unroll
        for (int mi = 0; mi < 8; ++mi)
#pragma unroll
            for (int ni = 0; ni < 2; ++ni) {
                const int row = m0 + 128 * c.wr + 16 * mi + c.fr;
                const int col = n0 + 32 * c.wc + 16 * ni + 4 * c.fq;
                const f32x4 gm = *(const f32x4*)(mod + b * NMOD + 2 * D + col);
                const f32x4 xv = *(const f32x4*)(x + (size_t)row * D + col);
                *(f32x4*)(x1 + (size_t)row * D + col) = xv + gm * acc[mi][ni];
            }
    }
}

__device__ __forceinline__ void phase_norm2_route(const Params& p, const Ctx& c) {
    const float* x1 = (const float*)(p.ws + WS_X1); const float* g = p.in[15];
    const float* mod = (const float*)(p.ws + WS_MOD);
    const float* w_rg = p.in[16]; const float* b_rg = p.in[17]; const float* w_re = p.in[18]; const float* b_re = p.in[19];
    bf16_t* h2 = (bf16_t*)(p.ws + WS_H2);
    unsigned* cnt = (unsigned*)(p.ws + WS_CTL) + CW_CNT;
    int* ltok = (int*)(p.ws + WS_LTOK); float* lw = (float*)(p.ws + WS_LW);
    for (int row = c.bid * 8 + c.wid; row < NTOK; row += c.nblk * 8) {
        const int b = row >> 11;
        f32x4 v[8]; float ss = 0.f;
#pragma unroll
        for (int i = 0; i < 8; ++i) { v[i] = *(const f32x4*)(x1 + (size_t)row * D + i * 256 + c.lane * 4); ss += v[i][0] * v[i][0] + v[i][1] * v[i][1] + v[i][2] * v[i][2] + v[i][3] * v[i][3]; }
        ss = wave_sum(ss);
        const float rstd = rsqrtf(ss * (1.0f / D) + EPS);
        float gl[8];
#pragma unroll
        for (int j = 0; j < 8; ++j) gl[j] = 0.f;
#pragma unroll
        for (int i = 0; i < 8; ++i) {
            const int col = i * 256 + c.lane * 4;
            const f32x4 gg = *(const f32x4*)(g + col), sh = *(const f32x4*)(mod + b * NMOD + 3 * D + col), scl = *(const f32x4*)(mod + b * NMOD + 4 * D + col);
#pragma unroll
            for (int j = 0; j < 4; ++j) v[i][j] = (v[i][j] * rstd * gg[j]) * (1.0f + scl[j]) + sh[j];
            u32x2 w; w.x = pack_bf16(v[i][0], v[i][1]); w.y = pack_bf16(v[i][2], v[i][3]);
            *(u32x2*)(h2 + (size_t)row * D + col) = w;
#pragma unroll
            for (int j = 0; j < 4; ++j) {
                const f32x4 w0 = *(const f32x4*)(w_rg + (size_t)(col + j) * 8), w1 = *(const f32x4*)(w_rg + (size_t)(col + j) * 8 + 4);
#pragma unroll
                for (int e = 0; e < 4; ++e) { gl[e] += v[i][j] * w0[e]; gl[4 + e] += v[i][j] * w1[e]; }
            }
        }
#pragma unroll
        for (int j = 0; j < 8; ++j) gl[j] = wave_sum(gl[j]) + b_rg[j];
        int gi = 0; float gmax = gl[0];
#pragma unroll
        for (int j = 1; j < 8; ++j) if (gl[j] > gmax) { gmax = gl[j]; gi = j; }
        float gsum = 0.f;
#pragma unroll
        for (int j = 0; j < 8; ++j) gsum += __expf(gl[j] - gmax);
        const float pg = 1.0f / gsum;
        float el[8];
#pragma unroll
        for (int j = 0; j < 8; ++j) el[j] = 0.f;
#pragma unroll
        for (int i = 0; i < 8; ++i) {
            const int col = i * 256 + c.lane * 4;
#pragma unroll
            for (int j = 0; j < 4; ++j) {
                const f32x4 w0 = *(const f32x4*)(w_re + (size_t)(col + j) * 64 + gi * 8), w1 = *(const f32x4*)(w_re + (size_t)(col + j) * 64 + gi * 8 + 4);
#pragma unroll
                for (int e = 0; e < 4; ++e) { el[e] += v[i][j] * w0[e]; el[4 + e] += v[i][j] * w1[e]; }
            }
        }
#pragma unroll
        for (int j = 0; j < 8; ++j) el[j] = wave_sum(el[j]) + b_re[gi * 8 + j];
        int i1 = 0; float e1 = el[0];
#pragma unroll
        for (int j = 1; j < 8; ++j) if (el[j] > e1) { e1 = el[j]; i1 = j; }
        int i2 = -1; float e2 = -3.0e38f;
#pragma unroll
        for (int j = 0; j < 8; ++j) if (j != i1 && el[j] > e2) { e2 = el[j]; i2 = j; }
        const float r2 = __expf(e2 - e1);
        const float tp1 = 1.0f / (1.0f + r2), tp2 = r2 / (1.0f + r2);
        if (c.lane == 0) {
            const int ea = gi * 8 + i1, eb = gi * 8 + i2;
            const unsigned sa = atomicAdd(&cnt[ea], 1u), sb = atomicAdd(&cnt[eb], 1u);
            ltok[ea * NTOK + sa] = row * 2; lw[ea * NTOK + sa] = pg * tp1;
            ltok[eb * NTOK + sb] = row * 2 + 1; lw[eb * NTOK + sb] = pg * tp2;
        }
    }
}

__device__ __forceinline__ void phase_norm2_route2(const Params& p, const Ctx& c, int dummy = 0) {
    const float* x1 = (const float*)(p.ws + WS_X1); const float* g = p.in[15];
    const float* mod = (const float*)(p.ws + WS_MOD);
    const bf16_t* WtH = (const bf16_t*)(p.ws + WS_RW); const bf16_t* WtL = WtH + (size_t)NB * 80 * D; const float* cb = (const float*)(p.ws + WS_RC);
    bf16_t* h2 = (bf16_t*)(p.ws + WS_H2);
    unsigned* cnt = (unsigned*)(p.ws + WS_CTL) + CW_CNT + (dummy ? 128 : 0);
    int* ltok = (int*)(p.ws + (dummy ? WS_ACT : WS_LTOK)); float* lw = (float*)(p.ws + (dummy ? WS_ACT + (size_t)NE * NTOK * 4 : WS_LW));
    LAS float* red = (LAS float*)c.lds;
    LAS float* ssr = (LAS float*)(c.lds + 81920);
    LAS float* rs = (LAS float*)(c.lds + 81920 + 1024);
    for (int it = c.bid; it < NTOK / 32; it += c.nblk) {
        const int tok0 = it * 32, b = tok0 >> 11;
        const int ks = c.wid, i16 = c.lane & 15, kk = c.lane >> 4;
        const float* ap0 = x1 + (size_t)(tok0 + i16) * D + 256 * ks + 8 * kk;
        const float* ap1 = ap0 + (size_t)16 * D;
        const bf16_t* bph = WtH + ((size_t)b * 80 + i16) * D + 256 * ks + 8 * kk;
        const bf16_t* bpl = WtL + ((size_t)b * 80 + i16) * D + 256 * ks + 8 * kk;
        f32x4 acc[2][5];
#pragma unroll
        for (int g2 = 0; g2 < 2; ++g2)
#pragma unroll
            for (int nb = 0; nb < 5; ++nb) acc[g2][nb] = (f32x4){0.f, 0.f, 0.f, 0.f};
        float ss0 = 0.f, ss1 = 0.f;
#pragma unroll 2
        for (int kb8 = 0; kb8 < 8; ++kb8) {
            bf16x8 ah[2], al[2];
#pragma unroll
            for (int g2 = 0; g2 < 2; ++g2) {
                const float* ap = (g2 ? ap1 : ap0) + 32 * kb8;
                const f32x4 v0 = *(const f32x4*)ap, v1 = *(const f32x4*)(ap + 4);
                const float sq = v0[0] * v0[0] + v0[1] * v0[1] + v0[2] * v0[2] + v0[3] * v0[3] + v1[0] * v1[0] + v1[1] * v1[1] + v1[2] * v1[2] + v1[3] * v1[3];
                if (g2) ss1 += sq; else ss0 += sq;
                u32x4 h, l;
                h.x = pack_bf16(v0[0], v0[1]); h.y = pack_bf16(v0[2], v0[3]); h.z = pack_bf16(v1[0], v1[1]); h.w = pack_bf16(v1[2], v1[3]);
                l.x = pack_bf16(v0[0] - __uint_as_float(h.x << 16), v0[1] - __uint_as_float(h.x & 0xffff0000u));
                l.y = pack_bf16(v0[2] - __uint_as_float(h.y << 16), v0[3] - __uint_as_float(h.y & 0xffff0000u));
                l.z = pack_bf16(v1[0] - __uint_as_float(h.z << 16), v1[1] - __uint_as_float(h.z & 0xffff0000u));
                l.w = pack_bf16(v1[2] - __uint_as_float(h.w << 16), v1[3] - __uint_as_float(h.w & 0xffff0000u));
                ah[g2] = __builtin_bit_cast(bf16x8, h); al[g2] = __builtin_bit_cast(bf16x8, l);
            }
#pragma unroll
            for (int nb = 0; nb < 5; ++nb) {
                const bf16x8 bh = *(const bf16x8*)(bph + (size_t)nb * 16 * D + 32 * kb8), bl = *(const bf16x8*)(bpl + (size_t)nb * 16 * D + 32 * kb8);
#pragma unroll
                for (int g2 = 0; g2 < 2; ++g2) {
                    acc[g2][nb] = __builtin_amdgcn_mfma_f32_16x16x32_bf16(ah[g2], bh, acc[g2][nb], 0, 0, 0);
                    acc[g2][nb] = __builtin_amdgcn_mfma_f32_16x16x32_bf16(ah[g2], bl, acc[g2][nb], 0, 0, 0);
                    acc[g2][nb] = __builtin_amdgcn_mfma_f32_16x16x32_bf16(al[g2], bh, acc[g2][nb], 0, 0, 0);
                }
            }
        }
        ss0 += __shfl_xor(ss0, 16); ss0 += __shfl_xor(ss0, 32);
        ss1 += __shfl_xor(ss1, 16); ss1 += __shfl_xor(ss1, 32);
        __syncthreads();
#pragma unroll
        for (int g2 = 0; g2 < 2; ++g2)
#pragma unroll
            for (int nb = 0; nb < 5; ++nb)
#pragma unroll
                for (int r = 0; r < 4; ++r) red[(c.wid * 32 + g2 * 16 + 4 * kk + r) * 80 + nb * 16 + i16] = acc[g2][nb][r];
        if (kk == 0) { ssr[c.wid * 32 + i16] = ss0; ssr[c.wid * 32 + 16 + i16] = ss1; }
        __syncthreads();
        if (c.tid < 32) {
            const int t = c.tid;
            float ssum = 0.f;
#pragma unroll
            for (int q = 0; q < 8; ++q) ssum += ssr[q * 32 + t];
            const float rstd = rsqrtf(ssum * (1.0f / D) + EPS);
            rs[t] = rstd;
            float gl[8];
#pragma unroll
            for (int j = 0; j < 8; ++j) {
                float a = 0.f;
#pragma unroll
                for (int q = 0; q < 8; ++q) a += red[(q * 32 + t) * 80 + j];
                gl[j] = a * rstd + cb[b * 80 + j];
            }
            int gi = 0; float gmax = gl[0];
#pragma unroll
            for (int j = 1; j < 8; ++j) if (gl[j] > gmax) { gmax = gl[j]; gi = j; }
            float gsum = 0.f;
#pragma unroll
            for (int j = 0; j < 8; ++j) gsum += __expf(gl[j] - gmax);
            const float pg = 1.0f / gsum;
            float el[8];
#pragma unroll
            for (int j = 0; j < 8; ++j) {
                float a = 0.f;
#pragma unroll
                for (int q = 0; q < 8; ++q) a += red[(q * 32 + t) * 80 + 8 + gi * 8 + j];
                el[j] = a * rstd + cb[b * 80 + 8 + gi * 8 + j];
            }
            int i1 = 0; float e1 = el[0];
#pragma unroll
            for (int j = 1; j < 8; ++j) if (el[j] > e1) { e1 = el[j]; i1 = j; }
            int i2 = -1; float e2 = -3.0e38f;
#pragma unroll
            for (int j = 0; j < 8; ++j) if (j != i1 && el[j] > e2) { e2 = el[j]; i2 = j; }
            const float r2 = __expf(e2 - e1);
            const float tp1 = 1.0f / (1.0f + r2), tp2 = r2 / (1.0f + r2);
            const int row = tok0 + t;
            const int ea = gi * 8 + i1, eb = gi * 8 + i2;
            const unsigned sa = atomicAdd(&cnt[ea], 1u), sb = atomicAdd(&cnt[eb], 1u);
            ltok[ea * NTOK + sa] = row * 2; lw[ea * NTOK + sa] = pg * tp1;
            ltok[eb * NTOK + sb] = row * 2 + 1; lw[eb * NTOK + sb] = pg * tp2;
            if (!dummy) { u32x4 rec; rec.x = ((unsigned)ea << 13) | sa; rec.y = __float_as_uint(pg * tp1); rec.z = ((unsigned)eb << 13) | sb; rec.w = __float_as_uint(pg * tp2);
                *(u32x4*)(p.ws + WS_TREC + (size_t)row * 16) = rec; }
        }
#pragma unroll 1
        for (int q = 0; q < 4; ++q) {
            const int row = tok0 + c.wid * 4 + q;
            float ssum = 0.f;
#pragma unroll
            for (int q8 = 0; q8 < 8; ++q8) ssum += ssr[q8 * 32 + c.wid * 4 + q];
            const float rstd = rsqrtf(ssum * (1.0f / D) + EPS);
#pragma unroll
            for (int i = 0; i < 8; ++i) {
                const int col = i * 256 + c.lane * 4;
                const f32x4 v = *(const f32x4*)(x1 + (size_t)row * D + col);
                const f32x4 gg = *(const f32x4*)(g + col), sh = *(const f32x4*)(mod + b * NMOD + 3 * D + col), scl = *(const f32x4*)(mod + b * NMOD + 4 * D + col);
                float o[4];
#pragma unroll
                for (int j = 0; j < 4; ++j) o[j] = (v[j] * rstd * gg[j]) * (1.0f + scl[j]) + sh[j];
                u32x2 w; w.x = pack_bf16(o[0], o[1]); w.y = pack_bf16(o[2], o[3]);
                *(u32x2*)(h2 + (size_t)row * D + col) = w;
            }
        }
    }
}

constexpr int MOE_TAB = 100 * 1024;
__device__ __forceinline__ void moe_table(const Params& p, const Ctx& c) {
    const unsigned* cnt = (const unsigned*)(p.ws + WS_CTL) + CW_CNT;
    LAS int* tab = (LAS int*)(c.lds + MOE_TAB);
    __syncthreads();
    if (c.tid == 0) {
        int rp = 0;
        for (int e = 0; e < NE; ++e) { const int n = (int)cnt[e]; tab[e] = n; tab[64 + e] = rp; rp += n; }
        tab[64 + 64] = rp;
        for (int q = 0; q < 8; ++q) { int ip = 0; for (int j = 0; j < 8; ++j) { tab[256 + 16 * q + j] = ip; ip += ((tab[q + 8 * j] + 255) >> 8) * 16; } tab[256 + 16 * q + 8] = ip; }
    }
    __syncthreads();
}
__device__ __forceinline__ bool moe_next(XQueue& q, const Ctx& c, int& e, int& mt, int& ntile, int& cnt_e, int& rbase) {
    LAS int* tab = (LAS int*)(c.lds + MOE_TAB);
    while (q.v < 8) {
        const int qi = (q.x + q.v) & 7;
        const int L = next_item(q.heads + qi * 64, c);
        if (L < tab[256 + 16 * qi + 8]) {
            int j = 0;
#pragma unroll
            for (int k = 1; k < 8; ++k) if (tab[256 + 16 * qi + k] <= L) j = k;
            e = qi + 8 * j;
            while (tab[e] == 0 && j > 0) { --j; e -= 8; }
            cnt_e = tab[e]; rbase = tab[64 + e];
            const int loc = L - tab[256 + 16 * qi + j], nmt = (cnt_e + 255) >> 8;
            ntile = loc / nmt; mt = loc - ntile * nmt;
            return true;
        }
        ++q.v;
    }
    return false;
}

__device__ __forceinline__ void phase_moe1(const Params& p, const Ctx& c, int qsel = 1) {
    const bf16_t* h2 = (const bf16_t*)(p.ws + WS_H2);
    const int* ltok = (const int*)(p.ws + WS_LTOK);
    bf16_t* act = (bf16_t*)(p.ws + WS_ACT);
    const float* wg = p.in[20]; const float* wu = p.in[21];
    moe_table(p, c);
    XQueue q = xq_make(p, qsel);
    for (;;) {
        int e, mt, ntile, cnt_e, rbase;
        if (!moe_next(q, c, e, mt, ntile, cnt_e, rbase)) break;
        const int n0 = ntile * 64;
        const bf16_t* arow[4];
#pragma unroll
        for (int i = 0; i < 4; ++i) {
            const int r = mt * 256 + a_piece_row(c, i);
            const int tok = r < cnt_e ? (ltok[e * NTOK + r] >> 1) : 0;
            arow[i] = h2 + (size_t)tok * D + a_piece_col(c);
        }
        const int nq = b_nq(c), blk = nq >> 2;
        const float* wsrc = ((blk & 1) ? wu : wg) + (size_t)e * D * DE;
        const float* bptr = wsrc + (size_t)b_k0(c) * DE + n0 + 16 * (blk >> 1) + 4 * (nq & 3);
        f32x4 acc[8][2]; zero_acc(acc);
        gemm_mainloop<MOE_NT, D>(acc, arow, bptr, DE, c);
#pragma unroll
        for (int mi = 0; mi < 8; ++mi) {
            const int r = mt * 256 + 128 * c.wr + 16 * mi + c.fr;
            if (r < cnt_e) {
                const int col = n0 + 16 * c.wc + 4 * c.fq;
                float o[4];
#pragma unroll
                for (int j = 0; j < 4; ++j) { const float a = acc[mi][0][j], u = acc[mi][1][j]; o[j] = a / (1.0f + __expf(-a)) * u; }
                u32x2 w; w.x = pack_bf16(o[0], o[1]); w.y = pack_bf16(o[2], o[3]);
                *(u32x2*)(act + (size_t)(rbase + r) * DE + col) = w;
            }
        }
    }
}
__device__ __forceinline__ void phase_moe2(const Params& p, const Ctx& c, int qsel = 2) {
    const int* ltok = (const int*)(p.ws + WS_LTOK); const float* lw = (const float*)(p.ws + WS_LW);
    const bf16_t* act = (const bf16_t*)(p.ws + WS_ACT);
    float* y = (float*)(p.ws + WS_Y);
    const float* wd = p.in[22];
    moe_table(p, c);
    XQueue q = xq_make(p, qsel);
    for (;;) {
        int e, mt, ntile, cnt_e, rbase;
        if (!moe_next(q, c, e, mt, ntile, cnt_e, rbase)) break;
        const int n0 = ntile * 128;
        const bf16_t* arow[4];
#pragma unroll
        for (int i = 0; i < 4; ++i) arow[i] = act + (size_t)(rbase + mt * 256 + a_piece_row(c, i)) * DE + a_piece_col(c);
        const float* bptr = wd + (size_t)e * DE * D + (size_t)b_k0(c) * D + n0 + 4 * b_nq(c);
        f32x4 acc[8][2]; zero_acc(acc);
        gemm_mainloop<MOE_NT, DE>(acc, arow, bptr, D, c);
#pragma unroll
        for (int mi = 0; mi < 8; ++mi) {
            const int r = mt * 256 + 128 * c.wr + 16 * mi + c.fr;
            if (r < cnt_e) {
                const int ent = ltok[e * NTOK + r]; const float w = lw[e * NTOK + r];
#pragma unroll
                for (int ni = 0; ni < 2; ++ni) {
                    const int col = n0 + 32 * c.wc + 16 * ni + 4 * c.fq;
                    *(f32x4*)(y + (size_t)ent * D + col) = acc[mi][ni] * w;
                }
            }
        }
    }
}

constexpr int MOE_TAB2 = 132 * 1024;
__device__ __forceinline__ void moe_table2(const Params& p, const Ctx& c) {
    const unsigned* cnt = (const unsigned*)(p.ws + WS_CTL) + CW_CNT;
    LAS int* tab = (LAS int*)(c.lds + MOE_TAB2);
    __syncthreads();
    if (c.tid == 0) {
        int rp = 0;
        for (int e = 0; e < NE; ++e) { const int n = (int)cnt[e]; tab[e] = n; tab[64 + e] = rp; rp += n; }
        tab[64 + 64] = rp;
        for (int q = 0; q < 8; ++q) { int ip = 0; for (int j = 0; j < 8; ++j) { tab[256 + 16 * q + j] = ip; ip += ((tab[q + 8 * j] + 255) >> 8) * 8; } tab[256 + 16 * q + 8] = ip; }
    }
    __syncthreads();
}
__device__ __forceinline__ bool moe_next2(XQueue& q, const Ctx& c, int& e, int& mt, int& ntile, int& cnt_e, int& rbase) {
    LAS int* tab = (LAS int*)(c.lds + MOE_TAB2);
    while (q.v < 8) {
        const int qi = (q.x + q.v) & 7;
        const int L = next_item(q.heads + qi * 64, c);
        if (L < tab[256 + 16 * qi + 8]) {
            int j = 0;
#pragma unroll
            for (int k = 1; k < 8; ++k) if (tab[256 + 16 * qi + k] <= L) j = k;
            e = qi + 8 * j;
            while (tab[e] == 0 && j > 0) { --j; e -= 8; }
            cnt_e = tab[e]; rbase = tab[64 + e];
            const int loc = L - tab[256 + 16 * qi + j], nmt = (cnt_e + 255) >> 8;
            ntile = loc / nmt; mt = loc - ntile * nmt;
            return true;
        }
        ++q.v;
    }
    return false;
}
__device__ __forceinline__ void zero_acc4(f32x4 (&acc)[8][4]) {
#pragma unroll
    for (int mi = 0; mi < 8; ++mi)
#pragma unroll
        for (int ni = 0; ni < 4; ++ni) acc[mi][ni] = (f32x4){0.f, 0.f, 0.f, 0.f};
}
__device__ __forceinline__ void phase_moe1w(const Params& p, const Ctx& c, int qsel = 1) {
    const bf16_t* h2 = (const bf16_t*)(p.ws + WS_H2);
    const int* ltok = (const int*)(p.ws + WS_LTOK);
    bf16_t* act = (bf16_t*)(p.ws + WS_ACT);
    const float* wg = p.in[20]; const float* wu = p.in[21];
    moe_table2(p, c);
    XQueue q = xq_make(p, qsel);
    const int blk = c.lane >> 2;
    const float* wsel = (blk & 1) ? wu : wg;
    const int bcol = 16 * (blk >> 1) + 4 * (c.lane & 3);
    int e, mt, ntile, cnt_e, rbase;
    if (!moe_next2(q, c, e, mt, ntile, cnt_e, rbase)) return;
    int aoff[4];
#pragma unroll
    for (int i = 0; i < 4; ++i) { const int r = mt * 256 + a_piece_row(c, i); const int tok = r < cnt_e ? (ltok[e * NTOK + r] >> 1) : 0; aoff[i] = tok * D + a_piece_col(c); }
    const float* bptr = wsel + (size_t)e * D * DE + (size_t)(8 * c.wid) * DE + ntile * 128 + bcol;
    bool staged = false;
    f32x4 rb[8];
    for (;;) {
        int en, mtn, ntilen, cntn, rbasen;
        const bool hn = moe_next2(q, c, en, mtn, ntilen, cntn, rbasen);
        int aoffn[4]; const float* bptrn; int nrn;
        if (hn) {
#pragma unroll
            for (int i = 0; i < 4; ++i) { const int r = mtn * 256 + a_piece_row(c, i); const int tok = r < cntn ? (ltok[en * NTOK + r] >> 1) : 0; aoffn[i] = tok * D + a_piece_col(c); }
            bptrn = wsel + (size_t)en * D * DE + (size_t)(8 * c.wid) * DE + ntilen * 128 + bcol; nrn = cntn - mtn * 256;
        } else {
#pragma unroll
            for (int i = 0; i < 4; ++i) aoffn[i] = aoff[i] + (D / 64 - 1) * 64;
            bptrn = bptr + (size_t)((D / 64 - 1) * 64) * DE; nrn = cnt_e - mt * 256;
        }
        const int n0 = ntile * 128;
        f32x4 acc[8][4]; zero_acc4(acc);
        gemm_mainloop256<D>(acc, rb, h2, aoff, bptr, DE, cnt_e - mt * 256, c, staged, aoffn, bptrn, nrn, hn);
#pragma unroll
        for (int mi = 0; mi < 8; ++mi) {
            const int r = mt * 256 + 128 * c.wr + 16 * mi + c.fr;
            if (r < cnt_e) {
#pragma unroll
                for (int hh = 0; hh < 2; ++hh) {
                    const int col = n0 + 16 * (2 * c.wc + hh) + 4 * c.fq;
                    float o[4];
#pragma unroll
                    for (int j = 0; j < 4; ++j) { const float a = acc[mi][2 * hh][j], u = acc[mi][2 * hh + 1][j]; o[j] = a * sigmoidf_(a) * u; }
                    u32x2 w; w.x = pack_bf16(o[0], o[1]); w.y = pack_bf16(o[2], o[3]);
                    *(u32x2*)(act + (size_t)(rbase + r) * DE + col) = w;
                }
            }
        }
        if (!hn) break;
        e = en; mt = mtn; ntile = ntilen; cnt_e = cntn; rbase = rbasen; bptr = bptrn; staged = true;
#pragma unroll
        for (int i = 0; i < 4; ++i) aoff[i] = aoffn[i];
    }
    asm volatile("s_waitcnt vmcnt(0)" ::: "memory");
}
__device__ __forceinline__ void phase_moe2w(const Params& p, const Ctx& c, int qsel = 2) {
    const bf16_t* act = (const bf16_t*)(p.ws + WS_ACT);
    bf16_t* yb = (bf16_t*)(p.ws + WS_Y);
    const float* wd = p.in[22];
    moe_table2(p, c);
    XQueue q = xq_make(p, qsel);
    int e, mt, ntile, cnt_e, rbase;
    if (!moe_next2(q, c, e, mt, ntile, cnt_e, rbase)) return;
    int aoff[4];
#pragma unroll
    for (int i = 0; i < 4; ++i) aoff[i] = (rbase + mt * 256 + a_piece_row(c, i)) * DE + a_piece_col(c);
    const float* bptr = wd + (size_t)e * DE * D + (size_t)(8 * c.wid) * D + ntile * 256 + 4 * c.lane;
    bool staged = false;
    f32x4 rb[8];
    for (;;) {
        int en, mtn, ntilen, cntn, rbasen;
        const bool hn = moe_next2(q, c, en, mtn, ntilen, cntn, rbasen);
        int aoffn[4]; const float* bptrn; int nrn;
        if (hn) {
#pragma unroll
            for (int i = 0; i < 4; ++i) aoffn[i] = (rbasen + mtn * 256 + a_piece_row(c, i)) * DE + a_piece_col(c);
            bptrn = wd + (size_t)en * DE * D + (size_t)(8 * c.wid) * D + ntilen * 256 + 4 * c.lane; nrn = cntn - mtn * 256;
        } else {
#pragma unroll
            for (int i = 0; i < 4; ++i) aoffn[i] = aoff[i] + (DE / 64 - 1) * 64;
            bptrn = bptr + (size_t)((DE / 64 - 1) * 64) * D; nrn = cnt_e - mt * 256;
        }
        const int n0 = ntile * 256;
        f32x4 acc[8][4]; zero_acc4(acc);
        gemm_mainloop256<DE>(acc, rb, act, aoff, bptr, D, cnt_e - mt * 256, c, staged, aoffn, bptrn, nrn, hn);
#pragma unroll
        for (int mi = 0; mi < 8; ++mi) {
            const int r = mt * 256 + 128 * c.wr + 16 * mi + c.fr;
            if (r < cnt_e) {
#pragma unroll
                for (int ni = 0; ni < 4; ++ni) {
                    const int col = n0 + 64 * c.wc + 16 * ni + 4 * c.fq;
                    const f32x4 v = acc[mi][ni];
                    u32x2 pk; pk.x = pack_bf16(v[0], v[1]); pk.y = pack_bf16(v[2], v[3]);
                    *(u32x2*)(yb + (size_t)(rbase + r) * D + col) = pk;
                }
            }
        }
        if (!hn) break;
        e = en; mt = mtn; ntile = ntilen; cnt_e = cntn; rbase = rbasen; bptr = bptrn; staged = true;
#pragma unroll
        for (int i = 0; i < 4; ++i) aoff[i] = aoffn[i];
    }
    asm volatile("s_waitcnt vmcnt(0)" ::: "memory");
}

__device__ __forceinline__ void phase_final(const Params& p, const Ctx& c) {
    const float* x1 = (const float*)(p.ws + WS_X1); const bf16_t* yb = (const bf16_t*)(p.ws + WS_Y);
    const float* mod = (const float*)(p.ws + WS_MOD); const float* g = p.in[23];
    const unsigned* cnt = (const unsigned*)(p.ws + WS_CTL) + CW_CNT;
    LAS int* rpre = (LAS int*)c.lds;
    __syncthreads();
    if (c.tid == 0) { int rp = 0; for (int e = 0; e < NE; ++e) { rpre[e] = rp; rp += (int)cnt[e]; } }
    __syncthreads();
    for (int row = c.bid * 8 + c.wid; row < NTOK; row += c.nblk * 8) {
        const int b = row >> 11;
        const u32x4 rec = *(const u32x4*)(p.ws + WS_TREC + (size_t)row * 16);
        const size_t r0 = (size_t)(rpre[rec.x >> 13] + (int)(rec.x & 8191u)), r1 = (size_t)(rpre[rec.z >> 13] + (int)(rec.z & 8191u));
        const float w0 = __uint_as_float(rec.y), w1 = __uint_as_float(rec.w);
        f32x4 v[8]; float ss = 0.f;
#pragma unroll
        for (int i = 0; i < 8; ++i) {
            const int col = i * 256 + c.lane * 4;
            const f32x4 xv = *(const f32x4*)(x1 + (size_t)row * D + col);
            const u32x2 a0 = *(const u32x2*)(yb + r0 * D + col), a1 = *(const u32x2*)(yb + r1 * D + col);
            f32x4 y0, y1;
            y0[0] = __uint_as_float(a0.x << 16); y0[1] = __uint_as_float(a0.x & 0xffff0000u); y0[2] = __uint_as_float(a0.y << 16); y0[3] = __uint_as_float(a0.y & 0xffff0000u);
            y1[0] = __uint_as_float(a1.x << 16); y1[1] = __uint_as_float(a1.x & 0xffff0000u); y1[2] = __uint_as_float(a1.y << 16); y1[3] = __uint_as_float(a1.y & 0xffff0000u);
            const f32x4 gf = *(const f32x4*)(mod + b * NMOD + 5 * D + col);
            v[i] = xv + gf * (y0 * w0 + y1 * w1);
            ss += v[i][0] * v[i][0] + v[i][1] * v[i][1] + v[i][2] * v[i][2] + v[i][3] * v[i][3];
        }
        ss = wave_sum(ss);
        const float rstd = rsqrtf(ss * (1.0f / D) + EPS);
#pragma unroll
        for (int i = 0; i < 8; ++i) {
            const int col = i * 256 + c.lane * 4;
            const f32x4 gg = *(const f32x4*)(g + col);
            *(f32x4*)(p.out + (size_t)row * D + col) = v[i] * rstd * gg;
        }
    }
}

struct EpiProjIn {
    static constexpr bool PERM = false, AFTER_DRAIN = false;
    unsigned char* ws;
    __device__ __forceinline__ void operator()(const pg8::f32x4 (&acc)[2][2][4][2], const pg8::Unit& u, int wr, int wc, int fr, int fq) const {
        const int region = (u.pn * 256) >> 10;
#pragma unroll
        for (int ai = 0; ai < 2; ++ai)
#pragma unroll
            for (int m = 0; m < 4; ++m) {
                const int row = u.pm * 256 + ai * 128 + wr * 64 + m * 16 + fr;
#pragma unroll
                for (int bj = 0; bj < 2; ++bj)
#pragma unroll
                    for (int n = 0; n < 2; ++n) {
                        const int col = u.pn * 256 + bj * 128 + wc * 32 + n * 16 + 4 * fq;
                        const f32x4 a = acc[ai][bj][m][n];
                        if (region < 6) {
                            const int cin = col & 1023;
                            if (region == 2 || region == 5) {
                                bf16_t* vt = (bf16_t*)(ws + (region == 2 ? WS_VAT : WS_VBT));
                                const int b = row >> 11, s0 = row & 2047, hh = cin >> 7, d = cin & 127;
                                const int s = (s0 & ~31) | ((s0 & 12) << 1) | ((s0 & 16) >> 2) | (s0 & 3);
                                const unsigned w0 = pack_bf16(a[0], a[1]), w1 = pack_bf16(a[2], a[3]);
                                bf16_t* base = vt + ((size_t)((b * 8 + hh) * 128 + d)) * SEQ + s;
                                base[0] = (bf16_t)(w0 & 0xffff); base[SEQ] = (bf16_t)(w0 >> 16); base[2 * SEQ] = (bf16_t)(w1 & 0xffff); base[3 * SEQ] = (bf16_t)(w1 >> 16);
                            } else {
                                const size_t off = region == 0 ? WS_QA : region == 1 ? WS_KA : region == 3 ? WS_QB : WS_KB;
                                bf16_t* dst = (bf16_t*)(ws + off);
                                u32x2 w; w.x = pack_bf16(a[0], a[1]); w.y = pack_bf16(a[2], a[3]);
                                *(u32x2*)(dst + (size_t)row * 1024 + cin) = w;
                            }
                        } else {
                            bf16_t* dst = (bf16_t*)(ws + (region < 8 ? WS_GA : WS_GB));
                            const int cin = col - (region < 8 ? 6144 : 8192);
                            u32x2 w; w.x = pack_bf16(sigmoidf_(a[0]), sigmoidf_(a[1])); w.y = pack_bf16(sigmoidf_(a[2]), sigmoidf_(a[3]));
                            *(u32x2*)(dst + (size_t)row * D + cin) = w;
                        }
                    }
            }
    }
};
template <int PASS> struct EpiGate {
    static constexpr bool PERM = false, AFTER_DRAIN = false;
    const bf16_t* G; float* tmp; bf16_t* out;
    __device__ __forceinline__ void operator()(const pg8::f32x4 (&acc)[2][2][4][2], const pg8::Unit& u, int wr, int wc, int fr, int fq) const {
#pragma unroll
        for (int ai = 0; ai < 2; ++ai)
#pragma unroll
            for (int m = 0; m < 4; ++m) {
                const int row = u.pm * 256 + ai * 128 + wr * 64 + m * 16 + fr;
#pragma unroll
                for (int bj = 0; bj < 2; ++bj)
#pragma unroll
                    for (int n = 0; n < 2; ++n) {
                        const int col = u.pn * 256 + bj * 128 + wc * 32 + n * 16 + 4 * fq;
                        const u32x2 gw = *(const u32x2*)(G + (size_t)row * D + col);
                        f32x4 g; g[0] = __uint_as_float(gw.x << 16); g[1] = __uint_as_float(gw.x & 0xffff0000u); g[2] = __uint_as_float(gw.y << 16); g[3] = __uint_as_float(gw.y & 0xffff0000u);
                        f32x4 v = acc[ai][bj][m][n] * g;
                        if (PASS == 0) *(f32x4*)(tmp + (size_t)row * D + col) = v;
                        else {
                            v += *(const f32x4*)(tmp + (size_t)row * D + col);
                            u32x2 w; w.x = pack_bf16(v[0], v[1]); w.y = pack_bf16(v[2], v[3]);
                            *(u32x2*)(out + (size_t)row * D + col) = w;
                        }
                    }
            }
    }
};
struct EpiX1 {
    static constexpr bool PERM = false, AFTER_DRAIN = false;
    const float* x; const float* mod; float* x1;
    __device__ __forceinline__ void operator()(const pg8::f32x4 (&acc)[2][2][4][2], const pg8::Unit& u, int wr, int wc, int fr, int fq) const {
        const int b = (u.pm * 256) >> 11;
#pragma unroll
        for (int ai = 0; ai < 2; ++ai)
#pragma unroll
            for (int m = 0; m < 4; ++m) {
                const int row = u.pm * 256 + ai * 128 + wr * 64 + m * 16 + fr;
#pragma unroll
                for (int bj = 0; bj < 2; ++bj)
#pragma unroll
                    for (int n = 0; n < 2; ++n) {
                        const int col = u.pn * 256 + bj * 128 + wc * 32 + n * 16 + 4 * fq;
                        const f32x4 gm = *(const f32x4*)(mod + b * NMOD + 2 * D + col);
                        const f32x4 xv = *(const f32x4*)(x + (size_t)row * D + col);
                        *(f32x4*)(x1 + (size_t)row * D + col) = xv + gm * acc[ai][bj][m][n];
                    }
            }
    }
};
__device__ __forceinline__ void phase_proj_in2(const Params& p, const Ctx& c) {
    pg8::Gemm g{(const bf16_t*)(p.ws + WS_H), (const bf16_t*)(p.ws + WS_WIN_T), NTOK, INC, D};
    pg8::StaticOrder S; S.init(NTOK, INC, c.nblk, c.bid);
    EpiProjIn E{p.ws};
    pg8::gemm_phase<EpiProjIn, pg8::StaticOrder>(c.lds, g, S, E, nullptr, c.wid);
}
__device__ __forceinline__ void phase_merge2(const Params& p, const Ctx& c) {
    float* tmp = (float*)(p.ws + WS_X1);
    {
        pg8::Gemm g{(const bf16_t*)(p.ws + WS_OA), (const bf16_t*)(p.ws + WS_WPA_T), NTOK, D, 1024};
        pg8::StaticOrder S; S.init(NTOK, D, c.nblk, c.bid);
        EpiGate<0> E{(const bf16_t*)(p.ws + WS_GA), tmp, nullptr};
        pg8::gemm_phase<EpiGate<0>, pg8::StaticOrder>(c.lds, g, S, E, nullptr, c.wid);
    }
    {
        pg8::Gemm g{(const bf16_t*)(p.ws + WS_OB), (const bf16_t*)(p.ws + WS_WPB_T), NTOK, D, 1024};
        pg8::StaticOrder S; S.init(NTOK, D, c.nblk, c.bid);
        EpiGate<1> E{(const bf16_t*)(p.ws + WS_GB), tmp, (bf16_t*)(p.ws + WS_MRG)};
        pg8::gemm_phase<EpiGate<1>, pg8::StaticOrder>(c.lds, g, S, E, nullptr, c.wid);
    }
}
struct MidGate {
    static constexpr int AT = 16;
    const bf16_t* GA; const bf16_t* GB;
    __device__ __forceinline__ void operator()(pg8::f32x4 (&acc)[2][2][4][2], const pg8::Unit& u, int wr, int wc, int fr, int fq) const {
        int off0 = (u.pm * 256 + wr * 64 + fr) * D + u.pn * 256 + wc * 32 + 4 * fq;
        asm volatile("" : "+v"(off0));
#pragma unroll
        for (int ai = 0; ai < 2; ++ai)
#pragma unroll
            for (int m = 0; m < 4; ++m) {
#pragma unroll
                for (int bj = 0; bj < 2; ++bj)
#pragma unroll
                    for (int n = 0; n < 2; ++n) {
                        const int off = off0 + (ai * 128 + m * 16) * D + bj * 128 + n * 16;
                        const u32x2 a = *(const u32x2*)(GA + off), b = *(const u32x2*)(GB + off);
                        f32x4 r;
                        r[0] = __uint_as_float(a.x << 16) * __builtin_amdgcn_rcpf(__uint_as_float(b.x << 16)); r[1] = __uint_as_float(a.x & 0xffff0000u) * __builtin_amdgcn_rcpf(__uint_as_float(b.x & 0xffff0000u));
                        r[2] = __uint_as_float(a.y << 16) * __builtin_amdgcn_rcpf(__uint_as_float(b.y << 16)); r[3] = __uint_as_float(a.y & 0xffff0000u) * __builtin_amdgcn_rcpf(__uint_as_float(b.y & 0xffff0000u));
                        acc[ai][bj][m][n] *= r;
                    }
                asm volatile("" ::: "memory");
            }
    }
};
struct EpiGateB {
    static constexpr bool PERM = false, AFTER_DRAIN = false;
    const bf16_t* GB; bf16_t* out;
    __device__ __forceinline__ void operator()(const pg8::f32x4 (&acc)[2][2][4][2], const pg8::Unit& u, int wr, int wc, int fr, int fq) const {
#pragma unroll
        for (int ai = 0; ai < 2; ++ai)
#pragma unroll
            for (int m = 0; m < 4; ++m) {
                const int row = u.pm * 256 + ai * 128 + wr * 64 + m * 16 + fr;
#pragma unroll
                for (int bj = 0; bj < 2; ++bj)
#pragma unroll
                    for (int n = 0; n < 2; ++n) {
                        const int col = u.pn * 256 + bj * 128 + wc * 32 + n * 16 + 4 * fq;
                        const u32x2 gw = *(const u32x2*)(GB + (size_t)row * D + col);
                        f32x4 g; g[0] = __uint_as_float(gw.x << 16); g[1] = __uint_as_float(gw.x & 0xffff0000u); g[2] = __uint_as_float(gw.y << 16); g[3] = __uint_as_float(gw.y & 0xffff0000u);
                        const f32x4 v = acc[ai][bj][m][n] * g;
                        u32x2 w; w.x = pack_bf16(v[0], v[1]); w.y = pack_bf16(v[2], v[3]);
                        *(u32x2*)(out + (size_t)row * D + col) = w;
                    }
            }
    }
};
__device__ __forceinline__ void phase_merge3(const Params& p, const Ctx& c) {
    pg8::Gemm g{(const bf16_t*)(p.ws + WS_OA), (const bf16_t*)(p.ws + WS_WPA_T), NTOK, D, D};
    pg8::StaticOrder S; S.init(NTOK, D, c.nblk, c.bid);
    EpiGateB E{(const bf16_t*)(p.ws + WS_GB), (bf16_t*)(p.ws + WS_MRG)};
    MidGate M{(const bf16_t*)(p.ws + WS_GA), (const bf16_t*)(p.ws + WS_GB)};
    pg8::gemm_phase<EpiGateB, pg8::StaticOrder, false, MidGate>(c.lds, g, S, E, nullptr, c.wid, M);
}
__device__ __forceinline__ void phase_out2(const Params& p, const Ctx& c) {
    pg8::Gemm g{(const bf16_t*)(p.ws + WS_MRG), (const bf16_t*)(p.ws + WS_WOUT_T), NTOK, D, D};
    pg8::StaticOrder S; S.init(NTOK, D, c.nblk, c.bid);
    EpiX1 E{p.in[0], (const float*)(p.ws + WS_MOD), (float*)(p.ws + WS_X1)};
    pg8::gemm_phase<EpiX1, pg8::StaticOrder>(c.lds, g, S, E, nullptr, c.wid);
}

constexpr int LDS_BYTES = 160 * 1024;
__global__ void __launch_bounds__(512, 2) mk_fwd(Params p) {
    extern __shared__ __attribute__((aligned(16))) unsigned char smem[];
    LAS unsigned char* ldsb = (LAS unsigned char*)smem;
    Ctx c; c.lds = ldsb; c.tid = threadIdx.x; c.lane = c.tid & 63; c.wid = __builtin_amdgcn_readfirstlane(c.tid >> 6); c.wr = c.wid >> 2; c.wc = c.wid & 3;
    c.fr = c.lane & 15; c.fq = c.lane >> 4; c.bid = blockIdx.x; c.nblk = gridDim.x;
#define MKCTX() do {} while (0)
#define LEADER() (c.tid == 0)
    volatile LAS unsigned* bst = (volatile LAS unsigned*)(ldsb + LDS_BYTES - 32);
    if (LEADER()) { bst[0] = 0u; bst[1] = 0u; }
    __syncthreads();
    unsigned* barw = (unsigned*)(p.ws + WS_CTL);
    XcdBarrier bar; bar.bar = barw; bar.x = 0; bar.st = bst;
#if !MK_SPLIT
    bar = xcd_barrier_post(barw, bst, LEADER());
#define GRID_BAR() xcd_barrier(bar, LEADER())
#else
#define GRID_BAR() do {} while (0)
#endif
    const int lo = p.ph_lo, hi = p.ph_hi;
#define IN(k) (lo <= (k) && (k) < hi)
#define BOTH(k) (IN(k) && IN((k) + 1))
#define DUP(k) ((DUP_MASK >> (k)) & 1)
    if (IN(0)) { MKCTX(); phase_mod(p, c); phase_convert(p, c); if (DUP(0)) { GRID_BAR(); phase_mod(p, c); phase_convert(p, c); } if (BOTH(0)) GRID_BAR(); }
    if (IN(1)) { MKCTX(); phase_norm1(p, c); phase_router_prep(p, c); if (DUP(1)) { GRID_BAR(); phase_norm1(p, c); } if (BOTH(1)) GRID_BAR(); }
    if (IN(2)) { MKCTX(); phase_proj_in2(p, c); if (DUP(2)) { GRID_BAR(); phase_proj_in2(p, c); } if (BOTH(2)) GRID_BAR(); }
    if (IN(3)) { MKCTX(); phase_attn(p, c, 0); if (DUP(3)) { GRID_BAR(); phase_attn(p, c, 3); } if (BOTH(3)) GRID_BAR(); }
    if (IN(4)) { MKCTX(); phase_merge3(p, c); if (DUP(4)) { GRID_BAR(); phase_merge3(p, c); } if (BOTH(4)) GRID_BAR(); }
    if (IN(5)) { MKCTX(); phase_out2(p, c); if (DUP(5)) { GRID_BAR(); phase_out2(p, c); } if (BOTH(5)) GRID_BAR(); }
    if (IN(6)) { MKCTX(); phase_norm2_route2(p, c); if (DUP(6)) { GRID_BAR(); phase_norm2_route2(p, c, 1); } if (BOTH(6)) GRID_BAR(); }
    if (IN(7)) { MKCTX(); phase_moe1w(p, c, 1); if (DUP(7)) { GRID_BAR(); phase_moe1w(p, c, 4); } if (BOTH(7)) GRID_BAR(); }
    if (IN(8)) { MKCTX(); phase_moe2w(p, c, 2); if (DUP(8)) { GRID_BAR(); phase_moe2w(p, c, 5); } if (BOTH(8)) GRID_BAR(); }
    if (IN(9)) { MKCTX(); phase_final(p, c); if (DUP(9)) { GRID_BAR(); phase_final(p, c); } }
}

extern "C" void kernel_launch(void* const* d_in, const int* in_sizes, int n_in, void* d_out, int out_size, void* d_ws, size_t ws_size, hipStream_t stream) {
    static int grid = 0;
    if (grid == 0) {
        if (n_in != 24 || out_size != NTOK * D || ws_size < WS_END) { fprintf(stderr, "kernel_launch: unexpected shapes (n_in %d out %d ws %zu need %zu)\n", n_in, out_size, ws_size, (size_t)WS_END); grid = -1; return; }
        int dev = 0, cus = 0, per_cu = 0;
        (void)hipGetDevice(&dev); (void)hipDeviceGetAttribute(&cus, hipDeviceAttributeMultiprocessorCount, dev);
        if (hipFuncSetAttribute((const void*)mk_fwd, hipFuncAttributeMaxDynamicSharedMemorySize, LDS_BYTES) != hipSuccess) { fprintf(stderr, "kernel_launch: hipFuncSetAttribute failed\n"); grid = -1; return; }
        if (hipOccupancyMaxActiveBlocksPerMultiprocessor(&per_cu, (const void*)mk_fwd, 512, LDS_BYTES) != hipSuccess || per_cu < 1) { fprintf(stderr, "kernel_launch: occupancy query says %d\n", per_cu); }
        (void)hipGetLastError();
        grid = cus > 0 ? cus : 256;
    }
    if (grid < 0) return;
    (void)hipMemsetAsync((char*)d_ws + WS_CTL, 0, CTL_BYTES, stream);
    Params p{};
    for (int i = 0; i < 24; ++i) p.in[i] = (const float*)d_in[i];
    p.out = (float*)d_out; p.ws = (unsigned char*)d_ws;
#if MK_SPLIT
    for (int ph = 0; ph < NPHASE; ++ph) { p.ph_lo = ph; p.ph_hi = ph + 1; hipLaunchKernelGGL(mk_fwd, dim3(grid), dim3(512), LDS_BYTES, stream, p); }
#else
    p.ph_lo = 0; p.ph_hi = NPHASE;
    hipLaunchKernelGGL(mk_fwd, dim3(grid), dim3(512), LDS_BYTES, stream, p);
#endif
}
```

```cpp
#include <hip/hip_runtime.h>
#include <stdint.h>
#include <stdio.h>

#ifndef DUP_MASK
#define DUP_MASK 0
#endif
#ifndef MOE_NT
#define MOE_NT false
#endif
#ifndef MK_SPLIT
#define MK_SPLIT 0
#endif

typedef unsigned short bf16_t;
typedef short bf16x8 __attribute__((ext_vector_type(8)));
typedef short bf16x4 __attribute__((ext_vector_type(4)));
typedef float f32x4 __attribute__((ext_vector_type(4)));
typedef unsigned u32x4 __attribute__((ext_vector_type(4)));
typedef unsigned u32x2 __attribute__((ext_vector_type(2)));
#define LAS __attribute__((address_space(3)))

constexpr int D = 2048, NB = 4, SEQ = 2048, NTOK = NB * SEQ;
constexpr int INC = 10240, NMOD = 6 * D;
constexpr int NE = 64, DE = 1024;
constexpr float EPS = 1e-6f;
constexpr int NPHASE = 10;

constexpr size_t WS_CTL = 0;
constexpr size_t CTL_BYTES = 32768;
constexpr size_t CW_CNT = 4096;
constexpr size_t CW_Q = 4096 + 256;
constexpr size_t WS_MOD = WS_CTL + CTL_BYTES;
constexpr size_t WS_H = WS_MOD + (size_t)NB * NMOD * 4;
constexpr size_t WS_QA = WS_H + (size_t)NTOK * D * 2;
constexpr size_t WS_KA = WS_QA + (size_t)NTOK * 1024 * 2;
constexpr size_t WS_VAT = WS_KA + (size_t)NTOK * 1024 * 2;
constexpr size_t WS_QB = WS_VAT + (size_t)NTOK * 1024 * 2;
constexpr size_t WS_KB = WS_QB + (size_t)NTOK * 1024 * 2;
constexpr size_t WS_VBT = WS_KB + (size_t)NTOK * 1024 * 2;
constexpr size_t WS_GA = WS_VBT + (size_t)NTOK * 1024 * 2;
constexpr size_t WS_GB = WS_GA + (size_t)NTOK * D * 2;
constexpr size_t WS_OA = WS_GB + (size_t)NTOK * D * 2;
constexpr size_t WS_OB = WS_OA + (size_t)NTOK * 1024 * 2;
constexpr size_t WS_MRG = WS_OB + (size_t)NTOK * 1024 * 2;
constexpr size_t WS_X1 = WS_MRG + (size_t)NTOK * D * 2;
constexpr size_t WS_H2 = WS_X1 + (size_t)NTOK * D * 4;
constexpr size_t WS_LTOK = WS_H2 + (size_t)NTOK * D * 2;
constexpr size_t WS_LW = WS_LTOK + (size_t)NE * NTOK * 4;
constexpr size_t WS_ACT = WS_LW + (size_t)NE * NTOK * 4;
constexpr size_t WS_Y = WS_ACT + (size_t)(2 * NTOK + 512) * DE * 2;
constexpr size_t WS_WIN_T = WS_Y + (size_t)2 * NTOK * D * 4;
constexpr size_t WS_WPA_T = WS_WIN_T + (size_t)INC * D * 2;
constexpr size_t WS_WPB_T = WS_WPA_T + (size_t)D * 1024 * 2;
constexpr size_t WS_WOUT_T = WS_WPB_T + (size_t)D * 1024 * 2;
constexpr size_t WS_RW = WS_WOUT_T + (size_t)D * D * 2;
constexpr size_t WS_RC = WS_RW + (size_t)NB * 80 * D * 4;
constexpr size_t WS_TREC = WS_RC + 4096;
constexpr size_t WS_END = WS_TREC + (size_t)NTOK * 16;

#define XB_TMO      128
#define XB_XCNT(j)  (256  + 64 * (j))
#define XB_XSUB(j)  (1280 + 64 * (j))
#define XB_XGEN(j)  (2304 + 64 * (j))
#define XB_TOP      3328
#define XB_TOPGEN   3392
#define XCD_BAR_WORDS 3456
#define XB_SPIN_CAP (1u << 24)

__device__ __forceinline__ unsigned xb_ld(unsigned* p)              { return __hip_atomic_load(p, __ATOMIC_RELAXED, __HIP_MEMORY_SCOPE_AGENT); }
__device__ __forceinline__ unsigned xb_add(unsigned* p, unsigned v) { return __hip_atomic_fetch_add(p, v, __ATOMIC_RELAXED, __HIP_MEMORY_SCOPE_AGENT); }
__device__ __forceinline__ unsigned xb_xcc_id() { return (unsigned)__builtin_amdgcn_s_getreg((3 << 11) | 20) & 0xFu; }
#define XB_SPIN(cond, bar) do { unsigned _sp = 0; while (cond) { __builtin_amdgcn_s_sleep(1); \
    if ((++_sp & 255u) == 0u) { if (xb_ld(&(bar)[XB_TMO])) break; if (_sp > XB_SPIN_CAP) { atomicAdd(&(bar)[XB_TMO], 1u); break; } } } } while (0)

struct XcdBarrier { unsigned* bar; unsigned x; volatile LAS unsigned* st; };

__device__ __forceinline__ XcdBarrier xcd_barrier_post(unsigned* bar, volatile LAS unsigned* st, bool leader) {
    XcdBarrier b; b.bar = bar; b.x = xb_xcc_id(); b.st = st;
    if (leader) (void)xb_add(&bar[XB_XCNT(b.x)], 1u);
    return b;
}
__device__ __forceinline__ void xcd_barrier_complete(unsigned* bar, unsigned x, unsigned& nloc, unsigned& nx) {
    const unsigned G = gridDim.x * gridDim.y * gridDim.z;
    unsigned sum, cnt, mine, sp = 0u;
    for (;;) {
        sum = 0u; cnt = 0u; mine = 0u;
#pragma unroll
        for (unsigned j = 0; j < 16; ++j) { const unsigned c = xb_ld(&bar[XB_XCNT(j)]); sum += c; cnt += (c > 0u) ? 1u : 0u; mine = (j == x) ? c : mine; }
        if (sum == G) break;
        __builtin_amdgcn_s_sleep(1);
        if ((++sp & 255u) == 0u) { if (xb_ld(&bar[XB_TMO])) break; if (sp > XB_SPIN_CAP) { atomicAdd(&bar[XB_TMO], 1u); break; } }
    }
    nloc = mine > 0u ? mine : 1u; nx = cnt > 0u ? cnt : 1u;
}
__device__ __forceinline__ void xcd_barrier(const XcdBarrier& b, bool leader) {
    asm volatile("s_waitcnt vmcnt(0)" ::: "memory");
    __syncthreads();
    if (leader) {
        unsigned* bar = b.bar;
        __builtin_amdgcn_s_waitcnt(0);
        unsigned nloc = b.st[0], nx = b.st[1];
        if (nloc == 0u) { xcd_barrier_complete(bar, b.x, nloc, nx); b.st[0] = nloc; b.st[1] = nx; }
        const unsigned old = xb_add(&bar[XB_XSUB(b.x)], 1u);
        const unsigned gen = old / nloc;
        if (old + 1u == (gen + 1u) * nloc) {
            __builtin_amdgcn_fence(__ATOMIC_RELEASE, "agent");
            asm volatile("s_waitcnt vmcnt(0)" ::: "memory");
            const unsigned og = xb_add(&bar[XB_TOP], 1u);
            const unsigned tg = og / nx;
            if (og + 1u == (tg + 1u) * nx) xb_add(&bar[XB_TOPGEN], 1u);
            else XB_SPIN(xb_ld(&bar[XB_TOPGEN]) == tg, bar);
            __builtin_amdgcn_fence(__ATOMIC_ACQUIRE, "agent");
            xb_add(&bar[XB_XGEN(b.x)], 1u);
            asm volatile("s_waitcnt vmcnt(0)" ::: "memory");
        } else {
            XB_SPIN(xb_ld(&bar[XB_XGEN(b.x)]) == gen, bar);
            __builtin_amdgcn_fence(__ATOMIC_ACQUIRE, "agent");
            asm volatile("s_waitcnt vmcnt(0)" ::: "memory");
        }
    }
    __syncthreads();
}

typedef __bf16 bf16v2_t __attribute__((ext_vector_type(2)));
typedef float f32x2 __attribute__((ext_vector_type(2)));
__device__ __forceinline__ unsigned pack_bf16(float lo, float hi) {
    const f32x2 v = {lo, hi};
    return __builtin_bit_cast(unsigned, __builtin_convertvector(v, bf16v2_t));
}
__device__ __forceinline__ float wave_sum(float v) {
#pragma unroll
    for (int o = 32; o > 0; o >>= 1) v += __shfl_xor(v, o);
    return v;
}
__device__ __forceinline__ float xmax16(float v) { const auto r = __builtin_amdgcn_permlane16_swap(__float_as_uint(v), __float_as_uint(v), false, false); return fmaxf(__uint_as_float(r[0]), __uint_as_float(r[1])); }
__device__ __forceinline__ float xmax32(float v) { const auto r = __builtin_amdgcn_permlane32_swap(__float_as_uint(v), __float_as_uint(v), false, false); return fmaxf(__uint_as_float(r[0]), __uint_as_float(r[1])); }
__device__ __forceinline__ float xsum16(float v) { const auto r = __builtin_amdgcn_permlane16_swap(__float_as_uint(v), __float_as_uint(v), false, false); return __uint_as_float(r[0]) + __uint_as_float(r[1]); }
__device__ __forceinline__ float xsum32(float v) { const auto r = __builtin_amdgcn_permlane32_swap(__float_as_uint(v), __float_as_uint(v), false, false); return __uint_as_float(r[0]) + __uint_as_float(r[1]); }
__device__ __forceinline__ float sigmoidf_(float x) { return __builtin_amdgcn_rcpf(1.0f + __builtin_amdgcn_exp2f(-1.4426950408889634f * x)); }

__device__ __forceinline__ int lane_id_fresh() { int l; asm volatile("v_mbcnt_lo_u32_b32 %0, -1, 0\n\tv_mbcnt_hi_u32_b32 %0, -1, %0" : "=v"(l)); return l; }
struct Params { const float* in[24]; float* out; unsigned char* ws; int ph_lo, ph_hi; };

struct Ctx {
    int tid, lane, wid, wr, wc, fr, fq, bid, nblk;
    LAS unsigned char* lds;
};

__device__ __forceinline__ int next_item(unsigned* ctr, const Ctx& c) {
    LAS int* slot = (LAS int*)(c.lds + 160 * 1024 - 64);
    __syncthreads();
    if (c.tid == 0) *slot = (int)__hip_atomic_fetch_add(ctr, 1u, __ATOMIC_RELAXED, __HIP_MEMORY_SCOPE_AGENT);
    __syncthreads();
    return *slot;
}

struct XQueue { unsigned* heads; int x, v; };
__device__ __forceinline__ XQueue xq_make(const Params& p, int qsel) { XQueue q; q.heads = (unsigned*)(p.ws + WS_CTL) + CW_Q + qsel * 512; q.x = (int)(xb_xcc_id() & 7u); q.v = 0; return q; }
__device__ __forceinline__ bool xq_next(XQueue& q, int per_tile, int ntiles, const Ctx& c, int& tile, int& sub) {
    while (q.v < 8) {
        const int qi = (q.x + q.v) & 7;
        const int L = next_item(q.heads + qi * 64, c);
        const int t = qi + 8 * (L / per_tile);
        if (t < ntiles) { tile = t; sub = L % per_tile; return true; }
        ++q.v;
    }
    return false;
}

namespace pg8 {
#define PG8_LAS __attribute__((address_space(3)))
typedef unsigned short bf16_t;
typedef short bf16x8 __attribute__((ext_vector_type(8)));
typedef float f32x4 __attribute__((ext_vector_type(4)));
typedef unsigned u32x4 __attribute__((ext_vector_type(4)));
constexpr int BM = 256, BK = 64, HALF = 128, HTB = HALF * BK * 2  , STAGE_BYTES = 8 * HTB, NXCD = 8, WGM = 8;

__host__ __device__ __forceinline__ int lds_byte(int r, int c) { const int st = (r >> 4) * 2 + (c >> 5), rr = r & 15, cc = c & 31, ob = rr * 64 + cc * 2; return st * 1024 + (ob ^ (((ob >> 9) & 1) << 5)); }
__host__ __device__ __forceinline__ void stage_rc(int b, int& R, int& C) { const int st = b / 1024, sb = b % 1024, swz = sb ^ (((sb >> 9) & 1) << 5); R = (st >> 1) * 16 + swz / 64; C = (st & 1) * 32 + (swz % 64) / 2; }
__host__ __device__ __forceinline__ int perm32(int rho) { const int n = rho >> 4, i = rho & 15; return 8 * (i >> 2) + 4 * n + (i & 3); }

struct Unit { int pm, pn; };
struct Gemm { const bf16_t* A; const bf16_t* Bt; int M, N, K; };

struct StaticOrder {
    int nM, nN, nwg, G, c;
    __host__ __device__ void init(int M, int N, int G_, int c_) { nM = M / BM; nN = N / BM; nwg = nM * nN; G = G_; c = c_; }
    __host__ __device__ bool next(int i, Unit& u) const {
        const long L = (long)i * G + c; if (L >= nwg) return false;
        int wgid = (int)L; { const int q = nwg / NXCD, r = nwg % NXCD, xcd = wgid % NXCD, off = wgid / NXCD; wgid = (xcd < r ? xcd * (q + 1) : r * (q + 1) + (xcd - r) * q) + off; }
        const int nig = WGM * nN, gid = wgid / nig, fm = gid * WGM, gsz = (nM - fm) < WGM ? (nM - fm) : WGM;
        u.pm = fm + ((wgid % nig) % gsz); u.pn = (wgid % nig) / gsz; return true;
    }
    __device__ __forceinline__ void a_ready(const Unit&) const {}
    __device__ __forceinline__ void done(const Unit&) const {}
};
struct NoMid { static constexpr int AT = -1; __device__ __forceinline__ void operator()(f32x4 (&)[2][2][4][2], const Unit&, int, int, int, int) const {} };
template <class Epi, class Sched, bool STAMP = false, class Mid = NoMid>
__device__ __forceinline__ void gemm_phase(PG8_LAS unsigned char* lds, const Gemm g, const Sched& S, const Epi& E, unsigned long long* stamps, const int wid_in, const Mid& MH = Mid()) {
    const int wid = __builtin_amdgcn_readfirstlane(wid_in), lane = lane_id_fresh(), tid = wid * 64 + lane, wr = wid >> 2, wc = wid & 3, fr = lane & 15, fq = lane >> 4;
    const int K = g.K, nt = K / BK;
    int ts_lo = 0, ts_hi = 0, nts = 0; const unsigned long long rt_entry = STAMP ? (unsigned long long)wall_clock64() : 0ull;
#define PG8_STAMP() do { if (STAMP && wid == 0 && nts < 64) { const unsigned long long _c = (unsigned long long)clock64(); \
        ts_lo = (lane == nts) ? (int)(unsigned)_c : ts_lo; ts_hi = (lane == nts) ? (int)(unsigned)(_c >> 32) : ts_hi; ++nts; } } while (0)
    PG8_STAMP();
    unsigned voffA[2], voffB[2];
#pragma unroll
    for (int i = 0; i < 2; ++i) { int R, C; stage_rc(tid * 16 + i * 8192, R, C); const int Rb = Epi::PERM ? ((R & ~31) + perm32(R & 31)) : R;
        voffA[i] = (unsigned)(R * K + C) * 2u; voffB[i] = (unsigned)(Rb * K + C) * 2u; }
    const size_t kstep = (size_t)(BK * 2);
    const size_t hstep = (size_t)HALF * K * 2;
    const size_t tstep = 2 * hstep;
    const unsigned ldsw = (unsigned)wid * 1024u;
    const int aoff = lds_byte(wr * 64 + fr, fq * 8), boff = lds_byte(wc * 32 + fr, fq * 8);
#define PG8_SA(b, h) (((b) * 2 + (h)) * HTB)
#define PG8_SB(b, h) ((4 + (b) * 2 + (h)) * HTB)
#define PG8_STAGE(bufoff, gbase, voff) do { _Pragma("unroll") for (int _i = 0; _i < 2; ++_i) \
        __builtin_amdgcn_global_load_lds((const unsigned*)((const char*)(gbase) + (voff)[_i]), (PG8_LAS unsigned*)(lds + (bufoff) + ldsw + _i * 8192), 16, 0, 0); } while (0)
#define PG8_LDA(dst, b, h) do { _Pragma("unroll") for (int m = 0; m < 4; ++m) _Pragma("unroll") for (int k = 0; k < 2; ++k) dst[m][k] = *(const PG8_LAS bf16x8*)(lds + PG8_SA(b, h) + aoff + m * 2048 + k * 1024); } while (0)
#define PG8_LDB(dst, b, h) do { _Pragma("unroll") for (int n = 0; n < 2; ++n) _Pragma("unroll") for (int k = 0; k < 2; ++k) dst[n][k] = *(const PG8_LAS bf16x8*)(lds + PG8_SB(b, h) + boff + n * 2048 + k * 1024); } while (0)
#define PG8_MMA(ai, bj, At, Bt) do { __builtin_amdgcn_s_setprio(1); _Pragma("unroll") for (int m = 0; m < 4; ++m) _Pragma("unroll") for (int n = 0; n < 2; ++n) _Pragma("unroll") for (int k = 0; k < 2; ++k) \
        acc[ai][bj][m][n] = __builtin_amdgcn_mfma_f32_16x16x32_bf16(Bt[n][k], At[m][k], acc[ai][bj][m][n], 0, 0, 0); __builtin_amdgcn_s_setprio(0); } while (0)
#define PG8_WAIT_V(n) asm volatile("s_waitcnt vmcnt(" #n ")" ::: "memory")
#define PG8_WAIT_L(n) asm volatile("s_waitcnt lgkmcnt(" #n ")" ::: "memory")
#define PG8_BAR __builtin_amdgcn_s_barrier()
#define PG8_SCHED __builtin_amdgcn_sched_barrier(0)
    Unit cur, nxt; int ui = 0;
    if (!S.next(0, cur)) return;
    f32x4 acc[2][2][4][2];
#pragma unroll
    for (int a = 0; a < 2; ++a)
#pragma unroll
        for (int b = 0; b < 2; ++b)
#pragma unroll
            for (int m = 0; m < 4; ++m)
#pragma unroll
                for (int n = 0; n < 2; ++n) acc[a][b][m][n] = (f32x4){0.f, 0.f, 0.f, 0.f};
    bf16x8 At[4][2], B0[2][2], B1[2][2];
    const char* cA = (const char*)g.A + (size_t)cur.pm * tstep; const char* cB = (const char*)g.Bt + (size_t)cur.pn * tstep;
    S.a_ready(cur);
    PG8_STAGE(PG8_SB(0, 0), cB, voffB); PG8_STAGE(PG8_SA(0, 0), cA, voffA); PG8_STAGE(PG8_SB(0, 1), cB + hstep, voffB); PG8_STAGE(PG8_SA(0, 1), cA + hstep, voffA);
    if (wr == 1) PG8_BAR;
    PG8_WAIT_V(4); PG8_BAR;
    PG8_STAGE(PG8_SB(1, 0), cB + kstep, voffB); PG8_STAGE(PG8_SA(1, 0), cA + kstep, voffA); PG8_STAGE(PG8_SB(1, 1), cB + hstep + kstep, voffB);
    PG8_WAIT_V(6); PG8_BAR;
    PG8_STAMP();
    for (;;) {
        const bool has_next = S.next(ui + 1, nxt);
        const char* nA = has_next ? (const char*)g.A + (size_t)nxt.pm * tstep : cA; const char* nB = has_next ? (const char*)g.Bt + (size_t)nxt.pn * tstep : cB;
        for (int t = 0; t < nt; t += 2) {
            if (Mid::AT >= 0 && t == Mid::AT) MH(acc, cur, wr, wc, fr, fq);
            const bool last = (t == nt - 2);
            const char* a1 = cA + (size_t)(t + 1) * kstep;
            const char* a2 = last ? nA : cA + (size_t)(t + 2) * kstep; const char* b2 = last ? nB : cB + (size_t)(t + 2) * kstep;
            const char* a3 = a2 + kstep; const char* b3 = b2 + kstep;
            if (last && has_next) S.a_ready(nxt);
            PG8_LDB(B0, 0, 0); PG8_SCHED; PG8_LDA(At, 0, 0); PG8_STAGE(PG8_SA(1, 1), a1 + hstep, voffA);
            PG8_WAIT_L(8); PG8_BAR; PG8_WAIT_L(0); PG8_MMA(0, 0, At, B0); PG8_BAR; PG8_SCHED;
            PG8_LDB(B1, 0, 1); PG8_STAGE(PG8_SB(0, 0), b2, voffB);
            PG8_BAR; PG8_WAIT_L(0); PG8_MMA(0, 1, At, B1); PG8_BAR;
            PG8_LDA(At, 0, 1); PG8_STAGE(PG8_SA(0, 0), a2, voffA);
            PG8_BAR; PG8_WAIT_L(0); PG8_MMA(1, 0, At, B0); PG8_BAR; PG8_SCHED;
            PG8_STAGE(PG8_SB(0, 1), b2 + hstep, voffB);
            PG8_WAIT_V(6); PG8_BAR; PG8_MMA(1, 1, At, B1); PG8_BAR;
            PG8_LDB(B0, 1, 0); PG8_SCHED; PG8_LDA(At, 1, 0); PG8_STAGE(PG8_SA(0, 1), a2 + hstep, voffA);
            PG8_WAIT_L(8); PG8_BAR; PG8_WAIT_L(0); PG8_MMA(0, 0, At, B0); PG8_BAR; PG8_SCHED;
            PG8_LDB(B1, 1, 1); PG8_STAGE(PG8_SB(1, 0), b3, voffB);
            PG8_BAR; PG8_WAIT_L(0); PG8_MMA(0, 1, At, B1); PG8_BAR;
            PG8_LDA(At, 1, 1); PG8_STAGE(PG8_SA(1, 0), a3, voffA);
            PG8_BAR; PG8_WAIT_L(0); PG8_MMA(1, 0, At, B0); PG8_BAR; PG8_SCHED;
            PG8_STAGE(PG8_SB(1, 1), b3 + hstep, voffB);
            PG8_WAIT_V(6); PG8_BAR; PG8_MMA(1, 1, At, B1); PG8_BAR;
        }
        PG8_STAMP();
        if constexpr (!Epi::AFTER_DRAIN) { E(acc, cur, wr, wc, fr, fq); S.done(cur); }
        PG8_STAMP();
        if (!has_next) break;
#pragma unroll
        for (int a = 0; a < 2; ++a)
#pragma unroll
            for (int b = 0; b < 2; ++b)
#pragma unroll
                for (int m = 0; m < 4; ++m)
#pragma unroll
                    for (int n = 0; n < 2; ++n) acc[a][b][m][n] = (f32x4){0.f, 0.f, 0.f, 0.f};
        cur = nxt; cA = nA; cB = nB; ++ui;
    }
    PG8_WAIT_V(0);
    if (wr == 0) PG8_BAR;
    PG8_BAR;
    if constexpr (Epi::AFTER_DRAIN) { E.fused(acc, cur, wr, wc, fr, fq, lds, wid, lane); S.done(cur); }
    PG8_STAMP();
    if (STAMP && wid == 0) { stamps[lane] = lane < nts ? (((unsigned long long)(unsigned)ts_hi << 32) | (unsigned)ts_lo) : 0ull;
        if (lane == 62) stamps[62] = rt_entry; if (lane == 63) stamps[63] = (unsigned long long)wall_clock64(); }
#undef PG8_STAMP
#undef PG8_SA
#undef PG8_SB
#undef PG8_STAGE
#undef PG8_LDA
#undef PG8_LDB
#undef PG8_MMA
#undef PG8_WAIT_V
#undef PG8_WAIT_L
#undef PG8_BAR
#undef PG8_SCHED
}
}

constexpr int G_STAGE = 49152, G_BOFF = 32768;
template <bool NTB, int K>
__device__ __forceinline__ void gemm_mainloop(f32x4 (&acc)[8][2], const bf16_t* const (&arow)[4], const float* bptr, const int ldb, const Ctx& c) {
    const int lane = c.lane, wid = c.wid;
    constexpr int nt = K >> 6;
    const int half = lane & 1, nq = ((lane >> 1) & 7) | ((lane >> 4) << 3);
    int b_wr[4];
#pragma unroll
    for (int j = 0; j < 4; ++j) { const int n = 4 * nq + j; b_wr[j] = G_BOFF + n * 128 + ((wid ^ ((n >> 1) & 7)) << 4) + half * 8; }
    const int a_wr = wid * 4096 + lane * 16;
    const int fr = c.fr, fq = c.fq;
    int a_rd[2], b_rd[2][2];
#pragma unroll
    for (int kb = 0; kb < 2; ++kb) {
        a_rd[kb] = (128 * c.wr + fr) * 128 + ((((4 * kb + fq) ^ (fr & 7))) << 4);
#pragma unroll
        for (int ni = 0; ni < 2; ++ni) { const int n = 32 * c.wc + 16 * ni + fr; b_rd[kb][ni] = G_BOFF + n * 128 + (((4 * kb + fq) ^ ((n >> 1) & 7)) << 4); }
    }
    u32x4 ra[4]; f32x4 rb0[4], rb1[4];
    bf16x8 A0[8], A1[8], B0[2], B1[2];
#define G_LOADA(T) do { _Pragma("unroll") for (int i = 0; i < 4; ++i) ra[i] = *(const u32x4*)(arow[i] + (T) * 64); } while (0)
#define G_LOADB(RB, T) do { _Pragma("unroll") for (int i = 0; i < 4; ++i) { \
        if (NTB) RB[i] = __builtin_nontemporal_load((const f32x4*)(bptr + (size_t)((T) * 64 + i) * ldb)); else RB[i] = *(const f32x4*)(bptr + (size_t)((T) * 64 + i) * ldb); } } while (0)
#define G_WRITE(ST, RB) do { _Pragma("unroll") for (int i = 0; i < 4; ++i) *(LAS u32x4*)((ST) + a_wr + i * 1024) = ra[i]; \
        _Pragma("unroll") for (int j = 0; j < 4; ++j) { u32x2 w; w.x = pack_bf16(RB[0][j], RB[1][j]); w.y = pack_bf16(RB[2][j], RB[3][j]); *(LAS u32x2*)((ST) + b_wr[j]) = w; } } while (0)
#define G_LDF(ST, kb, AF, BF) do { _Pragma("unroll") for (int ni = 0; ni < 2; ++ni) BF[ni] = *(const LAS bf16x8*)((ST) + b_rd[kb][ni]); \
        _Pragma("unroll") for (int mi = 0; mi < 8; ++mi) AF[mi] = *(const LAS bf16x8*)((ST) + a_rd[kb] + mi * 2048); } while (0)
#define G_MMA(AF, BF) do { _Pragma("unroll") for (int mi = 0; mi < 8; ++mi) _Pragma("unroll") for (int ni = 0; ni < 2; ++ni) \
        acc[mi][ni] = __builtin_amdgcn_mfma_f32_16x16x32_bf16(BF[ni], AF[mi], acc[mi][ni], 0, 0, 0); } while (0)
#define G_SB __builtin_amdgcn_sched_barrier(0)
    LAS unsigned char* st0 = c.lds; LAS unsigned char* st1 = c.lds + G_STAGE;
    constexpr int tl = nt - 1;
    G_LOADA(0); G_LOADB(rb0, 0); G_LOADB(rb1, 1);
    G_WRITE(st0, rb0);
    G_LOADA(1); G_LOADB(rb0, 2);
    __syncthreads();
#pragma unroll 1
    for (int t = 0; t < nt; t += 2) {
        const int t2 = (t + 2 < tl) ? t + 2 : tl, t3 = (t + 3 < tl) ? t + 3 : tl, t4 = (t + 4 < tl) ? t + 4 : tl;
        G_LDF(st0, 0, A0, B0); G_LDF(st0, 1, A1, B1); G_SB;
        G_MMA(A0, B0); G_SB;
        G_WRITE(st1, rb1); G_SB;
        G_MMA(A1, B1); G_SB;
        G_LOADA(t2); G_LOADB(rb1, t3);
        __syncthreads();
        G_LDF(st1, 0, A0, B0); G_LDF(st1, 1, A1, B1); G_SB;
        G_MMA(A0, B0); G_SB;
        G_WRITE(st0, rb0); G_SB;
        G_MMA(A1, B1); G_SB;
        G_LOADA(t3); G_LOADB(rb0, t4);
        __syncthreads();
    }
#undef G_LOADA
#undef G_LOADB
#undef G_WRITE
#undef G_LDF
#undef G_MMA
#undef G_SB
}
constexpr int W_STAGE = 65536, W_BOFF = 32768;
__device__ __forceinline__ int swzb(int n) { return ((n >> 2) & 1) | ((((n >> 1) ^ (n >> 3)) & 1) << 1) | ((((n >> 2) ^ (n >> 4)) & 1) << 2); }
template <int K>
__device__ __forceinline__ void gemm_mainloop256(f32x4 (&acc)[8][4], f32x4 (&rb)[8], const bf16_t* abase, const int (&aoff)[4], const float* bptr, const int ldb, const int nrows, const Ctx& c,
                                                 const bool staged, const int (&aoffn)[4], const float* bptrn, const int nrows_n, const bool hn) {
    const int lane = c.lane, wid = c.wid;
    constexpr int nt = K >> 6;
    int b_wr[2];
#pragma unroll
    for (int jh = 0; jh < 2; ++jh) { const int n = 4 * lane + 2 * jh; b_wr[jh] = W_BOFF + n * 128 + ((wid ^ swzb(n)) << 4); }
    const int a_dma = wid * 4096;
    const int fr = c.fr, fq = c.fq;
    int a_rd[2], b_rd[2][2];
#pragma unroll
    for (int kb = 0; kb < 2; ++kb) {
        a_rd[kb] = (128 * c.wr + fr) * 128 + ((((4 * kb + fq) ^ (fr & 7))) << 4);
#pragma unroll
        for (int ni = 0; ni < 2; ++ni) { const int n = 64 * c.wc + 16 * ni + fr; b_rd[kb][ni] = W_BOFF + n * 128 + (((4 * kb + fq) ^ swzb(n)) << 4); }
    }
    const int nfr = __builtin_amdgcn_readfirstlane(max(0, min(8, (nrows - 128 * c.wr + 15) >> 4)));
    const int npc = __builtin_amdgcn_readfirstlane(max(0, min(4, (nrows - 32 * wid + 7) >> 3)));
    const int npcn = __builtin_amdgcn_readfirstlane(max(0, min(4, (nrows_n - 32 * wid + 7) >> 3)));
    const int n1a = hn ? 64 : 0;
    const size_t n1b = hn ? (size_t)64 * ldb : 0;
#define W_FA(ST, T, NT1) do { const bool nx = ((T) >= nt); const int np = nx ? npcn : npc; \
        _Pragma("unroll") for (int i = 0; i < 4; ++i) if (i < np) \
            __builtin_amdgcn_global_load_lds((const unsigned*)(abase + (nx ? aoffn[i] + ((NT1) ? n1a : 0) : aoff[i] + (T) * 64)), (LAS unsigned*)((ST) + a_dma + i * 1024), 16, 0, 0); } while (0)
#define W_FB(T, NT1) do { const bool nx = ((T) >= nt); \
        const float* bq = nx ? bptrn + ((NT1) ? n1b : 0) : bptr + (size_t)((T) * 64) * ldb; \
        _Pragma("unroll") for (int i = 0; i < 8; ++i) rb[i] = *(const f32x4*)(bq + (size_t)i * ldb); } while (0)
#define W_CVT() do { _Pragma("unroll") for (int j = 0; j < 4; ++j) { wv[j].x = pack_bf16(rb[0][j], rb[1][j]); wv[j].y = pack_bf16(rb[2][j], rb[3][j]); \
            wv[j].z = pack_bf16(rb[4][j], rb[5][j]); wv[j].w = pack_bf16(rb[6][j], rb[7][j]); } } while (0)
#define W_ST(ST) do { _Pragma("unroll") for (int j = 0; j < 4; ++j) *(LAS u32x4*)((ST) + b_wr[j >> 1] + (j & 1) * 128) = wv[j]; } while (0)
#define W_SB __builtin_amdgcn_sched_barrier(0)
#define W_DSR(dst, addr, off) asm volatile("ds_read_b128 %0, %1 offset:%2" : "=v"(dst) : "v"(addr), "i"(off))
#define W_COMPUTE(ST) do { const unsigned stb = (unsigned)(unsigned long)(ST); \
    _Pragma("unroll") for (int kb = 0; kb < 2; ++kb) { bf16x8 bf0, bf1, bf2, bf3, afc, afn; \
        const unsigned ba0 = stb + b_rd[kb][0], ba1 = stb + b_rd[kb][1], aa = stb + a_rd[kb]; \
        W_DSR(bf0, ba0, 0); W_DSR(bf1, ba1, 0); W_DSR(bf2, ba0, 4096); W_DSR(bf3, ba1, 4096); W_DSR(afc, aa, 0); \
        _Pragma("unroll") for (int mi = 0; mi < 8; ++mi) { \
            if (mi < 7) { W_DSR(afn, aa, (mi + 1) * 2048); } \
            if (mi == 0) asm volatile("s_waitcnt lgkmcnt(1)" : "+v"(afc), "+v"(bf0), "+v"(bf1), "+v"(bf2), "+v"(bf3)); \
            else if (mi < 7) asm volatile("s_waitcnt lgkmcnt(1)" : "+v"(afc)); \
            else asm volatile("s_waitcnt lgkmcnt(0)" : "+v"(afc)); \
            if (mi < nfr) { \
                acc[mi][0] = __builtin_amdgcn_mfma_f32_16x16x32_bf16(bf0, afc, acc[mi][0], 0, 0, 0); acc[mi][1] = __builtin_amdgcn_mfma_f32_16x16x32_bf16(bf1, afc, acc[mi][1], 0, 0, 0); \
                acc[mi][2] = __builtin_amdgcn_mfma_f32_16x16x32_bf16(bf2, afc, acc[mi][2], 0, 0, 0); acc[mi][3] = __builtin_amdgcn_mfma_f32_16x16x32_bf16(bf3, afc, acc[mi][3], 0, 0, 0); } \
            afc = afn; } } } while (0)
    LAS unsigned char* st0 = c.lds; LAS unsigned char* st1 = c.lds + W_STAGE;
    u32x4 wv[4];
    if (!staged) {
        W_FA(st0, 0, 0); W_FB(0, 0);
        W_CVT(); W_SB; W_FB(1, 0); W_SB; W_ST(st0);
        asm volatile("s_waitcnt vmcnt(8)" ::: "memory");
        __syncthreads();
        W_FA(st1, 1, 0);
    }
#pragma unroll 1
    for (int t = 0; t < nt; t += 2) {
        W_COMPUTE(st0);
        W_CVT(); W_SB; W_FB(t + 2, 0); W_SB; W_ST(st1);
        asm volatile("s_waitcnt vmcnt(8)" ::: "memory");
        __syncthreads();
        W_FA(st0, t + 2, 0);
        W_COMPUTE(st1);
        W_CVT(); W_SB; W_FB(t + 3, 1); W_SB; W_ST(st0);
        asm volatile("s_waitcnt vmcnt(8)" ::: "memory");
        __syncthreads();
        W_FA(st1, t + 3, 1);
    }
#undef W_FA
#undef W_FB
#undef W_CVT
#undef W_ST
#undef W_SB
#undef W_COMPUTE
#undef W_DSR
}
__device__ __forceinline__ int a_piece_row(const Ctx& c, int i) { return 32 * c.wid + 8 * i + (c.lane >> 3); }
__device__ __forceinline__ int a_piece_col(const Ctx& c) { return 8 * ((c.lane & 7) ^ ((c.lane >> 3) & 7)); }
__device__ __forceinline__ void zero_acc(f32x4 (&acc)[8][2]) {
#pragma unroll
    for (int mi = 0; mi < 8; ++mi)
#pragma unroll
        for (int ni = 0; ni < 2; ++ni) acc[mi][ni] = (f32x4){0.f, 0.f, 0.f, 0.f};
}
__device__ __forceinline__ int b_nq(const Ctx& c) { return ((c.lane >> 1) & 7) | ((c.lane >> 4) << 3); }
__device__ __forceinline__ int b_k0(const Ctx& c) { return 8 * c.wid + 4 * (c.lane & 1); }

__device__ __forceinline__ void phase_mod(const Params& p, const Ctx& c) {
    const float* cc = p.in[1]; const float* w_ada = p.in[3]; const float* b_ada = p.in[4];
    float* mod = (float*)(p.ws + WS_MOD);
    LAS float* sc = (LAS float*)c.lds;
    LAS float* red = (LAS float*)(c.lds + 32768);
    for (int i = c.tid; i < NB * D; i += 512) { const float v = cc[i]; sc[i] = v / (1.0f + __expf(-v)); }
    __syncthreads();
    const int cq = c.tid % 12, kl = c.tid / 12;
    for (int item = c.bid; item < 256; item += c.nblk) {
        float acc[4][4];
#pragma unroll
        for (int b = 0; b < 4; ++b)
#pragma unroll
            for (int j = 0; j < 4; ++j) acc[b][j] = 0.f;
        if (kl < 42) {
            const float* wp = w_ada + item * 48 + cq * 4;
            for (int k = kl; k < D; k += 42) {
                const f32x4 w = *(const f32x4*)(wp + (size_t)k * NMOD);
#pragma unroll
                for (int b = 0; b < 4; ++b) { const float s = sc[b * D + k];
#pragma unroll
                    for (int j = 0; j < 4; ++j) acc[b][j] += s * w[j]; }
            }
#pragma unroll
            for (int b = 0; b < 4; ++b)
#pragma unroll
                for (int j = 0; j < 4; ++j) red[(kl * 12 + cq) * 16 + b * 4 + j] = acc[b][j];
        }
        __syncthreads();
        if (c.tid < 192) {
            const int b = c.tid / 48, col = c.tid % 48;
            float s = 0.f;
            for (int k2 = 0; k2 < 42; ++k2) s += red[(k2 * 12 + (col >> 2)) * 16 + b * 4 + (col & 3)];
            mod[b * NMOD + item * 48 + col] = s + b_ada[item * 48 + col];
        }
        __syncthreads();
    }
}

__device__ __forceinline__ void convert_tile(const float* W, int K, int N, bf16_t* Wt, int kt, int ntile, const Ctx& c, int ldt = 0, int koff = 0) {
    if (ldt == 0) ldt = K;
    const int half = c.lane & 1, nq = b_nq(c);
    const float* src = W + (size_t)(kt * 64 + 8 * c.wid + 4 * half) * N + ntile * 128 + 4 * nq;
    f32x4 rb_[4];
#pragma unroll
    for (int i = 0; i < 4; ++i) rb_[i] = *(const f32x4*)(src + (size_t)i * N);
    const int wo = (4 * nq) * 128 + ((c.wid ^ (nq & 7)) << 4) + half * 8;
#pragma unroll
    for (int j = 0; j < 4; ++j) { u32x2 w; w.x = pack_bf16(rb_[0][j], rb_[1][j]); w.y = pack_bf16(rb_[2][j], rb_[3][j]); *(LAS u32x2*)(c.lds + wo + j * 128) = w; }
    __syncthreads();
#pragma unroll
    for (int i = 0; i < 2; ++i) {
        const int idx = c.tid + 512 * i, n = idx >> 3, ch = idx & 7;
        const u32x4 v = *(const LAS u32x4*)(c.lds + n * 128 + ((ch ^ ((n >> 2) & 7)) << 4));
        *(u32x4*)(Wt + (size_t)(ntile * 128 + n) * ldt + koff + kt * 64 + ch * 8) = v;
    }
    __syncthreads();
}
__device__ __forceinline__ void phase_convert(const Params& p, const Ctx& c) {
    for (int t = c.bid; t < 3584; t += c.nblk) {
        if (t < 2560) convert_tile(p.in[6], D, INC, (bf16_t*)(p.ws + WS_WIN_T), t & 31, t >> 5, c);
        else if (t < 2816) { const int u = t - 2560; convert_tile(p.in[12], 1024, D, (bf16_t*)(p.ws + WS_WPA_T), u & 15, u >> 4, c, D, 0); }
        else if (t < 3072) { const int u = t - 2816; convert_tile(p.in[13], 1024, D, (bf16_t*)(p.ws + WS_WPA_T), u & 15, u >> 4, c, D, 1024); }
        else { const int u = t - 3072; convert_tile(p.in[14], D, D, (bf16_t*)(p.ws + WS_WOUT_T), u & 31, u >> 5, c); }
    }
}

__device__ __forceinline__ void phase_norm1(const Params& p, const Ctx& c) {
    const float* x = p.in[0]; const float* g = p.in[5];
    const float* mod = (const float*)(p.ws + WS_MOD);
    bf16_t* h = (bf16_t*)(p.ws + WS_H);
    for (int row = c.bid * 8 + c.wid; row < NTOK; row += c.nblk * 8) {
        const int b = row >> 11;
        f32x4 v[8]; float ss = 0.f;
#pragma unroll
        for (int i = 0; i < 8; ++i) { v[i] = *(const f32x4*)(x + (size_t)row * D + i * 256 + c.lane * 4); ss += v[i][0] * v[i][0] + v[i][1] * v[i][1] + v[i][2] * v[i][2] + v[i][3] * v[i][3]; }
        ss = wave_sum(ss);
        const float rstd = rsqrtf(ss * (1.0f / D) + EPS);
#pragma unroll
        for (int i = 0; i < 8; ++i) {
            const int col = i * 256 + c.lane * 4;
            const f32x4 gg = *(const f32x4*)(g + col), sh = *(const f32x4*)(mod + b * NMOD + col), scl = *(const f32x4*)(mod + b * NMOD + D + col);
            float o[4];
#pragma unroll
            for (int j = 0; j < 4; ++j) o[j] = (v[i][j] * rstd * gg[j]) * (1.0f + scl[j]) + sh[j];
            u32x2 w; w.x = pack_bf16(o[0], o[1]); w.y = pack_bf16(o[2], o[3]);
            *(u32x2*)(h + (size_t)row * D + col) = w;
        }
    }
}

__device__ __forceinline__ void phase_router_prep(const Params& p, const Ctx& c) {
    const float* mod = (const float*)(p.ws + WS_MOD); const float* g = p.in[15];
    const float* w_rg = p.in[16]; const float* b_rg = p.in[17]; const float* w_re = p.in[18]; const float* b_re = p.in[19];
    bf16_t* WtH = (bf16_t*)(p.ws + WS_RW); bf16_t* WtL = WtH + (size_t)NB * 80 * D; float* cb = (float*)(p.ws + WS_RC);
    for (int task = c.bid * 8 + c.wid; task < NB * 80; task += c.nblk * 8) {
        const int b = task / 80, j = task % 80;
        float cs = 0.f;
        for (int k = c.lane; k < D; k += 64) {
            float w = 0.f;
            if (j < 8) w = w_rg[(size_t)k * 8 + j]; else if (j < 72) w = w_re[(size_t)k * 64 + (j - 8)];
            const float wv = g[k] * (1.0f + mod[b * NMOD + 4 * D + k]) * w;
            const unsigned hi = pack_bf16(wv, 0.f) & 0xffffu; const float hif = __uint_as_float(hi << 16);
            WtH[((size_t)b * 80 + j) * D + k] = (bf16_t)hi; WtL[((size_t)b * 80 + j) * D + k] = (bf16_t)(pack_bf16(wv - hif, 0.f) & 0xffffu);
            cs += mod[b * NMOD + 3 * D + k] * w;
        }
        cs = wave_sum(cs);
        if (c.lane == 0) cb[b * 80 + j] = cs + (j < 8 ? b_rg[j] : (j < 72 ? b_re[j - 8] : 0.f));
    }
}

__device__ __forceinline__ void phase_proj_in(const Params& p, const Ctx& c) {
    const bf16_t* h = (const bf16_t*)(p.ws + WS_H); const float* w_in = p.in[6];
    for (int item = c.bid; item < 32 * 80; item += c.nblk) {
        const int mt = item & 31, ntile = item >> 5;
        const int m0 = mt * 256, n0 = ntile * 128;
        const bf16_t* arow[4];
#pragma unroll
        for (int i = 0; i < 4; ++i) arow[i] = h + (size_t)(m0 + a_piece_row(c, i)) * D + a_piece_col(c);
        const float* bptr = w_in + (size_t)b_k0(c) * INC + n0 + 4 * b_nq(c);
        f32x4 acc[8][2]; zero_acc(acc);
        gemm_mainloop<false, D>(acc, arow, bptr, INC, c);
        const int region = n0 >> 10;
#pragma unroll
        for (int mi = 0; mi < 8; ++mi)
#pragma unroll
            for (int ni = 0; ni < 2; ++ni) {
                const int row = m0 + 128 * c.wr + 16 * mi + c.fr;
                const int col = n0 + 32 * c.wc + 16 * ni + 4 * c.fq;
                const f32x4 a = acc[mi][ni];
                if (region < 6) {
                    const int cin = col & 1023;
                    if (region == 2 || region == 5) {
                        bf16_t* vt = (bf16_t*)(p.ws + (region == 2 ? WS_VAT : WS_VBT));
                        const int b = row >> 11, s = row & 2047, hh = cin >> 7, d = cin & 127;
                        const unsigned w0 = pack_bf16(a[0], a[1]), w1 = pack_bf16(a[2], a[3]);
                        bf16_t* base = vt + ((size_t)((b * 8 + hh) * 128 + d)) * SEQ + s;
                        base[0] = (bf16_t)(w0 & 0xffff); base[SEQ] = (bf16_t)(w0 >> 16); base[2 * SEQ] = (bf16_t)(w1 & 0xffff); base[3 * SEQ] = (bf16_t)(w1 >> 16);
                    } else {
                        const size_t off = region == 0 ? WS_QA : region == 1 ? WS_KA : region == 3 ? WS_QB : WS_KB;
                        bf16_t* dst = (bf16_t*)(p.ws + off);
                        u32x2 w; w.x = pack_bf16(a[0], a[1]); w.y = pack_bf16(a[2], a[3]);
                        *(u32x2*)(dst + (size_t)row * 1024 + cin) = w;
                    }
                } else {
                    bf16_t* dst = (bf16_t*)(p.ws + (region < 8 ? WS_GA : WS_GB));
                    const int cin = col - (region < 8 ? 6144 : 8192);
                    u32x2 w; w.x = pack_bf16(sigmoidf_(a[0]), sigmoidf_(a[1])); w.y = pack_bf16(sigmoidf_(a[2]), sigmoidf_(a[3]));
                    *(u32x2*)(dst + (size_t)row * D + cin) = w;
                }
            }
    }
}

constexpr int AT_STAGE = 32768, AT_VOFF = 16384, AT_BIAS = 98304;
__device__ __forceinline__ int rel_bucket_dev(int n) {
    if (n < 16) return n;
    int b = 16;
    b += (n >= 19) + (n >= 21) + (n >= 24) + (n >= 27) + (n >= 31) + (n >= 35) + (n >= 40) + (n >= 46) + (n >= 52) + (n >= 59) + (n >= 67) + (n >= 77) + (n >= 87) + (n >= 99) + (n >= 113);
    return b;
}
struct KVRegs { u32x4 k[2], v[2]; };
__device__ __forceinline__ void kv_load(KVRegs& r, const bf16_t* kbase, const bf16_t* vtbase, int kt, const Ctx& c) {
#pragma unroll
    for (int i = 0; i < 2; ++i) {
        const int key = (c.tid >> 4) + 32 * i, ck = c.tid & 15;
        r.k[i] = *(const u32x4*)(kbase + (size_t)(kt * 64 + key) * 1024 + ck * 8);
        const int d = (c.tid >> 3) + 64 * i, cv = c.tid & 7;
        r.v[i] = *(const u32x4*)(vtbase + (size_t)d * SEQ + kt * 64 + cv * 8);
    }
}
__device__ __forceinline__ void kv_store(const KVRegs& r, LAS unsigned char* st, const Ctx& c) {
#pragma unroll
    for (int i = 0; i < 2; ++i) {
        const int key = (c.tid >> 4) + 32 * i, ck = c.tid & 15;
        *(LAS u32x4*)(st + key * 256 + ((ck ^ (key & 15)) << 4)) = r.k[i];
        const int d = (c.tid >> 3) + 64 * i, cv = c.tid & 7;
        *(LAS u32x4*)(st + AT_VOFF + d * 128 + ((cv ^ ((d >> 1) & 7)) << 4)) = r.v[i];
    }
}
__device__ __forceinline__ bf16x8 v_frag(LAS unsigned char* st, int nf, int kb2, const Ctx& c) {
    const int d = 16 * nf + c.fr; const int sw = (c.fr >> 1) & 7;
    return *(const LAS bf16x8*)(st + AT_VOFF + d * 128 + (((4 * kb2 + c.fq) ^ sw) << 4));
}
__device__ __forceinline__ bf16x8 pack_p(const f32x4& a, const f32x4& b) {
    u32x4 w; w.x = pack_bf16(a[0], a[1]); w.y = pack_bf16(a[2], a[3]); w.z = pack_bf16(b[0], b[1]); w.w = pack_bf16(b[2], b[3]);
    return __builtin_bit_cast(bf16x8, w);
}

__device__ __forceinline__ void diff_attn_item(const Params& p, const Ctx& c, int b, int h, int qb, float lam, bf16x8 (&qf)[4], KVRegs& kr,
                                               const bf16_t* qn, const bf16_t* kbn, const bf16_t* vtn, const int ktn) {
    const bf16_t* ka = (const bf16_t*)(p.ws + WS_KA); const bf16_t* vat = (const bf16_t*)(p.ws + WS_VAT);
    bf16_t* oa = (bf16_t*)(p.ws + WS_OA);
    const float* rel = p.in[2]; const float* gsub = p.in[11];
    LAS float* bias = (LAS float*)(c.lds + AT_BIAS);
    __syncthreads();
    if (c.tid < 128) bias[c.tid] = rel[rel_bucket_dev(c.tid) * 8 + h] * 1.4426950408889634f;
    const int qpos = 128 * qb + 16 * c.wid + c.fr;
    const size_t qtok = (size_t)b * SEQ + qpos;
    const bf16_t* kbase = ka + (size_t)b * SEQ * 1024 + h * 128;
    const bf16_t* vtbase = vat + (size_t)((b * 8 + h) * 128) * SEQ;
    f32x4 O1[8], O2[8];
#pragma unroll
    for (int nf = 0; nf < 8; ++nf) { O1[nf] = (f32x4){0.f, 0.f, 0.f, 0.f}; O2[nf] = (f32x4){0.f, 0.f, 0.f, 0.f}; }
    float m1 = -1e30f, m2 = -1e30f, l1 = 0.f, l2 = 0.f;
    const int ntiles = 2 * qb + 2;
    const int qmax_w = 128 * qb + 16 * c.wid + 15, qmin_w = 128 * qb + 16 * c.wid;
    const float L2E = 1.4426950408889634f;
    const bool defer = c.wid >= 4;
    bf16x8 pq1[2], pq2[2]; bool pend = false;
#pragma unroll
    for (int kb2 = 0; kb2 < 2; ++kb2) { pq1[kb2] = (bf16x8){0, 0, 0, 0, 0, 0, 0, 0}; pq2[kb2] = pq1[kb2]; }
    int sidx = 0, sprev = 2;
    for (int kt = 0; kt < ntiles; ++kt) {
        LAS unsigned char* st = c.lds + sidx * AT_STAGE;
        kv_store(kr, st, c);
        { const bool last = (kt + 1 >= ntiles);
          kv_load(kr, last ? kbn : kbase, last ? vtn : vtbase, last ? ktn : kt + 1, c); }
        __syncthreads();
        if (pend) {
            LAS unsigned char* sp = c.lds + sprev * AT_STAGE;
#pragma unroll
            for (int kb2 = 0; kb2 < 2; ++kb2)
#pragma unroll
                for (int nf = 0; nf < 8; ++nf) {
                    const bf16x8 vf = v_frag(sp, nf, kb2, c);
                    O1[nf] = __builtin_amdgcn_mfma_f32_16x16x32_bf16(vf, pq1[kb2], O1[nf], 0, 0, 0);
                    O2[nf] = __builtin_amdgcn_mfma_f32_16x16x32_bf16(vf, pq2[kb2], O2[nf], 0, 0, 0);
                }
            pend = false;
        }
        if (64 * kt <= qmax_w) {
            f32x4 s1[4], s2[4];
#pragma unroll
            for (int f = 0; f < 4; ++f) {
                bf16x8 kf[4];
#pragma unroll
                for (int kb = 0; kb < 4; ++kb) kf[kb] = *(const LAS bf16x8*)(st + (16 * f + c.fr) * 256 + (((4 * kb + c.fq) ^ c.fr) << 4));
                f32x4 z = (f32x4){0.f, 0.f, 0.f, 0.f};
                z = __builtin_amdgcn_mfma_f32_16x16x32_bf16(kf[0], qf[0], z, 0, 0, 0);
                s1[f] = __builtin_amdgcn_mfma_f32_16x16x32_bf16(kf[1], qf[1], z, 0, 0, 0);
                z = (f32x4){0.f, 0.f, 0.f, 0.f};
                z = __builtin_amdgcn_mfma_f32_16x16x32_bf16(kf[2], qf[2], z, 0, 0, 0);
                s2[f] = __builtin_amdgcn_mfma_f32_16x16x32_bf16(kf[3], qf[3], z, 0, 0, 0);
            }
            const bool nearb = (qmin_w - (64 * kt + 63)) < 113;
            const float CS = 0.125f * L2E, THR = 8.0f;
            float mx1, mx2;
            if (!nearb) {
                const float bf_ = bias[127];
                float r1 = s1[0][0], r2 = s2[0][0];
#pragma unroll
                for (int f = 0; f < 4; ++f)
#pragma unroll
                    for (int r = 0; r < 4; ++r) { r1 = fmaxf(r1, s1[f][r]); r2 = fmaxf(r2, s2[f][r]); }
                mx1 = r1 * CS + bf_; mx2 = r2 * CS + bf_;
            } else {
                mx1 = -1e30f; mx2 = -1e30f;
#pragma unroll
                for (int f = 0; f < 4; ++f)
#pragma unroll
                    for (int r = 0; r < 4; ++r) {
                        const int n = qpos - (64 * kt + 16 * f + 4 * c.fq + r);
                        const float bv = bias[n < 0 ? 0 : (n > 127 ? 127 : n)];
                        float a1 = s1[f][r] * CS + bv, a2 = s2[f][r] * CS + bv;
                        if (n < 0) { a1 = -1e30f; a2 = -1e30f; }
                        s1[f][r] = a1; s2[f][r] = a2;
                        mx1 = fmaxf(mx1, a1); mx2 = fmaxf(mx2, a2);
                    }
            }
            mx1 = xmax32(xmax16(mx1)); mx2 = xmax32(xmax16(mx2));
            if (__any((mx1 - m1 > THR) || (mx2 - m2 > THR))) {
                const float mn1 = fmaxf(m1, mx1), mn2 = fmaxf(m2, mx2);
                const float al1 = __builtin_amdgcn_exp2f(m1 - mn1), al2 = __builtin_amdgcn_exp2f(m2 - mn2);
                m1 = mn1; m2 = mn2; l1 *= al1; l2 *= al2;
#pragma unroll
                for (int nf = 0; nf < 8; ++nf) { O1[nf] *= al1; O2[nf] *= al2; }
            }
            if (!nearb) {
                const float d1 = bias[127] - m1, d2 = bias[127] - m2;
#pragma unroll
                for (int f = 0; f < 4; ++f) { s1[f] = s1[f] * CS + d1; s2[f] = s2[f] * CS + d2; }
            } else {
#pragma unroll
                for (int f = 0; f < 4; ++f) { s1[f] = s1[f] - m1; s2[f] = s2[f] - m2; }
            }
            float ps1 = 0.f, ps2 = 0.f;
#pragma unroll
            for (int f = 0; f < 4; ++f)
#pragma unroll
                for (int r = 0; r < 4; ++r) {
                    const float e1 = __builtin_amdgcn_exp2f(s1[f][r]), e2 = __builtin_amdgcn_exp2f(s2[f][r]);
                    s1[f][r] = e1; s2[f][r] = e2; ps1 += e1; ps2 += e2;
                }
            l1 += ps1; l2 += ps2;
#pragma unroll
            for (int kb2 = 0; kb2 < 2; ++kb2) { pq1[kb2] = pack_p(s1[2 * kb2], s1[2 * kb2 + 1]); pq2[kb2] = pack_p(s2[2 * kb2], s2[2 * kb2 + 1]); }
            if (defer) pend = true;
            else {
#pragma unroll
                for (int kb2 = 0; kb2 < 2; ++kb2)
#pragma unroll
                    for (int nf = 0; nf < 8; ++nf) {
                        const bf16x8 vf = v_frag(st, nf, kb2, c);
                        O1[nf] = __builtin_amdgcn_mfma_f32_16x16x32_bf16(vf, pq1[kb2], O1[nf], 0, 0, 0);
                        O2[nf] = __builtin_amdgcn_mfma_f32_16x16x32_bf16(vf, pq2[kb2], O2[nf], 0, 0, 0);
                    }
            }
        }
        sprev = sidx; sidx = (sidx == 2) ? 0 : sidx + 1;
    }
    if (pend) {
        LAS unsigned char* sp = c.lds + sprev * AT_STAGE;
#pragma unroll
        for (int kb2 = 0; kb2 < 2; ++kb2)
#pragma unroll
            for (int nf = 0; nf < 8; ++nf) {
                const bf16x8 vf = v_frag(sp, nf, kb2, c);
                O1[nf] = __builtin_amdgcn_mfma_f32_16x16x32_bf16(vf, pq1[kb2], O1[nf], 0, 0, 0);
                O2[nf] = __builtin_amdgcn_mfma_f32_16x16x32_bf16(vf, pq2[kb2], O2[nf], 0, 0, 0);
            }
    }
#pragma unroll
    for (int kb = 0; kb < 4; ++kb) qf[kb] = *(const bf16x8*)(qn + 32 * kb + 8 * c.fq);
    l1 = xsum32(xsum16(l1)); l2 = xsum32(xsum16(l2));
    const float i1 = 1.0f / l1, i2 = lam / l2;
    float ss = 0.f;
#pragma unroll
    for (int nf = 0; nf < 8; ++nf)
#pragma unroll
        for (int r = 0; r < 4; ++r) { const float o = O1[nf][r] * i1 - O2[nf][r] * i2; O1[nf][r] = o; ss += o * o; }
    ss += __shfl_xor(ss, 16); ss += __shfl_xor(ss, 32);
    const float rstd = rsqrtf(ss * (1.0f / 128.0f) + EPS) * 0.8f;
#pragma unroll
    for (int nf = 0; nf < 8; ++nf) {
        const int d = 16 * nf + 4 * c.fq;
        const f32x4 g = *(const f32x4*)(gsub + d);
        u32x2 w; w.x = pack_bf16(O1[nf][0] * rstd * g[0], O1[nf][1] * rstd * g[1]); w.y = pack_bf16(O1[nf][2] * rstd * g[2], O1[nf][3] * rstd * g[3]);
        *(u32x2*)(oa + qtok * 2048 + h * 128 + d) = w;
    }
}

__device__ __forceinline__ void sb_attn_item(const Params& p, const Ctx& c, int b, int h, int qb, bf16x8 (&qf)[4], KVRegs& kr,
                                             const bf16_t* qn, const bf16_t* kbn, const bf16_t* vtn, const int ktn) {
    const bf16_t* kbuf = (const bf16_t*)(p.ws + WS_KB); const bf16_t* vbt = (const bf16_t*)(p.ws + WS_VBT);
    bf16_t* ob = (bf16_t*)(p.ws + WS_OA) + 1024;
    __syncthreads();
    const int qpos = 128 * qb + 16 * c.wid + c.fr;
    const size_t qtok = (size_t)b * SEQ + qpos;
    const bf16_t* kbase = kbuf + (size_t)b * SEQ * 1024 + h * 128;
    const bf16_t* vtbase = vbt + (size_t)((b * 8 + h) * 128) * SEQ;
    f32x4 O[8];
#pragma unroll
    for (int nf = 0; nf < 8; ++nf) O[nf] = (f32x4){0.f, 0.f, 0.f, 0.f};
    float carry = 0.f;
    const int ntiles = 2 * qb + 2;
    const int qmax_w = 128 * qb + 16 * c.wid + 15;
    const float scale = 0.08838834764831845f * 1.4426950408889634f;
    LAS int* dflag = (LAS int*)(c.lds + AT_BIAS + 1024);
    if (c.lane == 0) dflag[c.wid] = 0;
    bool wdone = false, nxt = false;
    for (int it = 0; it < ntiles; ++it) {
        const int kt = ntiles - 1 - it;
        LAS unsigned char* st = c.lds + (it & 1) * AT_STAGE;
        kv_store(kr, st, c);
        __syncthreads();
        {
            int alld = 1;
#pragma unroll
            for (int w8 = 0; w8 < 8; ++w8) alld &= dflag[w8];
            if (alld) break;
        }
        { const bool last = (kt == 0);
          kv_load(kr, last ? kbn : kbase, last ? vtn : vtbase, last ? ktn : kt - 1, c); nxt = last; }
        if (!wdone && 64 * kt < qmax_w) {
            f32x4 z[4];
#pragma unroll
            for (int f = 0; f < 4; ++f) {
                f32x4 a = (f32x4){0.f, 0.f, 0.f, 0.f};
#pragma unroll
                for (int kb = 0; kb < 4; ++kb) {
                    const bf16x8 kf = *(const LAS bf16x8*)(st + (16 * f + c.fr) * 256 + (((4 * kb + c.fq) ^ c.fr) << 4));
                    a = __builtin_amdgcn_mfma_f32_16x16x32_bf16(kf, qf[kb], a, 0, 0, 0);
                }
                z[f] = a;
            }
            f32x4 lb[4], lk[4]; float T[4];
#pragma unroll
            for (int f = 0; f < 4; ++f) {
                float t = 0.f;
#pragma unroll
                for (int r = 0; r < 4; ++r) {
                    const int kpos = 64 * kt + 16 * f + 4 * c.fq + r;
                    const float zz = z[f][r] * scale;
                    const float sp = __builtin_amdgcn_logf(1.0f + __builtin_amdgcn_exp2f(-fabsf(zz)));
                    const float lbv = fminf(zz, 0.f) - sp;
                    const bool valid = kpos < qpos;
                    const float lkv = valid ? (lbv - zz) : 0.f;
                    lb[f][r] = valid ? lbv : -1e30f; lk[f][r] = lkv; t += lkv;
                }
                T[f] = t;
            }
            float tile_tot = 0.f; float Gl[4], Ft[4];
#pragma unroll
            for (int f = 0; f < 4; ++f) {
                const float A1 = __shfl_xor(T[f], 16), A2 = __shfl_xor(T[f], 32), A3 = __shfl_xor(T[f], 48);
                Gl[f] = ((c.fq & 1) == 0 ? A1 : 0.f) + ((c.fq & 2) == 0 ? (A2 + A3) : 0.f);
                Ft[f] = T[f] + A1 + A2 + A3; tile_tot += Ft[f];
            }
            float after = carry;
#pragma unroll
            for (int f = 3; f >= 0; --f) {
                float suf = 0.f;
#pragma unroll
                for (int r = 3; r >= 0; --r) {
                    const float later = after + Gl[f] + suf;
                    z[f][r] = __builtin_amdgcn_exp2f(lb[f][r] + later);
                    suf += lk[f][r];
                }
                after += Ft[f];
            }
            carry += tile_tot;
#pragma unroll
            for (int kb2 = 0; kb2 < 2; ++kb2) {
                const bf16x8 pp = pack_p(z[2 * kb2], z[2 * kb2 + 1]);
#pragma unroll
                for (int nf = 0; nf < 8; ++nf) {
                    const bf16x8 vf = v_frag(st, nf, kb2, c);
                    O[nf] = __builtin_amdgcn_mfma_f32_16x16x32_bf16(vf, pp, O[nf], 0, 0, 0);
                }
            }
            if (__all(carry < -64.0f)) { wdone = true; if (c.lane == 0) dflag[c.wid] = 1; }
        }
    }
    if (!nxt) kv_load(kr, kbn, vtn, ktn, c);
#pragma unroll
    for (int kb = 0; kb < 4; ++kb) qf[kb] = *(const bf16x8*)(qn + 32 * kb + 8 * c.fq);
#pragma unroll
    for (int nf = 0; nf < 8; ++nf) {
        const int d = 16 * nf + 4 * c.fq;
        u32x2 w; w.x = pack_bf16(O[nf][0], O[nf][1]); w.y = pack_bf16(O[nf][2], O[nf][3]);
        *(u32x2*)(ob + qtok * 2048 + h * 128 + d) = w;
    }
}

__device__ __forceinline__ void attn_sub(const Params& p, const Ctx& c, int sub, int& kind, int& bh, int& qb, const bf16_t*& qp, const bf16_t*& kb, const bf16_t*& vt, int& kt0) {
    const int kh = sub >> 8, i2 = sub & 255, half = kh & 1, pr = i2 >> 5;
    kind = kh >> 1; bh = i2 & 31; qb = half ? pr : 15 - pr;
    const int b = bh >> 3, h = bh & 7;
    const size_t qtok = (size_t)b * SEQ + 128 * qb + 16 * c.wid + c.fr;
    qp = (const bf16_t*)(p.ws + (kind ? WS_QB : WS_QA)) + qtok * 1024 + h * 128;
    kb = (const bf16_t*)(p.ws + (kind ? WS_KB : WS_KA)) + (size_t)b * SEQ * 1024 + h * 128;
    vt = (const bf16_t*)(p.ws + (kind ? WS_VBT : WS_VAT)) + (size_t)(bh * 128) * SEQ;
    kt0 = kind ? 2 * qb + 1 : 0;
}
__device__ __forceinline__ void phase_attn(const Params& p, const Ctx& c, int qsel = 0) {
    float d1 = 0.f, d2 = 0.f;
    if (c.lane < 64) { d1 = p.in[7][c.lane] * p.in[8][c.lane]; d2 = p.in[9][c.lane] * p.in[10][c.lane]; }
    d1 = wave_sum(d1); d2 = wave_sum(d2);
    const float lam = expf(d1) - expf(d2) + 0.2f;
    (void)qsel;
    if (c.bid >= 1024) return;
    int kind, bh, qb, kt0; const bf16_t* qp; const bf16_t* kb; const bf16_t* vt;
    attn_sub(p, c, c.bid, kind, bh, qb, qp, kb, vt, kt0);
    bf16x8 qf[4]; KVRegs kr;
#pragma unroll
    for (int k4 = 0; k4 < 4; ++k4) qf[k4] = *(const bf16x8*)(qp + 32 * k4 + 8 * c.fq);
    kv_load(kr, kb, vt, kt0, c);
#pragma unroll 1
    for (int sub = c.bid; sub < 1024; sub += c.nblk) {
        int kindn, bhn, qbn, kt0n; const bf16_t* qpn; const bf16_t* kbn; const bf16_t* vtn;
        attn_sub(p, c, (sub + c.nblk < 1024) ? sub + c.nblk : sub, kindn, bhn, qbn, qpn, kbn, vtn, kt0n);
        if (kind == 0) diff_attn_item(p, c, bh >> 3, bh & 7, qb, lam, qf, kr, qpn, kbn, vtn, kt0n);
        else sb_attn_item(p, c, bh >> 3, bh & 7, qb, qf, kr, qpn, kbn, vtn, kt0n);
        kind = kindn; bh = bhn; qb = qbn;
    }
}

__device__ __forceinline__ void phase_merge(const Params& p, const Ctx& c) {
    const bf16_t* oa = (const bf16_t*)(p.ws + WS_OA); const bf16_t* ob = (const bf16_t*)(p.ws + WS_OB);
    const bf16_t* ga = (const bf16_t*)(p.ws + WS_GA); const bf16_t* gb = (const bf16_t*)(p.ws + WS_GB);
    bf16_t* mrg = (bf16_t*)(p.ws + WS_MRG);
    for (int item = c.bid; item < 32 * 16; item += c.nblk) {
        const int mt = item & 31, ntile = item >> 5;
        const int m0 = mt * 256, n0 = ntile * 128;
        f32x4 acc[8][2];
#pragma unroll 1
        for (int pass = 0; pass < 2; ++pass) {
            const bf16_t* A = pass ? ob : oa; const float* W = pass ? p.in[13] : p.in[12]; const bf16_t* G = pass ? gb : ga;
            const bf16_t* arow[4];
#pragma unroll
            for (int i = 0; i < 4; ++i) arow[i] = A + (size_t)(m0 + a_piece_row(c, i)) * 1024 + a_piece_col(c);
            const float* bptr = W + (size_t)b_k0(c) * D + n0 + 4 * b_nq(c);
            zero_acc(acc);
            gemm_mainloop<false, 1024>(acc, arow, bptr, D, c);
            float* tmp = (float*)(p.ws + WS_X1);
#pragma unroll
            for (int mi = 0; mi < 8; ++mi)
#pragma unroll
                for (int ni = 0; ni < 2; ++ni) {
                    const int row = m0 + 128 * c.wr + 16 * mi + c.fr;
                    const int col = n0 + 32 * c.wc + 16 * ni + 4 * c.fq;
                    const u32x2 gw = *(const u32x2*)(G + (size_t)row * D + col);
                    f32x4 g; g[0] = __uint_as_float(gw.x << 16); g[1] = __uint_as_float(gw.x & 0xffff0000u); g[2] = __uint_as_float(gw.y << 16); g[3] = __uint_as_float(gw.y & 0xffff0000u);
                    f32x4 v = acc[mi][ni] * g;
                    if (pass == 0) *(f32x4*)(tmp + (size_t)row * D + col) = v;
                    else {
                        v += *(const f32x4*)(tmp + (size_t)row * D + col);
                        u32x2 w; w.x = pack_bf16(v[0], v[1]); w.y = pack_bf16(v[2], v[3]);
                        *(u32x2*)(mrg + (size_t)row * D + col) = w;
                    }
                }
        }
    }
}

__device__ __forceinline__ void phase_out(const Params& p, const Ctx& c) {
    const bf16_t* mrg = (const bf16_t*)(p.ws + WS_MRG); const float* w_out = p.in[14]; const float* x = p.in[0];
    const float* mod = (const float*)(p.ws + WS_MOD);
    float* x1 = (float*)(p.ws + WS_X1);
    for (int item = c.bid; item < 32 * 16; item += c.nblk) {
        const int mt = item & 31, ntile = item >> 5;
        const int m0 = mt * 256, n0 = ntile * 128;
        const bf16_t* arow[4];
#pragma unroll
        for (int i = 0; i < 4; ++i) arow[i] = mrg + (size_t)(m0 + a_piece_row(c, i)) * D + a_piece_col(c);
        const float* bptr = w_out + (size_t)b_k0(c) * D + n0 + 4 * b_nq(c);
        f32x4 acc[8][2]; zero_acc(acc);
        gemm_mainloop<false, D>(acc, arow, bptr, D, c);
        const int b = m0 >> 11;
#pragma unroll
        for (int mi = 0; mi < 8; ++mi)
#pragma unroll
            for (int ni = 0; ni < 2; ++ni) {
                const int row = m0 + 128 * c.wr + 16 * mi + c.fr;
                const int col = n0 + 32 * c.wc + 16 * ni + 4 * c.fq;
                const f32x4 gm = *(const f32x4*)(mod + b * NMOD + 2 * D + col);
                const f32x4 xv = *(const f32x4*)(x + (size_t)row * D + col);
                *(f32x4*)(x1 + (size_t)row * D + col) = xv + gm * acc[mi][ni];
            }
    }
}

__device__ __forceinline__ void phase_norm2_route(const Params& p, const Ctx& c) {
    const float* x1 = (const float*)(p.ws + WS_X1); const float* g = p.in[15];
    const float* mod = (const float*)(p.ws + WS_MOD);
    const float* w_rg = p.in[16]; const float* b_rg = p.in[17]; const float* w_re = p.in[18]; const float* b_re = p.in[19];
    bf16_t* h2 = (bf16_t*)(p.ws + WS_H2);
    unsigned* cnt = (unsigned*)(p.ws + WS_CTL) + CW_CNT;
    int* ltok = (int*)(p.ws + WS_LTOK); float* lw = (float*)(p.ws + WS_LW);
    for (int row = c.bid * 8 + c.wid; row < NTOK; row += c.nblk * 8) {
        const int b = row >> 11;
        f32x4 v[8]; float ss = 0.f;
#pragma unroll
        for (int i = 0; i < 8; ++i) { v[i] = *(const f32x4*)(x1 + (size_t)row * D + i * 256 + c.lane * 4); ss += v[i][0] * v[i][0] + v[i][1] * v[i][1] + v[i][2] * v[i][2] + v[i][3] * v[i][3]; }
        ss = wave_sum(ss);
        const float rstd = rsqrtf(ss * (1.0f / D) + EPS);
        float gl[8];
#pragma unroll
        for (int j = 0; j < 8; ++j) gl[j] = 0.f;
#pragma unroll
        for (int i = 0; i < 8; ++i) {
            const int col = i * 256 + c.lane * 4;
            const f32x4 gg = *(const f32x4*)(g + col), sh = *(const f32x4*)(mod + b * NMOD + 3 * D + col), scl = *(const f32x4*)(mod + b * NMOD + 4 * D + col);
#pragma unroll
            for (int j = 0; j < 4; ++j) v[i][j] = (v[i][j] * rstd * gg[j]) * (1.0f + scl[j]) + sh[j];
            u32x2 w; w.x = pack_bf16(v[i][0], v[i][1]); w.y = pack_bf16(v[i][2], v[i][3]);
            *(u32x2*)(h2 + (size_t)row * D + col) = w;
#pragma unroll
            for (int j = 0; j < 4; ++j) {
                const f32x4 w0 = *(const f32x4*)(w_rg + (size_t)(col + j) * 8), w1 = *(const f32x4*)(w_rg + (size_t)(col + j) * 8 + 4);
#pragma unroll
                for (int e = 0; e < 4; ++e) { gl[e] += v[i][j] * w0[e]; gl[4 + e] += v[i][j] * w1[e]; }
            }
        }
#pragma unroll
        for (int j = 0; j < 8; ++j) gl[j] = wave_sum(gl[j]) + b_rg[j];
        int gi = 0; float gmax = gl[0];
#pragma unroll
        for (int j = 1; j < 8; ++j) if (gl[j] > gmax) { gmax = gl[j]; gi = j; }
        float gsum = 0.f;
#pragma unroll
        for (int j = 0; j < 8; ++j) gsum += __expf(gl[j] - gmax);
        const float pg = 1.0f / gsum;
        float el[8];
#pragma unroll
        for (int j = 0; j < 8; ++j) el[j] = 0.f;
#pragma unroll
        for (int i = 0; i < 8; ++i) {
            const int col = i * 256 + c.lane * 4;
#pragma unroll
            for (int j = 0; j < 4; ++j) {
                const f32x4 w0 = *(const f32x4*)(w_re + (size_t)(col + j) * 64 + gi * 8), w1 = *(const f32x4*)(w_re + (size_t)(col + j) * 64 + gi * 8 + 4);
#pragma unroll
                for (int e = 0; e < 4; ++e) { el[e] += v[i][j] * w0[e]; el[4 + e] += v[i][j] * w1[e]; }
            }
        }
#pragma unroll
        for (int j = 0; j < 8; ++j) el[j] = wave_sum(el[j]) + b_re[gi * 8 + j];
        int i1 = 0; float e1 = el[0];
#pragma unroll
        for (int j = 1; j < 8; ++j) if (el[j] > e1) { e1 = el[j]; i1 = j; }
        int i2 = -1; float e2 = -3.0e38f;
#pragma unroll
        for (int j = 0; j < 8; ++j) if (j != i1 && el[j] > e2) { e2 = el[j]; i2 = j; }
        const float r2 = __expf(e2 - e1);
        const float tp1 = 1.0f / (1.0f + r2), tp2 = r2 / (1.0f + r2);
        if (c.lane == 0) {
            const int ea = gi * 8 + i1, eb = gi * 8 + i2;
            const unsigned sa = atomicAdd(&cnt[ea], 1u), sb = atomicAdd(&cnt[eb], 1u);
            ltok[ea * NTOK + sa] = row * 2; lw[ea * NTOK + sa] = pg * tp1;
            ltok[eb * NTOK + sb] = row * 2 + 1; lw[eb * NTOK + sb] = pg * tp2;
        }
    }
}

__device__ __forceinline__ void phase_norm2_route2(const Params& p, const Ctx& c, int dummy = 0) {
    const float* x1 = (const float*)(p.ws + WS_X1); const float* g = p.in[15];
    const float* mod = (const float*)(p.ws + WS_MOD);
    const bf16_t* WtH = (const bf16_t*)(p.ws + WS_RW); const bf16_t* WtL = WtH + (size_t)NB * 80 * D; const float* cb = (const float*)(p.ws + WS_RC);
    bf16_t* h2 = (bf16_t*)(p.ws + WS_H2);
    unsigned* cnt = (unsigned*)(p.ws + WS_CTL) + CW_CNT + (dummy ? 128 : 0);
    int* ltok = (int*)(p.ws + (dummy ? WS_ACT : WS_LTOK)); float* lw = (float*)(p.ws + (dummy ? WS_ACT + (size_t)NE * NTOK * 4 : WS_LW));
    LAS float* red = (LAS float*)c.lds;
    LAS float* ssr = (LAS float*)(c.lds + 81920);
    LAS float* rs = (LAS float*)(c.lds + 81920 + 1024);
    for (int it = c.bid; it < NTOK / 32; it += c.nblk) {
        const int tok0 = it * 32, b = tok0 >> 11;
        const int ks = c.wid, i16 = c.lane & 15, kk = c.lane >> 4;
        const float* ap0 = x1 + (size_t)(tok0 + i16) * D + 256 * ks + 8 * kk;
        const float* ap1 = ap0 + (size_t)16 * D;
        const bf16_t* bph = WtH + ((size_t)b * 80 + i16) * D + 256 * ks + 8 * kk;
        const bf16_t* bpl = WtL + ((size_t)b * 80 + i16) * D + 256 * ks + 8 * kk;
        f32x4 acc[2][5];
#pragma unroll
        for (int g2 = 0; g2 < 2; ++g2)
#pragma unroll
            for (int nb = 0; nb < 5; ++nb) acc[g2][nb] = (f32x4){0.f, 0.f, 0.f, 0.f};
        float ss0 = 0.f, ss1 = 0.f;
#pragma unroll 4
        for (int kb8 = 0; kb8 < 8; ++kb8) {
            bf16x8 ah[2], al[2];
#pragma unroll
            for (int g2 = 0; g2 < 2; ++g2) {
                const float* ap = (g2 ? ap1 : ap0) + 32 * kb8;
                const f32x4 v0 = *(const f32x4*)ap, v1 = *(const f32x4*)(ap + 4);
                const float sq = v0[0] * v0[0] + v0[1] * v0[1] + v0[2] * v0[2] + v0[3] * v0[3] + v1[0] * v1[0] + v1[1] * v1[1] + v1[2] * v1[2] + v1[3] * v1[3];
                if (g2) ss1 += sq; else ss0 += sq;
                u32x4 h, l;
                h.x = pack_bf16(v0[0], v0[1]); h.y = pack_bf16(v0[2], v0[3]); h.z = pack_bf16(v1[0], v1[1]); h.w = pack_bf16(v1[2], v1[3]);
                l.x = pack_bf16(v0[0] - __uint_as_float(h.x << 16), v0[1] - __uint_as_float(h.x & 0xffff0000u));
                l.y = pack_bf16(v0[2] - __uint_as_float(h.y << 16), v0[3] - __uint_as_float(h.y & 0xffff0000u));
                l.z = pack_bf16(v1[0] - __uint_as_float(h.z << 16), v1[1] - __uint_as_float(h.z & 0xffff0000u));
                l.w = pack_bf16(v1[2] - __uint_as_float(h.w << 16), v1[3] - __uint_as_float(h.w & 0xffff0000u));
                ah[g2] = __builtin_bit_cast(bf16x8, h); al[g2] = __builtin_bit_cast(bf16x8, l);
            }
#pragma unroll
            for (int nb = 0; nb < 5; ++nb) {
                const bf16x8 bh = *(const bf16x8*)(bph + (size_t)nb * 16 * D + 32 * kb8), bl = *(const bf16x8*)(bpl + (size_t)nb * 16 * D + 32 * kb8);
#pragma unroll
                for (int g2 = 0; g2 < 2; ++g2) {
                    acc[g2][nb] = __builtin_amdgcn_mfma_f32_16x16x32_bf16(ah[g2], bh, acc[g2][nb], 0, 0, 0);
                    acc[g2][nb] = __builtin_amdgcn_mfma_f32_16x16x32_bf16(ah[g2], bl, acc[g2][nb], 0, 0, 0);
                    acc[g2][nb] = __builtin_amdgcn_mfma_f32_16x16x32_bf16(al[g2], bh, acc[g2][nb], 0, 0, 0);
                }
            }
        }
        ss0 += __shfl_xor(ss0, 16); ss0 += __shfl_xor(ss0, 32);
        ss1 += __shfl_xor(ss1, 16); ss1 += __shfl_xor(ss1, 32);
        __syncthreads();
#pragma unroll
        for (int g2 = 0; g2 < 2; ++g2)
#pragma unroll
            for (int nb = 0; nb < 5; ++nb)
#pragma unroll
                for (int r = 0; r < 4; ++r) red[(c.wid * 32 + g2 * 16 + 4 * kk + r) * 80 + nb * 16 + i16] = acc[g2][nb][r];
        if (kk == 0) { ssr[c.wid * 32 + i16] = ss0; ssr[c.wid * 32 + 16 + i16] = ss1; }
        __syncthreads();
        if (c.tid < 32) {
            const int t = c.tid;
            float ssum = 0.f;
#pragma unroll
            for (int q = 0; q < 8; ++q) ssum += ssr[q * 32 + t];
            const float rstd = rsqrtf(ssum * (1.0f / D) + EPS);
            rs[t] = rstd;
            float gl[8];
#pragma unroll
            for (int j = 0; j < 8; ++j) {
                float a = 0.f;
#pragma unroll
                for (int q = 0; q < 8; ++q) a += red[(q * 32 + t) * 80 + j];
                gl[j] = a * rstd + cb[b * 80 + j];
            }
            int gi = 0; float gmax = gl[0];
#pragma unroll
            for (int j = 1; j < 8; ++j) if (gl[j] > gmax) { gmax = gl[j]; gi = j; }
            float gsum = 0.f;
#pragma unroll
            for (int j = 0; j < 8; ++j) gsum += __expf(gl[j] - gmax);
            const float pg = 1.0f / gsum;
            float el[8];
#pragma unroll
            for (int j = 0; j < 8; ++j) {
                float a = 0.f;
#pragma unroll
                for (int q = 0; q < 8; ++q) a += red[(q * 32 + t) * 80 + 8 + gi * 8 + j];
                el[j] = a * rstd + cb[b * 80 + 8 + gi * 8 + j];
            }
            int i1 = 0; float e1 = el[0];
#pragma unroll
            for (int j = 1; j < 8; ++j) if (el[j] > e1) { e1 = el[j]; i1 = j; }
            int i2 = -1; float e2 = -3.0e38f;
#pragma unroll
            for (int j = 0; j < 8; ++j) if (j != i1 && el[j] > e2) { e2 = el[j]; i2 = j; }
            const float r2 = __expf(e2 - e1);
            const float tp1 = 1.0f / (1.0f + r2), tp2 = r2 / (1.0f + r2);
            const int row = tok0 + t;
            const int ea = gi * 8 + i1, eb = gi * 8 + i2;
            const unsigned sa = atomicAdd(&cnt[ea], 1u), sb = atomicAdd(&cnt[eb], 1u);
            ltok[ea * NTOK + sa] = row * 2; lw[ea * NTOK + sa] = pg * tp1;
            ltok[eb * NTOK + sb] = row * 2 + 1; lw[eb * NTOK + sb] = pg * tp2;
            if (!dummy) { u32x4 rec; rec.x = ((unsigned)ea << 13) | sa; rec.y = __float_as_uint(pg * tp1); rec.z = ((unsigned)eb << 13) | sb; rec.w = __float_as_uint(pg * tp2);
                *(u32x4*)(p.ws + WS_TREC + (size_t)row * 16) = rec; }
        }
        float rstd4[4];
#pragma unroll
        for (int q = 0; q < 4; ++q) {
            float ssum = 0.f;
#pragma unroll
            for (int q8 = 0; q8 < 8; ++q8) ssum += ssr[q8 * 32 + c.wid * 4 + q];
            rstd4[q] = rsqrtf(ssum * (1.0f / D) + EPS);
        }
#pragma unroll 2
        for (int i = 0; i < 8; ++i) {
            const int col = i * 256 + c.lane * 4;
            const f32x4 gg = *(const f32x4*)(g + col), sh = *(const f32x4*)(mod + b * NMOD + 3 * D + col), scl = *(const f32x4*)(mod + b * NMOD + 4 * D + col);
            f32x4 v[4];
#pragma unroll
            for (int q = 0; q < 4; ++q) v[q] = *(const f32x4*)(x1 + (size_t)(tok0 + c.wid * 4 + q) * D + col);
#pragma unroll
            for (int q = 0; q < 4; ++q) {
                float o[4];
#pragma unroll
                for (int j = 0; j < 4; ++j) o[j] = (v[q][j] * rstd4[q] * gg[j]) * (1.0f + scl[j]) + sh[j];
                u32x2 w; w.x = pack_bf16(o[0], o[1]); w.y = pack_bf16(o[2], o[3]);
                *(u32x2*)(h2 + (size_t)(tok0 + c.wid * 4 + q) * D + col) = w;
            }
        }
    }
}

constexpr int MOE_TAB = 100 * 1024;
__device__ __forceinline__ void moe_table(const Params& p, const Ctx& c) {
    const unsigned* cnt = (const unsigned*)(p.ws + WS_CTL) + CW_CNT;
    LAS int* tab = (LAS int*)(c.lds + MOE_TAB);
    __syncthreads();
    if (c.tid == 0) {
        int rp = 0;
        for (int e = 0; e < NE; ++e) { const int n = (int)cnt[e]; tab[e] = n; tab[64 + e] = rp; rp += n; }
        tab[64 + 64] = rp;
        for (int q = 0; q < 8; ++q) { int ip = 0; for (int j = 0; j < 8; ++j) { tab[256 + 16 * q + j] = ip; ip += ((tab[q + 8 * j] + 255) >> 8) * 16; } tab[256 + 16 * q + 8] = ip; }
    }
    __syncthreads();
}
__device__ __forceinline__ bool moe_next(XQueue& q, const Ctx& c, int& e, int& mt, int& ntile, int& cnt_e, int& rbase) {
    LAS int* tab = (LAS int*)(c.lds + MOE_TAB);
    while (q.v < 8) {
        const int qi = (q.x + q.v) & 7;
        const int L = next_item(q.heads + qi * 64, c);
        if (L < tab[256 + 16 * qi + 8]) {
            int j = 0;
#pragma unroll
            for (int k = 1; k < 8; ++k) if (tab[256 + 16 * qi + k] <= L) j = k;
            e = qi + 8 * j;
            while (tab[e] == 0 && j > 0) { --j; e -= 8; }
            cnt_e = tab[e]; rbase = tab[64 + e];
            const int loc = L - tab[256 + 16 * qi + j], nmt = (cnt_e + 255) >> 8;
            ntile = loc / nmt; mt = loc - ntile * nmt;
            return true;
        }
        ++q.v;
    }
    return false;
}

__device__ __forceinline__ void phase_moe1(const Params& p, const Ctx& c, int qsel = 1) {
    const bf16_t* h2 = (const bf16_t*)(p.ws + WS_H2);
    const int* ltok = (const int*)(p.ws + WS_LTOK);
    bf16_t* act = (bf16_t*)(p.ws + WS_ACT);
    const float* wg = p.in[20]; const float* wu = p.in[21];
    moe_table(p, c);
    XQueue q = xq_make(p, qsel);
    for (;;) {
        int e, mt, ntile, cnt_e, rbase;
        if (!moe_next(q, c, e, mt, ntile, cnt_e, rbase)) break;
        const int n0 = ntile * 64;
        const bf16_t* arow[4];
#pragma unroll
        for (int i = 0; i < 4; ++i) {
            const int r = mt * 256 + a_piece_row(c, i);
            const int tok = r < cnt_e ? (ltok[e * NTOK + r] >> 1) : 0;
            arow[i] = h2 + (size_t)tok * D + a_piece_col(c);
        }
        const int nq = b_nq(c), blk = nq >> 2;
        const float* wsrc = ((blk & 1) ? wu : wg) + (size_t)e * D * DE;
        const float* bptr = wsrc + (size_t)b_k0(c) * DE + n0 + 16 * (blk >> 1) + 4 * (nq & 3);
        f32x4 acc[8][2]; zero_acc(acc);
        gemm_mainloop<MOE_NT, D>(acc, arow, bptr, DE, c);
#pragma unroll
        for (int mi = 0; mi < 8; ++mi) {
            const int r = mt * 256 + 128 * c.wr + 16 * mi + c.fr;
            if (r < cnt_e) {
                const int col = n0 + 16 * c.wc + 4 * c.fq;
                float o[4];
#pragma unroll
                for (int j = 0; j < 4; ++j) { const float a = acc[mi][0][j], u = acc[mi][1][j]; o[j] = a / (1.0f + __expf(-a)) * u; }
                u32x2 w; w.x = pack_bf16(o[0], o[1]); w.y = pack_bf16(o[2], o[3]);
                *(u32x2*)(act + (size_t)(rbase + r) * DE + col) = w;
            }
        }
    }
}
__device__ __forceinline__ void phase_moe2(const Params& p, const Ctx& c, int qsel = 2) {
    const int* ltok = (const int*)(p.ws + WS_LTOK); const float* lw = (const float*)(p.ws + WS_LW);
    const bf16_t* act = (const bf16_t*)(p.ws + WS_ACT);
    float* y = (float*)(p.ws + WS_Y);
    const float* wd = p.in[22];
    moe_table(p, c);
    XQueue q = xq_make(p, qsel);
    for (;;) {
        int e, mt, ntile, cnt_e, rbase;
        if (!moe_next(q, c, e, mt, ntile, cnt_e, rbase)) break;
        const int n0 = ntile * 128;
        const bf16_t* arow[4];
#pragma unroll
        for (int i = 0; i < 4; ++i) arow[i] = act + (size_t)(rbase + mt * 256 + a_piece_row(c, i)) * DE + a_piece_col(c);
        const float* bptr = wd + (size_t)e * DE * D + (size_t)b_k0(c) * D + n0 + 4 * b_nq(c);
        f32x4 acc[8][2]; zero_acc(acc);
        gemm_mainloop<MOE_NT, DE>(acc, arow, bptr, D, c);
#pragma unroll
        for (int mi = 0; mi < 8; ++mi) {
            const int r = mt * 256 + 128 * c.wr + 16 * mi + c.fr;
            if (r < cnt_e) {
                const int ent = ltok[e * NTOK + r]; const float w = lw[e * NTOK + r];
#pragma unroll
                for (int ni = 0; ni < 2; ++ni) {
                    const int col = n0 + 32 * c.wc + 16 * ni + 4 * c.fq;
                    *(f32x4*)(y + (size_t)ent * D + col) = acc[mi][ni] * w;
                }
            }
        }
    }
}

constexpr int MOE_TAB2 = 132 * 1024;
__device__ __forceinline__ void moe_table2(const Params& p, const Ctx& c) {
    const unsigned* cnt = (const unsigned*)(p.ws + WS_CTL) + CW_CNT;
    LAS int* tab = (LAS int*)(c.lds + MOE_TAB2);
    __syncthreads();
    if (c.tid == 0) {
        int rp = 0;
        for (int e = 0; e < NE; ++e) { const int n = (int)cnt[e]; tab[e] = n; tab[64 + e] = rp; rp += n; }
        tab[64 + 64] = rp;
        for (int q = 0; q < 8; ++q) { int ip = 0; for (int j = 0; j < 8; ++j) { tab[256 + 16 * q + j] = ip; ip += ((tab[q + 8 * j] + 255) >> 8) * 8; } tab[256 + 16 * q + 8] = ip; }
    }
    __syncthreads();
}
__device__ __forceinline__ bool moe_next2(XQueue& q, const Ctx& c, int& e, int& mt, int& ntile, int& cnt_e, int& rbase) {
    LAS int* tab = (LAS int*)(c.lds + MOE_TAB2);
    while (q.v < 8) {
        const int qi = (q.x + q.v) & 7;
        const int L = next_item(q.heads + qi * 64, c);
        if (L < tab[256 + 16 * qi + 8]) {
            int j = 0;
#pragma unroll
            for (int k = 1; k < 8; ++k) if (tab[256 + 16 * qi + k] <= L) j = k;
            e = qi + 8 * j;
            while (tab[e] == 0 && j > 0) { --j; e -= 8; }
            cnt_e = tab[e]; rbase = tab[64 + e];
            const int loc = L - tab[256 + 16 * qi + j], nmt = (cnt_e + 255) >> 8;
            ntile = loc / nmt; mt = loc - ntile * nmt;
            return true;
        }
        ++q.v;
    }
    return false;
}
__device__ __forceinline__ void zero_acc4(f32x4 (&acc)[8][4]) {
#pragma unroll
    for (int mi = 0; mi < 8; ++mi)
#pragma unroll
        for (int ni = 0; ni < 4; ++ni) acc[mi][ni] = (f32x4){0.f, 0.f, 0.f, 0.f};
}
__device__ __forceinline__ void phase_moe1w(const Params& p, const Ctx& c, int qsel = 1) {
    const bf16_t* h2 = (const bf16_t*)(p.ws + WS_H2);
    const int* ltok = (const int*)(p.ws + WS_LTOK);
    bf16_t* act = (bf16_t*)(p.ws + WS_ACT);
    const float* wg = p.in[20]; const float* wu = p.in[21];
    moe_table2(p, c);
    XQueue q = xq_make(p, qsel);
    const int blk = c.lane >> 2;
    const float* wsel = (blk & 1) ? wu : wg;
    const int bcol = 16 * (blk >> 1) + 4 * (c.lane & 3);
    int e, mt, ntile, cnt_e, rbase;
    if (!moe_next2(q, c, e, mt, ntile, cnt_e, rbase)) return;
    int aoff[4];
#pragma unroll
    for (int i = 0; i < 4; ++i) { const int r = mt * 256 + a_piece_row(c, i); const int tok = r < cnt_e ? (ltok[e * NTOK + r] >> 1) : 0; aoff[i] = tok * D + a_piece_col(c); }
    const float* bptr = wsel + (size_t)e * D * DE + (size_t)(8 * c.wid) * DE + ntile * 128 + bcol;
    bool staged = false;
    f32x4 rb[8];
    for (;;) {
        int en, mtn, ntilen, cntn, rbasen;
        const bool hn = moe_next2(q, c, en, mtn, ntilen, cntn, rbasen);
        int aoffn[4]; const float* bptrn; int nrn;
        if (hn) {
#pragma unroll
            for (int i = 0; i < 4; ++i) { const int r = mtn * 256 + a_piece_row(c, i); const int tok = r < cntn ? (ltok[en * NTOK + r] >> 1) : 0; aoffn[i] = tok * D + a_piece_col(c); }
            bptrn = wsel + (size_t)en * D * DE + (size_t)(8 * c.wid) * DE + ntilen * 128 + bcol; nrn = cntn - mtn * 256;
        } else {
#pragma unroll
            for (int i = 0; i < 4; ++i) aoffn[i] = aoff[i] + (D / 64 - 1) * 64;
            bptrn = bptr + (size_t)((D / 64 - 1) * 64) * DE; nrn = cnt_e - mt * 256;
        }
        const int n0 = ntile * 128;
        f32x4 acc[8][4]; zero_acc4(acc);
        gemm_mainloop256<D>(acc, rb, h2, aoff, bptr, DE, cnt_e - mt * 256, c, staged, aoffn, bptrn, nrn, hn);
#pragma unroll
        for (int mi = 0; mi < 8; ++mi) {
            const int r = mt * 256 + 128 * c.wr + 16 * mi + c.fr;
            if (r < cnt_e) {
#pragma unroll
                for (int hh = 0; hh < 2; ++hh) {
                    const int col = n0 + 16 * (2 * c.wc + hh) + 4 * c.fq;
                    float o[4];
#pragma unroll
                    for (int j = 0; j < 4; ++j) { const float a = acc[mi][2 * hh][j], u = acc[mi][2 * hh + 1][j]; o[j] = a * sigmoidf_(a) * u; }
                    u32x2 w; w.x = pack_bf16(o[0], o[1]); w.y = pack_bf16(o[2], o[3]);
                    *(u32x2*)(act + (size_t)(rbase + r) * DE + col) = w;
                }
            }
        }
        if (!hn) break;
        e = en; mt = mtn; ntile = ntilen; cnt_e = cntn; rbase = rbasen; bptr = bptrn; staged = true;
#pragma unroll
        for (int i = 0; i < 4; ++i) aoff[i] = aoffn[i];
    }
    asm volatile("s_waitcnt vmcnt(0)" ::: "memory");
}
__device__ __forceinline__ void phase_moe2w(const Params& p, const Ctx& c, int qsel = 2) {
    const bf16_t* act = (const bf16_t*)(p.ws + WS_ACT);
    bf16_t* yb = (bf16_t*)(p.ws + WS_Y);
    const float* wd = p.in[22];
    moe_table2(p, c);
    XQueue q = xq_make(p, qsel);
    int e, mt, ntile, cnt_e, rbase;
    if (!moe_next2(q, c, e, mt, ntile, cnt_e, rbase)) return;
    int aoff[4];
#pragma unroll
    for (int i = 0; i < 4; ++i) aoff[i] = (rbase + mt * 256 + a_piece_row(c, i)) * DE + a_piece_col(c);
    const float* bptr = wd + (size_t)e * DE * D + (size_t)(8 * c.wid) * D + ntile * 256 + 4 * c.lane;
    bool staged = false;
    f32x4 rb[8];
    for (;;) {
        int en, mtn, ntilen, cntn, rbasen;
        const bool hn = moe_next2(q, c, en, mtn, ntilen, cntn, rbasen);
        int aoffn[4]; const float* bptrn; int nrn;
        if (hn) {
#pragma unroll
            for (int i = 0; i < 4; ++i) aoffn[i] = (rbasen + mtn * 256 + a_piece_row(c, i)) * DE + a_piece_col(c);
            bptrn = wd + (size_t)en * DE * D + (size_t)(8 * c.wid) * D + ntilen * 256 + 4 * c.lane; nrn = cntn - mtn * 256;
        } else {
#pragma unroll
            for (int i = 0; i < 4; ++i) aoffn[i] = aoff[i] + (DE / 64 - 1) * 64;
            bptrn = bptr + (size_t)((DE / 64 - 1) * 64) * D; nrn = cnt_e - mt * 256;
        }
        const int n0 = ntile * 256;
        f32x4 acc[8][4]; zero_acc4(acc);
        gemm_mainloop256<DE>(acc, rb, act, aoff, bptr, D, cnt_e - mt * 256, c, staged, aoffn, bptrn, nrn, hn);
#pragma unroll
        for (int mi = 0; mi < 8; ++mi) {
            const int r = mt * 256 + 128 * c.wr + 16 * mi + c.fr;
            if (r < cnt_e) {
#pragma unroll
                for (int ni = 0; ni < 4; ++ni) {
                    const int col = n0 + 64 * c.wc + 16 * ni + 4 * c.fq;
                    const f32x4 v = acc[mi][ni];
                    u32x2 pk; pk.x = pack_bf16(v[0], v[1]); pk.y = pack_bf16(v[2], v[3]);
                    *(u32x2*)(yb + (size_t)(rbase + r) * D + col) = pk;
                }
            }
        }
        if (!hn) break;
        e = en; mt = mtn; ntile = ntilen; cnt_e = cntn; rbase = rbasen; bptr = bptrn; staged = true;
#pragma unroll
        for (int i = 0; i < 4; ++i) aoff[i] = aoffn[i];
    }
    asm volatile("s_waitcnt vmcnt(0)" ::: "memory");
}

__device__ __forceinline__ void phase_final(const Params& p, const Ctx& c) {
    const float* x1 = (const float*)(p.ws + WS_X1); const bf16_t* yb = (const bf16_t*)(p.ws + WS_Y);
    const float* mod = (const float*)(p.ws + WS_MOD); const float* g = p.in[23];
    const unsigned* cnt = (const unsigned*)(p.ws + WS_CTL) + CW_CNT;
    LAS int* rpre = (LAS int*)c.lds;
    __syncthreads();
    if (c.tid == 0) { int rp = 0; for (int e = 0; e < NE; ++e) { rpre[e] = rp; rp += (int)cnt[e]; } }
    __syncthreads();
    for (int row = c.bid * 8 + c.wid; row < NTOK; row += c.nblk * 8) {
        const int b = row >> 11;
        const u32x4 rec = *(const u32x4*)(p.ws + WS_TREC + (size_t)row * 16);
        const size_t r0 = (size_t)(rpre[rec.x >> 13] + (int)(rec.x & 8191u)), r1 = (size_t)(rpre[rec.z >> 13] + (int)(rec.z & 8191u));
        const float w0 = __uint_as_float(rec.y), w1 = __uint_as_float(rec.w);
        f32x4 v[8]; float ss = 0.f;
#pragma unroll
        for (int i = 0; i < 8; ++i) {
            const int col = i * 256 + c.lane * 4;
            const f32x4 xv = *(const f32x4*)(x1 + (size_t)row * D + col);
            const u32x2 a0 = *(const u32x2*)(yb + r0 * D + col), a1 = *(const u32x2*)(yb + r1 * D + col);
            f32x4 y0, y1;
            y0[0] = __uint_as_float(a0.x << 16); y0[1] = __uint_as_float(a0.x & 0xffff0000u); y0[2] = __uint_as_float(a0.y << 16); y0[3] = __uint_as_float(a0.y & 0xffff0000u);
            y1[0] = __uint_as_float(a1.x << 16); y1[1] = __uint_as_float(a1.x & 0xffff0000u); y1[2] = __uint_as_float(a1.y << 16); y1[3] = __uint_as_float(a1.y & 0xffff0000u);
            const f32x4 gf = *(const f32x4*)(mod + b * NMOD + 5 * D + col);
            v[i] = xv + gf * (y0 * w0 + y1 * w1);
            ss += v[i][0] * v[i][0] + v[i][1] * v[i][1] + v[i][2] * v[i][2] + v[i][3] * v[i][3];
        }
        ss = wave_sum(ss);
        const float rstd = rsqrtf(ss * (1.0f / D) + EPS);
#pragma unroll
        for (int i = 0; i < 8; ++i) {
            const int col = i * 256 + c.lane * 4;
            const f32x4 gg = *(const f32x4*)(g + col);
            *(f32x4*)(p.out + (size_t)row * D + col) = v[i] * rstd * gg;
        }
    }
}

struct EpiProjIn {
    static constexpr bool PERM = false, AFTER_DRAIN = false;
    unsigned char* ws;
    __device__ __forceinline__ void operator()(const pg8::f32x4 (&acc)[2][2][4][2], const pg8::Unit& u, int wr, int wc, int fr, int fq) const {
        const int region = (u.pn * 256) >> 10;
#pragma unroll
        for (int ai = 0; ai < 2; ++ai)
#pragma unroll
            for (int m = 0; m < 4; ++m) {
                const int row = u.pm * 256 + ai * 128 + wr * 64 + m * 16 + fr;
#pragma unroll
                for (int bj = 0; bj < 2; ++bj)
#pragma unroll
                    for (int n = 0; n < 2; ++n) {
                        const int col = u.pn * 256 + bj * 128 + wc * 32 + n * 16 + 4 * fq;
                        const f32x4 a = acc[ai][bj][m][n];
                        if (region < 6) {
                            const int cin = col & 1023;
                            if (region == 2 || region == 5) {
                                bf16_t* vt = (bf16_t*)(ws + (region == 2 ? WS_VAT : WS_VBT));
                                const int b = row >> 11, s0 = row & 2047, hh = cin >> 7, d = cin & 127;
                                const int s = (s0 & ~31) | ((s0 & 12) << 1) | ((s0 & 16) >> 2) | (s0 & 3);
                                const unsigned w0 = pack_bf16(a[0], a[1]), w1 = pack_bf16(a[2], a[3]);
                                bf16_t* base = vt + ((size_t)((b * 8 + hh) * 128 + d)) * SEQ + s;
                                base[0] = (bf16_t)(w0 & 0xffff); base[SEQ] = (bf16_t)(w0 >> 16); base[2 * SEQ] = (bf16_t)(w1 & 0xffff); base[3 * SEQ] = (bf16_t)(w1 >> 16);
                            } else {
                                const size_t off = region == 0 ? WS_QA : region == 1 ? WS_KA : region == 3 ? WS_QB : WS_KB;
                                bf16_t* dst = (bf16_t*)(ws + off);
                                u32x2 w; w.x = pack_bf16(a[0], a[1]); w.y = pack_bf16(a[2], a[3]);
                                *(u32x2*)(dst + (size_t)row * 1024 + cin) = w;
                            }
                        } else {
                            bf16_t* dst = (bf16_t*)(ws + (region < 8 ? WS_GA : WS_GB));
                            const int cin = col - (region < 8 ? 6144 : 8192);
                            u32x2 w; w.x = pack_bf16(sigmoidf_(a[0]), sigmoidf_(a[1])); w.y = pack_bf16(sigmoidf_(a[2]), sigmoidf_(a[3]));
                            *(u32x2*)(dst + (size_t)row * D + cin) = w;
                        }
                    }
            }
    }
};
template <int PASS> struct EpiGate {
    static constexpr bool PERM = false, AFTER_DRAIN = false;
    const bf16_t* G; float* tmp; bf16_t* out;
    __device__ __forceinline__ void operator()(const pg8::f32x4 (&acc)[2][2][4][2], const pg8::Unit& u, int wr, int wc, int fr, int fq) const {
#pragma unroll
        for (int ai = 0; ai < 2; ++ai)
#pragma unroll
            for (int m = 0; m < 4; ++m) {
                const int row = u.pm * 256 + ai * 128 + wr * 64 + m * 16 + fr;
#pragma unroll
                for (int bj = 0; bj < 2; ++bj)
#pragma unroll
                    for (int n = 0; n < 2; ++n) {
                        const int col = u.pn * 256 + bj * 128 + wc * 32 + n * 16 + 4 * fq;
                        const u32x2 gw = *(const u32x2*)(G + (size_t)row * D + col);
                        f32x4 g; g[0] = __uint_as_float(gw.x << 16); g[1] = __uint_as_float(gw.x & 0xffff0000u); g[2] = __uint_as_float(gw.y << 16); g[3] = __uint_as_float(gw.y & 0xffff0000u);
                        f32x4 v = acc[ai][bj][m][n] * g;
                        if (PASS == 0) *(f32x4*)(tmp + (size_t)row * D + col) = v;
                        else {
                            v += *(const f32x4*)(tmp + (size_t)row * D + col);
                            u32x2 w; w.x = pack_bf16(v[0], v[1]); w.y = pack_bf16(v[2], v[3]);
                            *(u32x2*)(out + (size_t)row * D + col) = w;
                        }
                    }
            }
    }
};
struct EpiX1 {
    static constexpr bool PERM = false, AFTER_DRAIN = false;
    const float* x; const float* mod; float* x1;
    __device__ __forceinline__ void operator()(const pg8::f32x4 (&acc)[2][2][4][2], const pg8::Unit& u, int wr, int wc, int fr, int fq) const {
        const int b = (u.pm * 256) >> 11;
#pragma unroll
        for (int ai = 0; ai < 2; ++ai)
#pragma unroll
            for (int m = 0; m < 4; ++m) {
                const int row = u.pm * 256 + ai * 128 + wr * 64 + m * 16 + fr;
#pragma unroll
                for (int bj = 0; bj < 2; ++bj)
#pragma unroll
                    for (int n = 0; n < 2; ++n) {
                        const int col = u.pn * 256 + bj * 128 + wc * 32 + n * 16 + 4 * fq;
                        const f32x4 gm = *(const f32x4*)(mod + b * NMOD + 2 * D + col);
                        const f32x4 xv = *(const f32x4*)(x + (size_t)row * D + col);
                        *(f32x4*)(x1 + (size_t)row * D + col) = xv + gm * acc[ai][bj][m][n];
                    }
            }
    }
};
__device__ __forceinline__ void phase_proj_in2(const Params& p, const Ctx& c) {
    pg8::Gemm g{(const bf16_t*)(p.ws + WS_H), (const bf16_t*)(p.ws + WS_WIN_T), NTOK, INC, D};
    pg8::StaticOrder S; S.init(NTOK, INC, c.nblk, c.bid);
    EpiProjIn E{p.ws};
    pg8::gemm_phase<EpiProjIn, pg8::StaticOrder>(c.lds, g, S, E, nullptr, c.wid);
}
__device__ __forceinline__ void phase_merge2(const Params& p, const Ctx& c) {
    float* tmp = (float*)(p.ws + WS_X1);
    {
        pg8::Gemm g{(const bf16_t*)(p.ws + WS_OA), (const bf16_t*)(p.ws + WS_WPA_T), NTOK, D, 1024};
        pg8::StaticOrder S; S.init(NTOK, D, c.nblk, c.bid);
        EpiGate<0> E{(const bf16_t*)(p.ws + WS_GA), tmp, nullptr};
        pg8::gemm_phase<EpiGate<0>, pg8::StaticOrder>(c.lds, g, S, E, nullptr, c.wid);
    }
    {
        pg8::Gemm g{(const bf16_t*)(p.ws + WS_OB), (const bf16_t*)(p.ws + WS_WPB_T), NTOK, D, 1024};
        pg8::StaticOrder S; S.init(NTOK, D, c.nblk, c.bid);
        EpiGate<1> E{(const bf16_t*)(p.ws + WS_GB), tmp, (bf16_t*)(p.ws + WS_MRG)};
        pg8::gemm_phase<EpiGate<1>, pg8::StaticOrder>(c.lds, g, S, E, nullptr, c.wid);
    }
}
struct MidGate {
    static constexpr int AT = 16;
    const bf16_t* GA; const bf16_t* GB;
    __device__ __forceinline__ void operator()(pg8::f32x4 (&acc)[2][2][4][2], const pg8::Unit& u, int wr, int wc, int fr, int fq) const {
        int off0 = (u.pm * 256 + wr * 64 + fr) * D + u.pn * 256 + wc * 32 + 4 * fq;
        asm volatile("" : "+v"(off0));
#pragma unroll
        for (int ai = 0; ai < 2; ++ai)
#pragma unroll
            for (int m = 0; m < 4; ++m) {
#pragma unroll
                for (int bj = 0; bj < 2; ++bj)
#pragma unroll
                    for (int n = 0; n < 2; ++n) {
                        const int off = off0 + (ai * 128 + m * 16) * D + bj * 128 + n * 16;
                        const u32x2 a = *(const u32x2*)(GA + off), b = *(const u32x2*)(GB + off);
                        f32x4 r;
                        r[0] = __uint_as_float(a.x << 16) * __builtin_amdgcn_rcpf(__uint_as_float(b.x << 16)); r[1] = __uint_as_float(a.x & 0xffff0000u) * __builtin_amdgcn_rcpf(__uint_as_float(b.x & 0xffff0000u));
                        r[2] = __uint_as_float(a.y << 16) * __builtin_amdgcn_rcpf(__uint_as_float(b.y << 16)); r[3] = __uint_as_float(a.y & 0xffff0000u) * __builtin_amdgcn_rcpf(__uint_as_float(b.y & 0xffff0000u));
                        acc[ai][bj][m][n] *= r;
                    }
                asm volatile("" ::: "memory");
            }
    }
};
struct EpiGateB {
    static constexpr bool PERM = false, AFTER_DRAIN = false;
    const bf16_t* GB; bf16_t* out;
    __device__ __forceinline__ void operator()(const pg8::f32x4 (&acc)[2][2][4][2], const pg8::Unit& u, int wr, int wc, int fr, int fq) const {
#pragma unroll
        for (int ai = 0; ai < 2; ++ai)
#pragma unroll
            for (int m = 0; m < 4; ++m) {
                const int row = u.pm * 256 + ai * 128 + wr * 64 + m * 16 + fr;
#pragma unroll
                for (int bj = 0; bj < 2; ++bj)
#pragma unroll
                    for (int n = 0; n < 2; ++n) {
                        const int col = u.pn * 256 + bj * 128 + wc * 32 + n * 16 + 4 * fq;
                        const u32x2 gw = *(const u32x2*)(GB + (size_t)row * D + col);
                        f32x4 g; g[0] = __uint_as_float(gw.x << 16); g[1] = __uint_as_float(gw.x & 0xffff0000u); g[2] = __uint_as_float(gw.y << 16); g[3] = __uint_as_float(gw.y & 0xffff0000u);
                        const f32x4 v = acc[ai][bj][m][n] * g;
                        u32x2 w; w.x = pack_bf16(v[0], v[1]); w.y = pack_bf16(v[2], v[3]);
                        *(u32x2*)(out + (size_t)row * D + col) = w;
                    }
            }
    }
};
__device__ __forceinline__ void phase_merge3(const Params& p, const Ctx& c) {
    pg8::Gemm g{(const bf16_t*)(p.ws + WS_OA), (const bf16_t*)(p.ws + WS_WPA_T), NTOK, D, D};
    pg8::StaticOrder S; S.init(NTOK, D, c.nblk, c.bid);
    EpiGateB E{(const bf16_t*)(p.ws + WS_GB), (bf16_t*)(p.ws + WS_MRG)};
    MidGate M{(const bf16_t*)(p.ws + WS_GA), (const bf16_t*)(p.ws + WS_GB)};
    pg8::gemm_phase<EpiGateB, pg8::StaticOrder, false, MidGate>(c.lds, g, S, E, nullptr, c.wid, M);
}
__device__ __forceinline__ void phase_out2(const Params& p, const Ctx& c) {
    pg8::Gemm g{(const bf16_t*)(p.ws + WS_MRG), (const bf16_t*)(p.ws + WS_WOUT_T), NTOK, D, D};
    pg8::StaticOrder S; S.init(NTOK, D, c.nblk, c.bid);
    EpiX1 E{p.in[0], (const float*)(p.ws + WS_MOD), (float*)(p.ws + WS_X1)};
    pg8::gemm_phase<EpiX1, pg8::StaticOrder>(c.lds, g, S, E, nullptr, c.wid);
}

constexpr int LDS_BYTES = 160 * 1024;
__global__ void __launch_bounds__(512, 2) mk_fwd(Params p) {
    extern __shared__ __attribute__((aligned(16))) unsigned char smem[];
    LAS unsigned char* ldsb = (LAS unsigned char*)smem;
    Ctx c; c.lds = ldsb; c.tid = threadIdx.x; c.lane = c.tid & 63; c.wid = __builtin_amdgcn_readfirstlane(c.tid >> 6); c.wr = c.wid >> 2; c.wc = c.wid & 3;
    c.fr = c.lane & 15; c.fq = c.lane >> 4; c.bid = blockIdx.x; c.nblk = gridDim.x;
#define MKCTX() do {} while (0)
#define LEADER() (c.tid == 0)
    volatile LAS unsigned* bst = (volatile LAS unsigned*)(ldsb + LDS_BYTES - 32);
    if (LEADER()) { bst[0] = 0u; bst[1] = 0u; }
    __syncthreads();
    unsigned* barw = (unsigned*)(p.ws + WS_CTL);
    XcdBarrier bar; bar.bar = barw; bar.x = 0; bar.st = bst;
#if !MK_SPLIT
    bar = xcd_barrier_post(barw, bst, LEADER());
#define GRID_BAR() xcd_barrier(bar, LEADER())
#else
#define GRID_BAR() do {} while (0)
#endif
    const int lo = p.ph_lo, hi = p.ph_hi;
#define IN(k) (lo <= (k) && (k) < hi)
#define BOTH(k) (IN(k) && IN((k) + 1))
#define DUP(k) ((DUP_MASK >> (k)) & 1)
    if (IN(0)) { MKCTX(); phase_mod(p, c); phase_convert(p, c); if (DUP(0)) { GRID_BAR(); phase_mod(p, c); phase_convert(p, c); } if (BOTH(0)) GRID_BAR(); }
    if (IN(1)) { MKCTX(); phase_norm1(p, c); phase_router_prep(p, c); if (DUP(1)) { GRID_BAR(); phase_norm1(p, c); } if (BOTH(1)) GRID_BAR(); }
    if (IN(2)) { MKCTX(); phase_proj_in2(p, c); if (DUP(2)) { GRID_BAR(); phase_proj_in2(p, c); } if (BOTH(2)) GRID_BAR(); }
    if (IN(3)) { MKCTX(); phase_attn(p, c, 0); if (DUP(3)) { GRID_BAR(); phase_attn(p, c, 3); } if (BOTH(3)) GRID_BAR(); }
    if (IN(4)) { MKCTX(); phase_merge3(p, c); if (DUP(4)) { GRID_BAR(); phase_merge3(p, c); } if (BOTH(4)) GRID_BAR(); }
    if (IN(5)) { MKCTX(); phase_out2(p, c); if (DUP(5)) { GRID_BAR(); phase_out2(p, c); } if (BOTH(5)) GRID_BAR(); }
    if (IN(6)) { MKCTX(); phase_norm2_route2(p, c); if (DUP(6)) { GRID_BAR(); phase_norm2_route2(p, c, 1); } if (BOTH(6)) GRID_BAR(); }
    if (IN(7)) { MKCTX(); phase_moe1w(p, c, 1); if (DUP(7)) { GRID_BAR(); phase_moe1w(p, c, 4); } if (BOTH(7)) GRID_BAR(); }
    if (IN(8)) { MKCTX(); phase_moe2w(p, c, 2); if (DUP(8)) { GRID_BAR(); phase_moe2w(p, c, 5); } if (BOTH(8)) GRID_BAR(); }
    if (IN(9)) { MKCTX(); phase_final(p, c); if (DUP(9)) { GRID_BAR(); phase_final(p, c); } }
}

extern "C" void kernel_launch(void* const* d_in, const int* in_sizes, int n_in, void* d_out, int out_size, void* d_ws, size_t ws_size, hipStream_t stream) {
    static int grid = 0;
    if (grid == 0) {
        if (n_in != 24 || out_size != NTOK * D || ws_size < WS_END) { fprintf(stderr, "kernel_launch: unexpected shapes (n_in %d out %d ws %zu need %zu)\n", n_in, out_size, ws_size, (size_t)WS_END); grid = -1; return; }
        int dev = 0, cus = 0, per_cu = 0;
        (void)hipGetDevice(&dev); (void)hipDeviceGetAttribute(&cus, hipDeviceAttributeMultiprocessorCount, dev);
        if (hipFuncSetAttribute((const void*)mk_fwd, hipFuncAttributeMaxDynamicSharedMemorySize, LDS_BYTES) != hipSuccess) { fprintf(stderr, "kernel_launch: hipFuncSetAttribute failed\n"); grid = -1; return; }
        if (hipOccupancyMaxActiveBlocksPerMultiprocessor(&per_cu, (const void*)mk_fwd, 512, LDS_BYTES) != hipSuccess || per_cu < 1) { fprintf(stderr, "kernel_launch: occupancy query says %d\n", per_cu); }
        (void)hipGetLastError();
        grid = cus > 0 ? cus : 256;
    }
    if (grid < 0) return;
    (void)hipMemsetAsync((char*)d_ws + WS_CTL, 0, CTL_BYTES, stream);
    Params p{};
    for (int i = 0; i < 24; ++i) p.in[i] = (const float*)d_in[i];
    p.out = (float*)d_out; p.ws = (unsigned char*)d_ws;
#if MK_SPLIT
    for (int ph = 0; ph < NPHASE; ++ph) { p.ph_lo = ph; p.ph_hi = ph + 1; hipLaunchKernelGGL(mk_fwd, dim3(grid), dim3(512), LDS_BYTES, stream, p); }
#else
    p.ph_lo = 0; p.ph_hi = NPHASE;
    hipLaunchKernelGGL(mk_fwd, dim3(grid), dim3(512), LDS_BYTES, stream, p);
#endif
}
```

```cpp
#include <hip/hip_runtime.h>
#include <stdint.h>
#include <stdio.h>

#ifndef DUP_MASK
#define DUP_MASK 0
#endif
#ifndef MOE_NT
#define MOE_NT false
#endif
#ifndef MK_SPLIT
#define MK_SPLIT 0
#endif

typedef unsigned short bf16_t;
typedef short bf16x8 __attribute__((ext_vector_type(8)));
typedef short bf16x4 __attribute__((ext_vector_type(4)));
typedef float f32x4 __attribute__((ext_vector_type(4)));
typedef unsigned u32x4 __attribute__((ext_vector_type(4)));
typedef unsigned u32x2 __attribute__((ext_vector_type(2)));
#define LAS __attribute__((address_space(3)))

constexpr int D = 2048, NB = 4, SEQ = 2048, NTOK = NB * SEQ;
constexpr int INC = 10240, NMOD = 6 * D;
constexpr int NE = 64, DE = 1024;
constexpr float EPS = 1e-6f;
constexpr int NPHASE = 10;

constexpr size_t WS_CTL = 0;
constexpr size_t CTL_BYTES = 32768;
constexpr size_t CW_CNT = 4096;
constexpr size_t CW_Q = 4096 + 256;
constexpr size_t WS_MOD = WS_CTL + CTL_BYTES;
constexpr size_t WS_H = WS_MOD + (size_t)NB * NMOD * 4;
constexpr size_t WS_QA = WS_H + (size_t)NTOK * D * 2;
constexpr size_t WS_KA = WS_QA + (size_t)NTOK * 1024 * 2;
constexpr size_t WS_VAT = WS_KA + (size_t)NTOK * 1024 * 2;
constexpr size_t WS_QB = WS_VAT + (size_t)NTOK * 1024 * 2;
constexpr size_t WS_KB = WS_QB + (size_t)NTOK * 1024 * 2;
constexpr size_t WS_VBT = WS_KB + (size_t)NTOK * 1024 * 2;
constexpr size_t WS_GA = WS_VBT + (size_t)NTOK * 1024 * 2;
constexpr size_t WS_GB = WS_GA + (size_t)NTOK * D * 2;
constexpr size_t WS_OA = WS_GB + (size_t)NTOK * D * 2;
constexpr size_t WS_OB = WS_OA + (size_t)NTOK * 1024 * 2;
constexpr size_t WS_MRG = WS_OB + (size_t)NTOK * 1024 * 2;
constexpr size_t WS_X1 = WS_MRG + (size_t)NTOK * D * 2;
constexpr size_t WS_H2 = WS_X1 + (size_t)NTOK * D * 4;
constexpr size_t WS_LTOK = WS_H2 + (size_t)NTOK * D * 2;
constexpr size_t WS_LW = WS_LTOK + (size_t)NE * NTOK * 4;
constexpr size_t WS_ACT = WS_LW + (size_t)NE * NTOK * 4;
constexpr size_t WS_Y = WS_ACT + (size_t)(2 * NTOK + 512) * DE * 2;
constexpr size_t WS_WIN_T = WS_Y + (size_t)2 * NTOK * D * 4;
constexpr size_t WS_WPA_T = WS_WIN_T + (size_t)INC * D * 2;
constexpr size_t WS_WPB_T = WS_WPA_T + (size_t)D * 1024 * 2;
constexpr size_t WS_WOUT_T = WS_WPB_T + (size_t)D * 1024 * 2;
constexpr size_t WS_RW = WS_WOUT_T + (size_t)D * D * 2;
constexpr size_t WS_RC = WS_RW + (size_t)NB * 80 * D * 4;
constexpr size_t WS_TREC = WS_RC + 4096;
constexpr size_t WS_END = WS_TREC + (size_t)NTOK * 16;

#define XB_TMO      128
#define XB_XCNT(j)  (256  + 64 * (j))
#define XB_XSUB(j)  (1280 + 64 * (j))
#define XB_XGEN(j)  (2304 + 64 * (j))
#define XB_TOP      3328
#define XB_TOPGEN   3392
#define XCD_BAR_WORDS 3456
#define XB_SPIN_CAP (1u << 24)

__device__ __forceinline__ unsigned xb_ld(unsigned* p)              { return __hip_atomic_load(p, __ATOMIC_RELAXED, __HIP_MEMORY_SCOPE_AGENT); }
__device__ __forceinline__ unsigned xb_add(unsigned* p, unsigned v) { return __hip_atomic_fetch_add(p, v, __ATOMIC_RELAXED, __HIP_MEMORY_SCOPE_AGENT); }
__device__ __forceinline__ unsigned xb_xcc_id() { return (unsigned)__builtin_amdgcn_s_getreg((3 << 11) | 20) & 0xFu; }
#define XB_SPIN(cond, bar) do { unsigned _sp = 0; while (cond) { __builtin_amdgcn_s_sleep(1); \
    if ((++_sp & 255u) == 0u) { if (xb_ld(&(bar)[XB_TMO])) break; if (_sp > XB_SPIN_CAP) { atomicAdd(&(bar)[XB_TMO], 1u); break; } } } } while (0)

struct XcdBarrier { unsigned* bar; unsigned x; volatile LAS unsigned* st; };

__device__ __forceinline__ XcdBarrier xcd_barrier_post(unsigned* bar, volatile LAS unsigned* st, bool leader) {
    XcdBarrier b; b.bar = bar; b.x = xb_xcc_id(); b.st = st;
    if (leader) (void)xb_add(&bar[XB_XCNT(b.x)], 1u);
    return b;
}
__device__ __forceinline__ void xcd_barrier_complete(unsigned* bar, unsigned x, unsigned& nloc, unsigned& nx) {
    const unsigned G = gridDim.x * gridDim.y * gridDim.z;
    unsigned sum, cnt, mine, sp = 0u;
    for (;;) {
        sum = 0u; cnt = 0u; mine = 0u;
#pragma unroll
        for (unsigned j = 0; j < 16; ++j) { const unsigned c = xb_ld(&bar[XB_XCNT(j)]); sum += c; cnt += (c > 0u) ? 1u : 0u; mine = (j == x) ? c : mine; }
        if (sum == G) break;
        __builtin_amdgcn_s_sleep(1);
        if ((++sp & 255u) == 0u) { if (xb_ld(&bar[XB_TMO])) break; if (sp > XB_SPIN_CAP) { atomicAdd(&bar[XB_TMO], 1u); break; } }
    }
    nloc = mine > 0u ? mine : 1u; nx = cnt > 0u ? cnt : 1u;
}
__device__ __forceinline__ void xcd_barrier(const XcdBarrier& b, bool leader) {
    asm volatile("s_waitcnt vmcnt(0)" ::: "memory");
    __syncthreads();
    if (leader) {
        unsigned* bar = b.bar;
        __builtin_amdgcn_s_waitcnt(0);
        unsigned nloc = b.st[0], nx = b.st[1];
        if (nloc == 0u) { xcd_barrier_complete(bar, b.x, nloc, nx); b.st[0] = nloc; b.st[1] = nx; }
        const unsigned old = xb_add(&bar[XB_XSUB(b.x)], 1u);
        const unsigned gen = old / nloc;
        if (old + 1u == (gen + 1u) * nloc) {
            __builtin_amdgcn_fence(__ATOMIC_RELEASE, "agent");
            asm volatile("s_waitcnt vmcnt(0)" ::: "memory");
            const unsigned og = xb_add(&bar[XB_TOP], 1u);
            const unsigned tg = og / nx;
            if (og + 1u == (tg + 1u) * nx) xb_add(&bar[XB_TOPGEN], 1u);
            else XB_SPIN(xb_ld(&bar[XB_TOPGEN]) == tg, bar);
            __builtin_amdgcn_fence(__ATOMIC_ACQUIRE, "agent");
            xb_add(&bar[XB_XGEN(b.x)], 1u);
            asm volatile("s_waitcnt vmcnt(0)" ::: "memory");
        } else {
            XB_SPIN(xb_ld(&bar[XB_XGEN(b.x)]) == gen, bar);
            __builtin_amdgcn_fence(__ATOMIC_ACQUIRE, "agent");
            asm volatile("s_waitcnt vmcnt(0)" ::: "memory");
        }
    }
    __syncthreads();
}

typedef __bf16 bf16v2_t __attribute__((ext_vector_type(2)));
typedef float f32x2 __attribute__((ext_vector_type(2)));
__device__ __forceinline__ unsigned pack_bf16(float lo, float hi) {
    const f32x2 v = {lo, hi};
    return __builtin_bit_cast(unsigned, __builtin_convertvector(v, bf16v2_t));
}
__device__ __forceinline__ float wave_sum(float v) {
#pragma unroll
    for (int o = 32; o > 0; o >>= 1) v += __shfl_xor(v, o);
    return v;
}
__device__ __forceinline__ float xmax16(float v) { const auto r = __builtin_amdgcn_permlane16_swap(__float_as_uint(v), __float_as_uint(v), false, false); return fmaxf(__uint_as_float(r[0]), __uint_as_float(r[1])); }
__device__ __forceinline__ float xmax32(float v) { const auto r = __builtin_amdgcn_permlane32_swap(__float_as_uint(v), __float_as_uint(v), false, false); return fmaxf(__uint_as_float(r[0]), __uint_as_float(r[1])); }
__device__ __forceinline__ float xsum16(float v) { const auto r = __builtin_amdgcn_permlane16_swap(__float_as_uint(v), __float_as_uint(v), false, false); return __uint_as_float(r[0]) + __uint_as_float(r[1]); }
__device__ __forceinline__ float xsum32(float v) { const auto r = __builtin_amdgcn_permlane32_swap(__float_as_uint(v), __float_as_uint(v), false, false); return __uint_as_float(r[0]) + __uint_as_float(r[1]); }
__device__ __forceinline__ float sigmoidf_(float x) { return __builtin_amdgcn_rcpf(1.0f + __builtin_amdgcn_exp2f(-1.4426950408889634f * x)); }

__device__ __forceinline__ int lane_id_fresh() { int l; asm volatile("v_mbcnt_lo_u32_b32 %0, -1, 0\n\tv_mbcnt_hi_u32_b32 %0, -1, %0" : "=v"(l)); return l; }
struct Params { const float* in[24]; float* out; unsigned char* ws; int ph_lo, ph_hi; };

struct Ctx {
    int tid, lane, wid, wr, wc, fr, fq, bid, nblk;
    LAS unsigned char* lds;
};

__device__ __forceinline__ int next_item(unsigned* ctr, const Ctx& c) {
    LAS int* slot = (LAS int*)(c.lds + 160 * 1024 - 64);
    __syncthreads();
    if (c.tid == 0) *slot = (int)__hip_atomic_fetch_add(ctr, 1u, __ATOMIC_RELAXED, __HIP_MEMORY_SCOPE_AGENT);
    __syncthreads();
    return *slot;
}

struct XQueue { unsigned* heads; int x, v; };
__device__ __forceinline__ XQueue xq_make(const Params& p, int qsel) { XQueue q; q.heads = (unsigned*)(p.ws + WS_CTL) + CW_Q + qsel * 512; q.x = (int)(xb_xcc_id() & 7u); q.v = 0; return q; }
__device__ __forceinline__ bool xq_next(XQueue& q, int per_tile, int ntiles, const Ctx& c, int& tile, int& sub) {
    while (q.v < 8) {
        const int qi = (q.x + q.v) & 7;
        const int L = next_item(q.heads + qi * 64, c);
        const int t = qi + 8 * (L / per_tile);
        if (t < ntiles) { tile = t; sub = L % per_tile; return true; }
        ++q.v;
    }
    return false;
}

namespace pg8 {
#define PG8_LAS __attribute__((address_space(3)))
typedef unsigned short bf16_t;
typedef short bf16x8 __attribute__((ext_vector_type(8)));
typedef float f32x4 __attribute__((ext_vector_type(4)));
typedef unsigned u32x4 __attribute__((ext_vector_type(4)));
constexpr int BM = 256, BK = 64, HALF = 128, HTB = HALF * BK * 2  , STAGE_BYTES = 8 * HTB, NXCD = 8, WGM = 8;

__host__ __device__ __forceinline__ int lds_byte(int r, int c) { const int st = (r >> 4) * 2 + (c >> 5), rr = r & 15, cc = c & 31, ob = rr * 64 + cc * 2; return st * 1024 + (ob ^ (((ob >> 9) & 1) << 5)); }
__host__ __device__ __forceinline__ void stage_rc(int b, int& R, int& C) { const int st = b / 1024, sb = b % 1024, swz = sb ^ (((sb >> 9) & 1) << 5); R = (st >> 1) * 16 + swz / 64; C = (st & 1) * 32 + (swz % 64) / 2; }
__host__ __device__ __forceinline__ int perm32(int rho) { const int n = rho >> 4, i = rho & 15; return 8 * (i >> 2) + 4 * n + (i & 3); }

struct Unit { int pm, pn; };
struct Gemm { const bf16_t* A; const bf16_t* Bt; int M, N, K; };

struct StaticOrder {
    int nM, nN, nwg, G, c;
    __host__ __device__ void init(int M, int N, int G_, int c_) { nM = M / BM; nN = N / BM; nwg = nM * nN; G = G_; c = c_; }
    __host__ __device__ bool next(int i, Unit& u) const {
        const long L = (long)i * G + c; if (L >= nwg) return false;
        int wgid = (int)L; { const int q = nwg / NXCD, r = nwg % NXCD, xcd = wgid % NXCD, off = wgid / NXCD; wgid = (xcd < r ? xcd * (q + 1) : r * (q + 1) + (xcd - r) * q) + off; }
        const int nig = WGM * nN, gid = wgid / nig, fm = gid * WGM, gsz = (nM - fm) < WGM ? (nM - fm) : WGM;
        u.pm = fm + ((wgid % nig) % gsz); u.pn = (wgid % nig) / gsz; return true;
    }
    __device__ __forceinline__ void a_ready(const Unit&) const {}
    __device__ __forceinline__ void done(const Unit&) const {}
};
struct NoMid { static constexpr int AT = -1; __device__ __forceinline__ void operator()(f32x4 (&)[2][2][4][2], const Unit&, int, int, int, int) const {} };
template <class Epi, class Sched, bool STAMP = false, class Mid = NoMid>
__device__ __forceinline__ void gemm_phase(PG8_LAS unsigned char* lds, const Gemm g, const Sched& S, const Epi& E, unsigned long long* stamps, const int wid_in, const Mid& MH = Mid()) {
    const int wid = __builtin_amdgcn_readfirstlane(wid_in), lane = lane_id_fresh(), tid = wid * 64 + lane, wr = wid >> 2, wc = wid & 3, fr = lane & 15, fq = lane >> 4;
    const int K = g.K, nt = K / BK;
    int ts_lo = 0, ts_hi = 0, nts = 0; const unsigned long long rt_entry = STAMP ? (unsigned long long)wall_clock64() : 0ull;
#define PG8_STAMP() do { if (STAMP && wid == 0 && nts < 64) { const unsigned long long _c = (unsigned long long)clock64(); \
        ts_lo = (lane == nts) ? (int)(unsigned)_c : ts_lo; ts_hi = (lane == nts) ? (int)(unsigned)(_c >> 32) : ts_hi; ++nts; } } while (0)
    PG8_STAMP();
    unsigned voffA[2], voffB[2];
#pragma unroll
    for (int i = 0; i < 2; ++i) { int R, C; stage_rc(tid * 16 + i * 8192, R, C); const int Rb = Epi::PERM ? ((R & ~31) + perm32(R & 31)) : R;
        voffA[i] = (unsigned)(R * K + C) * 2u; voffB[i] = (unsigned)(Rb * K + C) * 2u; }
    const size_t kstep = (size_t)(BK * 2);
    const size_t hstep = (size_t)HALF * K * 2;
    const size_t tstep = 2 * hstep;
    const unsigned ldsw = (unsigned)wid * 1024u;
    const int aoff = lds_byte(wr * 64 + fr, fq * 8), boff = lds_byte(wc * 32 + fr, fq * 8);
#define PG8_SA(b, h) (((b) * 2 + (h)) * HTB)
#define PG8_SB(b, h) ((4 + (b) * 2 + (h)) * HTB)
#define PG8_STAGE(bufoff, gbase, voff) do { _Pragma("unroll") for (int _i = 0; _i < 2; ++_i) \
        __builtin_amdgcn_global_load_lds((const unsigned*)((const char*)(gbase) + (voff)[_i]), (PG8_LAS unsigned*)(lds + (bufoff) + ldsw + _i * 8192), 16, 0, 0); } while (0)
#define PG8_LDA(dst, b, h) do { _Pragma("unroll") for (int m = 0; m < 4; ++m) _Pragma("unroll") for (int k = 0; k < 2; ++k) dst[m][k] = *(const PG8_LAS bf16x8*)(lds + PG8_SA(b, h) + aoff + m * 2048 + k * 1024); } while (0)
#define PG8_LDB(dst, b, h) do { _Pragma("unroll") for (int n = 0; n < 2; ++n) _Pragma("unroll") for (int k = 0; k < 2; ++k) dst[n][k] = *(const PG8_LAS bf16x8*)(lds + PG8_SB(b, h) + boff + n * 2048 + k * 1024); } while (0)
#define PG8_MMA(ai, bj, At, Bt) do { __builtin_amdgcn_s_setprio(1); _Pragma("unroll") for (int m = 0; m < 4; ++m) _Pragma("unroll") for (int n = 0; n < 2; ++n) _Pragma("unroll") for (int k = 0; k < 2; ++k) \
        acc[ai][bj][m][n] = __builtin_amdgcn_mfma_f32_16x16x32_bf16(Bt[n][k], At[m][k], acc[ai][bj][m][n], 0, 0, 0); __builtin_amdgcn_s_setprio(0); } while (0)
#define PG8_WAIT_V(n) asm volatile("s_waitcnt vmcnt(" #n ")" ::: "memory")
#define PG8_WAIT_L(n) asm volatile("s_waitcnt lgkmcnt(" #n ")" ::: "memory")
#define PG8_BAR __builtin_amdgcn_s_barrier()
#define PG8_SCHED __builtin_amdgcn_sched_barrier(0)
    Unit cur, nxt; int ui = 0;
    if (!S.next(0, cur)) return;
    f32x4 acc[2][2][4][2];
#pragma unroll
    for (int a = 0; a < 2; ++a)
#pragma unroll
        for (int b = 0; b < 2; ++b)
#pragma unroll
            for (int m = 0; m < 4; ++m)
#pragma unroll
                for (int n = 0; n < 2; ++n) acc[a][b][m][n] = (f32x4){0.f, 0.f, 0.f, 0.f};
    bf16x8 At[4][2], B0[2][2], B1[2][2];
    const char* cA = (const char*)g.A + (size_t)cur.pm * tstep; const char* cB = (const char*)g.Bt + (size_t)cur.pn * tstep;
    S.a_ready(cur);
    PG8_STAGE(PG8_SB(0, 0), cB, voffB); PG8_STAGE(PG8_SA(0, 0), cA, voffA); PG8_STAGE(PG8_SB(0, 1), cB + hstep, voffB); PG8_STAGE(PG8_SA(0, 1), cA + hstep, voffA);
    if (wr == 1) PG8_BAR;
    PG8_WAIT_V(4); PG8_BAR;
    PG8_STAGE(PG8_SB(1, 0), cB + kstep, voffB); PG8_STAGE(PG8_SA(1, 0), cA + kstep, voffA); PG8_STAGE(PG8_SB(1, 1), cB + hstep + kstep, voffB);
    PG8_WAIT_V(6); PG8_BAR;
    PG8_STAMP();
    for (;;) {
        const bool has_next = S.next(ui + 1, nxt);
        const char* nA = has_next ? (const char*)g.A + (size_t)nxt.pm * tstep : cA; const char* nB = has_next ? (const char*)g.Bt + (size_t)nxt.pn * tstep : cB;
        for (int t = 0; t < nt; t += 2) {
            if (Mid::AT >= 0 && t == Mid::AT) MH(acc, cur, wr, wc, fr, fq);
            const bool last = (t == nt - 2);
            const char* a1 = cA + (size_t)(t + 1) * kstep;
            const char* a2 = last ? nA : cA + (size_t)(t + 2) * kstep; const char* b2 = last ? nB : cB + (size_t)(t + 2) * kstep;
            const char* a3 = a2 + kstep; const char* b3 = b2 + kstep;
            if (last && has_next) S.a_ready(nxt);
            PG8_LDB(B0, 0, 0); PG8_SCHED; PG8_LDA(At, 0, 0); PG8_STAGE(PG8_SA(1, 1), a1 + hstep, voffA);
            PG8_WAIT_L(8); PG8_BAR; PG8_WAIT_L(0); PG8_MMA(0, 0, At, B0); PG8_BAR; PG8_SCHED;
            PG8_LDB(B1, 0, 1); PG8_STAGE(PG8_SB(0, 0), b2, voffB);
            PG8_BAR; PG8_WAIT_L(0); PG8_MMA(0, 1, At, B1); PG8_BAR;
            PG8_LDA(At, 0, 1); PG8_STAGE(PG8_SA(0, 0), a2, voffA);
            PG8_BAR; PG8_WAIT_L(0); PG8_MMA(1, 0, At, B0); PG8_BAR; PG8_SCHED;
            PG8_STAGE(PG8_SB(0, 1), b2 + hstep, voffB);
            PG8_WAIT_V(6); PG8_BAR; PG8_MMA(1, 1, At, B1); PG8_BAR;
            PG8_LDB(B0, 1, 0); PG8_SCHED; PG8_LDA(At, 1, 0); PG8_STAGE(PG8_SA(0, 1), a2 + hstep, voffA);
            PG8_WAIT_L(8); PG8_BAR; PG8_WAIT_L(0); PG8_MMA(0, 0, At, B0); PG8_BAR; PG8_SCHED;
            PG8_LDB(B1, 1, 1); PG8_STAGE(PG8_SB(1, 0), b3, voffB);
            PG8_BAR; PG8_WAIT_L(0); PG8_MMA(0, 1, At, B1); PG8_BAR;
            PG8_LDA(At, 1, 1); PG8_STAGE(PG8_SA(1, 0), a3, voffA);
            PG8_BAR; PG8_WAIT_L(0); PG8_MMA(1, 0, At, B0); PG8_BAR; PG8_SCHED;
            PG8_STAGE(PG8_SB(1, 1), b3 + hstep, voffB);
            PG8_WAIT_V(6); PG8_BAR; PG8_MMA(1, 1, At, B1); PG8_BAR;
        }
        PG8_STAMP();
        if constexpr (!Epi::AFTER_DRAIN) { E(acc, cur, wr, wc, fr, fq); S.done(cur); }
        PG8_STAMP();
        if (!has_next) break;
#pragma unroll
        for (int a = 0; a < 2; ++a)
#pragma unroll
            for (int b = 0; b < 2; ++b)
#pragma unroll
                for (int m = 0; m < 4; ++m)
#pragma unroll
                    for (int n = 0; n < 2; ++n) acc[a][b][m][n] = (f32x4){0.f, 0.f, 0.f, 0.f};
        cur = nxt; cA = nA; cB = nB; ++ui;
    }
    PG8_WAIT_V(0);
    if (wr == 0) PG8_BAR;
    PG8_BAR;
    if constexpr (Epi::AFTER_DRAIN) { E.fused(acc, cur, wr, wc, fr, fq, lds, wid, lane); S.done(cur); }
    PG8_STAMP();
    if (STAMP && wid == 0) { stamps[lane] = lane < nts ? (((unsigned long long)(unsigned)ts_hi << 32) | (unsigned)ts_lo) : 0ull;
        if (lane == 62) stamps[62] = rt_entry; if (lane == 63) stamps[63] = (unsigned long long)wall_clock64(); }
#undef PG8_STAMP
#undef PG8_SA
#undef PG8_SB
#undef PG8_STAGE
#undef PG8_LDA
#undef PG8_LDB
#undef PG8_MMA
#undef PG8_WAIT_V
#undef PG8_WAIT_L
#undef PG8_BAR
#undef PG8_SCHED
}
}

constexpr int G_STAGE = 49152, G_BOFF = 32768;
template <bool NTB, int K>
__device__ __forceinline__ void gemm_mainloop(f32x4 (&acc)[8][2], const bf16_t* const (&arow)[4], const float* bptr, const int ldb, const Ctx& c) {
    const int lane = c.lane, wid = c.wid;
    constexpr int nt = K >> 6;
    const int half = lane & 1, nq = ((lane >> 1) & 7) | ((lane >> 4) << 3);
    int b_wr[4];
#pragma unroll
    for (int j = 0; j < 4; ++j) { const int n = 4 * nq + j; b_wr[j] = G_BOFF + n * 128 + ((wid ^ ((n >> 1) & 7)) << 4) + half * 8; }
    const int a_wr = wid * 4096 + lane * 16;
    const int fr = c.fr, fq = c.fq;
    int a_rd[2], b_rd[2][2];
#pragma unroll
    for (int kb = 0; kb < 2; ++kb) {
        a_rd[kb] = (128 * c.wr + fr) * 128 + ((((4 * kb + fq) ^ (fr & 7))) << 4);
#pragma unroll
        for (int ni = 0; ni < 2; ++ni) { const int n = 32 * c.wc + 16 * ni + fr; b_rd[kb][ni] = G_BOFF + n * 128 + (((4 * kb + fq) ^ ((n >> 1) & 7)) << 4); }
    }
    u32x4 ra[4]; f32x4 rb0[4], rb1[4];
    bf16x8 A0[8], A1[8], B0[2], B1[2];
#define G_LOADA(T) do { _Pragma("unroll") for (int i = 0; i < 4; ++i) ra[i] = *(const u32x4*)(arow[i] + (T) * 64); } while (0)
#define G_LOADB(RB, T) do { _Pragma("unroll") for (int i = 0; i < 4; ++i) { \
        if (NTB) RB[i] = __builtin_nontemporal_load((const f32x4*)(bptr + (size_t)((T) * 64 + i) * ldb)); else RB[i] = *(const f32x4*)(bptr + (size_t)((T) * 64 + i) * ldb); } } while (0)
#define G_WRITE(ST, RB) do { _Pragma("unroll") for (int i = 0; i < 4; ++i) *(LAS u32x4*)((ST) + a_wr + i * 1024) = ra[i]; \
        _Pragma("unroll") for (int j = 0; j < 4; ++j) { u32x2 w; w.x = pack_bf16(RB[0][j], RB[1][j]); w.y = pack_bf16(RB[2][j], RB[3][j]); *(LAS u32x2*)((ST) + b_wr[j]) = w; } } while (0)
#define G_LDF(ST, kb, AF, BF) do { _Pragma("unroll") for (int ni = 0; ni < 2; ++ni) BF[ni] = *(const LAS bf16x8*)((ST) + b_rd[kb][ni]); \
        _Pragma("unroll") for (int mi = 0; mi < 8; ++mi) AF[mi] = *(const LAS bf16x8*)((ST) + a_rd[kb] + mi * 2048); } while (0)
#define G_MMA(AF, BF) do { _Pragma("unroll") for (int mi = 0; mi < 8; ++mi) _Pragma("unroll") for (int ni = 0; ni < 2; ++ni) \
        acc[mi][ni] = __builtin_amdgcn_mfma_f32_16x16x32_bf16(BF[ni], AF[mi], acc[mi][ni], 0, 0, 0); } while (0)
#define G_SB __builtin_amdgcn_sched_barrier(0)
    LAS unsigned char* st0 = c.lds; LAS unsigned char* st1 = c.lds + G_STAGE;
    constexpr int tl = nt - 1;
    G_LOADA(0); G_LOADB(rb0, 0); G_LOADB(rb1, 1);
    G_WRITE(st0, rb0);
    G_LOADA(1); G_LOADB(rb0, 2);
    __syncthreads();
#pragma unroll 1
    for (int t = 0; t < nt; t += 2) {
        const int t2 = (t + 2 < tl) ? t + 2 : tl, t3 = (t + 3 < tl) ? t + 3 : tl, t4 = (t + 4 < tl) ? t + 4 : tl;
        G_LDF(st0, 0, A0, B0); G_LDF(st0, 1, A1, B1); G_SB;
        G_MMA(A0, B0); G_SB;
        G_WRITE(st1, rb1); G_SB;
        G_MMA(A1, B1); G_SB;
        G_LOADA(t2); G_LOADB(rb1, t3);
        __syncthreads();
        G_LDF(st1, 0, A0, B0); G_LDF(st1, 1, A1, B1); G_SB;
        G_MMA(A0, B0); G_SB;
        G_WRITE(st0, rb0); G_SB;
        G_MMA(A1, B1); G_SB;
        G_LOADA(t3); G_LOADB(rb0, t4);
        __syncthreads();
    }
#undef G_LOADA
#undef G_LOADB
#undef G_WRITE
#undef G_LDF
#undef G_MMA
#undef G_SB
}
constexpr int W_STAGE = 65536, W_BOFF = 32768;
__device__ __forceinline__ int swzb(int n) { return ((n >> 2) & 1) | ((((n >> 1) ^ (n >> 3)) & 1) << 1) | ((((n >> 2) ^ (n >> 4)) & 1) << 2); }
template <int K>
__device__ __forceinline__ void gemm_mainloop256(f32x4 (&acc)[8][4], f32x4 (&rb)[8], const bf16_t* abase, const int (&aoff)[4], const float* bptr, const int ldb, const int nrows, const Ctx& c,
                                                 const bool staged, const int (&aoffn)[4], const float* bptrn, const int nrows_n, const bool hn) {
    const int lane = c.lane, wid = c.wid;
    constexpr int nt = K >> 6;
    int b_wr[2];
#pragma unroll
    for (int jh = 0; jh < 2; ++jh) { const int n = 4 * lane + 2 * jh; b_wr[jh] = W_BOFF + n * 128 + ((wid ^ swzb(n)) << 4); }
    const int a_dma = wid * 4096;
    const int fr = c.fr, fq = c.fq;
    int a_rd[2], b_rd[2][2];
#pragma unroll
    for (int kb = 0; kb < 2; ++kb) {
        a_rd[kb] = (128 * c.wr + fr) * 128 + ((((4 * kb + fq) ^ (fr & 7))) << 4);
#pragma unroll
        for (int ni = 0; ni < 2; ++ni) { const int n = 64 * c.wc + 16 * ni + fr; b_rd[kb][ni] = W_BOFF + n * 128 + (((4 * kb + fq) ^ swzb(n)) << 4); }
    }
    const int nfr = __builtin_amdgcn_readfirstlane(max(0, min(8, (nrows - 128 * c.wr + 15) >> 4)));
    const int npc = __builtin_amdgcn_readfirstlane(max(0, min(4, (nrows - 32 * wid + 7) >> 3)));
    const int npcn = __builtin_amdgcn_readfirstlane(max(0, min(4, (nrows_n - 32 * wid + 7) >> 3)));
    const int n1a = hn ? 64 : 0;
    const size_t n1b = hn ? (size_t)64 * ldb : 0;
#define W_FA(ST, T, NT1) do { const bool nx = ((T) >= nt); const int np = nx ? npcn : npc; \
        _Pragma("unroll") for (int i = 0; i < 4; ++i) if (i < np) \
            __builtin_amdgcn_global_load_lds((const unsigned*)(abase + (nx ? aoffn[i] + ((NT1) ? n1a : 0) : aoff[i] + (T) * 64)), (LAS unsigned*)((ST) + a_dma + i * 1024), 16, 0, 0); } while (0)
#define W_FB(T, NT1) do { const bool nx = ((T) >= nt); \
        const float* bq = nx ? bptrn + ((NT1) ? n1b : 0) : bptr + (size_t)((T) * 64) * ldb; \
        _Pragma("unroll") for (int i = 0; i < 8; ++i) rb[i] = *(const f32x4*)(bq + (size_t)i * ldb); } while (0)
#define W_CVT() do { _Pragma("unroll") for (int j = 0; j < 4; ++j) { wv[j].x = pack_bf16(rb[0][j], rb[1][j]); wv[j].y = pack_bf16(rb[2][j], rb[3][j]); \
            wv[j].z = pack_bf16(rb[4][j], rb[5][j]); wv[j].w = pack_bf16(rb[6][j], rb[7][j]); } } while (0)
#define W_ST(ST) do { _Pragma("unroll") for (int j = 0; j < 4; ++j) *(LAS u32x4*)((ST) + b_wr[j >> 1] + (j & 1) * 128) = wv[j]; } while (0)
#define W_SB __builtin_amdgcn_sched_barrier(0)
#define W_DSR(dst, addr, off) asm volatile("ds_read_b128 %0, %1 offset:%2" : "=v"(dst) : "v"(addr), "i"(off))
#define W_COMPUTE(ST) do { const unsigned stb = (unsigned)(unsigned long)(ST); \
    _Pragma("unroll") for (int kb = 0; kb < 2; ++kb) { bf16x8 bf0, bf1, bf2, bf3, afc, afn; \
        const unsigned ba0 = stb + b_rd[kb][0], ba1 = stb + b_rd[kb][1], aa = stb + a_rd[kb]; \
        W_DSR(bf0, ba0, 0); W_DSR(bf1, ba1, 0); W_DSR(bf2, ba0, 4096); W_DSR(bf3, ba1, 4096); W_DSR(afc, aa, 0); \
        _Pragma("unroll") for (int mi = 0; mi < 8; ++mi) { \
            if (mi < 7) { W_DSR(afn, aa, (mi + 1) * 2048); } \
            if (mi == 0) asm volatile("s_waitcnt lgkmcnt(1)" : "+v"(afc), "+v"(bf0), "+v"(bf1), "+v"(bf2), "+v"(bf3)); \
            else if (mi < 7) asm volatile("s_waitcnt lgkmcnt(1)" : "+v"(afc)); \
            else asm volatile("s_waitcnt lgkmcnt(0)" : "+v"(afc)); \
            if (mi < nfr) { \
                acc[mi][0] = __builtin_amdgcn_mfma_f32_16x16x32_bf16(bf0, afc, acc[mi][0], 0, 0, 0); acc[mi][1] = __builtin_amdgcn_mfma_f32_16x16x32_bf16(bf1, afc, acc[mi][1], 0, 0, 0); \
                acc[mi][2] = __builtin_amdgcn_mfma_f32_16x16x32_bf16(bf2, afc, acc[mi][2], 0, 0, 0); acc[mi][3] = __builtin_amdgcn_mfma_f32_16x16x32_bf16(bf3, afc, acc[mi][3], 0, 0, 0); } \
            afc = afn; } } } while (0)
    LAS unsigned char* st0 = c.lds; LAS unsigned char* st1 = c.lds + W_STAGE;
    u32x4 wv[4];
    if (!staged) {
        W_FA(st0, 0, 0); W_FB(0, 0);
        W_CVT(); W_SB; W_FB(1, 0); W_SB; W_ST(st0);
        asm volatile("s_waitcnt vmcnt(8)" ::: "memory");
        __syncthreads();
        W_FA(st1, 1, 0);
    }
#pragma unroll 1
    for (int t = 0; t < nt; t += 2) {
        W_COMPUTE(st0);
        W_CVT(); W_SB; W_FB(t + 2, 0); W_SB; W_ST(st1);
        asm volatile("s_waitcnt vmcnt(8)" ::: "memory");
        __syncthreads();
        W_FA(st0, t + 2, 0);
        W_COMPUTE(st1);
        W_CVT(); W_SB; W_FB(t + 3, 1); W_SB; W_ST(st0);
        asm volatile("s_waitcnt vmcnt(8)" ::: "memory");
        __syncthreads();
        W_FA(st1, t + 3, 1);
    }
#undef W_FA
#undef W_FB
#undef W_CVT
#undef W_ST
#undef W_SB
#undef W_COMPUTE
#undef W_DSR
}
__device__ __forceinline__ int a_piece_row(const Ctx& c, int i) { return 32 * c.wid + 8 * i + (c.lane >> 3); }
__device__ __forceinline__ int a_piece_col(const Ctx& c) { return 8 * ((c.lane & 7) ^ ((c.lane >> 3) & 7)); }
__device__ __forceinline__ void zero_acc(f32x4 (&acc)[8][2]) {
#pragma unroll
    for (int mi = 0; mi < 8; ++mi)
#pragma unroll
        for (int ni = 0; ni < 2; ++ni) acc[mi][ni] = (f32x4){0.f, 0.f, 0.f, 0.f};
}
__device__ __forceinline__ int b_nq(const Ctx& c) { return ((c.lane >> 1) & 7) | ((c.lane >> 4) << 3); }
__device__ __forceinline__ int b_k0(const Ctx& c) { return 8 * c.wid + 4 * (c.lane & 1); }

__device__ __forceinline__ void phase_mod(const Params& p, const Ctx& c) {
    const float* cc = p.in[1]; const float* w_ada = p.in[3]; const float* b_ada = p.in[4];
    float* mod = (float*)(p.ws + WS_MOD);
    LAS float* sc = (LAS float*)c.lds;
    LAS float* red = (LAS float*)(c.lds + 32768);
    for (int i = c.tid; i < NB * D; i += 512) { const float v = cc[i]; sc[i] = v / (1.0f + __expf(-v)); }
    __syncthreads();
    const int cq = c.tid % 12, kl = c.tid / 12;
    for (int item = c.bid; item < 256; item += c.nblk) {
        float acc[4][4];
#pragma unroll
        for (int b = 0; b < 4; ++b)
#pragma unroll
            for (int j = 0; j < 4; ++j) acc[b][j] = 0.f;
        if (kl < 42) {
            const float* wp = w_ada + item * 48 + cq * 4;
#pragma unroll 8
            for (int k = kl; k < D; k += 42) {
                const f32x4 w = *(const f32x4*)(wp + (size_t)k * NMOD);
#pragma unroll
                for (int b = 0; b < 4; ++b) { const float s = sc[b * D + k];
#pragma unroll
                    for (int j = 0; j < 4; ++j) acc[b][j] += s * w[j]; }
            }
#pragma unroll
            for (int b = 0; b < 4; ++b)
#pragma unroll
                for (int j = 0; j < 4; ++j) red[(kl * 12 + cq) * 16 + b * 4 + j] = acc[b][j];
        }
        __syncthreads();
        if (c.tid < 192) {
            const int b = c.tid / 48, col = c.tid % 48;
            float s = 0.f;
            for (int k2 = 0; k2 < 42; ++k2) s += red[(k2 * 12 + (col >> 2)) * 16 + b * 4 + (col & 3)];
            mod[b * NMOD + item * 48 + col] = s + b_ada[item * 48 + col];
        }
        __syncthreads();
    }
}

struct CvTile { const float* src; bf16_t* dst; int N, ldt; };
__device__ __forceinline__ CvTile cv_tile(const Params& p, const Ctx& c, int t) {
    const float* W; bf16_t* Wt; int N, ldt, koff, kt, ntile;
    if (t < 2560) { W = p.in[6]; Wt = (bf16_t*)(p.ws + WS_WIN_T); N = INC; ldt = D; koff = 0; kt = t & 31; ntile = t >> 5; }
    else if (t < 2816) { const int u = t - 2560; W = p.in[12]; Wt = (bf16_t*)(p.ws + WS_WPA_T); N = D; ldt = D; koff = 0; kt = u & 15; ntile = u >> 4; }
    else if (t < 3072) { const int u = t - 2816; W = p.in[13]; Wt = (bf16_t*)(p.ws + WS_WPA_T); N = D; ldt = D; koff = 1024; kt = u & 15; ntile = u >> 4; }
    else { const int u = t - 3072; W = p.in[14]; Wt = (bf16_t*)(p.ws + WS_WOUT_T); N = D; ldt = D; koff = 0; kt = u & 31; ntile = u >> 5; }
    CvTile r;
    r.src = W + (size_t)(kt * 64 + 8 * c.wid + 4 * (c.lane & 1)) * N + ntile * 128 + 4 * b_nq(c);
    r.dst = Wt + (size_t)(ntile * 128) * ldt + koff + kt * 64;
    r.N = N; r.ldt = ldt;
    return r;
}
__device__ __forceinline__ void phase_convert(const Params& p, const Ctx& c) {
    if (c.bid >= 3584) return;
    const int half = c.lane & 1, nq = b_nq(c);
    const int wo = (4 * nq) * 128 + ((c.wid ^ (nq & 7)) << 4) + half * 8;
    CvTile cur = cv_tile(p, c, c.bid);
    f32x4 rb_[4];
#pragma unroll
    for (int i = 0; i < 4; ++i) rb_[i] = *(const f32x4*)(cur.src + (size_t)i * cur.N);
#pragma unroll 1
    for (int t = c.bid; t < 3584; t += c.nblk) {
        u32x2 w[4];
#pragma unroll
        for (int j = 0; j < 4; ++j) { w[j].x = pack_bf16(rb_[0][j], rb_[1][j]); w[j].y = pack_bf16(rb_[2][j], rb_[3][j]); }
        const CvTile nxt = cv_tile(p, c, (t + c.nblk < 3584) ? t + c.nblk : t);
#pragma unroll
        for (int i = 0; i < 4; ++i) rb_[i] = *(const f32x4*)(nxt.src + (size_t)i * nxt.N);
#pragma unroll
        for (int j = 0; j < 4; ++j) *(LAS u32x2*)(c.lds + wo + j * 128) = w[j];
        __syncthreads();
#pragma unroll
        for (int i = 0; i < 2; ++i) {
            const int idx = c.tid + 512 * i, n = idx >> 3, ch = idx & 7;
            const u32x4 v = *(const LAS u32x4*)(c.lds + n * 128 + ((ch ^ ((n >> 2) & 7)) << 4));
            *(u32x4*)(cur.dst + (size_t)n * cur.ldt + ch * 8) = v;
        }
        __syncthreads();
        cur = nxt;
    }
}

__device__ __forceinline__ void phase_norm1(const Params& p, const Ctx& c) {
    const float* x = p.in[0]; const float* g = p.in[5];
    const float* mod = (const float*)(p.ws + WS_MOD);
    bf16_t* h = (bf16_t*)(p.ws + WS_H);
    for (int row = c.bid * 8 + c.wid; row < NTOK; row += c.nblk * 8) {
        const int b = row >> 11;
        f32x4 v[8]; float ss = 0.f;
#pragma unroll
        for (int i = 0; i < 8; ++i) { v[i] = *(const f32x4*)(x + (size_t)row * D + i * 256 + c.lane * 4); ss += v[i][0] * v[i][0] + v[i][1] * v[i][1] + v[i][2] * v[i][2] + v[i][3] * v[i][3]; }
        ss = wave_sum(ss);
        const float rstd = rsqrtf(ss * (1.0f / D) + EPS);
#pragma unroll
        for (int i = 0; i < 8; ++i) {
            const int col = i * 256 + c.lane * 4;
            const f32x4 gg = *(const f32x4*)(g + col), sh = *(const f32x4*)(mod + b * NMOD + col), scl = *(const f32x4*)(mod + b * NMOD + D + col);
            float o[4];
#pragma unroll
            for (int j = 0; j < 4; ++j) o[j] = (v[i][j] * rstd * gg[j]) * (1.0f + scl[j]) + sh[j];
            u32x2 w; w.x = pack_bf16(o[0], o[1]); w.y = pack_bf16(o[2], o[3]);
            *(u32x2*)(h + (size_t)row * D + col) = w;
        }
    }
}

__device__ __forceinline__ void phase_router_prep(const Params& p, const Ctx& c) {
    const float* mod = (const float*)(p.ws + WS_MOD); const float* g = p.in[15];
    const float* w_rg = p.in[16]; const float* b_rg = p.in[17]; const float* w_re = p.in[18]; const float* b_re = p.in[19];
    bf16_t* WtH = (bf16_t*)(p.ws + WS_RW); bf16_t* WtL = WtH + (size_t)NB * 80 * D; float* cb = (float*)(p.ws + WS_RC);
    for (int task = c.bid * 8 + c.wid; task < NB * 80; task += c.nblk * 8) {
        const int b = task / 80, j = task % 80;
        float cs = 0.f;
        for (int k = c.lane; k < D; k += 64) {
            float w = 0.f;
            if (j < 8) w = w_rg[(size_t)k * 8 + j]; else if (j < 72) w = w_re[(size_t)k * 64 + (j - 8)];
            const float wv = g[k] * (1.0f + mod[b * NMOD + 4 * D + k]) * w;
            const unsigned hi = pack_bf16(wv, 0.f) & 0xffffu; const float hif = __uint_as_float(hi << 16);
            WtH[((size_t)b * 80 + j) * D + k] = (bf16_t)hi; WtL[((size_t)b * 80 + j) * D + k] = (bf16_t)(pack_bf16(wv - hif, 0.f) & 0xffffu);
            cs += mod[b * NMOD + 3 * D + k] * w;
        }
        cs = wave_sum(cs);
        if (c.lane == 0) cb[b * 80 + j] = cs + (j < 8 ? b_rg[j] : (j < 72 ? b_re[j - 8] : 0.f));
    }
}

__device__ __forceinline__ void phase_proj_in(const Params& p, const Ctx& c) {
    const bf16_t* h = (const bf16_t*)(p.ws + WS_H); const float* w_in = p.in[6];
    for (int item = c.bid; item < 32 * 80; item += c.nblk) {
        const int mt = item & 31, ntile = item >> 5;
        const int m0 = mt * 256, n0 = ntile * 128;
        const bf16_t* arow[4];
#pragma unroll
        for (int i = 0; i < 4; ++i) arow[i] = h + (size_t)(m0 + a_piece_row(c, i)) * D + a_piece_col(c);
        const float* bptr = w_in + (size_t)b_k0(c) * INC + n0 + 4 * b_nq(c);
        f32x4 acc[8][2]; zero_acc(acc);
        gemm_mainloop<false, D>(acc, arow, bptr, INC, c);
        const int region = n0 >> 10;
#pragma unroll
        for (int mi = 0; mi < 8; ++mi)
#pragma unroll
            for (int ni = 0; ni < 2; ++ni) {
                const int row = m0 + 128 * c.wr + 16 * mi + c.fr;
                const int col = n0 + 32 * c.wc + 16 * ni + 4 * c.fq;
                const f32x4 a = acc[mi][ni];
                if (region < 6) {
                    const int cin = col & 1023;
                    if (region == 2 || region == 5) {
                        bf16_t* vt = (bf16_t*)(p.ws + (region == 2 ? WS_VAT : WS_VBT));
                        const int b = row >> 11, s = row & 2047, hh = cin >> 7, d = cin & 127;
                        const unsigned w0 = pack_bf16(a[0], a[1]), w1 = pack_bf16(a[2], a[3]);
                        bf16_t* base = vt + ((size_t)((b * 8 + hh) * 128 + d)) * SEQ + s;
                        base[0] = (bf16_t)(w0 & 0xffff); base[SEQ] = (bf16_t)(w0 >> 16); base[2 * SEQ] = (bf16_t)(w1 & 0xffff); base[3 * SEQ] = (bf16_t)(w1 >> 16);
                    } else {
                        const size_t off = region == 0 ? WS_QA : region == 1 ? WS_KA : region == 3 ? WS_QB : WS_KB;
                        bf16_t* dst = (bf16_t*)(p.ws + off);
                        u32x2 w; w.x = pack_bf16(a[0], a[1]); w.y = pack_bf16(a[2], a[3]);
                        *(u32x2*)(dst + (size_t)row * 1024 + cin) = w;
                    }
                } else {
                    bf16_t* dst = (bf16_t*)(p.ws + (region < 8 ? WS_GA : WS_GB));
                    const int cin = col - (region < 8 ? 6144 : 8192);
                    u32x2 w; w.x = pack_bf16(sigmoidf_(a[0]), sigmoidf_(a[1])); w.y = pack_bf16(sigmoidf_(a[2]), sigmoidf_(a[3]));
                    *(u32x2*)(dst + (size_t)row * D + cin) = w;
                }
            }
    }
}

constexpr int AT_STAGE = 32768, AT_VOFF = 16384, AT_BIAS = 98304;
__device__ __forceinline__ int rel_bucket_dev(int n) {
    if (n < 16) return n;
    int b = 16;
    b += (n >= 19) + (n >= 21) + (n >= 24) + (n >= 27) + (n >= 31) + (n >= 35) + (n >= 40) + (n >= 46) + (n >= 52) + (n >= 59) + (n >= 67) + (n >= 77) + (n >= 87) + (n >= 99) + (n >= 113);
    return b;
}
struct KVRegs { u32x4 k[2], v[2]; };
__device__ __forceinline__ void kv_load(KVRegs& r, const bf16_t* kbase, const bf16_t* vtbase, int kt, const Ctx& c) {
#pragma unroll
    for (int i = 0; i < 2; ++i) {
        const int key = (c.tid >> 4) + 32 * i, ck = c.tid & 15;
        r.k[i] = *(const u32x4*)(kbase + (size_t)(kt * 64 + key) * 1024 + ck * 8);
        const int d = (c.tid >> 3) + 64 * i, cv = c.tid & 7;
        r.v[i] = *(const u32x4*)(vtbase + (size_t)d * SEQ + kt * 64 + cv * 8);
    }
}
__device__ __forceinline__ void kv_store(const KVRegs& r, LAS unsigned char* st, const Ctx& c) {
#pragma unroll
    for (int i = 0; i < 2; ++i) {
        const int key = (c.tid >> 4) + 32 * i, ck = c.tid & 15;
        *(LAS u32x4*)(st + key * 256 + ((ck ^ (key & 15)) << 4)) = r.k[i];
        const int d = (c.tid >> 3) + 64 * i, cv = c.tid & 7;
        *(LAS u32x4*)(st + AT_VOFF + d * 128 + ((cv ^ ((d >> 1) & 7)) << 4)) = r.v[i];
    }
}
__device__ __forceinline__ bf16x8 v_frag(LAS unsigned char* st, int nf, int kb2, const Ctx& c) {
    const int d = 16 * nf + c.fr; const int sw = (c.fr >> 1) & 7;
    return *(const LAS bf16x8*)(st + AT_VOFF + d * 128 + (((4 * kb2 + c.fq) ^ sw) << 4));
}
__device__ __forceinline__ bf16x8 pack_p(const f32x4& a, const f32x4& b) {
    u32x4 w; w.x = pack_bf16(a[0], a[1]); w.y = pack_bf16(a[2], a[3]); w.z = pack_bf16(b[0], b[1]); w.w = pack_bf16(b[2], b[3]);
    return __builtin_bit_cast(bf16x8, w);
}

__device__ __forceinline__ void diff_attn_item(const Params& p, const Ctx& c, int b, int h, int qb, float lam, bf16x8 (&qf)[4], KVRegs& kr,
                                               const bf16_t* qn, const bf16_t* kbn, const bf16_t* vtn, const int ktn) {
    const bf16_t* ka = (const bf16_t*)(p.ws + WS_KA); const bf16_t* vat = (const bf16_t*)(p.ws + WS_VAT);
    bf16_t* oa = (bf16_t*)(p.ws + WS_OA);
    const float* rel = p.in[2]; const float* gsub = p.in[11];
    LAS float* bias = (LAS float*)(c.lds + AT_BIAS);
    __syncthreads();
    if (c.tid < 128) bias[c.tid] = rel[rel_bucket_dev(c.tid) * 8 + h] * 1.4426950408889634f;
    const int qpos = 128 * qb + 16 * c.wid + c.fr;
    const size_t qtok = (size_t)b * SEQ + qpos;
    const bf16_t* kbase = ka + (size_t)b * SEQ * 1024 + h * 128;
    const bf16_t* vtbase = vat + (size_t)((b * 8 + h) * 128) * SEQ;
    f32x4 O1[8], O2[8];
#pragma unroll
    for (int nf = 0; nf < 8; ++nf) { O1[nf] = (f32x4){0.f, 0.f, 0.f, 0.f}; O2[nf] = (f32x4){0.f, 0.f, 0.f, 0.f}; }
    float m1 = -1e30f, m2 = -1e30f, l1 = 0.f, l2 = 0.f;
    const int ntiles = 2 * qb + 2;
    const int qmax_w = 128 * qb + 16 * c.wid + 15, qmin_w = 128 * qb + 16 * c.wid;
    const float L2E = 1.4426950408889634f;
    const bool defer = c.wid >= 4;
    bf16x8 pq1[2], pq2[2]; bool pend = false;
#pragma unroll
    for (int kb2 = 0; kb2 < 2; ++kb2) { pq1[kb2] = (bf16x8){0, 0, 0, 0, 0, 0, 0, 0}; pq2[kb2] = pq1[kb2]; }
    int sidx = 0, sprev = 2;
    for (int kt = 0; kt < ntiles; ++kt) {
        LAS unsigned char* st = c.lds + sidx * AT_STAGE;
        kv_store(kr, st, c);
        { const bool last = (kt + 1 >= ntiles);
          kv_load(kr, last ? kbn : kbase, last ? vtn : vtbase, last ? ktn : kt + 1, c); }
        __syncthreads();
        if (pend) {
            LAS unsigned char* sp = c.lds + sprev * AT_STAGE;
#pragma unroll
            for (int kb2 = 0; kb2 < 2; ++kb2)
#pragma unroll
                for (int nf = 0; nf < 8; ++nf) {
                    const bf16x8 vf = v_frag(sp, nf, kb2, c);
                    O1[nf] = __builtin_amdgcn_mfma_f32_16x16x32_bf16(vf, pq1[kb2], O1[nf], 0, 0, 0);
                    O2[nf] = __builtin_amdgcn_mfma_f32_16x16x32_bf16(vf, pq2[kb2], O2[nf], 0, 0, 0);
                }
            pend = false;
        }
        if (64 * kt <= qmax_w) {
            f32x4 s1[4], s2[4];
#pragma unroll
            for (int f = 0; f < 4; ++f) {
                bf16x8 kf[4];
#pragma unroll
                for (int kb = 0; kb < 4; ++kb) kf[kb] = *(const LAS bf16x8*)(st + (16 * f + c.fr) * 256 + (((4 * kb + c.fq) ^ c.fr) << 4));
                f32x4 z = (f32x4){0.f, 0.f, 0.f, 0.f};
                z = __builtin_amdgcn_mfma_f32_16x16x32_bf16(kf[0], qf[0], z, 0, 0, 0);
                s1[f] = __builtin_amdgcn_mfma_f32_16x16x32_bf16(kf[1], qf[1], z, 0, 0, 0);
                z = (f32x4){0.f, 0.f, 0.f, 0.f};
                z = __builtin_amdgcn_mfma_f32_16x16x32_bf16(kf[2], qf[2], z, 0, 0, 0);
                s2[f] = __builtin_amdgcn_mfma_f32_16x16x32_bf16(kf[3], qf[3], z, 0, 0, 0);
            }
            const bool nearb = (qmin_w - (64 * kt + 63)) < 113;
            const float CS = 0.125f * L2E, THR = 8.0f;
            float mx1, mx2;
            if (!nearb) {
                const float bf_ = bias[127];
                float r1 = s1[0][0], r2 = s2[0][0];
#pragma unroll
                for (int f = 0; f < 4; ++f)
#pragma unroll
                    for (int r = 0; r < 4; ++r) { r1 = fmaxf(r1, s1[f][r]); r2 = fmaxf(r2, s2[f][r]); }
                mx1 = r1 * CS + bf_; mx2 = r2 * CS + bf_;
            } else {
                mx1 = -1e30f; mx2 = -1e30f;
#pragma unroll
                for (int f = 0; f < 4; ++f)
#pragma unroll
                    for (int r = 0; r < 4; ++r) {
                        const int n = qpos - (64 * kt + 16 * f + 4 * c.fq + r);
                        const float bv = bias[n < 0 ? 0 : (n > 127 ? 127 : n)];
                        float a1 = s1[f][r] * CS + bv, a2 = s2[f][r] * CS + bv;
                        if (n < 0) { a1 = -1e30f; a2 = -1e30f; }
                        s1[f][r] = a1; s2[f][r] = a2;
                        mx1 = fmaxf(mx1, a1); mx2 = fmaxf(mx2, a2);
                    }
            }
            mx1 = xmax32(xmax16(mx1)); mx2 = xmax32(xmax16(mx2));
            if (__any((mx1 - m1 > THR) || (mx2 - m2 > THR))) {
                const float mn1 = fmaxf(m1, mx1), mn2 = fmaxf(m2, mx2);
                const float al1 = __builtin_amdgcn_exp2f(m1 - mn1), al2 = __builtin_amdgcn_exp2f(m2 - mn2);
                m1 = mn1; m2 = mn2; l1 *= al1; l2 *= al2;
#pragma unroll
                for (int nf = 0; nf < 8; ++nf) { O1[nf] *= al1; O2[nf] *= al2; }
            }
            if (!nearb) {
                const float d1 = bias[127] - m1, d2 = bias[127] - m2;
#pragma unroll
                for (int f = 0; f < 4; ++f) { s1[f] = s1[f] * CS + d1; s2[f] = s2[f] * CS + d2; }
            } else {
#pragma unroll
                for (int f = 0; f < 4; ++f) { s1[f] = s1[f] - m1; s2[f] = s2[f] - m2; }
            }
            float ps1 = 0.f, ps2 = 0.f;
#pragma unroll
            for (int f = 0; f < 4; ++f)
#pragma unroll
                for (int r = 0; r < 4; ++r) {
                    const float e1 = __builtin_amdgcn_exp2f(s1[f][r]), e2 = __builtin_amdgcn_exp2f(s2[f][r]);
                    s1[f][r] = e1; s2[f][r] = e2; ps1 += e1; ps2 += e2;
                }
            l1 += ps1; l2 += ps2;
#pragma unroll
            for (int kb2 = 0; kb2 < 2; ++kb2) { pq1[kb2] = pack_p(s1[2 * kb2], s1[2 * kb2 + 1]); pq2[kb2] = pack_p(s2[2 * kb2], s2[2 * kb2 + 1]); }
            if (defer) pend = true;
            else {
#pragma unroll
                for (int kb2 = 0; kb2 < 2; ++kb2)
#pragma unroll
                    for (int nf = 0; nf < 8; ++nf) {
                        const bf16x8 vf = v_frag(st, nf, kb2, c);
                        O1[nf] = __builtin_amdgcn_mfma_f32_16x16x32_bf16(vf, pq1[kb2], O1[nf], 0, 0, 0);
                        O2[nf] = __builtin_amdgcn_mfma_f32_16x16x32_bf16(vf, pq2[kb2], O2[nf], 0, 0, 0);
                    }
            }
        }
        sprev = sidx; sidx = (sidx == 2) ? 0 : sidx + 1;
    }
    if (pend) {
        LAS unsigned char* sp = c.lds + sprev * AT_STAGE;
#pragma unroll
        for (int kb2 = 0; kb2 < 2; ++kb2)
#pragma unroll
            for (int nf = 0; nf < 8; ++nf) {
                const bf16x8 vf = v_frag(sp, nf, kb2, c);
                O1[nf] = __builtin_amdgcn_mfma_f32_16x16x32_bf16(vf, pq1[kb2], O1[nf], 0, 0, 0);
                O2[nf] = __builtin_amdgcn_mfma_f32_16x16x32_bf16(vf, pq2[kb2], O2[nf], 0, 0, 0);
            }
    }
#pragma unroll
    for (int kb = 0; kb < 4; ++kb) qf[kb] = *(const bf16x8*)(qn + 32 * kb + 8 * c.fq);
    l1 = xsum32(xsum16(l1)); l2 = xsum32(xsum16(l2));
    const float i1 = 1.0f / l1, i2 = lam / l2;
    float ss = 0.f;
#pragma unroll
    for (int nf = 0; nf < 8; ++nf)
#pragma unroll
        for (int r = 0; r < 4; ++r) { const float o = O1[nf][r] * i1 - O2[nf][r] * i2; O1[nf][r] = o; ss += o * o; }
    ss += __shfl_xor(ss, 16); ss += __shfl_xor(ss, 32);
    const float rstd = rsqrtf(ss * (1.0f / 128.0f) + EPS) * 0.8f;
#pragma unroll
    for (int nf = 0; nf < 8; ++nf) {
        const int d = 16 * nf + 4 * c.fq;
        const f32x4 g = *(const f32x4*)(gsub + d);
        u32x2 w; w.x = pack_bf16(O1[nf][0] * rstd * g[0], O1[nf][1] * rstd * g[1]); w.y = pack_bf16(O1[nf][2] * rstd * g[2], O1[nf][3] * rstd * g[3]);
        *(u32x2*)(oa + qtok * 2048 + h * 128 + d) = w;
    }
}

__device__ __forceinline__ void sb_attn_item(const Params& p, const Ctx& c, int b, int h, int qb, bf16x8 (&qf)[4], KVRegs& kr,
                                             const bf16_t* qn, const bf16_t* kbn, const bf16_t* vtn, const int ktn) {
    const bf16_t* kbuf = (const bf16_t*)(p.ws + WS_KB); const bf16_t* vbt = (const bf16_t*)(p.ws + WS_VBT);
    bf16_t* ob = (bf16_t*)(p.ws + WS_OA) + 1024;
    __syncthreads();
    const int qpos = 128 * qb + 16 * c.wid + c.fr;
    const size_t qtok = (size_t)b * SEQ + qpos;
    const bf16_t* kbase = kbuf + (size_t)b * SEQ * 1024 + h * 128;
    const bf16_t* vtbase = vbt + (size_t)((b * 8 + h) * 128) * SEQ;
    f32x4 O[8];
#pragma unroll
    for (int nf = 0; nf < 8; ++nf) O[nf] = (f32x4){0.f, 0.f, 0.f, 0.f};
    float carry = 0.f;
    const int ntiles = 2 * qb + 2;
    const int qmax_w = 128 * qb + 16 * c.wid + 15;
    const float scale = 0.08838834764831845f * 1.4426950408889634f;
    LAS int* dflag = (LAS int*)(c.lds + AT_BIAS + 1024);
    if (c.lane == 0) dflag[c.wid] = 0;
    bool wdone = false, nxt = false;
    for (int it = 0; it < ntiles; ++it) {
        const int kt = ntiles - 1 - it;
        LAS unsigned char* st = c.lds + (it & 1) * AT_STAGE;
        kv_store(kr, st, c);
        __syncthreads();
        {
            int alld = 1;
#pragma unroll
            for (int w8 = 0; w8 < 8; ++w8) alld &= dflag[w8];
            if (alld) break;
        }
        { const bool last = (kt == 0);
          kv_load(kr, last ? kbn : kbase, last ? vtn : vtbase, last ? ktn : kt - 1, c); nxt = last; }
        if (!wdone && 64 * kt < qmax_w) {
            f32x4 z[4];
#pragma unroll
            for (int f = 0; f < 4; ++f) {
                f32x4 a = (f32x4){0.f, 0.f, 0.f, 0.f};
#pragma unroll
                for (int kb = 0; kb < 4; ++kb) {
                    const bf16x8 kf = *(const LAS bf16x8*)(st + (16 * f + c.fr) * 256 + (((4 * kb + c.fq) ^ c.fr) << 4));
                    a = __builtin_amdgcn_mfma_f32_16x16x32_bf16(kf, qf[kb], a, 0, 0, 0);
                }
                z[f] = a;
            }
            f32x4 lb[4], lk[4]; float T[4];
#pragma unroll
            for (int f = 0; f < 4; ++f) {
                float t = 0.f;
#pragma unroll
                for (int r = 0; r < 4; ++r) {
                    const int kpos = 64 * kt + 16 * f + 4 * c.fq + r;
                    const float zz = z[f][r] * scale;
                    const float sp = __builtin_amdgcn_logf(1.0f + __builtin_amdgcn_exp2f(-fabsf(zz)));
                    const float lbv = fminf(zz, 0.f) - sp;
                    const bool valid = kpos < qpos;
                    const float lkv = valid ? (lbv - zz) : 0.f;
                    lb[f][r] = valid ? lbv : -1e30f; lk[f][r] = lkv; t += lkv;
                }
                T[f] = t;
            }
            float tile_tot = 0.f; float Gl[4], Ft[4];
#pragma unroll
            for (int f = 0; f < 4; ++f) {
                const float A1 = __shfl_xor(T[f], 16), A2 = __shfl_xor(T[f], 32), A3 = __shfl_xor(T[f], 48);
                Gl[f] = ((c.fq & 1) == 0 ? A1 : 0.f) + ((c.fq & 2) == 0 ? (A2 + A3) : 0.f);
                Ft[f] = T[f] + A1 + A2 + A3; tile_tot += Ft[f];
            }
            float after = carry;
#pragma unroll
            for (int f = 3; f >= 0; --f) {
                float suf = 0.f;
#pragma unroll
                for (int r = 3; r >= 0; --r) {
                    const float later = after + Gl[f] + suf;
                    z[f][r] = __builtin_amdgcn_exp2f(lb[f][r] + later);
                    suf += lk[f][r];
                }
                after += Ft[f];
            }
            carry += tile_tot;
#pragma unroll
            for (int kb2 = 0; kb2 < 2; ++kb2) {
                const bf16x8 pp = pack_p(z[2 * kb2], z[2 * kb2 + 1]);
#pragma unroll
                for (int nf = 0; nf < 8; ++nf) {
                    const bf16x8 vf = v_frag(st, nf, kb2, c);
                    O[nf] = __builtin_amdgcn_mfma_f32_16x16x32_bf16(vf, pp, O[nf], 0, 0, 0);
                }
            }
            if (__all(carry < -64.0f)) { wdone = true; if (c.lane == 0) dflag[c.wid] = 1; }
        }
    }
    if (!nxt) kv_load(kr, kbn, vtn, ktn, c);
#pragma unroll
    for (int kb = 0; kb < 4; ++kb) qf[kb] = *(const bf16x8*)(qn + 32 * kb + 8 * c.fq);
#pragma unroll
    for (int nf = 0; nf < 8; ++nf) {
        const int d = 16 * nf + 4 * c.fq;
        u32x2 w; w.x = pack_bf16(O[nf][0], O[nf][1]); w.y = pack_bf16(O[nf][2], O[nf][3]);
        *(u32x2*)(ob + qtok * 2048 + h * 128 + d) = w;
    }
}

__device__ __forceinline__ void attn_sub(const Params& p, const Ctx& c, int sub, int& kind, int& bh, int& qb, const bf16_t*& qp, const bf16_t*& kb, const bf16_t*& vt, int& kt0) {
    const int kh = sub >> 8, i2 = sub & 255, half = kh & 1, pr = i2 >> 5;
    kind = kh >> 1; bh = i2 & 31; qb = half ? pr : 15 - pr;
    const int b = bh >> 3, h = bh & 7;
    const size_t qtok = (size_t)b * SEQ + 128 * qb + 16 * c.wid + c.fr;
    qp = (const bf16_t*)(p.ws + (kind ? WS_QB : WS_QA)) + qtok * 1024 + h * 128;
    kb = (const bf16_t*)(p.ws + (kind ? WS_KB : WS_KA)) + (size_t)b * SEQ * 1024 + h * 128;
    vt = (const bf16_t*)(p.ws + (kind ? WS_VBT : WS_VAT)) + (size_t)(bh * 128) * SEQ;
    kt0 = kind ? 2 * qb + 1 : 0;
}
__device__ __forceinline__ void phase_attn(const Params& p, const Ctx& c, int qsel = 0) {
    float d1 = 0.f, d2 = 0.f;
    if (c.lane < 64) { d1 = p.in[7][c.lane] * p.in[8][c.lane]; d2 = p.in[9][c.lane] * p.in[10][c.lane]; }
    d1 = wave_sum(d1); d2 = wave_sum(d2);
    const float lam = expf(d1) - expf(d2) + 0.2f;
    (void)qsel;
    if (c.bid >= 1024) return;
    int kind, bh, qb, kt0; const bf16_t* qp; const bf16_t* kb; const bf16_t* vt;
    attn_sub(p, c, c.bid, kind, bh, qb, qp, kb, vt, kt0);
    bf16x8 qf[4]; KVRegs kr;
#pragma unroll
    for (int k4 = 0; k4 < 4; ++k4) qf[k4] = *(const bf16x8*)(qp + 32 * k4 + 8 * c.fq);
    kv_load(kr, kb, vt, kt0, c);
#pragma unroll 1
    for (int sub = c.bid; sub < 1024; sub += c.nblk) {
        int kindn, bhn, qbn, kt0n; const bf16_t* qpn; const bf16_t* kbn; const bf16_t* vtn;
        attn_sub(p, c, (sub + c.nblk < 1024) ? sub + c.nblk : sub, kindn, bhn, qbn, qpn, kbn, vtn, kt0n);
        if (kind == 0) diff_attn_item(p, c, bh >> 3, bh & 7, qb, lam, qf, kr, qpn, kbn, vtn, kt0n);
        else sb_attn_item(p, c, bh >> 3, bh & 7, qb, qf, kr, qpn, kbn, vtn, kt0n);
        kind = kindn; bh = bhn; qb = qbn;
    }
}

__device__ __forceinline__ void phase_merge(const Params& p, const Ctx& c) {
    const bf16_t* oa = (const bf16_t*)(p.ws + WS_OA); const bf16_t* ob = (const bf16_t*)(p.ws + WS_OB);
    const bf16_t* ga = (const bf16_t*)(p.ws + WS_GA); const bf16_t* gb = (const bf16_t*)(p.ws + WS_GB);
    bf16_t* mrg = (bf16_t*)(p.ws + WS_MRG);
    for (int item = c.bid; item < 32 * 16; item += c.nblk) {
        const int mt = item & 31, ntile = item >> 5;
        const int m0 = mt * 256, n0 = ntile * 128;
        f32x4 acc[8][2];
#pragma unroll 1
        for (int pass = 0; pass < 2; ++pass) {
            const bf16_t* A = pass ? ob : oa; const float* W = pass ? p.in[13] : p.in[12]; const bf16_t* G = pass ? gb : ga;
            const bf16_t* arow[4];
#pragma unroll
            for (int i = 0; i < 4; ++i) arow[i] = A + (size_t)(m0 + a_piece_row(c, i)) * 1024 + a_piece_col(c);
            const float* bptr = W + (size_t)b_k0(c) * D + n0 + 4 * b_nq(c);
            zero_acc(acc);
            gemm_mainloop<false, 1024>(acc, arow, bptr, D, c);
            float* tmp = (float*)(p.ws + WS_X1);
#pragma unroll
            for (int mi = 0; mi < 8; ++mi)
#pragma unroll
                for (int ni = 0; ni < 2; ++ni) {
                    const int row = m0 + 128 * c.wr + 16 * mi + c.fr;
                    const int col = n0 + 32 * c.wc + 16 * ni + 4 * c.fq;
                    const u32x2 gw = *(const u32x2*)(G + (size_t)row * D + col);
                    f32x4 g; g[0] = __uint_as_float(gw.x << 16); g[1] = __uint_as_float(gw.x & 0xffff0000u); g[2] = __uint_as_float(gw.y << 16); g[3] = __uint_as_float(gw.y & 0xffff0000u);
                    f32x4 v = acc[mi][ni] * g;
                    if (pass == 0) *(f32x4*)(tmp + (size_t)row * D + col) = v;
                    else {
                        v += *(const f32x4*)(tmp + (size_t)row * D + col);
                        u32x2 w; w.x = pack_bf16(v[0], v[1]); w.y = pack_bf16(v[2], v[3]);
                        *(u32x2*)(mrg + (size_t)row * D + col) = w;
                    }
                }
        }
    }
}

__device__ __forceinline__ void phase_out(const Params& p, const Ctx& c) {
    const bf16_t* mrg = (const bf16_t*)(p.ws + WS_MRG); const float* w_out = p.in[14]; const float* x = p.in[0];
    const float* mod = (const float*)(p.ws + WS_MOD);
    float* x1 = (float*)(p.ws + WS_X1);
    for (int item = c.bid; item < 32 * 16; item += c.nblk) {
        const int mt = item & 31, ntile = item >> 5;
        const int m0 = mt * 256, n0 = ntile * 128;
        const bf16_t* arow[4];
#pragma unroll
        for (int i = 0; i < 4; ++i) arow[i] = mrg + (size_t)(m0 + a_piece_row(c, i)) * D + a_piece_col(c);
        const float* bptr = w_out + (size_t)b_k0(c) * D + n0 + 4 * b_nq(c);
        f32x4 acc[8][2]; zero_acc(acc);
        gemm_mainloop<false, D>(acc, arow, bptr, D, c);
        const int b = m0 >> 11;
#pragma unroll
        for (int mi = 0; mi < 8; ++mi)
#pragma unroll
            for (int ni = 0; ni < 2; ++ni) {
                const int row = m0 + 128 * c.wr + 16 * mi + c.fr;
                const int col = n0 + 32 * c.wc + 16 * ni + 4 * c.fq;
                const f32x4 gm = *(const f32x4*)(mod + b * NMOD + 2 * D + col);
                const f32x4 xv = *(const f32x4*)(x + (size_t)row * D + col);
                *(f32x4*)(x1 + (size_t)row * D + col) = xv + gm * acc[mi][ni];
            }
    }
}

__device__ __forceinline__ void phase_norm2_route(const Params& p, const Ctx& c) {
    const float* x1 = (const float*)(p.ws + WS_X1); const float* g = p.in[15];
    const float* mod = (const float*)(p.ws + WS_MOD);
    const float* w_rg = p.in[16]; const float* b_rg = p.in[17]; const float* w_re = p.in[18]; const float* b_re = p.in[19];
    bf16_t* h2 = (bf16_t*)(p.ws + WS_H2);
    unsigned* cnt = (unsigned*)(p.ws + WS_CTL) + CW_CNT;
    int* ltok = (int*)(p.ws + WS_LTOK); float* lw = (float*)(p.ws + WS_LW);
    for (int row = c.bid * 8 + c.wid; row < NTOK; row += c.nblk * 8) {
        const int b = row >> 11;
        f32x4 v[8]; float ss = 0.f;
#pragma unroll
        for (int i = 0; i < 8; ++i) { v[i] = *(const f32x4*)(x1 + (size_t)row * D + i * 256 + c.lane * 4); ss += v[i][0] * v[i][0] + v[i][1] * v[i][1] + v[i][2] * v[i][2] + v[i][3] * v[i][3]; }
        ss = wave_sum(ss);
        const float rstd = rsqrtf(ss * (1.0f / D) + EPS);
        float gl[8];
#pragma unroll
        for (int j = 0; j < 8; ++j) gl[j] = 0.f;
#pragma unroll
        for (int i = 0; i < 8; ++i) {
            const int col = i * 256 + c.lane * 4;
            const f32x4 gg = *(const f32x4*)(g + col), sh = *(const f32x4*)(mod + b * NMOD + 3 * D + col), scl = *(const f32x4*)(mod + b * NMOD + 4 * D + col);
#pragma unroll
            for (int j = 0; j < 4; ++j) v[i][j] = (v[i][j] * rstd * gg[j]) * (1.0f + scl[j]) + sh[j];
            u32x2 w; w.x = pack_bf16(v[i][0], v[i][1]); w.y = pack_bf16(v[i][2], v[i][3]);
            *(u32x2*)(h2 + (size_t)row * D + col) = w;
#pragma unroll
            for (int j = 0; j < 4; ++j) {
                const f32x4 w0 = *(const f32x4*)(w_rg + (size_t)(col + j) * 8), w1 = *(const f32x4*)(w_rg + (size_t)(col + j) * 8 + 4);
#pragma unroll
                for (int e = 0; e < 4; ++e) { gl[e] += v[i][j] * w0[e]; gl[4 + e] += v[i][j] * w1[e]; }
            }
        }
#pragma unroll
        for (int j = 0; j < 8; ++j) gl[j] = wave_sum(gl[j]) + b_rg[j];
        int gi = 0; float gmax = gl[0];
#pragma unroll
        for (int j = 1; j < 8; ++j) if (gl[j] > gmax) { gmax = gl[j]; gi = j; }
        float gsum = 0.f;
#pragma unroll
        for (int j = 0; j < 8; ++j) gsum += __expf(gl[j] - gmax);
        const float pg = 1.0f / gsum;
        float el[8];
#pragma unroll
        for (int j = 0; j < 8; ++j) el[j] = 0.f;
#pragma unroll
        for (int i = 0; i < 8; ++i) {
            const int col = i * 256 + c.lane * 4;
#pragma unroll
            for (int j = 0; j < 4; ++j) {
                const f32x4 w0 = *(const f32x4*)(w_re + (size_t)(col + j) * 64 + gi * 8), w1 = *(const f32x4*)(w_re + (size_t)(col + j) * 64 + gi * 8 + 4);
#pragma unroll
                for (int e = 0; e < 4; ++e) { el[e] += v[i][j] * w0[e]; el[4 + e] += v[i][j] * w1[e]; }
            }
        }
#pragma unroll
        for (int j = 0; j < 8; ++j) el[j] = wave_sum(el[j]) + b_re[gi * 8 + j];
        int i1 = 0; float e1 = el[0];
#pragma unroll
        for (int j = 1; j < 8; ++j) if (el[j] > e1) { e1 = el[j]; i1 = j; }
        int i2 = -1; float e2 = -3.0e38f;
#pragma unroll
        for (int j = 0; j < 8; ++j) if (j != i1 && el[j] > e2) { e2 = el[j]; i2 = j; }
        const float r2 = __expf(e2 - e1);
        const float tp1 = 1.0f / (1.0f + r2), tp2 = r2 / (1.0f + r2);
        if (c.lane == 0) {
            const int ea = gi * 8 + i1, eb = gi * 8 + i2;
            const unsigned sa = atomicAdd(&cnt[ea], 1u), sb = atomicAdd(&cnt[eb], 1u);
            ltok[ea * NTOK + sa] = row * 2; lw[ea * NTOK + sa] = pg * tp1;
            ltok[eb * NTOK + sb] = row * 2 + 1; lw[eb * NTOK + sb] = pg * tp2;
        }
    }
}

__device__ __forceinline__ void phase_norm2_route2(const Params& p, const Ctx& c, int dummy = 0) {
    const float* x1 = (const float*)(p.ws + WS_X1); const float* g = p.in[15];
    const float* mod = (const float*)(p.ws + WS_MOD);
    const bf16_t* WtH = (const bf16_t*)(p.ws + WS_RW); const bf16_t* WtL = WtH + (size_t)NB * 80 * D; const float* cb = (const float*)(p.ws + WS_RC);
    bf16_t* h2 = (bf16_t*)(p.ws + WS_H2);
    unsigned* cnt = (unsigned*)(p.ws + WS_CTL) + CW_CNT + (dummy ? 128 : 0);
    int* ltok = (int*)(p.ws + (dummy ? WS_ACT : WS_LTOK)); float* lw = (float*)(p.ws + (dummy ? WS_ACT + (size_t)NE * NTOK * 4 : WS_LW));
    LAS float* red = (LAS float*)c.lds;
    LAS float* ssr = (LAS float*)(c.lds + 81920);
    LAS float* rs = (LAS float*)(c.lds + 81920 + 1024);
    for (int it = c.bid; it < NTOK / 32; it += c.nblk) {
        const int tok0 = it * 32, b = tok0 >> 11;
        const int ks = c.wid, i16 = c.lane & 15, kk = c.lane >> 4;
        const float* ap0 = x1 + (size_t)(tok0 + i16) * D + 256 * ks + 8 * kk;
        const float* ap1 = ap0 + (size_t)16 * D;
        const bf16_t* bph = WtH + ((size_t)b * 80 + i16) * D + 256 * ks + 8 * kk;
        const bf16_t* bpl = WtL + ((size_t)b * 80 + i16) * D + 256 * ks + 8 * kk;
        f32x4 acc[2][5];
#pragma unroll
        for (int g2 = 0; g2 < 2; ++g2)
#pragma unroll
            for (int nb = 0; nb < 5; ++nb) acc[g2][nb] = (f32x4){0.f, 0.f, 0.f, 0.f};
        float ss0 = 0.f, ss1 = 0.f;
#pragma unroll 4
        for (int kb8 = 0; kb8 < 8; ++kb8) {
            bf16x8 ah[2], al[2];
#pragma unroll
            for (int g2 = 0; g2 < 2; ++g2) {
                const float* ap = (g2 ? ap1 : ap0) + 32 * kb8;
                const f32x4 v0 = *(const f32x4*)ap, v1 = *(const f32x4*)(ap + 4);
                const float sq = v0[0] * v0[0] + v0[1] * v0[1] + v0[2] * v0[2] + v0[3] * v0[3] + v1[0] * v1[0] + v1[1] * v1[1] + v1[2] * v1[2] + v1[3] * v1[3];
                if (g2) ss1 += sq; else ss0 += sq;
                u32x4 h, l;
                h.x = pack_bf16(v0[0], v0[1]); h.y = pack_bf16(v0[2], v0[3]); h.z = pack_bf16(v1[0], v1[1]); h.w = pack_bf16(v1[2], v1[3]);
                l.x = pack_bf16(v0[0] - __uint_as_float(h.x << 16), v0[1] - __uint_as_float(h.x & 0xffff0000u));
                l.y = pack_bf16(v0[2] - __uint_as_float(h.y << 16), v0[3] - __uint_as_float(h.y & 0xffff0000u));
                l.z = pack_bf16(v1[0] - __uint_as_float(h.z << 16), v1[1] - __uint_as_float(h.z & 0xffff0000u));
                l.w = pack_bf16(v1[2] - __uint_as_float(h.w << 16), v1[3] - __uint_as_float(h.w & 0xffff0000u));
                ah[g2] = __builtin_bit_cast(bf16x8, h); al[g2] = __builtin_bit_cast(bf16x8, l);
            }
#pragma unroll
            for (int nb = 0; nb < 5; ++nb) {
                const bf16x8 bh = *(const bf16x8*)(bph + (size_t)nb * 16 * D + 32 * kb8), bl = *(const bf16x8*)(bpl + (size_t)nb * 16 * D + 32 * kb8);
#pragma unroll
                for (int g2 = 0; g2 < 2; ++g2) {
                    acc[g2][nb] = __builtin_amdgcn_mfma_f32_16x16x32_bf16(ah[g2], bh, acc[g2][nb], 0, 0, 0);
                    acc[g2][nb] = __builtin_amdgcn_mfma_f32_16x16x32_bf16(ah[g2], bl, acc[g2][nb], 0, 0, 0);
                    acc[g2][nb] = __builtin_amdgcn_mfma_f32_16x16x32_bf16(al[g2], bh, acc[g2][nb], 0, 0, 0);
                }
            }
        }
        ss0 += __shfl_xor(ss0, 16); ss0 += __shfl_xor(ss0, 32);
        ss1 += __shfl_xor(ss1, 16); ss1 += __shfl_xor(ss1, 32);
        __syncthreads();
#pragma unroll
        for (int g2 = 0; g2 < 2; ++g2)
#pragma unroll
            for (int nb = 0; nb < 5; ++nb)
#pragma unroll
                for (int r = 0; r < 4; ++r) red[(c.wid * 32 + g2 * 16 + 4 * kk + r) * 80 + nb * 16 + i16] = acc[g2][nb][r];
        if (kk == 0) { ssr[c.wid * 32 + i16] = ss0; ssr[c.wid * 32 + 16 + i16] = ss1; }
        __syncthreads();
        if (c.tid < 32) {
            const int t = c.tid;
            float ssum = 0.f;
#pragma unroll
            for (int q = 0; q < 8; ++q) ssum += ssr[q * 32 + t];
            const float rstd = rsqrtf(ssum * (1.0f / D) + EPS);
            rs[t] = rstd;
            float gl[8];
#pragma unroll
            for (int j = 0; j < 8; ++j) {
                float a = 0.f;
#pragma unroll
                for (int q = 0; q < 8; ++q) a += red[(q * 32 + t) * 80 + j];
                gl[j] = a * rstd + cb[b * 80 + j];
            }
            int gi = 0; float gmax = gl[0];
#pragma unroll
            for (int j = 1; j < 8; ++j) if (gl[j] > gmax) { gmax = gl[j]; gi = j; }
            float gsum = 0.f;
#pragma unroll
            for (int j = 0; j < 8; ++j) gsum += __expf(gl[j] - gmax);
            const float pg = 1.0f / gsum;
            float el[8];
#pragma unroll
            for (int j = 0; j < 8; ++j) {
                float a = 0.f;
#pragma unroll
                for (int q = 0; q < 8; ++q) a += red[(q * 32 + t) * 80 + 8 + gi * 8 + j];
                el[j] = a * rstd + cb[b * 80 + 8 + gi * 8 + j];
            }
            int i1 = 0; float e1 = el[0];
#pragma unroll
            for (int j = 1; j < 8; ++j) if (el[j] > e1) { e1 = el[j]; i1 = j; }
            int i2 = -1; float e2 = -3.0e38f;
#pragma unroll
            for (int j = 0; j < 8; ++j) if (j != i1 && el[j] > e2) { e2 = el[j]; i2 = j; }
            const float r2 = __expf(e2 - e1);
            const float tp1 = 1.0f / (1.0f + r2), tp2 = r2 / (1.0f + r2);
            const int row = tok0 + t;
            const int ea = gi * 8 + i1, eb = gi * 8 + i2;
            const unsigned sa = atomicAdd(&cnt[ea], 1u), sb = atomicAdd(&cnt[eb], 1u);
            ltok[ea * NTOK + sa] = row * 2; lw[ea * NTOK + sa] = pg * tp1;
            ltok[eb * NTOK + sb] = row * 2 + 1; lw[eb * NTOK + sb] = pg * tp2;
            if (!dummy) { u32x4 rec; rec.x = ((unsigned)ea << 13) | sa; rec.y = __float_as_uint(pg * tp1); rec.z = ((unsigned)eb << 13) | sb; rec.w = __float_as_uint(pg * tp2);
                *(u32x4*)(p.ws + WS_TREC + (size_t)row * 16) = rec; }
        }
        float rstd4[4];
#pragma unroll
        for (int q = 0; q < 4; ++q) {
            float ssum = 0.f;
#pragma unroll
            for (int q8 = 0; q8 < 8; ++q8) ssum += ssr[q8 * 32 + c.wid * 4 + q];
            rstd4[q] = rsqrtf(ssum * (1.0f / D) + EPS);
        }
#pragma unroll 2
        for (int i = 0; i < 8; ++i) {
            const int col = i * 256 + c.lane * 4;
            const f32x4 gg = *(const f32x4*)(g + col), sh = *(const f32x4*)(mod + b * NMOD + 3 * D + col), scl = *(const f32x4*)(mod + b * NMOD + 4 * D + col);
            f32x4 v[4];
#pragma unroll
            for (int q = 0; q < 4; ++q) v[q] = *(const f32x4*)(x1 + (size_t)(tok0 + c.wid * 4 + q) * D + col);
#pragma unroll
            for (int q = 0; q < 4; ++q) {
                float o[4];
#pragma unroll
                for (int j = 0; j < 4; ++j) o[j] = (v[q][j] * rstd4[q] * gg[j]) * (1.0f + scl[j]) + sh[j];
                u32x2 w; w.x = pack_bf16(o[0], o[1]); w.y = pack_bf16(o[2], o[3]);
                *(u32x2*)(h2 + (size_t)(tok0 + c.wid * 4 + q) * D + col) = w;
            }
        }
    }
}

constexpr int MOE_TAB = 100 * 1024;
__device__ __forceinline__ void moe_table(const Params& p, const Ctx& c) {
    const unsigned* cnt = (const unsigned*)(p.ws + WS_CTL) + CW_CNT;
    LAS int* tab = (LAS int*)(c.lds + MOE_TAB);
    __syncthreads();
    if (c.tid == 0) {
        int rp = 0;
        for (int e = 0; e < NE; ++e) { const int n = (int)cnt[e]; tab[e] = n; tab[64 + e] = rp; rp += n; }
        tab[64 + 64] = rp;
        for (int q = 0; q < 8; ++q) { int ip = 0; for (int j = 0; j < 8; ++j) { tab[256 + 16 * q + j] = ip; ip += ((tab[q + 8 * j] + 255) >> 8) * 16; } tab[256 + 16 * q + 8] = ip; }
    }
    __syncthreads();
}
__device__ __forceinline__ bool moe_next(XQueue& q, const Ctx& c, int& e, int& mt, int& ntile, int& cnt_e, int& rbase) {
    LAS int* tab = (LAS int*)(c.lds + MOE_TAB);
    while (q.v < 8) {
        const int qi = (q.x + q.v) & 7;
        const int L = next_item(q.heads + qi * 64, c);
        if (L < tab[256 + 16 * qi + 8]) {
            int j = 0;
#pragma unroll
            for (int k = 1; k < 8; ++k) if (tab[256 + 16 * qi + k] <= L) j = k;
            e = qi + 8 * j;
            while (tab[e] == 0 && j > 0) { --j; e -= 8; }
            cnt_e = tab[e]; rbase = tab[64 + e];
            const int loc = L - tab[256 + 16 * qi + j], nmt = (cnt_e + 255) >> 8;
            ntile = loc / nmt; mt = loc - ntile * nmt;
            return true;
        }
        ++q.v;
    }
    return false;
}

__device__ __forceinline__ void phase_moe1(const Params& p, const Ctx& c, int qsel = 1) {
    const bf16_t* h2 = (const bf16_t*)(p.ws + WS_H2);
    const int* ltok = (const int*)(p.ws + WS_LTOK);
    bf16_t* act = (bf16_t*)(p.ws + WS_ACT);
    const float* wg = p.in[20]; const float* wu = p.in[21];
    moe_table(p, c);
    XQueue q = xq_make(p, qsel);
    for (;;) {
        int e, mt, ntile, cnt_e, rbase;
        if (!moe_next(q, c, e, mt, ntile, cnt_e, rbase)) break;
        const int n0 = ntile * 64;
        const bf16_t* arow[4];
#pragma unroll
        for (int i = 0; i < 4; ++i) {
            const int r = mt * 256 + a_piece_row(c, i);
            const int tok = r < cnt_e ? (ltok[e * NTOK + r] >> 1) : 0;
            arow[i] = h2 + (size_t)tok * D + a_piece_col(c);
        }
        const int nq = b_nq(c), blk = nq >> 2;
        const float* wsrc = ((blk & 1) ? wu : wg) + (size_t)e * D * DE;
        const float* bptr = wsrc + (size_t)b_k0(c) * DE + n0 + 16 * (blk >> 1) + 4 * (nq & 3);
        f32x4 acc[8][2]; zero_acc(acc);
        gemm_mainloop<MOE_NT, D>(acc, arow, bptr, DE, c);
#pragma unroll
        for (int mi = 0; mi < 8; ++mi) {
            const int r = mt * 256 + 128 * c.wr + 16 * mi + c.fr;
            if (r < cnt_e) {
                const int col = n0 + 16 * c.wc + 4 * c.fq;
                float o[4];
#pragma unroll
                for (int j = 0; j < 4; ++j) { const float a = acc[mi][0][j], u = acc[mi][1][j]; o[j] = a / (1.0f + __expf(-a)) * u; }
                u32x2 w; w.x = pack_bf16(o[0], o[1]); w.y = pack_bf16(o[2], o[3]);
                *(u32x2*)(act + (size_t)(rbase + r) * DE + col) = w;
            }
        }
    }
}
__device__ __forceinline__ void phase_moe2(const Params& p, const Ctx& c, int qsel = 2) {
    const int* ltok = (const int*)(p.ws + WS_LTOK); const float* lw = (const float*)(p.ws + WS_LW);
    const bf16_t* act = (const bf16_t*)(p.ws + WS_ACT);
    float* y = (float*)(p.ws + WS_Y);
    const float* wd = p.in[22];
    moe_table(p, c);
    XQueue q = xq_make(p, qsel);
    for (;;) {
        int e, mt, ntile, cnt_e, rbase;
        if (!moe_next(q, c, e, mt, ntile, cnt_e, rbase)) break;
        const int n0 = ntile * 128;
        const bf16_t* arow[4];
#pragma unroll
        for (int i = 0; i < 4; ++i) arow[i] = act + (size_t)(rbase + mt * 256 + a_piece_row(c, i)) * DE + a_piece_col(c);
        const float* bptr = wd + (size_t)e * DE * D + (size_t)b_k0(c) * D + n0 + 4 * b_nq(c);
        f32x4 acc[8][2]; zero_acc(acc);
        gemm_mainloop<MOE_NT, DE>(acc, arow, bptr, D, c);
#pragma unroll
        for (int mi = 0; mi < 8; ++mi) {
            const int r = mt * 256 + 128 * c.wr + 16 * mi + c.fr;
            if (r < cnt_e) {
                const int ent = ltok[e * NTOK + r]; const float w = lw[e * NTOK + r];
#pragma unroll
                for (int ni = 0; ni < 2; ++ni) {
                    const int col = n0 + 32 * c.wc + 16 * ni + 4 * c.fq;
                    *(f32x4*)(y + (size_t)ent * D + col) = acc[mi][ni] * w;
                }
            }
        }
    }
}

constexpr int MOE_TAB2 = 132 * 1024;
__device__ __forceinline__ void moe_table2(const Params& p, const Ctx& c) {
    const unsigned* cnt = (const unsigned*)(p.ws + WS_CTL) + CW_CNT;
    LAS int* tab = (LAS int*)(c.lds + MOE_TAB2);
    __syncthreads();
    if (c.tid == 0) {
        int rp = 0;
        for (int e = 0; e < NE; ++e) { const int n = (int)cnt[e]; tab[e] = n; tab[64 + e] = rp; rp += n; }
        tab[64 + 64] = rp;
        for (int q = 0; q < 8; ++q) { int ip = 0; for (int j = 0; j < 8; ++j) { tab[256 + 16 * q + j] = ip; ip += ((tab[q + 8 * j] + 255) >> 8) * 8; } tab[256 + 16 * q + 8] = ip; }
    }
    __syncthreads();
}
__device__ __forceinline__ bool moe_next2(XQueue& q, const Ctx& c, int& e, int& mt, int& ntile, int& cnt_e, int& rbase) {
    LAS int* tab = (LAS int*)(c.lds + MOE_TAB2);
    while (q.v < 8) {
        const int qi = (q.x + q.v) & 7;
        const int L = next_item(q.heads + qi * 64, c);
        if (L < tab[256 + 16 * qi + 8]) {
            int j = 0;
#pragma unroll
            for (int k = 1; k < 8; ++k) if (tab[256 + 16 * qi + k] <= L) j = k;
            e = qi + 8 * j;
            while (tab[e] == 0 && j > 0) { --j; e -= 8; }
            cnt_e = tab[e]; rbase = tab[64 + e];
            const int loc = L - tab[256 + 16 * qi + j], nmt = (cnt_e + 255) >> 8;
            ntile = loc / nmt; mt = loc - ntile * nmt;
            return true;
        }
        ++q.v;
    }
    return false;
}
__device__ __forceinline__ void zero_acc4(f32x4 (&acc)[8][4]) {
#pragma unroll
    for (int mi = 0; mi < 8; ++mi)
#pragma unroll
        for (int ni = 0; ni < 4; ++ni) acc[mi][ni] = (f32x4){0.f, 0.f, 0.f, 0.f};
}
__device__ __forceinline__ void phase_moe1w(const Params& p, const Ctx& c, int qsel = 1) {
    const bf16_t* h2 = (const bf16_t*)(p.ws + WS_H2);
    const int* ltok = (const int*)(p.ws + WS_LTOK);
    bf16_t* act = (bf16_t*)(p.ws + WS_ACT);
    const float* wg = p.in[20]; const float* wu = p.in[21];
    moe_table2(p, c);
    XQueue q = xq_make(p, qsel);
    const int blk = c.lane >> 2;
    const float* wsel = (blk & 1) ? wu : wg;
    const int bcol = 16 * (blk >> 1) + 4 * (c.lane & 3);
    int e, mt, ntile, cnt_e, rbase;
    if (!moe_next2(q, c, e, mt, ntile, cnt_e, rbase)) return;
    int aoff[4];
#pragma unroll
    for (int i = 0; i < 4; ++i) { const int r = mt * 256 + a_piece_row(c, i); const int tok = r < cnt_e ? (ltok[e * NTOK + r] >> 1) : 0; aoff[i] = tok * D + a_piece_col(c); }
    const float* bptr = wsel + (size_t)e * D * DE + (size_t)(8 * c.wid) * DE + ntile * 128 + bcol;
    bool staged = false;
    f32x4 rb[8];
    for (;;) {
        int en, mtn, ntilen, cntn, rbasen;
        const bool hn = moe_next2(q, c, en, mtn, ntilen, cntn, rbasen);
        int aoffn[4]; const float* bptrn; int nrn;
        if (hn) {
#pragma unroll
            for (int i = 0; i < 4; ++i) { const int r = mtn * 256 + a_piece_row(c, i); const int tok = r < cntn ? (ltok[en * NTOK + r] >> 1) : 0; aoffn[i] = tok * D + a_piece_col(c); }
            bptrn = wsel + (size_t)en * D * DE + (size_t)(8 * c.wid) * DE + ntilen * 128 + bcol; nrn = cntn - mtn * 256;
        } else {
#pragma unroll
            for (int i = 0; i < 4; ++i) aoffn[i] = aoff[i] + (D / 64 - 1) * 64;
            bptrn = bptr + (size_t)((D / 64 - 1) * 64) * DE; nrn = cnt_e - mt * 256;
        }
        const int n0 = ntile * 128;
        f32x4 acc[8][4]; zero_acc4(acc);
        gemm_mainloop256<D>(acc, rb, h2, aoff, bptr, DE, cnt_e - mt * 256, c, staged, aoffn, bptrn, nrn, hn);
#pragma unroll
        for (int mi = 0; mi < 8; ++mi) {
            const int r = mt * 256 + 128 * c.wr + 16 * mi + c.fr;
            if (r < cnt_e) {
#pragma unroll
                for (int hh = 0; hh < 2; ++hh) {
                    const int col = n0 + 16 * (2 * c.wc + hh) + 4 * c.fq;
                    float o[4];
#pragma unroll
                    for (int j = 0; j < 4; ++j) { const float a = acc[mi][2 * hh][j], u = acc[mi][2 * hh + 1][j]; o[j] = a * sigmoidf_(a) * u; }
                    u32x2 w; w.x = pack_bf16(o[0], o[1]); w.y = pack_bf16(o[2], o[3]);
                    *(u32x2*)(act + (size_t)(rbase + r) * DE + col) = w;
                }
            }
        }
        if (!hn) break;
        e = en; mt = mtn; ntile = ntilen; cnt_e = cntn; rbase = rbasen; bptr = bptrn; staged = true;
#pragma unroll
        for (int i = 0; i < 4; ++i) aoff[i] = aoffn[i];
    }
    asm volatile("s_waitcnt vmcnt(0)" ::: "memory");
}
__device__ __forceinline__ void phase_moe2w(const Params& p, const Ctx& c, int qsel = 2) {
    const bf16_t* act = (const bf16_t*)(p.ws + WS_ACT);
    bf16_t* yb = (bf16_t*)(p.ws + WS_Y);
    const float* wd = p.in[22];
    moe_table2(p, c);
    XQueue q = xq_make(p, qsel);
    int e, mt, ntile, cnt_e, rbase;
    if (!moe_next2(q, c, e, mt, ntile, cnt_e, rbase)) return;
    int aoff[4];
#pragma unroll
    for (int i = 0; i < 4; ++i) aoff[i] = (rbase + mt * 256 + a_piece_row(c, i)) * DE + a_piece_col(c);
    const float* bptr = wd + (size_t)e * DE * D + (size_t)(8 * c.wid) * D + ntile * 256 + 4 * c.lane;
    bool staged = false;
    f32x4 rb[8];
    for (;;) {
        int en, mtn, ntilen, cntn, rbasen;
        const bool hn = moe_next2(q, c, en, mtn, ntilen, cntn, rbasen);
        int aoffn[4]; const float* bptrn; int nrn;
        if (hn) {
#pragma unroll
            for (int i = 0; i < 4; ++i) aoffn[i] = (rbasen + mtn * 256 + a_piece_row(c, i)) * DE + a_piece_col(c);
            bptrn = wd + (size_t)en * DE * D + (size_t)(8 * c.wid) * D + ntilen * 256 + 4 * c.lane; nrn = cntn - mtn * 256;
        } else {
#pragma unroll
            for (int i = 0; i < 4; ++i) aoffn[i] = aoff[i] + (DE / 64 - 1) * 64;
            bptrn = bptr + (size_t)((DE / 64 - 1) * 64) * D; nrn = cnt_e - mt * 256;
        }
        const int n0 = ntile * 256;
        f32x4 acc[8][4]; zero_acc4(acc);
        gemm_mainloop256<DE>(acc, rb, act, aoff, bptr, D, cnt_e - mt * 256, c, staged, aoffn, bptrn, nrn, hn);
#pragma unroll
        for (int mi = 0; mi < 8; ++mi) {
            const int r = mt * 256 + 128 * c.wr + 16 * mi + c.fr;
            if (r < cnt_e) {
#pragma unroll
                for (int ni = 0; ni < 4; ++ni) {
                    const int col = n0 + 64 * c.wc + 16 * ni + 4 * c.fq;
                    const f32x4 v = acc[mi][ni];
                    u32x2 pk; pk.x = pack_bf16(v[0], v[1]); pk.y = pack_bf16(v[2], v[3]);
                    *(u32x2*)(yb + (size_t)(rbase + r) * D + col) = pk;
                }
            }
        }
        if (!hn) break;
        e = en; mt = mtn; ntile = ntilen; cnt_e = cntn; rbase = rbasen; bptr = bptrn; staged = true;
#pragma unroll
        for (int i = 0; i < 4; ++i) aoff[i] = aoffn[i];
    }
    asm volatile("s_waitcnt vmcnt(0)" ::: "memory");
}

__device__ __forceinline__ void phase_final(const Params& p, const Ctx& c) {
    const float* x1 = (const float*)(p.ws + WS_X1); const bf16_t* yb = (const bf16_t*)(p.ws + WS_Y);
    const float* mod = (const float*)(p.ws + WS_MOD); const float* g = p.in[23];
    const unsigned* cnt = (const unsigned*)(p.ws + WS_CTL) + CW_CNT;
    LAS int* rpre = (LAS int*)c.lds;
    __syncthreads();
    if (c.tid == 0) { int rp = 0; for (int e = 0; e < NE; ++e) { rpre[e] = rp; rp += (int)cnt[e]; } }
    __syncthreads();
    for (int row = c.bid * 8 + c.wid; row < NTOK; row += c.nblk * 8) {
        const int b = row >> 11;
        const u32x4 rec = *(const u32x4*)(p.ws + WS_TREC + (size_t)row * 16);
        const size_t r0 = (size_t)(rpre[rec.x >> 13] + (int)(rec.x & 8191u)), r1 = (size_t)(rpre[rec.z >> 13] + (int)(rec.z & 8191u));
        const float w0 = __uint_as_float(rec.y), w1 = __uint_as_float(rec.w);
        f32x4 v[8]; float ss = 0.f;
#pragma unroll
        for (int i = 0; i < 8; ++i) {
            const int col = i * 256 + c.lane * 4;
            const f32x4 xv = *(const f32x4*)(x1 + (size_t)row * D + col);
            const u32x2 a0 = *(const u32x2*)(yb + r0 * D + col), a1 = *(const u32x2*)(yb + r1 * D + col);
            f32x4 y0, y1;
            y0[0] = __uint_as_float(a0.x << 16); y0[1] = __uint_as_float(a0.x & 0xffff0000u); y0[2] = __uint_as_float(a0.y << 16); y0[3] = __uint_as_float(a0.y & 0xffff0000u);
            y1[0] = __uint_as_float(a1.x << 16); y1[1] = __uint_as_float(a1.x & 0xffff0000u); y1[2] = __uint_as_float(a1.y << 16); y1[3] = __uint_as_float(a1.y & 0xffff0000u);
            const f32x4 gf = *(const f32x4*)(mod + b * NMOD + 5 * D + col);
            v[i] = xv + gf * (y0 * w0 + y1 * w1);
            ss += v[i][0] * v[i][0] + v[i][1] * v[i][1] + v[i][2] * v[i][2] + v[i][3] * v[i][3];
        }
        ss = wave_sum(ss);
        const float rstd = rsqrtf(ss * (1.0f / D) + EPS);
#pragma unroll
        for (int i = 0; i < 8; ++i) {
            const int col = i * 256 + c.lane * 4;
            const f32x4 gg = *(const f32x4*)(g + col);
            *(f32x4*)(p.out + (size_t)row * D + col) = v[i] * rstd * gg;
        }
    }
}

struct EpiProjIn {
    static constexpr bool PERM = false, AFTER_DRAIN = false;
    unsigned char* ws;
    __device__ __forceinline__ void operator()(const pg8::f32x4 (&acc)[2][2][4][2], const pg8::Unit& u, int wr, int wc, int fr, int fq) const {
        const int region = (u.pn * 256) >> 10;
#pragma unroll
        for (int ai = 0; ai < 2; ++ai)
#pragma unroll
            for (int m = 0; m < 4; ++m) {
                const int row = u.pm * 256 + ai * 128 + wr * 64 + m * 16 + fr;
#pragma unroll
                for (int bj = 0; bj < 2; ++bj)
#pragma unroll
                    for (int n = 0; n < 2; ++n) {
                        const int col = u.pn * 256 + bj * 128 + wc * 32 + n * 16 + 4 * fq;
                        const f32x4 a = acc[ai][bj][m][n];
                        if (region < 6) {
                            const int cin = col & 1023;
                            if (region == 2 || region == 5) {
                                bf16_t* vt = (bf16_t*)(ws + (region == 2 ? WS_VAT : WS_VBT));
                                const int b = row >> 11, s0 = row & 2047, hh = cin >> 7, d = cin & 127;
                                const int s = (s0 & ~31) | ((s0 & 12) << 1) | ((s0 & 16) >> 2) | (s0 & 3);
                                const unsigned w0 = pack_bf16(a[0], a[1]), w1 = pack_bf16(a[2], a[3]);
                                bf16_t* base = vt + ((size_t)((b * 8 + hh) * 128 + d)) * SEQ + s;
                                base[0] = (bf16_t)(w0 & 0xffff); base[SEQ] = (bf16_t)(w0 >> 16); base[2 * SEQ] = (bf16_t)(w1 & 0xffff); base[3 * SEQ] = (bf16_t)(w1 >> 16);
                            } else {
                                const size_t off = region == 0 ? WS_QA : region == 1 ? WS_KA : region == 3 ? WS_QB : WS_KB;
                                bf16_t* dst = (bf16_t*)(ws + off);
                                u32x2 w; w.x = pack_bf16(a[0], a[1]); w.y = pack_bf16(a[2], a[3]);
                                *(u32x2*)(dst + (size_t)row * 1024 + cin) = w;
                            }
                        } else {
                            bf16_t* dst = (bf16_t*)(ws + (region < 8 ? WS_GA : WS_GB));
                            const int cin = col - (region < 8 ? 6144 : 8192);
                            u32x2 w; w.x = pack_bf16(sigmoidf_(a[0]), sigmoidf_(a[1])); w.y = pack_bf16(sigmoidf_(a[2]), sigmoidf_(a[3]));
                            *(u32x2*)(dst + (size_t)row * D + cin) = w;
                        }
                    }
            }
    }
};
template <int PASS> struct EpiGate {
    static constexpr bool PERM = false, AFTER_DRAIN = false;
    const bf16_t* G; float* tmp; bf16_t* out;
    __device__ __forceinline__ void operator()(const pg8::f32x4 (&acc)[2][2][4][2], const pg8::Unit& u, int wr, int wc, int fr, int fq) const {
#pragma unroll
        for (int ai = 0; ai < 2; ++ai)
#pragma unroll
            for (int m = 0; m < 4; ++m) {
                const int row = u.pm * 256 + ai * 128 + wr * 64 + m * 16 + fr;
#pragma unroll
                for (int bj = 0; bj < 2; ++bj)
#pragma unroll
                    for (int n = 0; n < 2; ++n) {
                        const int col = u.pn * 256 + bj * 128 + wc * 32 + n * 16 + 4 * fq;
                        const u32x2 gw = *(const u32x2*)(G + (size_t)row * D + col);
                        f32x4 g; g[0] = __uint_as_float(gw.x << 16); g[1] = __uint_as_float(gw.x & 0xffff0000u); g[2] = __uint_as_float(gw.y << 16); g[3] = __uint_as_float(gw.y & 0xffff0000u);
                        f32x4 v = acc[ai][bj][m][n] * g;
                        if (PASS == 0) *(f32x4*)(tmp + (size_t)row * D + col) = v;
                        else {
                            v += *(const f32x4*)(tmp + (size_t)row * D + col);
                            u32x2 w; w.x = pack_bf16(v[0], v[1]); w.y = pack_bf16(v[2], v[3]);
                            *(u32x2*)(out + (size_t)row * D + col) = w;
                        }
                    }
            }
    }
};
struct EpiX1 {
    static constexpr bool PERM = false, AFTER_DRAIN = false;
    const float* x; const float* mod; float* x1;
    __device__ __forceinline__ void operator()(const pg8::f32x4 (&acc)[2][2][4][2], const pg8::Unit& u, int wr, int wc, int fr, int fq) const {
        const int b = (u.pm * 256) >> 11;
#pragma unroll
        for (int ai = 0; ai < 2; ++ai)
#pragma unroll
            for (int m = 0; m < 4; ++m) {
                const int row = u.pm * 256 + ai * 128 + wr * 64 + m * 16 + fr;
#pragma unroll
                for (int bj = 0; bj < 2; ++bj)
#pragma unroll
                    for (int n = 0; n < 2; ++n) {
                        const int col = u.pn * 256 + bj * 128 + wc * 32 + n * 16 + 4 * fq;
                        const f32x4 gm = *(const f32x4*)(mod + b * NMOD + 2 * D + col);
                        const f32x4 xv = *(const f32x4*)(x + (size_t)row * D + col);
                        *(f32x4*)(x1 + (size_t)row * D + col) = xv + gm * acc[ai][bj][m][n];
                    }
            }
    }
};
__device__ __forceinline__ void phase_proj_in2(const Params& p, const Ctx& c) {
    pg8::Gemm g{(const bf16_t*)(p.ws + WS_H), (const bf16_t*)(p.ws + WS_WIN_T), NTOK, INC, D};
    pg8::StaticOrder S; S.init(NTOK, INC, c.nblk, c.bid);
    EpiProjIn E{p.ws};
    pg8::gemm_phase<EpiProjIn, pg8::StaticOrder>(c.lds, g, S, E, nullptr, c.wid);
}
__device__ __forceinline__ void phase_merge2(const Params& p, const Ctx& c) {
    float* tmp = (float*)(p.ws + WS_X1);
    {
        pg8::Gemm g{(const bf16_t*)(p.ws + WS_OA), (const bf16_t*)(p.ws + WS_WPA_T), NTOK, D, 1024};
        pg8::StaticOrder S; S.init(NTOK, D, c.nblk, c.bid);
        EpiGate<0> E{(const bf16_t*)(p.ws + WS_GA), tmp, nullptr};
        pg8::gemm_phase<EpiGate<0>, pg8::StaticOrder>(c.lds, g, S, E, nullptr, c.wid);
    }
    {
        pg8::Gemm g{(const bf16_t*)(p.ws + WS_OB), (const bf16_t*)(p.ws + WS_WPB_T), NTOK, D, 1024};
        pg8::StaticOrder S; S.init(NTOK, D, c.nblk, c.bid);
        EpiGate<1> E{(const bf16_t*)(p.ws + WS_GB), tmp, (bf16_t*)(p.ws + WS_MRG)};
        pg8::gemm_phase<EpiGate<1>, pg8::StaticOrder>(c.lds, g, S, E, nullptr, c.wid);
    }
}
struct MidGate {
    static constexpr int AT = 16;
    const bf16_t* GA; const bf16_t* GB;
    __device__ __forceinline__ void operator()(pg8::f32x4 (&acc)[2][2][4][2], const pg8::Unit& u, int wr, int wc, int fr, int fq) const {
        int off0 = (u.pm * 256 + wr * 64 + fr) * D + u.pn * 256 + wc * 32 + 4 * fq;
        asm volatile("" : "+v"(off0));
#pragma unroll
        for (int ai = 0; ai < 2; ++ai)
#pragma unroll
            for (int m = 0; m < 4; ++m) {
#pragma unroll
                for (int bj = 0; bj < 2; ++bj)
#pragma unroll
                    for (int n = 0; n < 2; ++n) {
                        const int off = off0 + (ai * 128 + m * 16) * D + bj * 128 + n * 16;
                        const u32x2 a = *(const u32x2*)(GA + off), b = *(const u32x2*)(GB + off);
                        f32x4 r;
                        r[0] = __uint_as_float(a.x << 16) * __builtin_amdgcn_rcpf(__uint_as_float(b.x << 16)); r[1] = __uint_as_float(a.x & 0xffff0000u) * __builtin_amdgcn_rcpf(__uint_as_float(b.x & 0xffff0000u));
                        r[2] = __uint_as_float(a.y << 16) * __builtin_amdgcn_rcpf(__uint_as_float(b.y << 16)); r[3] = __uint_as_float(a.y & 0xffff0000u) * __builtin_amdgcn_rcpf(__uint_as_float(b.y & 0xffff0000u));
                        acc[ai][bj][m][n] *= r;
                    }
                asm volatile("" ::: "memory");
            }
    }
};
struct EpiGateB {
    static constexpr bool PERM = false, AFTER_DRAIN = false;
    const bf16_t* GB; bf16_t* out;
    __device__ __forceinline__ void operator()(const pg8::f32x4 (&acc)[2][2][4][2], const pg8::Unit& u, int wr, int wc, int fr, int fq) const {
#pragma unroll
        for (int ai = 0; ai < 2; ++ai)
#pragma unroll
            for (int m = 0; m < 4; ++m) {
                const int row = u.pm * 256 + ai * 128 + wr * 64 + m * 16 + fr;
#pragma unroll
                for (int bj = 0; bj < 2; ++bj)
#pragma unroll
                    for (int n = 0; n < 2; ++n) {
                        const int col = u.pn * 256 + bj * 128 + wc * 32 + n * 16 + 4 * fq;
                        const u32x2 gw = *(const u32x2*)(GB + (size_t)row * D + col);
                        f32x4 g; g[0] = __uint_as_float(gw.x << 16); g[1] = __uint_as_float(gw.x & 0xffff0000u); g[2] = __uint_as_float(gw.y << 16); g[3] = __uint_as_float(gw.y & 0xffff0000u);
                        const f32x4 v = acc[ai][bj][m][n] * g;
                        u32x2 w; w.x = pack_bf16(v[0], v[1]); w.y = pack_bf16(v[2], v[3]);
                        *(u32x2*)(out + (size_t)row * D + col) = w;
                    }
            }
    }
};
__device__ __forceinline__ void phase_merge3(const Params& p, const Ctx& c) {
    pg8::Gemm g{(const bf16_t*)(p.ws + WS_OA), (const bf16_t*)(p.ws + WS_WPA_T), NTOK, D, D};
    pg8::StaticOrder S; S.init(NTOK, D, c.nblk, c.bid);
    EpiGateB E{(const bf16_t*)(p.ws + WS_GB), (bf16_t*)(p.ws + WS_MRG)};
    MidGate M{(const bf16_t*)(p.ws + WS_GA), (const bf16_t*)(p.ws + WS_GB)};
    pg8::gemm_phase<EpiGateB, pg8::StaticOrder, false, MidGate>(c.lds, g, S, E, nullptr, c.wid, M);
}
__device__ __forceinline__ void phase_out2(const Params& p, const Ctx& c) {
    pg8::Gemm g{(const bf16_t*)(p.ws + WS_MRG), (const bf16_t*)(p.ws + WS_WOUT_T), NTOK, D, D};
    pg8::StaticOrder S; S.init(NTOK, D, c.nblk, c.bid);
    EpiX1 E{p.in[0], (const float*)(p.ws + WS_MOD), (float*)(p.ws + WS_X1)};
    pg8::gemm_phase<EpiX1, pg8::StaticOrder>(c.lds, g, S, E, nullptr, c.wid);
}

constexpr int LDS_BYTES = 160 * 1024;
__global__ void __launch_bounds__(512, 2) mk_fwd(Params p) {
    extern __shared__ __attribute__((aligned(16))) unsigned char smem[];
    LAS unsigned char* ldsb = (LAS unsigned char*)smem;
    Ctx c; c.lds = ldsb; c.tid = threadIdx.x; c.lane = c.tid & 63; c.wid = __builtin_amdgcn_readfirstlane(c.tid >> 6); c.wr = c.wid >> 2; c.wc = c.wid & 3;
    c.fr = c.lane & 15; c.fq = c.lane >> 4; c.bid = blockIdx.x; c.nblk = gridDim.x;
#define MKCTX() do {} while (0)
#define LEADER() (c.tid == 0)
    volatile LAS unsigned* bst = (volatile LAS unsigned*)(ldsb + LDS_BYTES - 32);
    if (LEADER()) { bst[0] = 0u; bst[1] = 0u; }
    __syncthreads();
    unsigned* barw = (unsigned*)(p.ws + WS_CTL);
    XcdBarrier bar; bar.bar = barw; bar.x = 0; bar.st = bst;
#if !MK_SPLIT
    bar = xcd_barrier_post(barw, bst, LEADER());
#define GRID_BAR() xcd_barrier(bar, LEADER())
#else
#define GRID_BAR() do {} while (0)
#endif
    const int lo = p.ph_lo, hi = p.ph_hi;
#define IN(k) (lo <= (k) && (k) < hi)
#define BOTH(k) (IN(k) && IN((k) + 1))
#define DUP(k) ((DUP_MASK >> (k)) & 1)
    if (IN(0)) { MKCTX(); phase_mod(p, c); phase_convert(p, c); if (DUP(0)) { GRID_BAR(); phase_mod(p, c); phase_convert(p, c); } if (BOTH(0)) GRID_BAR(); }
    if (IN(1)) { MKCTX(); phase_norm1(p, c); phase_router_prep(p, c); if (DUP(1)) { GRID_BAR(); phase_norm1(p, c); } if (BOTH(1)) GRID_BAR(); }
    if (IN(2)) { MKCTX(); phase_proj_in2(p, c); if (DUP(2)) { GRID_BAR(); phase_proj_in2(p, c); } if (BOTH(2)) GRID_BAR(); }
    if (IN(3)) { MKCTX(); phase_attn(p, c, 0); if (DUP(3)) { GRID_BAR(); phase_attn(p, c, 3); } if (BOTH(3)) GRID_BAR(); }
    if (IN(4)) { MKCTX(); phase_merge3(p, c); if (DUP(4)) { GRID_BAR(); phase_merge3(p, c); } if (BOTH(4)) GRID_BAR(); }
    if (IN(5)) { MKCTX(); phase_out2(p, c); if (DUP(5)) { GRID_BAR(); phase_out2(p, c); } if (BOTH(5)) GRID_BAR(); }
    if (IN(6)) { MKCTX(); phase_norm2_route2(p, c); if (DUP(6)) { GRID_BAR(); phase_norm2_route2(p, c, 1); } if (BOTH(6)) GRID_BAR(); }
    if (IN(7)) { MKCTX(); phase_moe1w(p, c, 1); if (DUP(7)) { GRID_BAR(); phase_moe1w(p, c, 4); } if (BOTH(7)) GRID_BAR(); }
    if (IN(8)) { MKCTX(); phase_moe2w(p, c, 2); if (DUP(8)) { GRID_BAR(); phase_moe2w(p, c, 5); } if (BOTH(8)) GRID_BAR(); }
    if (IN(9)) { MKCTX(); phase_final(p, c); if (DUP(9)) { GRID_BAR(); phase_final(p, c); } }
}

extern "C" void kernel_launch(void* const* d_in, const int* in_sizes, int n_in, void* d_out, int out_size, void* d_ws, size_t ws_size, hipStream_t stream) {
    static int grid = 0;
    if (grid == 0) {
        if (n_in != 24 || out_size != NTOK * D || ws_size < WS_END) { fprintf(stderr, "kernel_launch: unexpected shapes (n_in %d out %d ws %zu need %zu)\n", n_in, out_size, ws_size, (size_t)WS_END); grid = -1; return; }
        int dev = 0, cus = 0, per_cu = 0;
        (void)hipGetDevice(&dev); (void)hipDeviceGetAttribute(&cus, hipDeviceAttributeMultiprocessorCount, dev);
        if (hipFuncSetAttribute((const void*)mk_fwd, hipFuncAttributeMaxDynamicSharedMemorySize, LDS_BYTES) != hipSuccess) { fprintf(stderr, "kernel_launch: hipFuncSetAttribute failed\n"); grid = -1; return; }
        if (hipOccupancyMaxActiveBlocksPerMultiprocessor(&per_cu, (const void*)mk_fwd, 512, LDS_BYTES) != hipSuccess || per_cu < 1) { fprintf(stderr, "kernel_launch: occupancy query says %d\n", per_cu); }
        (void)hipGetLastError();
        grid = cus > 0 ? cus : 256;
    }
    if (grid < 0) return;
    (void)hipMemsetAsync((char*)d_ws + WS_CTL, 0, CTL_BYTES, stream);
    Params p{};
    for (int i = 0; i < 24; ++i) p.in[i] = (const float*)d_in[i];
    p.out = (float*)d_out; p.ws = (unsigned char*)d_ws;
#if MK_SPLIT
    for (int ph = 0; ph < NPHASE; ++ph) { p.ph_lo = ph; p.ph_hi = ph + 1; hipLaunchKernelGGL(mk_fwd, dim3(grid), dim3(512), LDS_BYTES, stream, p); }
#else
    p.ph_lo = 0; p.ph_hi = NPHASE;
    hipLaunchKernelGGL(mk_fwd, dim3(grid), dim3(512), LDS_BYTES, stream, p);
#endif
}
```

```cpp
#include <hip/hip_runtime.h>
#include <stdint.h>
#include <stdio.h>

#ifndef DUP_MASK
#define DUP_MASK 0
#endif
#ifndef MOE_NT
#define MOE_NT false
#endif
#ifndef MK_SPLIT
#define MK_SPLIT 0
#endif

typedef unsigned short bf16_t;
typedef short bf16x8 __attribute__((ext_vector_type(8)));
typedef short bf16x4 __attribute__((ext_vector_type(4)));
typedef float f32x4 __attribute__((ext_vector_type(4)));
typedef unsigned u32x4 __attribute__((ext_vector_type(4)));
typedef unsigned u32x2 __attribute__((ext_vector_type(2)));
#define LAS __attribute__((address_space(3)))

constexpr int D = 2048, NB = 4, SEQ = 2048, NTOK = NB * SEQ;
constexpr int INC = 10240, NMOD = 6 * D;
constexpr int NE = 64, DE = 1024;
constexpr float EPS = 1e-6f;
constexpr int NPHASE = 10;

constexpr size_t WS_CTL = 0;
constexpr size_t CTL_BYTES = 32768;
constexpr size_t CW_CNT = 4096;
constexpr size_t CW_Q = 4096 + 256;
constexpr size_t WS_MOD = WS_CTL + CTL_BYTES;
constexpr size_t WS_H = WS_MOD + (size_t)NB * NMOD * 4;
constexpr size_t WS_QA = WS_H + (size_t)NTOK * D * 2;
constexpr size_t WS_KA = WS_QA + (size_t)NTOK * 1024 * 2;
constexpr size_t WS_VAT = WS_KA + (size_t)NTOK * 1024 * 2;
constexpr size_t WS_QB = WS_VAT + (size_t)NTOK * 1024 * 2;
constexpr size_t WS_KB = WS_QB + (size_t)NTOK * 1024 * 2;
constexpr size_t WS_VBT = WS_KB + (size_t)NTOK * 1024 * 2;
constexpr size_t WS_GA = WS_VBT + (size_t)NTOK * 1024 * 2;
constexpr size_t WS_GB = WS_GA + (size_t)NTOK * D * 2;
constexpr size_t WS_OA = WS_GB + (size_t)NTOK * D * 2;
constexpr size_t WS_OB = WS_OA + (size_t)NTOK * 1024 * 2;
constexpr size_t WS_MRG = WS_OB + (size_t)NTOK * 1024 * 2;
constexpr size_t WS_X1 = WS_MRG + (size_t)NTOK * D * 2;
constexpr size_t WS_H2 = WS_X1 + (size_t)NTOK * D * 4;
constexpr size_t WS_LTOK = WS_H2 + (size_t)NTOK * D * 2;
constexpr size_t WS_LW = WS_LTOK + (size_t)NE * NTOK * 4;
constexpr size_t WS_ACT = WS_LW + (size_t)NE * NTOK * 4;
constexpr size_t WS_Y = WS_ACT + (size_t)(2 * NTOK + 512) * DE * 2;
constexpr size_t WS_WIN_T = WS_Y + (size_t)2 * NTOK * D * 4;
constexpr size_t WS_WPA_T = WS_WIN_T + (size_t)INC * D * 2;
constexpr size_t WS_WPB_T = WS_WPA_T + (size_t)D * 1024 * 2;
constexpr size_t WS_WOUT_T = WS_WPB_T + (size_t)D * 1024 * 2;
constexpr size_t WS_RW = WS_WOUT_T + (size_t)D * D * 2;
constexpr size_t WS_RC = WS_RW + (size_t)NB * 80 * D * 4;
constexpr size_t WS_TREC = WS_RC + 4096;
constexpr size_t WS_END = WS_TREC + (size_t)NTOK * 16;

#define XB_TMO      128
#define XB_XCNT(j)  (256  + 64 * (j))
#define XB_XSUB(j)  (1280 + 64 * (j))
#define XB_XGEN(j)  (2304 + 64 * (j))
#define XB_TOP      3328
#define XB_TOPGEN   3392
#define XCD_BAR_WORDS 3456
#define XB_SPIN_CAP (1u << 24)

__device__ __forceinline__ unsigned xb_ld(unsigned* p)              { return __hip_atomic_load(p, __ATOMIC_RELAXED, __HIP_MEMORY_SCOPE_AGENT); }
__device__ __forceinline__ unsigned xb_add(unsigned* p, unsigned v) { return __hip_atomic_fetch_add(p, v, __ATOMIC_RELAXED, __HIP_MEMORY_SCOPE_AGENT); }
__device__ __forceinline__ unsigned xb_xcc_id() { return (unsigned)__builtin_amdgcn_s_getreg((3 << 11) | 20) & 0xFu; }
#define XB_SPIN(cond, bar) do { unsigned _sp = 0; while (cond) { __builtin_amdgcn_s_sleep(1); \
    if ((++_sp & 255u) == 0u) { if (xb_ld(&(bar)[XB_TMO])) break; if (_sp > XB_SPIN_CAP) { atomicAdd(&(bar)[XB_TMO], 1u); break; } } } } while (0)

struct XcdBarrier { unsigned* bar; unsigned x; volatile LAS unsigned* st; };

__device__ __forceinline__ XcdBarrier xcd_barrier_post(unsigned* bar, volatile LAS unsigned* st, bool leader) {
    XcdBarrier b; b.bar = bar; b.x = xb_xcc_id(); b.st = st;
    if (leader) (void)xb_add(&bar[XB_XCNT(b.x)], 1u);
    return b;
}
__device__ __forceinline__ void xcd_barrier_complete(unsigned* bar, unsigned x, unsigned& nloc, unsigned& nx) {
    const unsigned G = gridDim.x * gridDim.y * gridDim.z;
    unsigned sum, cnt, mine, sp = 0u;
    for (;;) {
        sum = 0u; cnt = 0u; mine = 0u;
#pragma unroll
        for (unsigned j = 0; j < 16; ++j) { const unsigned c = xb_ld(&bar[XB_XCNT(j)]); sum += c; cnt += (c > 0u) ? 1u : 0u; mine = (j == x) ? c : mine; }
        if (sum == G) break;
        __builtin_amdgcn_s_sleep(1);
        if ((++sp & 255u) == 0u) { if (xb_ld(&bar[XB_TMO])) break; if (sp > XB_SPIN_CAP) { atomicAdd(&bar[XB_TMO], 1u); break; } }
    }
    nloc = mine > 0u ? mine : 1u; nx = cnt > 0u ? cnt : 1u;
}
__device__ __forceinline__ void xcd_barrier(const XcdBarrier& b, bool leader) {
    asm volatile("s_waitcnt vmcnt(0)" ::: "memory");
    __syncthreads();
    if (leader) {
        unsigned* bar = b.bar;
        __builtin_amdgcn_s_waitcnt(0);
        unsigned nloc = b.st[0], nx = b.st[1];
        if (nloc == 0u) { xcd_barrier_complete(bar, b.x, nloc, nx); b.st[0] = nloc; b.st[1] = nx; }
        const unsigned old = xb_add(&bar[XB_XSUB(b.x)], 1u);
        const unsigned gen = old / nloc;
        if (old + 1u == (gen + 1u) * nloc) {
            __builtin_amdgcn_fence(__ATOMIC_RELEASE, "agent");
            asm volatile("s_waitcnt vmcnt(0)" ::: "memory");
            const unsigned og = xb_add(&bar[XB_TOP], 1u);
            const unsigned tg = og / nx;
            if (og + 1u == (tg + 1u) * nx) xb_add(&bar[XB_TOPGEN], 1u);
            else XB_SPIN(xb_ld(&bar[XB_TOPGEN]) == tg, bar);
            __builtin_amdgcn_fence(__ATOMIC_ACQUIRE, "agent");
            xb_add(&bar[XB_XGEN(b.x)], 1u);
            asm volatile("s_waitcnt vmcnt(0)" ::: "memory");
        } else {
            XB_SPIN(xb_ld(&bar[XB_XGEN(b.x)]) == gen, bar);
            __builtin_amdgcn_fence(__ATOMIC_ACQUIRE, "agent");
            asm volatile("s_waitcnt vmcnt(0)" ::: "memory");
        }
    }
    __syncthreads();
}

typedef __bf16 bf16v2_t __attribute__((ext_vector_type(2)));
typedef float f32x2 __attribute__((ext_vector_type(2)));
__device__ __forceinline__ unsigned pack_bf16(float lo, float hi) {
    const f32x2 v = {lo, hi};
    return __builtin_bit_cast(unsigned, __builtin_convertvector(v, bf16v2_t));
}
__device__ __forceinline__ float wave_sum(float v) {
#pragma unroll
    for (int o = 32; o > 0; o >>= 1) v += __shfl_xor(v, o);
    return v;
}
__device__ __forceinline__ float xmax16(float v) { const auto r = __builtin_amdgcn_permlane16_swap(__float_as_uint(v), __float_as_uint(v), false, false); return fmaxf(__uint_as_float(r[0]), __uint_as_float(r[1])); }
__device__ __forceinline__ float xmax32(float v) { const auto r = __builtin_amdgcn_permlane32_swap(__float_as_uint(v), __float_as_uint(v), false, false); return fmaxf(__uint_as_float(r[0]), __uint_as_float(r[1])); }
__device__ __forceinline__ float xsum16(float v) { const auto r = __builtin_amdgcn_permlane16_swap(__float_as_uint(v), __float_as_uint(v), false, false); return __uint_as_float(r[0]) + __uint_as_float(r[1]); }
__device__ __forceinline__ float xsum32(float v) { const auto r = __builtin_amdgcn_permlane32_swap(__float_as_uint(v), __float_as_uint(v), false, false); return __uint_as_float(r[0]) + __uint_as_float(r[1]); }
__device__ __forceinline__ float sigmoidf_(float x) { return __builtin_amdgcn_rcpf(1.0f + __builtin_amdgcn_exp2f(-1.4426950408889634f * x)); }

__device__ __forceinline__ int lane_id_fresh() { int l; asm volatile("v_mbcnt_lo_u32_b32 %0, -1, 0\n\tv_mbcnt_hi_u32_b32 %0, -1, %0" : "=v"(l)); return l; }
struct Params { const float* in[24]; float* out; unsigned char* ws; int ph_lo, ph_hi; };

struct Ctx {
    int tid, lane, wid, wr, wc, fr, fq, bid, nblk;
    LAS unsigned char* lds;
};

__device__ __forceinline__ int next_item(unsigned* ctr, const Ctx& c) {
    LAS int* slot = (LAS int*)(c.lds + 160 * 1024 - 64);
    __syncthreads();
    if (c.tid == 0) *slot = (int)__hip_atomic_fetch_add(ctr, 1u, __ATOMIC_RELAXED, __HIP_MEMORY_SCOPE_AGENT);
    __syncthreads();
    return *slot;
}

struct XQueue { unsigned* heads; int x, v; };
__device__ __forceinline__ XQueue xq_make(const Params& p, int qsel) { XQueue q; q.heads = (unsigned*)(p.ws + WS_CTL) + CW_Q + qsel * 512; q.x = (int)(xb_xcc_id() & 7u); q.v = 0; return q; }
__device__ __forceinline__ bool xq_next(XQueue& q, int per_tile, int ntiles, const Ctx& c, int& tile, int& sub) {
    while (q.v < 8) {
        const int qi = (q.x + q.v) & 7;
        const int L = next_item(q.heads + qi * 64, c);
        const int t = qi + 8 * (L / per_tile);
        if (t < ntiles) { tile = t; sub = L % per_tile; return true; }
        ++q.v;
    }
    return false;
}

namespace pg8 {
#define PG8_LAS __attribute__((address_space(3)))
typedef unsigned short bf16_t;
typedef short bf16x8 __attribute__((ext_vector_type(8)));
typedef float f32x4 __attribute__((ext_vector_type(4)));
typedef unsigned u32x4 __attribute__((ext_vector_type(4)));
constexpr int BM = 256, BK = 64, HALF = 128, HTB = HALF * BK * 2  , STAGE_BYTES = 8 * HTB, NXCD = 8, WGM = 8;

__host__ __device__ __forceinline__ int lds_byte(int r, int c) { const int st = (r >> 4) * 2 + (c >> 5), rr = r & 15, cc = c & 31, ob = rr * 64 + cc * 2; return st * 1024 + (ob ^ (((ob >> 9) & 1) << 5)); }
__host__ __device__ __forceinline__ void stage_rc(int b, int& R, int& C) { const int st = b / 1024, sb = b % 1024, swz = sb ^ (((sb >> 9) & 1) << 5); R = (st >> 1) * 16 + swz / 64; C = (st & 1) * 32 + (swz % 64) / 2; }
__host__ __device__ __forceinline__ int perm32(int rho) { const int n = rho >> 4, i = rho & 15; return 8 * (i >> 2) + 4 * n + (i & 3); }

struct Unit { int pm, pn; };
struct Gemm { const bf16_t* A; const bf16_t* Bt; int M, N, K; };

struct StaticOrder {
    int nM, nN, nwg, G, c;
    __host__ __device__ void init(int M, int N, int G_, int c_) { nM = M / BM; nN = N / BM; nwg = nM * nN; G = G_; c = c_; }
    __host__ __device__ bool next(int i, Unit& u) const {
        const long L = (long)i * G + c; if (L >= nwg) return false;
        int wgid = (int)L; { const int q = nwg / NXCD, r = nwg % NXCD, xcd = wgid % NXCD, off = wgid / NXCD; wgid = (xcd < r ? xcd * (q + 1) : r * (q + 1) + (xcd - r) * q) + off; }
        const int nig = WGM * nN, gid = wgid / nig, fm = gid * WGM, gsz = (nM - fm) < WGM ? (nM - fm) : WGM;
        u.pm = fm + ((wgid % nig) % gsz); u.pn = (wgid % nig) / gsz; return true;
    }
    __device__ __forceinline__ void a_ready(const Unit&) const {}
    __device__ __forceinline__ void done(const Unit&) const {}
};
struct NoMid { static constexpr int AT = -1; __device__ __forceinline__ void operator()(f32x4 (&)[2][2][4][2], const Unit&, int, int, int, int) const {} };
template <class Epi, class Sched, bool STAMP = false, class Mid = NoMid>
__device__ __forceinline__ void gemm_phase(PG8_LAS unsigned char* lds, const Gemm g, const Sched& S, const Epi& E, unsigned long long* stamps, const int wid_in, const Mid& MH = Mid()) {
    const int wid = __builtin_amdgcn_readfirstlane(wid_in), lane = lane_id_fresh(), tid = wid * 64 + lane, wr = wid >> 2, wc = wid & 3, fr = lane & 15, fq = lane >> 4;
    const int K = g.K, nt = K / BK;
    int ts_lo = 0, ts_hi = 0, nts = 0; const unsigned long long rt_entry = STAMP ? (unsigned long long)wall_clock64() : 0ull;
#define PG8_STAMP() do { if (STAMP && wid == 0 && nts < 64) { const unsigned long long _c = (unsigned long long)clock64(); \
        ts_lo = (lane == nts) ? (int)(unsigned)_c : ts_lo; ts_hi = (lane == nts) ? (int)(unsigned)(_c >> 32) : ts_hi; ++nts; } } while (0)
    PG8_STAMP();
    unsigned voffA[2], voffB[2];
#pragma unroll
    for (int i = 0; i < 2; ++i) { int R, C; stage_rc(tid * 16 + i * 8192, R, C); const int Rb = Epi::PERM ? ((R & ~31) + perm32(R & 31)) : R;
        voffA[i] = (unsigned)(R * K + C) * 2u; voffB[i] = (unsigned)(Rb * K + C) * 2u; }
    const size_t kstep = (size_t)(BK * 2);
    const size_t hstep = (size_t)HALF * K * 2;
    const size_t tstep = 2 * hstep;
    const unsigned ldsw = (unsigned)wid * 1024u;
    const int aoff = lds_byte(wr * 64 + fr, fq * 8), boff = lds_byte(wc * 32 + fr, fq * 8);
#define PG8_SA(b, h) (((b) * 2 + (h)) * HTB)
#define PG8_SB(b, h) ((4 + (b) * 2 + (h)) * HTB)
#define PG8_STAGE(bufoff, gbase, voff) do { _Pragma("unroll") for (int _i = 0; _i < 2; ++_i) \
        __builtin_amdgcn_global_load_lds((const unsigned*)((const char*)(gbase) + (voff)[_i]), (PG8_LAS unsigned*)(lds + (bufoff) + ldsw + _i * 8192), 16, 0, 0); } while (0)
#define PG8_LDA(dst, b, h) do { _Pragma("unroll") for (int m = 0; m < 4; ++m) _Pragma("unroll") for (int k = 0; k < 2; ++k) dst[m][k] = *(const PG8_LAS bf16x8*)(lds + PG8_SA(b, h) + aoff + m * 2048 + k * 1024); } while (0)
#define PG8_LDB(dst, b, h) do { _Pragma("unroll") for (int n = 0; n < 2; ++n) _Pragma("unroll") for (int k = 0; k < 2; ++k) dst[n][k] = *(const PG8_LAS bf16x8*)(lds + PG8_SB(b, h) + boff + n * 2048 + k * 1024); } while (0)
#define PG8_MMA(ai, bj, At, Bt) do { __builtin_amdgcn_s_setprio(1); _Pragma("unroll") for (int m = 0; m < 4; ++m) _Pragma("unroll") for (int n = 0; n < 2; ++n) _Pragma("unroll") for (int k = 0; k < 2; ++k) \
        acc[ai][bj][m][n] = __builtin_amdgcn_mfma_f32_16x16x32_bf16(Bt[n][k], At[m][k], acc[ai][bj][m][n], 0, 0, 0); __builtin_amdgcn_s_setprio(0); } while (0)
#define PG8_WAIT_V(n) asm volatile("s_waitcnt vmcnt(" #n ")" ::: "memory")
#define PG8_WAIT_L(n) asm volatile("s_waitcnt lgkmcnt(" #n ")" ::: "memory")
#define PG8_BAR __builtin_amdgcn_s_barrier()
#define PG8_SCHED __builtin_amdgcn_sched_barrier(0)
    Unit cur, nxt; int ui = 0;
    if (!S.next(0, cur)) return;
    f32x4 acc[2][2][4][2];
#pragma unroll
    for (int a = 0; a < 2; ++a)
#pragma unroll
        for (int b = 0; b < 2; ++b)
#pragma unroll
            for (int m = 0; m < 4; ++m)
#pragma unroll
                for (int n = 0; n < 2; ++n) acc[a][b][m][n] = (f32x4){0.f, 0.f, 0.f, 0.f};
    bf16x8 At[4][2], B0[2][2], B1[2][2];
    const char* cA = (const char*)g.A + (size_t)cur.pm * tstep; const char* cB = (const char*)g.Bt + (size_t)cur.pn * tstep;
    S.a_ready(cur);
    PG8_STAGE(PG8_SB(0, 0), cB, voffB); PG8_STAGE(PG8_SA(0, 0), cA, voffA); PG8_STAGE(PG8_SB(0, 1), cB + hstep, voffB); PG8_STAGE(PG8_SA(0, 1), cA + hstep, voffA);
    if (wr == 1) PG8_BAR;
    PG8_WAIT_V(4); PG8_BAR;
    PG8_STAGE(PG8_SB(1, 0), cB + kstep, voffB); PG8_STAGE(PG8_SA(1, 0), cA + kstep, voffA); PG8_STAGE(PG8_SB(1, 1), cB + hstep + kstep, voffB);
    PG8_WAIT_V(6); PG8_BAR;
    PG8_STAMP();
    for (;;) {
        const bool has_next = S.next(ui + 1, nxt);
        const char* nA = has_next ? (const char*)g.A + (size_t)nxt.pm * tstep : cA; const char* nB = has_next ? (const char*)g.Bt + (size_t)nxt.pn * tstep : cB;
        for (int t = 0; t < nt; t += 2) {
            if (Mid::AT >= 0 && t == Mid::AT) MH(acc, cur, wr, wc, fr, fq);
            const bool last = (t == nt - 2);
            const char* a1 = cA + (size_t)(t + 1) * kstep;
            const char* a2 = last ? nA : cA + (size_t)(t + 2) * kstep; const char* b2 = last ? nB : cB + (size_t)(t + 2) * kstep;
            const char* a3 = a2 + kstep; const char* b3 = b2 + kstep;
            if (last && has_next) S.a_ready(nxt);
            PG8_LDB(B0, 0, 0); PG8_SCHED; PG8_LDA(At, 0, 0); PG8_STAGE(PG8_SA(1, 1), a1 + hstep, voffA);
            PG8_WAIT_L(8); PG8_BAR; PG8_WAIT_L(0); PG8_MMA(0, 0, At, B0); PG8_BAR; PG8_SCHED;
            PG8_LDB(B1, 0, 1); PG8_STAGE(PG8_SB(0, 0), b2, voffB);
            PG8_BAR; PG8_WAIT_L(0); PG8_MMA(0, 1, At, B1); PG8_BAR;
            PG8_LDA(At, 0, 1); PG8_STAGE(PG8_SA(0, 0), a2, voffA);
            PG8_BAR; PG8_WAIT_L(0); PG8_MMA(1, 0, At, B0); PG8_BAR; PG8_SCHED;
            PG8_STAGE(PG8_SB(0, 1), b2 + hstep, voffB);
            PG8_WAIT_V(6); PG8_BAR; PG8_MMA(1, 1, At, B1); PG8_BAR;
            PG8_LDB(B0, 1, 0); PG8_SCHED; PG8_LDA(At, 1, 0); PG8_STAGE(PG8_SA(0, 1), a2 + hstep, voffA);
            PG8_WAIT_L(8); PG8_BAR; PG8_WAIT_L(0); PG8_MMA(0, 0, At, B0); PG8_BAR; PG8_SCHED;
            PG8_LDB(B1, 1, 1); PG8_STAGE(PG8_SB(1, 0), b3, voffB);
            PG8_BAR; PG8_WAIT_L(0); PG8_MMA(0, 1, At, B1); PG8_BAR;
            PG8_LDA(At, 1, 1); PG8_STAGE(PG8_SA(1, 0), a3, voffA);
            PG8_BAR; PG8_WAIT_L(0); PG8_MMA(1, 0, At, B0); PG8_BAR; PG8_SCHED;
            PG8_STAGE(PG8_SB(1, 1), b3 + hstep, voffB);
            PG8_WAIT_V(6); PG8_BAR; PG8_MMA(1, 1, At, B1); PG8_BAR;
        }
        PG8_STAMP();
        if constexpr (!Epi::AFTER_DRAIN) { E(acc, cur, wr, wc, fr, fq); S.done(cur); }
        PG8_STAMP();
        if (!has_next) break;
#pragma unroll
        for (int a = 0; a < 2; ++a)
#pragma unroll
            for (int b = 0; b < 2; ++b)
#pragma unroll
                for (int m = 0; m < 4; ++m)
#pragma unroll
                    for (int n = 0; n < 2; ++n) acc[a][b][m][n] = (f32x4){0.f, 0.f, 0.f, 0.f};
        cur = nxt; cA = nA; cB = nB; ++ui;
    }
    PG8_WAIT_V(0);
    if (wr == 0) PG8_BAR;
    PG8_BAR;
    if constexpr (Epi::AFTER_DRAIN) { E.fused(acc, cur, wr, wc, fr, fq, lds, wid, lane); S.done(cur); }
    PG8_STAMP();
    if (STAMP && wid == 0) { stamps[lane] = lane < nts ? (((unsigned long long)(unsigned)ts_hi << 32) | (unsigned)ts_lo) : 0ull;
        if (lane == 62) stamps[62] = rt_entry; if (lane == 63) stamps[63] = (unsigned long long)wall_clock64(); }
#undef PG8_STAMP
#undef PG8_SA
#undef PG8_SB
#undef PG8_STAGE
#undef PG8_LDA
#undef PG8_LDB
#undef PG8_MMA
#undef PG8_WAIT_V
#undef PG8_WAIT_L
#undef PG8_BAR
#undef PG8_SCHED
}
}

constexpr int G_STAGE = 49152, G_BOFF = 32768;
template <bool NTB, int K>
__device__ __forceinline__ void gemm_mainloop(f32x4 (&acc)[8][2], const bf16_t* const (&arow)[4], const float* bptr, const int ldb, const Ctx& c) {
    const int lane = c.lane, wid = c.wid;
    constexpr int nt = K >> 6;
    const int half = lane & 1, nq = ((lane >> 1) & 7) | ((lane >> 4) << 3);
    int b_wr[4];
#pragma unroll
    for (int j = 0; j < 4; ++j) { const int n = 4 * nq + j; b_wr[j] = G_BOFF + n * 128 + ((wid ^ ((n >> 1) & 7)) << 4) + half * 8; }
    const int a_wr = wid * 4096 + lane * 16;
    const int fr = c.fr, fq = c.fq;
    int a_rd[2], b_rd[2][2];
#pragma unroll
    for (int kb = 0; kb < 2; ++kb) {
        a_rd[kb] = (128 * c.wr + fr) * 128 + ((((4 * kb + fq) ^ (fr & 7))) << 4);
#pragma unroll
        for (int ni = 0; ni < 2; ++ni) { const int n = 32 * c.wc + 16 * ni + fr; b_rd[kb][ni] = G_BOFF + n * 128 + (((4 * kb + fq) ^ ((n >> 1) & 7)) << 4); }
    }
    u32x4 ra[4]; f32x4 rb0[4], rb1[4];
    bf16x8 A0[8], A1[8], B0[2], B1[2];
#define G_LOADA(T) do { _Pragma("unroll") for (int i = 0; i < 4; ++i) ra[i] = *(const u32x4*)(arow[i] + (T) * 64); } while (0)
#define G_LOADB(RB, T) do { _Pragma("unroll") for (int i = 0; i < 4; ++i) { \
        if (NTB) RB[i] = __builtin_nontemporal_load((const f32x4*)(bptr + (size_t)((T) * 64 + i) * ldb)); else RB[i] = *(const f32x4*)(bptr + (size_t)((T) * 64 + i) * ldb); } } while (0)
#define G_WRITE(ST, RB) do { _Pragma("unroll") for (int i = 0; i < 4; ++i) *(LAS u32x4*)((ST) + a_wr + i * 1024) = ra[i]; \
        _Pragma("unroll") for (int j = 0; j < 4; ++j) { u32x2 w; w.x = pack_bf16(RB[0][j], RB[1][j]); w.y = pack_bf16(RB[2][j], RB[3][j]); *(LAS u32x2*)((ST) + b_wr[j]) = w; } } while (0)
#define G_LDF(ST, kb, AF, BF) do { _Pragma("unroll") for (int ni = 0; ni < 2; ++ni) BF[ni] = *(const LAS bf16x8*)((ST) + b_rd[kb][ni]); \
        _Pragma("unroll") for (int mi = 0; mi < 8; ++mi) AF[mi] = *(const LAS bf16x8*)((ST) + a_rd[kb] + mi * 2048); } while (0)
#define G_MMA(AF, BF) do { _Pragma("unroll") for (int mi = 0; mi < 8; ++mi) _Pragma("unroll") for (int ni = 0; ni < 2; ++ni) \
        acc[mi][ni] = __builtin_amdgcn_mfma_f32_16x16x32_bf16(BF[ni], AF[mi], acc[mi][ni], 0, 0, 0); } while (0)
#define G_SB __builtin_amdgcn_sched_barrier(0)
    LAS unsigned char* st0 = c.lds; LAS unsigned char* st1 = c.lds + G_STAGE;
    constexpr int tl = nt - 1;
    G_LOADA(0); G_LOADB(rb0, 0); G_LOADB(rb1, 1);
    G_WRITE(st0, rb0);
    G_LOADA(1); G_LOADB(rb0, 2);
    __syncthreads();
#pragma unroll 1
    for (int t = 0; t < nt; t += 2) {
        const int t2 = (t + 2 < tl) ? t + 2 : tl, t3 = (t + 3 < tl) ? t + 3 : tl, t4 = (t + 4 < tl) ? t + 4 : tl;
        G_LDF(st0, 0, A0, B0); G_LDF(st0, 1, A1, B1); G_SB;
        G_MMA(A0, B0); G_SB;
        G_WRITE(st1, rb1); G_SB;
        G_MMA(A1, B1); G_SB;
        G_LOADA(t2); G_LOADB(rb1, t3);
        __syncthreads();
        G_LDF(st1, 0, A0, B0); G_LDF(st1, 1, A1, B1); G_SB;
        G_MMA(A0, B0); G_SB;
        G_WRITE(st0, rb0); G_SB;
        G_MMA(A1, B1); G_SB;
        G_LOADA(t3); G_LOADB(rb0, t4);
        __syncthreads();
    }
#undef G_LOADA
#undef G_LOADB
#undef G_WRITE
#undef G_LDF
#undef G_MMA
#undef G_SB
}
constexpr int W_STAGE = 65536, W_BOFF = 32768;
__device__ __forceinline__ int swzb(int n) { return ((n >> 2) & 1) | ((((n >> 1) ^ (n >> 3)) & 1) << 1) | ((((n >> 2) ^ (n >> 4)) & 1) << 2); }
template <int K>
__device__ __forceinline__ void gemm_mainloop256(f32x4 (&acc)[8][4], f32x4 (&rb)[8], const bf16_t* abase, const int (&aoff)[4], const float* bptr, const int ldb, const int nrows, const Ctx& c,
                                                 const bool staged, const int (&aoffn)[4], const float* bptrn, const int nrows_n, const bool hn) {
    const int lane = c.lane, wid = c.wid;
    constexpr int nt = K >> 6;
    int b_wr[2];
#pragma unroll
    for (int jh = 0; jh < 2; ++jh) { const int n = 4 * lane + 2 * jh; b_wr[jh] = W_BOFF + n * 128 + ((wid ^ swzb(n)) << 4); }
    const int a_dma = wid * 4096;
    const int fr = c.fr, fq = c.fq;
    int a_rd[2], b_rd[2][2];
#pragma unroll
    for (int kb = 0; kb < 2; ++kb) {
        a_rd[kb] = (128 * c.wr + fr) * 128 + ((((4 * kb + fq) ^ (fr & 7))) << 4);
#pragma unroll
        for (int ni = 0; ni < 2; ++ni) { const int n = 64 * c.wc + 16 * ni + fr; b_rd[kb][ni] = W_BOFF + n * 128 + (((4 * kb + fq) ^ swzb(n)) << 4); }
    }
    const int nfr = __builtin_amdgcn_readfirstlane(max(0, min(8, (nrows - 128 * c.wr + 15) >> 4)));
    const int npc = __builtin_amdgcn_readfirstlane(max(0, min(4, (nrows - 32 * wid + 7) >> 3)));
    const int npcn = __builtin_amdgcn_readfirstlane(max(0, min(4, (nrows_n - 32 * wid + 7) >> 3)));
    const int n1a = hn ? 64 : 0;
    const size_t n1b = hn ? (size_t)64 * ldb : 0;
#define W_FA(ST, T, NT1) do { const bool nx = ((T) >= nt); const int np = nx ? npcn : npc; \
        _Pragma("unroll") for (int i = 0; i < 4; ++i) if (i < np) \
            __builtin_amdgcn_global_load_lds((const unsigned*)(abase + (nx ? aoffn[i] + ((NT1) ? n1a : 0) : aoff[i] + (T) * 64)), (LAS unsigned*)((ST) + a_dma + i * 1024), 16, 0, 0); } while (0)
#define W_FB(T, NT1) do { const bool nx = ((T) >= nt); \
        const float* bq = nx ? bptrn + ((NT1) ? n1b : 0) : bptr + (size_t)((T) * 64) * ldb; \
        _Pragma("unroll") for (int i = 0; i < 8; ++i) rb[i] = *(const f32x4*)(bq + (size_t)i * ldb); } while (0)
#define W_CVT() do { _Pragma("unroll") for (int j = 0; j < 4; ++j) { wv[j].x = pack_bf16(rb[0][j], rb[1][j]); wv[j].y = pack_bf16(rb[2][j], rb[3][j]); \
            wv[j].z = pack_bf16(rb[4][j], rb[5][j]); wv[j].w = pack_bf16(rb[6][j], rb[7][j]); } } while (0)
#define W_ST(ST) do { _Pragma("unroll") for (int j = 0; j < 4; ++j) *(LAS u32x4*)((ST) + b_wr[j >> 1] + (j & 1) * 128) = wv[j]; } while (0)
#define W_SB __builtin_amdgcn_sched_barrier(0)
#define W_DSR(dst, addr, off) asm volatile("ds_read_b128 %0, %1 offset:%2" : "=v"(dst) : "v"(addr), "i"(off))
#define W_COMPUTE(ST, KB0, KB1) do { const unsigned stb = (unsigned)(unsigned long)(ST); \
    _Pragma("unroll") for (int kb = (KB0); kb < (KB1); ++kb) { bf16x8 bf0, bf1, bf2, bf3, afc, afn; \
        const unsigned ba0 = stb + b_rd[kb][0], ba1 = stb + b_rd[kb][1], aa = stb + a_rd[kb]; \
        W_DSR(bf0, ba0, 0); W_DSR(bf1, ba1, 0); W_DSR(bf2, ba0, 4096); W_DSR(bf3, ba1, 4096); W_DSR(afc, aa, 0); \
        _Pragma("unroll") for (int mi = 0; mi < 8; ++mi) { \
            if (mi < 7) { W_DSR(afn, aa, (mi + 1) * 2048); } \
            if (mi == 0) asm volatile("s_waitcnt lgkmcnt(1)" : "+v"(afc), "+v"(bf0), "+v"(bf1), "+v"(bf2), "+v"(bf3)); \
            else if (mi < 7) asm volatile("s_waitcnt lgkmcnt(1)" : "+v"(afc)); \
            else asm volatile("s_waitcnt lgkmcnt(0)" : "+v"(afc)); \
            if (mi < nfr) { \
                acc[mi][0] = __builtin_amdgcn_mfma_f32_16x16x32_bf16(bf0, afc, acc[mi][0], 0, 0, 0); acc[mi][1] = __builtin_amdgcn_mfma_f32_16x16x32_bf16(bf1, afc, acc[mi][1], 0, 0, 0); \
                acc[mi][2] = __builtin_amdgcn_mfma_f32_16x16x32_bf16(bf2, afc, acc[mi][2], 0, 0, 0); acc[mi][3] = __builtin_amdgcn_mfma_f32_16x16x32_bf16(bf3, afc, acc[mi][3], 0, 0, 0); } \
            afc = afn; } } } while (0)
    LAS unsigned char* st0 = c.lds; LAS unsigned char* st1 = c.lds + W_STAGE;
    u32x4 wv[4];
    if (!staged) {
        W_FA(st0, 0, 0); W_FB(0, 0);
        W_CVT(); W_SB; W_FB(1, 0); W_SB; W_ST(st0);
        asm volatile("s_waitcnt vmcnt(8)" ::: "memory");
        __syncthreads();
        W_FA(st1, 1, 0);
    }
#pragma unroll 1
    for (int t = 0; t < nt; t += 2) {
        W_COMPUTE(st0, 0, 1);
        W_SB; W_CVT(); W_SB; W_FB(t + 2, 0); W_SB; W_ST(st1); W_SB;
        W_COMPUTE(st0, 1, 2);
        asm volatile("s_waitcnt vmcnt(8)" ::: "memory");
        __syncthreads();
        W_FA(st0, t + 2, 0);
        W_COMPUTE(st1, 0, 1);
        W_SB; W_CVT(); W_SB; W_FB(t + 3, 1); W_SB; W_ST(st0); W_SB;
        W_COMPUTE(st1, 1, 2);
        asm volatile("s_waitcnt vmcnt(8)" ::: "memory");
        __syncthreads();
        W_FA(st1, t + 3, 1);
    }
#undef W_FA
#undef W_FB
#undef W_CVT
#undef W_ST
#undef W_SB
#undef W_COMPUTE
#undef W_DSR
}
__device__ __forceinline__ int a_piece_row(const Ctx& c, int i) { return 32 * c.wid + 8 * i + (c.lane >> 3); }
__device__ __forceinline__ int a_piece_col(const Ctx& c) { return 8 * ((c.lane & 7) ^ ((c.lane >> 3) & 7)); }
__device__ __forceinline__ void zero_acc(f32x4 (&acc)[8][2]) {
#pragma unroll
    for (int mi = 0; mi < 8; ++mi)
#pragma unroll
        for (int ni = 0; ni < 2; ++ni) acc[mi][ni] = (f32x4){0.f, 0.f, 0.f, 0.f};
}
__device__ __forceinline__ int b_nq(const Ctx& c) { return ((c.lane >> 1) & 7) | ((c.lane >> 4) << 3); }
__device__ __forceinline__ int b_k0(const Ctx& c) { return 8 * c.wid + 4 * (c.lane & 1); }

__device__ __forceinline__ void phase_mod(const Params& p, const Ctx& c) {
    const float* cc = p.in[1]; const float* w_ada = p.in[3]; const float* b_ada = p.in[4];
    float* mod = (float*)(p.ws + WS_MOD);
    LAS float* sc = (LAS float*)c.lds;
    LAS float* red = (LAS float*)(c.lds + 32768);
    for (int i = c.tid; i < NB * D; i += 512) { const float v = cc[i]; sc[i] = v / (1.0f + __expf(-v)); }
    __syncthreads();
    const int cq = c.tid % 12, kl = c.tid / 12;
    for (int item = c.bid; item < 256; item += c.nblk) {
        float acc[4][4];
#pragma unroll
        for (int b = 0; b < 4; ++b)
#pragma unroll
            for (int j = 0; j < 4; ++j) acc[b][j] = 0.f;
        if (kl < 42) {
            const float* wp = w_ada + item * 48 + cq * 4;
#pragma unroll 8
            for (int k = kl; k < D; k += 42) {
                const f32x4 w = *(const f32x4*)(wp + (size_t)k * NMOD);
#pragma unroll
                for (int b = 0; b < 4; ++b) { const float s = sc[b * D + k];
#pragma unroll
                    for (int j = 0; j < 4; ++j) acc[b][j] += s * w[j]; }
            }
#pragma unroll
            for (int b = 0; b < 4; ++b)
#pragma unroll
                for (int j = 0; j < 4; ++j) red[(kl * 12 + cq) * 16 + b * 4 + j] = acc[b][j];
        }
        __syncthreads();
        if (c.tid < 192) {
            const int b = c.tid / 48, col = c.tid % 48;
            float s = 0.f;
            for (int k2 = 0; k2 < 42; ++k2) s += red[(k2 * 12 + (col >> 2)) * 16 + b * 4 + (col & 3)];
            mod[b * NMOD + item * 48 + col] = s + b_ada[item * 48 + col];
        }
        __syncthreads();
    }
}

struct CvTile { const float* src; bf16_t* dst; int N, ldt; };
__device__ __forceinline__ CvTile cv_tile(const Params& p, const Ctx& c, int t) {
    const float* W; bf16_t* Wt; int N, ldt, koff, kt, ntile;
    if (t < 2560) { W = p.in[6]; Wt = (bf16_t*)(p.ws + WS_WIN_T); N = INC; ldt = D; koff = 0; kt = t & 31; ntile = t >> 5; }
    else if (t < 2816) { const int u = t - 2560; W = p.in[12]; Wt = (bf16_t*)(p.ws + WS_WPA_T); N = D; ldt = D; koff = 0; kt = u & 15; ntile = u >> 4; }
    else if (t < 3072) { const int u = t - 2816; W = p.in[13]; Wt = (bf16_t*)(p.ws + WS_WPA_T); N = D; ldt = D; koff = 1024; kt = u & 15; ntile = u >> 4; }
    else { const int u = t - 3072; W = p.in[14]; Wt = (bf16_t*)(p.ws + WS_WOUT_T); N = D; ldt = D; koff = 0; kt = u & 31; ntile = u >> 5; }
    CvTile r;
    r.src = W + (size_t)(kt * 64 + 8 * c.wid + 4 * (c.lane & 1)) * N + ntile * 128 + 4 * b_nq(c);
    r.dst = Wt + (size_t)(ntile * 128) * ldt + koff + kt * 64;
    r.N = N; r.ldt = ldt;
    return r;
}
__device__ __forceinline__ void phase_convert(const Params& p, const Ctx& c) {
    if (c.bid >= 3584) return;
    const int half = c.lane & 1, nq = b_nq(c);
    const int wo = (4 * nq) * 128 + ((c.wid ^ (nq & 7)) << 4) + half * 8;
    CvTile cur = cv_tile(p, c, c.bid);
    f32x4 rb_[4];
#pragma unroll
    for (int i = 0; i < 4; ++i) rb_[i] = *(const f32x4*)(cur.src + (size_t)i * cur.N);
#pragma unroll 1
    for (int t = c.bid; t < 3584; t += c.nblk) {
        u32x2 w[4];
#pragma unroll
        for (int j = 0; j < 4; ++j) { w[j].x = pack_bf16(rb_[0][j], rb_[1][j]); w[j].y = pack_bf16(rb_[2][j], rb_[3][j]); }
        const CvTile nxt = cv_tile(p, c, (t + c.nblk < 3584) ? t + c.nblk : t);
#pragma unroll
        for (int i = 0; i < 4; ++i) rb_[i] = *(const f32x4*)(nxt.src + (size_t)i * nxt.N);
#pragma unroll
        for (int j = 0; j < 4; ++j) *(LAS u32x2*)(c.lds + wo + j * 128) = w[j];
        __syncthreads();
#pragma unroll
        for (int i = 0; i < 2; ++i) {
            const int idx = c.tid + 512 * i, n = idx >> 3, ch = idx & 7;
            const u32x4 v = *(const LAS u32x4*)(c.lds + n * 128 + ((ch ^ ((n >> 2) & 7)) << 4));
            *(u32x4*)(cur.dst + (size_t)n * cur.ldt + ch * 8) = v;
        }
        __syncthreads();
        cur = nxt;
    }
}

__device__ __forceinline__ void phase_norm1(const Params& p, const Ctx& c) {
    const float* x = p.in[0]; const float* g = p.in[5];
    const float* mod = (const float*)(p.ws + WS_MOD);
    bf16_t* h = (bf16_t*)(p.ws + WS_H);
    for (int row = c.bid * 8 + c.wid; row < NTOK; row += c.nblk * 8) {
        const int b = row >> 11;
        f32x4 v[8]; float ss = 0.f;
#pragma unroll
        for (int i = 0; i < 8; ++i) { v[i] = *(const f32x4*)(x + (size_t)row * D + i * 256 + c.lane * 4); ss += v[i][0] * v[i][0] + v[i][1] * v[i][1] + v[i][2] * v[i][2] + v[i][3] * v[i][3]; }
        ss = wave_sum(ss);
        const float rstd = rsqrtf(ss * (1.0f / D) + EPS);
#pragma unroll
        for (int i = 0; i < 8; ++i) {
            const int col = i * 256 + c.lane * 4;
            const f32x4 gg = *(const f32x4*)(g + col), sh = *(const f32x4*)(mod + b * NMOD + col), scl = *(const f32x4*)(mod + b * NMOD + D + col);
            float o[4];
#pragma unroll
            for (int j = 0; j < 4; ++j) o[j] = (v[i][j] * rstd * gg[j]) * (1.0f + scl[j]) + sh[j];
            u32x2 w; w.x = pack_bf16(o[0], o[1]); w.y = pack_bf16(o[2], o[3]);
            *(u32x2*)(h + (size_t)row * D + col) = w;
        }
    }
}

__device__ __forceinline__ void phase_router_prep(const Params& p, const Ctx& c) {
    const float* mod = (const float*)(p.ws + WS_MOD); const float* g = p.in[15];
    const float* w_rg = p.in[16]; const float* b_rg = p.in[17]; const float* w_re = p.in[18]; const float* b_re = p.in[19];
    bf16_t* WtH = (bf16_t*)(p.ws + WS_RW); bf16_t* WtL = WtH + (size_t)NB * 80 * D; float* cb = (float*)(p.ws + WS_RC);
    for (int task = c.bid * 8 + c.wid; task < NB * 80; task += c.nblk * 8) {
        const int b = task / 80, j = task % 80;
        float cs = 0.f;
        for (int k = c.lane; k < D; k += 64) {
            float w = 0.f;
            if (j < 8) w = w_rg[(size_t)k * 8 + j]; else if (j < 72) w = w_re[(size_t)k * 64 + (j - 8)];
            const float wv = g[k] * (1.0f + mod[b * NMOD + 4 * D + k]) * w;
            const unsigned hi = pack_bf16(wv, 0.f) & 0xffffu; const float hif = __uint_as_float(hi << 16);
            WtH[((size_t)b * 80 + j) * D + k] = (bf16_t)hi; WtL[((size_t)b * 80 + j) * D + k] = (bf16_t)(pack_bf16(wv - hif, 0.f) & 0xffffu);
            cs += mod[b * NMOD + 3 * D + k] * w;
        }
        cs = wave_sum(cs);
        if (c.lane == 0) cb[b * 80 + j] = cs + (j < 8 ? b_rg[j] : (j < 72 ? b_re[j - 8] : 0.f));
    }
}

__device__ __forceinline__ void phase_proj_in(const Params& p, const Ctx& c) {
    const bf16_t* h = (const bf16_t*)(p.ws + WS_H); const float* w_in = p.in[6];
    for (int item = c.bid; item < 32 * 80; item += c.nblk) {
        const int mt = item & 31, ntile = item >> 5;
        const int m0 = mt * 256, n0 = ntile * 128;
        const bf16_t* arow[4];
#pragma unroll
        for (int i = 0; i < 4; ++i) arow[i] = h + (size_t)(m0 + a_piece_row(c, i)) * D + a_piece_col(c);
        const float* bptr = w_in + (size_t)b_k0(c) * INC + n0 + 4 * b_nq(c);
        f32x4 acc[8][2]; zero_acc(acc);
        gemm_mainloop<false, D>(acc, arow, bptr, INC, c);
        const int region = n0 >> 10;
#pragma unroll
        for (int mi = 0; mi < 8; ++mi)
#pragma unroll
            for (int ni = 0; ni < 2; ++ni) {
                const int row = m0 + 128 * c.wr + 16 * mi + c.fr;
                const int col = n0 + 32 * c.wc + 16 * ni + 4 * c.fq;
                const f32x4 a = acc[mi][ni];
                if (region < 6) {
                    const int cin = col & 1023;
                    if (region == 2 || region == 5) {
                        bf16_t* vt = (bf16_t*)(p.ws + (region == 2 ? WS_VAT : WS_VBT));
                        const int b = row >> 11, s = row & 2047, hh = cin >> 7, d = cin & 127;
                        const unsigned w0 = pack_bf16(a[0], a[1]), w1 = pack_bf16(a[2], a[3]);
                        bf16_t* base = vt + ((size_t)((b * 8 + hh) * 128 + d)) * SEQ + s;
                        base[0] = (bf16_t)(w0 & 0xffff); base[SEQ] = (bf16_t)(w0 >> 16); base[2 * SEQ] = (bf16_t)(w1 & 0xffff); base[3 * SEQ] = (bf16_t)(w1 >> 16);
                    } else {
                        const size_t off = region == 0 ? WS_QA : region == 1 ? WS_KA : region == 3 ? WS_QB : WS_KB;
                        bf16_t* dst = (bf16_t*)(p.ws + off);
                        u32x2 w; w.x = pack_bf16(a[0], a[1]); w.y = pack_bf16(a[2], a[3]);
                        *(u32x2*)(dst + (size_t)row * 1024 + cin) = w;
                    }
                } else {
                    bf16_t* dst = (bf16_t*)(p.ws + (region < 8 ? WS_GA : WS_GB));
                    const int cin = col - (region < 8 ? 6144 : 8192);
                    u32x2 w; w.x = pack_bf16(sigmoidf_(a[0]), sigmoidf_(a[1])); w.y = pack_bf16(sigmoidf_(a[2]), sigmoidf_(a[3]));
                    *(u32x2*)(dst + (size_t)row * D + cin) = w;
                }
            }
    }
}

constexpr int AT_STAGE = 32768, AT_VOFF = 16384, AT_BIAS = 98304;
__device__ __forceinline__ int rel_bucket_dev(int n) {
    if (n < 16) return n;
    int b = 16;
    b += (n >= 19) + (n >= 21) + (n >= 24) + (n >= 27) + (n >= 31) + (n >= 35) + (n >= 40) + (n >= 46) + (n >= 52) + (n >= 59) + (n >= 67) + (n >= 77) + (n >= 87) + (n >= 99) + (n >= 113);
    return b;
}
struct KVRegs { u32x4 k[2], v[2]; };
__device__ __forceinline__ void kv_load(KVRegs& r, const bf16_t* kbase, const bf16_t* vtbase, int kt, const Ctx& c) {
#pragma unroll
    for (int i = 0; i < 2; ++i) {
        const int key = (c.tid >> 4) + 32 * i, ck = c.tid & 15;
        r.k[i] = *(const u32x4*)(kbase + (size_t)(kt * 64 + key) * 1024 + ck * 8);
        const int d = (c.tid >> 3) + 64 * i, cv = c.tid & 7;
        r.v[i] = *(const u32x4*)(vtbase + (size_t)d * SEQ + kt * 64 + cv * 8);
    }
}
__device__ __forceinline__ void kv_store(const KVRegs& r, LAS unsigned char* st, const Ctx& c) {
#pragma unroll
    for (int i = 0; i < 2; ++i) {
        const int key = (c.tid >> 4) + 32 * i, ck = c.tid & 15;
        *(LAS u32x4*)(st + key * 256 + ((ck ^ (key & 15)) << 4)) = r.k[i];
        const int d = (c.tid >> 3) + 64 * i, cv = c.tid & 7;
        *(LAS u32x4*)(st + AT_VOFF + d * 128 + ((cv ^ ((d >> 1) & 7)) << 4)) = r.v[i];
    }
}
__device__ __forceinline__ bf16x8 v_frag(LAS unsigned char* st, int nf, int kb2, const Ctx& c) {
    const int d = 16 * nf + c.fr; const int sw = (c.fr >> 1) & 7;
    return *(const LAS bf16x8*)(st + AT_VOFF + d * 128 + (((4 * kb2 + c.fq) ^ sw) << 4));
}
__device__ __forceinline__ bf16x8 pack_p(const f32x4& a, const f32x4& b) {
    u32x4 w; w.x = pack_bf16(a[0], a[1]); w.y = pack_bf16(a[2], a[3]); w.z = pack_bf16(b[0], b[1]); w.w = pack_bf16(b[2], b[3]);
    return __builtin_bit_cast(bf16x8, w);
}

__device__ __forceinline__ void diff_attn_item(const Params& p, const Ctx& c, int b, int h, int qb, float lam, bf16x8 (&qf)[4], KVRegs& kr,
                                               const bf16_t* qn, const bf16_t* kbn, const bf16_t* vtn, const int ktn) {
    const bf16_t* ka = (const bf16_t*)(p.ws + WS_KA); const bf16_t* vat = (const bf16_t*)(p.ws + WS_VAT);
    bf16_t* oa = (bf16_t*)(p.ws + WS_OA);
    const float* rel = p.in[2]; const float* gsub = p.in[11];
    LAS float* bias = (LAS float*)(c.lds + AT_BIAS);
    __syncthreads();
    if (c.tid < 128) bias[c.tid] = rel[rel_bucket_dev(c.tid) * 8 + h] * 1.4426950408889634f;
    const int qpos = 128 * qb + 16 * c.wid + c.fr;
    const size_t qtok = (size_t)b * SEQ + qpos;
    const bf16_t* kbase = ka + (size_t)b * SEQ * 1024 + h * 128;
    const bf16_t* vtbase = vat + (size_t)((b * 8 + h) * 128) * SEQ;
    f32x4 O1[8], O2[8];
#pragma unroll
    for (int nf = 0; nf < 8; ++nf) { O1[nf] = (f32x4){0.f, 0.f, 0.f, 0.f}; O2[nf] = (f32x4){0.f, 0.f, 0.f, 0.f}; }
    float m1 = -1e30f, m2 = -1e30f, l1 = 0.f, l2 = 0.f;
    const int ntiles = 2 * qb + 2;
    const int qmax_w = 128 * qb + 16 * c.wid + 15, qmin_w = 128 * qb + 16 * c.wid;
    const float L2E = 1.4426950408889634f;
    const bool defer = c.wid >= 4;
    bf16x8 pq1[2], pq2[2]; bool pend = false;
#pragma unroll
    for (int kb2 = 0; kb2 < 2; ++kb2) { pq1[kb2] = (bf16x8){0, 0, 0, 0, 0, 0, 0, 0}; pq2[kb2] = pq1[kb2]; }
    int sidx = 0, sprev = 2;
    for (int kt = 0; kt < ntiles; ++kt) {
        LAS unsigned char* st = c.lds + sidx * AT_STAGE;
        kv_store(kr, st, c);
        { const bool last = (kt + 1 >= ntiles);
          kv_load(kr, last ? kbn : kbase, last ? vtn : vtbase, last ? ktn : kt + 1, c); }
        __syncthreads();
        if (pend) {
            LAS unsigned char* sp = c.lds + sprev * AT_STAGE;
#pragma unroll
            for (int kb2 = 0; kb2 < 2; ++kb2)
#pragma unroll
                for (int nf = 0; nf < 8; ++nf) {
                    const bf16x8 vf = v_frag(sp, nf, kb2, c);
                    O1[nf] = __builtin_amdgcn_mfma_f32_16x16x32_bf16(vf, pq1[kb2], O1[nf], 0, 0, 0);
                    O2[nf] = __builtin_amdgcn_mfma_f32_16x16x32_bf16(vf, pq2[kb2], O2[nf], 0, 0, 0);
                }
            pend = false;
        }
        if (64 * kt <= qmax_w) {
            f32x4 s1[4], s2[4];
#pragma unroll
            for (int f = 0; f < 4; ++f) {
                bf16x8 kf[4];
#pragma unroll
                for (int kb = 0; kb < 4; ++kb) kf[kb] = *(const LAS bf16x8*)(st + (16 * f + c.fr) * 256 + (((4 * kb + c.fq) ^ c.fr) << 4));
                f32x4 z = (f32x4){0.f, 0.f, 0.f, 0.f};
                z = __builtin_amdgcn_mfma_f32_16x16x32_bf16(kf[0], qf[0], z, 0, 0, 0);
                s1[f] = __builtin_amdgcn_mfma_f32_16x16x32_bf16(kf[1], qf[1], z, 0, 0, 0);
                z = (f32x4){0.f, 0.f, 0.f, 0.f};
                z = __builtin_amdgcn_mfma_f32_16x16x32_bf16(kf[2], qf[2], z, 0, 0, 0);
                s2[f] = __builtin_amdgcn_mfma_f32_16x16x32_bf16(kf[3], qf[3], z, 0, 0, 0);
            }
            const bool nearb = (qmin_w - (64 * kt + 63)) < 113;
            const float CS = 0.125f * L2E, THR = 8.0f;
            float mx1, mx2;
            if (!nearb) {
                const float bf_ = bias[127];
                float r1 = s1[0][0], r2 = s2[0][0];
#pragma unroll
                for (int f = 0; f < 4; ++f)
#pragma unroll
                    for (int r = 0; r < 4; ++r) { r1 = fmaxf(r1, s1[f][r]); r2 = fmaxf(r2, s2[f][r]); }
                mx1 = r1 * CS + bf_; mx2 = r2 * CS + bf_;
            } else {
                mx1 = -1e30f; mx2 = -1e30f;
#pragma unroll
                for (int f = 0; f < 4; ++f)
#pragma unroll
                    for (int r = 0; r < 4; ++r) {
                        const int n = qpos - (64 * kt + 16 * f + 4 * c.fq + r);
                        const float bv = bias[n < 0 ? 0 : (n > 127 ? 127 : n)];
                        float a1 = s1[f][r] * CS + bv, a2 = s2[f][r] * CS + bv;
                        if (n < 0) { a1 = -1e30f; a2 = -1e30f; }
                        s1[f][r] = a1; s2[f][r] = a2;
                        mx1 = fmaxf(mx1, a1); mx2 = fmaxf(mx2, a2);
                    }
            }
            mx1 = xmax32(xmax16(mx1)); mx2 = xmax32(xmax16(mx2));
            if (__any((mx1 - m1 > THR) || (mx2 - m2 > THR))) {
                const float mn1 = fmaxf(m1, mx1), mn2 = fmaxf(m2, mx2);
                const float al1 = __builtin_amdgcn_exp2f(m1 - mn1), al2 = __builtin_amdgcn_exp2f(m2 - mn2);
                m1 = mn1; m2 = mn2; l1 *= al1; l2 *= al2;
#pragma unroll
                for (int nf = 0; nf < 8; ++nf) { O1[nf] *= al1; O2[nf] *= al2; }
            }
            if (!nearb) {
                const float d1 = bias[127] - m1, d2 = bias[127] - m2;
#pragma unroll
                for (int f = 0; f < 4; ++f) { s1[f] = s1[f] * CS + d1; s2[f] = s2[f] * CS + d2; }
            } else {
#pragma unroll
                for (int f = 0; f < 4; ++f) { s1[f] = s1[f] - m1; s2[f] = s2[f] - m2; }
            }
            float ps1 = 0.f, ps2 = 0.f;
#pragma unroll
            for (int f = 0; f < 4; ++f)
#pragma unroll
                for (int r = 0; r < 4; ++r) {
                    const float e1 = __builtin_amdgcn_exp2f(s1[f][r]), e2 = __builtin_amdgcn_exp2f(s2[f][r]);
                    s1[f][r] = e1; s2[f][r] = e2; ps1 += e1; ps2 += e2;
                }
            l1 += ps1; l2 += ps2;
#pragma unroll
            for (int kb2 = 0; kb2 < 2; ++kb2) { pq1[kb2] = pack_p(s1[2 * kb2], s1[2 * kb2 + 1]); pq2[kb2] = pack_p(s2[2 * kb2], s2[2 * kb2 + 1]); }
            if (defer) pend = true;
            else {
#pragma unroll
                for (int kb2 = 0; kb2 < 2; ++kb2)
#pragma unroll
                    for (int nf = 0; nf < 8; ++nf) {
                        const bf16x8 vf = v_frag(st, nf, kb2, c);
                        O1[nf] = __builtin_amdgcn_mfma_f32_16x16x32_bf16(vf, pq1[kb2], O1[nf], 0, 0, 0);
                        O2[nf] = __builtin_amdgcn_mfma_f32_16x16x32_bf16(vf, pq2[kb2], O2[nf], 0, 0, 0);
                    }
            }
        }
        sprev = sidx; sidx = (sidx == 2) ? 0 : sidx + 1;
    }
    if (pend) {
        LAS unsigned char* sp = c.lds + sprev * AT_STAGE;
#pragma unroll
        for (int kb2 = 0; kb2 < 2; ++kb2)
#pragma unroll
            for (int nf = 0; nf < 8; ++nf) {
                const bf16x8 vf = v_frag(sp, nf, kb2, c);
                O1[nf] = __builtin_amdgcn_mfma_f32_16x16x32_bf16(vf, pq1[kb2], O1[nf], 0, 0, 0);
                O2[nf] = __builtin_amdgcn_mfma_f32_16x16x32_bf16(vf, pq2[kb2], O2[nf], 0, 0, 0);
            }
    }
#pragma unroll
    for (int kb = 0; kb < 4; ++kb) qf[kb] = *(const bf16x8*)(qn + 32 * kb + 8 * c.fq);
    l1 = xsum32(xsum16(l1)); l2 = xsum32(xsum16(l2));
    const float i1 = 1.0f / l1, i2 = lam / l2;
    float ss = 0.f;
#pragma unroll
    for (int nf = 0; nf < 8; ++nf)
#pragma unroll
        for (int r = 0; r < 4; ++r) { const float o = O1[nf][r] * i1 - O2[nf][r] * i2; O1[nf][r] = o; ss += o * o; }
    ss += __shfl_xor(ss, 16); ss += __shfl_xor(ss, 32);
    const float rstd = rsqrtf(ss * (1.0f / 128.0f) + EPS) * 0.8f;
#pragma unroll
    for (int nf = 0; nf < 8; ++nf) {
        const int d = 16 * nf + 4 * c.fq;
        const f32x4 g = *(const f32x4*)(gsub + d);
        u32x2 w; w.x = pack_bf16(O1[nf][0] * rstd * g[0], O1[nf][1] * rstd * g[1]); w.y = pack_bf16(O1[nf][2] * rstd * g[2], O1[nf][3] * rstd * g[3]);
        *(u32x2*)(oa + qtok * 2048 + h * 128 + d) = w;
    }
}

__device__ __forceinline__ void sb_attn_item(const Params& p, const Ctx& c, int b, int h, int qb, bf16x8 (&qf)[4], KVRegs& kr,
                                             const bf16_t* qn, const bf16_t* kbn, const bf16_t* vtn, const int ktn) {
    const bf16_t* kbuf = (const bf16_t*)(p.ws + WS_KB); const bf16_t* vbt = (const bf16_t*)(p.ws + WS_VBT);
    bf16_t* ob = (bf16_t*)(p.ws + WS_OA) + 1024;
    __syncthreads();
    const int qpos = 128 * qb + 16 * c.wid + c.fr;
    const size_t qtok = (size_t)b * SEQ + qpos;
    const bf16_t* kbase = kbuf + (size_t)b * SEQ * 1024 + h * 128;
    const bf16_t* vtbase = vbt + (size_t)((b * 8 + h) * 128) * SEQ;
    f32x4 O[8];
#pragma unroll
    for (int nf = 0; nf < 8; ++nf) O[nf] = (f32x4){0.f, 0.f, 0.f, 0.f};
    float carry = 0.f;
    const int ntiles = 2 * qb + 2;
    const int qmax_w = 128 * qb + 16 * c.wid + 15;
    const float scale = 0.08838834764831845f * 1.4426950408889634f;
    LAS int* dflag = (LAS int*)(c.lds + AT_BIAS + 1024);
    if (c.lane == 0) dflag[c.wid] = 0;
    bool wdone = false, nxt = false;
    for (int it = 0; it < ntiles; ++it) {
        const int kt = ntiles - 1 - it;
        LAS unsigned char* st = c.lds + (it & 1) * AT_STAGE;
        kv_store(kr, st, c);
        __syncthreads();
        {
            int alld = 1;
#pragma unroll
            for (int w8 = 0; w8 < 8; ++w8) alld &= dflag[w8];
            if (alld) break;
        }
        { const bool last = (kt == 0);
          kv_load(kr, last ? kbn : kbase, last ? vtn : vtbase, last ? ktn : kt - 1, c); nxt = last; }
        if (!wdone && 64 * kt < qmax_w) {
            f32x4 z[4];
#pragma unroll
            for (int f = 0; f < 4; ++f) {
                f32x4 a = (f32x4){0.f, 0.f, 0.f, 0.f};
#pragma unroll
                for (int kb = 0; kb < 4; ++kb) {
                    const bf16x8 kf = *(const LAS bf16x8*)(st + (16 * f + c.fr) * 256 + (((4 * kb + c.fq) ^ c.fr) << 4));
                    a = __builtin_amdgcn_mfma_f32_16x16x32_bf16(kf, qf[kb], a, 0, 0, 0);
                }
                z[f] = a;
            }
            f32x4 lb[4], lk[4]; float T[4];
#pragma unroll
            for (int f = 0; f < 4; ++f) {
                float t = 0.f;
#pragma unroll
                for (int r = 0; r < 4; ++r) {
                    const int kpos = 64 * kt + 16 * f + 4 * c.fq + r;
                    const float zz = z[f][r] * scale;
                    const float sp = __builtin_amdgcn_logf(1.0f + __builtin_amdgcn_exp2f(-fabsf(zz)));
                    const float lbv = fminf(zz, 0.f) - sp;
                    const bool valid = kpos < qpos;
                    const float lkv = valid ? (lbv - zz) : 0.f;
                    lb[f][r] = valid ? lbv : -1e30f; lk[f][r] = lkv; t += lkv;
                }
                T[f] = t;
            }
            float tile_tot = 0.f; float Gl[4], Ft[4];
#pragma unroll
            for (int f = 0; f < 4; ++f) {
                const float A1 = __shfl_xor(T[f], 16), A2 = __shfl_xor(T[f], 32), A3 = __shfl_xor(T[f], 48);
                Gl[f] = ((c.fq & 1) == 0 ? A1 : 0.f) + ((c.fq & 2) == 0 ? (A2 + A3) : 0.f);
                Ft[f] = T[f] + A1 + A2 + A3; tile_tot += Ft[f];
            }
            float after = carry;
#pragma unroll
            for (int f = 3; f >= 0; --f) {
                float suf = 0.f;
#pragma unroll
                for (int r = 3; r >= 0; --r) {
                    const float later = after + Gl[f] + suf;
                    z[f][r] = __builtin_amdgcn_exp2f(lb[f][r] + later);
                    suf += lk[f][r];
                }
                after += Ft[f];
            }
            carry += tile_tot;
#pragma unroll
            for (int kb2 = 0; kb2 < 2; ++kb2) {
                const bf16x8 pp = pack_p(z[2 * kb2], z[2 * kb2 + 1]);
#pragma unroll
                for (int nf = 0; nf < 8; ++nf) {
                    const bf16x8 vf = v_frag(st, nf, kb2, c);
                    O[nf] = __builtin_amdgcn_mfma_f32_16x16x32_bf16(vf, pp, O[nf], 0, 0, 0);
                }
            }
            if (__all(carry < -64.0f)) { wdone = true; if (c.lane == 0) dflag[c.wid] = 1; }
        }
    }
    if (!nxt) kv_load(kr, kbn, vtn, ktn, c);
#pragma unroll
    for (int kb = 0; kb < 4; ++kb) qf[kb] = *(const bf16x8*)(qn + 32 * kb + 8 * c.fq);
#pragma unroll
    for (int nf = 0; nf < 8; ++nf) {
        const int d = 16 * nf + 4 * c.fq;
        u32x2 w; w.x = pack_bf16(O[nf][0], O[nf][1]); w.y = pack_bf16(O[nf][2], O[nf][3]);
        *(u32x2*)(ob + qtok * 2048 + h * 128 + d) = w;
    }
}

__device__ __forceinline__ void attn_sub(const Params& p, const Ctx& c, int sub, int& kind, int& bh, int& qb, const bf16_t*& qp, const bf16_t*& kb, const bf16_t*& vt, int& kt0) {
    const int kh = sub >> 8, i2 = sub & 255, half = kh & 1, pr = i2 >> 5;
    kind = kh >> 1; bh = i2 & 31; qb = half ? pr : 15 - pr;
    const int b = bh >> 3, h = bh & 7;
    const size_t qtok = (size_t)b * SEQ + 128 * qb + 16 * c.wid + c.fr;
    qp = (const bf16_t*)(p.ws + (kind ? WS_QB : WS_QA)) + qtok * 1024 + h * 128;
    kb = (const bf16_t*)(p.ws + (kind ? WS_KB : WS_KA)) + (size_t)b * SEQ * 1024 + h * 128;
    vt = (const bf16_t*)(p.ws + (kind ? WS_VBT : WS_VAT)) + (size_t)(bh * 128) * SEQ;
    kt0 = kind ? 2 * qb + 1 : 0;
}
__device__ __forceinline__ void phase_attn(const Params& p, const Ctx& c, int qsel = 0) {
    float d1 = 0.f, d2 = 0.f;
    if (c.lane < 64) { d1 = p.in[7][c.lane] * p.in[8][c.lane]; d2 = p.in[9][c.lane] * p.in[10][c.lane]; }
    d1 = wave_sum(d1); d2 = wave_sum(d2);
    const float lam = expf(d1) - expf(d2) + 0.2f;
    (void)qsel;
    if (c.bid >= 1024) return;
    int kind, bh, qb, kt0; const bf16_t* qp; const bf16_t* kb; const bf16_t* vt;
    attn_sub(p, c, c.bid, kind, bh, qb, qp, kb, vt, kt0);
    bf16x8 qf[4]; KVRegs kr;
#pragma unroll
    for (int k4 = 0; k4 < 4; ++k4) qf[k4] = *(const bf16x8*)(qp + 32 * k4 + 8 * c.fq);
    kv_load(kr, kb, vt, kt0, c);
#pragma unroll 1
    for (int sub = c.bid; sub < 1024; sub += c.nblk) {
        int kindn, bhn, qbn, kt0n; const bf16_t* qpn; const bf16_t* kbn; const bf16_t* vtn;
        attn_sub(p, c, (sub + c.nblk < 1024) ? sub + c.nblk : sub, kindn, bhn, qbn, qpn, kbn, vtn, kt0n);
        if (kind == 0) diff_attn_item(p, c, bh >> 3, bh & 7, qb, lam, qf, kr, qpn, kbn, vtn, kt0n);
        else sb_attn_item(p, c, bh >> 3, bh & 7, qb, qf, kr, qpn, kbn, vtn, kt0n);
        kind = kindn; bh = bhn; qb = qbn;
    }
}

__device__ __forceinline__ void phase_merge(const Params& p, const Ctx& c) {
    const bf16_t* oa = (const bf16_t*)(p.ws + WS_OA); const bf16_t* ob = (const bf16_t*)(p.ws + WS_OB);
    const bf16_t* ga = (const bf16_t*)(p.ws + WS_GA); const bf16_t* gb = (const bf16_t*)(p.ws + WS_GB);
    bf16_t* mrg = (bf16_t*)(p.ws + WS_MRG);
    for (int item = c.bid; item < 32 * 16; item += c.nblk) {
        const int mt = item & 31, ntile = item >> 5;
        const int m0 = mt * 256, n0 = ntile * 128;
        f32x4 acc[8][2];
#pragma unroll 1
        for (int pass = 0; pass < 2; ++pass) {
            const bf16_t* A = pass ? ob : oa; const float* W = pass ? p.in[13] : p.in[12]; const bf16_t* G = pass ? gb : ga;
            const bf16_t* arow[4];
#pragma unroll
            for (int i = 0; i < 4; ++i) arow[i] = A + (size_t)(m0 + a_piece_row(c, i)) * 1024 + a_piece_col(c);
            const float* bptr = W + (size_t)b_k0(c) * D + n0 + 4 * b_nq(c);
            zero_acc(acc);
            gemm_mainloop<false, 1024>(acc, arow, bptr, D, c);
            float* tmp = (float*)(p.ws + WS_X1);
#pragma unroll
            for (int mi = 0; mi < 8; ++mi)
#pragma unroll
                for (int ni = 0; ni < 2; ++ni) {
                    const int row = m0 + 128 * c.wr + 16 * mi + c.fr;
                    const int col = n0 + 32 * c.wc + 16 * ni + 4 * c.fq;
                    const u32x2 gw = *(const u32x2*)(G + (size_t)row * D + col);
                    f32x4 g; g[0] = __uint_as_float(gw.x << 16); g[1] = __uint_as_float(gw.x & 0xffff0000u); g[2] = __uint_as_float(gw.y << 16); g[3] = __uint_as_float(gw.y & 0xffff0000u);
                    f32x4 v = acc[mi][ni] * g;
                    if (pass == 0) *(f32x4*)(tmp + (size_t)row * D + col) = v;
                    else {
                        v += *(const f32x4*)(tmp + (size_t)row * D + col);
                        u32x2 w; w.x = pack_bf16(v[0], v[1]); w.y = pack_bf16(v[2], v[3]);
                        *(u32x2*)(mrg + (size_t)row * D + col) = w;
                    }
                }
        }
    }
}

__device__ __forceinline__ void phase_out(const Params& p, const Ctx& c) {
    const bf16_t* mrg = (const bf16_t*)(p.ws + WS_MRG); const float* w_out = p.in[14]; const float* x = p.in[0];
    const float* mod = (const float*)(p.ws + WS_MOD);
    float* x1 = (float*)(p.ws + WS_X1);
    for (int item = c.bid; item < 32 * 16; item += c.nblk) {
        const int mt = item & 31, ntile = item >> 5;
        const int m0 = mt * 256, n0 = ntile * 128;
        const bf16_t* arow[4];
#pragma unroll
        for (int i = 0; i < 4; ++i) arow[i] = mrg + (size_t)(m0 + a_piece_row(c, i)) * D + a_piece_col(c);
        const float* bptr = w_out + (size_t)b_k0(c) * D + n0 + 4 * b_nq(c);
        f32x4 acc[8][2]; zero_acc(acc);
        gemm_mainloop<false, D>(acc, arow, bptr, D, c);
        const int b = m0 >> 11;
#pragma unroll
        for (int mi = 0; mi < 8; ++mi)
#pragma unroll
            for (int ni = 0; ni < 2; ++ni) {
                const int row = m0 + 128 * c.wr + 16 * mi + c.fr;
                const int col = n0 + 32 * c.wc + 16 * ni + 4 * c.fq;
                const f32x4 gm = *(const f32x4*)(mod + b * NMOD + 2 * D + col);
                const f32x4 xv = *(const f32x4*)(x + (size_t)row * D + col);
                *(f32x4*)(x1 + (size_t)row * D + col) = xv + gm * acc[mi][ni];
            }
    }
}

__device__ __forceinline__ void phase_norm2_route(const Params& p, const Ctx& c) {
    const float* x1 = (const float*)(p.ws + WS_X1); const float* g = p.in[15];
    const float* mod = (const float*)(p.ws + WS_MOD);
    const float* w_rg = p.in[16]; const float* b_rg = p.in[17]; const float* w_re = p.in[18]; const float* b_re = p.in[19];
    bf16_t* h2 = (bf16_t*)(p.ws + WS_H2);
    unsigned* cnt = (unsigned*)(p.ws + WS_CTL) + CW_CNT;
    int* ltok = (int*)(p.ws + WS_LTOK); float* lw = (float*)(p.ws + WS_LW);
    for (int row = c.bid * 8 + c.wid; row < NTOK; row += c.nblk * 8) {
        const int b = row >> 11;
        f32x4 v[8]; float ss = 0.f;
#pragma unroll
        for (int i = 0; i < 8; ++i) { v[i] = *(const f32x4*)(x1 + (size_t)row * D + i * 256 + c.lane * 4); ss += v[i][0] * v[i][0] + v[i][1] * v[i][1] + v[i][2] * v[i][2] + v[i][3] * v[i][3]; }
        ss = wave_sum(ss);
        const float rstd = rsqrtf(ss * (1.0f / D) + EPS);
        float gl[8];
#pragma unroll
        for (int j = 0; j < 8; ++j) gl[j] = 0.f;
#pragma unroll
        for (int i = 0; i < 8; ++i) {
            const int col = i * 256 + c.lane * 4;
            const f32x4 gg = *(const f32x4*)(g + col), sh = *(const f32x4*)(mod + b * NMOD + 3 * D + col), scl = *(const f32x4*)(mod + b * NMOD + 4 * D + col);
#pragma unroll
            for (int j = 0; j < 4; ++j) v[i][j] = (v[i][j] * rstd * gg[j]) * (1.0f + scl[j]) + sh[j];
            u32x2 w; w.x = pack_bf16(v[i][0], v[i][1]); w.y = pack_bf16(v[i][2], v[i][3]);
            *(u32x2*)(h2 + (size_t)row * D + col) = w;
#pragma unroll
            for (int j = 0; j < 4; ++j) {
                const f32x4 w0 = *(const f32x4*)(w_rg + (size_t)(col + j) * 8), w1 = *(const f32x4*)(w_rg + (size_t)(col + j) * 8 + 4);
#pragma unroll
                for (int e = 0; e < 4; ++e) { gl[e] += v[i][j] * w0[e]; gl[4 + e] += v[i][j] * w1[e]; }
            }
        }
#pragma unroll
        for (int j = 0; j < 8; ++j) gl[j] = wave_sum(gl[j]) + b_rg[j];
        int gi = 0; float gmax = gl[0];
#pragma unroll
        for (int j = 1; j < 8; ++j) if (gl[j] > gmax) { gmax = gl[j]; gi = j; }
        float gsum = 0.f;
#pragma unroll
        for (int j = 0; j < 8; ++j) gsum += __expf(gl[j] - gmax);
        const float pg = 1.0f / gsum;
        float el[8];
#pragma unroll
        for (int j = 0; j < 8; ++j) el[j] = 0.f;
#pragma unroll
        for (int i = 0; i < 8; ++i) {
            const int col = i * 256 + c.lane * 4;
#pragma unroll
            for (int j = 0; j < 4; ++j) {
                const f32x4 w0 = *(const f32x4*)(w_re + (size_t)(col + j) * 64 + gi * 8), w1 = *(const f32x4*)(w_re + (size_t)(col + j) * 64 + gi * 8 + 4);
#pragma unroll
                for (int e = 0; e < 4; ++e) { el[e] += v[i][j] * w0[e]; el[4 + e] += v[i][j] * w1[e]; }
            }
        }
#pragma unroll
        for (int j = 0; j < 8; ++j) el[j] = wave_sum(el[j]) + b_re[gi * 8 + j];
        int i1 = 0; float e1 = el[0];
#pragma unroll
        for (int j = 1; j < 8; ++j) if (el[j] > e1) { e1 = el[j]; i1 = j; }
        int i2 = -1; float e2 = -3.0e38f;
#pragma unroll
        for (int j = 0; j < 8; ++j) if (j != i1 && el[j] > e2) { e2 = el[j]; i2 = j; }
        const float r2 = __expf(e2 - e1);
        const float tp1 = 1.0f / (1.0f + r2), tp2 = r2 / (1.0f + r2);
        if (c.lane == 0) {
            const int ea = gi * 8 + i1, eb = gi * 8 + i2;
            const unsigned sa = atomicAdd(&cnt[ea], 1u), sb = atomicAdd(&cnt[eb], 1u);
            ltok[ea * NTOK + sa] = row * 2; lw[ea * NTOK + sa] = pg * tp1;
            ltok[eb * NTOK + sb] = row * 2 + 1; lw[eb * NTOK + sb] = pg * tp2;
        }
    }
}

__device__ __forceinline__ void phase_norm2_route2(const Params& p, const Ctx& c, int dummy = 0) {
    const float* x1 = (const float*)(p.ws + WS_X1); const float* g = p.in[15];
    const float* mod = (const float*)(p.ws + WS_MOD);
    const bf16_t* WtH = (const bf16_t*)(p.ws + WS_RW); const bf16_t* WtL = WtH + (size_t)NB * 80 * D; const float* cb = (const float*)(p.ws + WS_RC);
    bf16_t* h2 = (bf16_t*)(p.ws + WS_H2);
    unsigned* cnt = (unsigned*)(p.ws + WS_CTL) + CW_CNT + (dummy ? 128 : 0);
    int* ltok = (int*)(p.ws + (dummy ? WS_ACT : WS_LTOK)); float* lw = (float*)(p.ws + (dummy ? WS_ACT + (size_t)NE * NTOK * 4 : WS_LW));
    LAS float* red = (LAS float*)c.lds;
    LAS float* ssr = (LAS float*)(c.lds + 81920);
    LAS float* rs = (LAS float*)(c.lds + 81920 + 1024);
    for (int it = c.bid; it < NTOK / 32; it += c.nblk) {
        const int tok0 = it * 32, b = tok0 >> 11;
        const int ks = c.wid, i16 = c.lane & 15, kk = c.lane >> 4;
        const float* ap0 = x1 + (size_t)(tok0 + i16) * D + 256 * ks + 8 * kk;
        const float* ap1 = ap0 + (size_t)16 * D;
        const bf16_t* bph = WtH + ((size_t)b * 80 + i16) * D + 256 * ks + 8 * kk;
        const bf16_t* bpl = WtL + ((size_t)b * 80 + i16) * D + 256 * ks + 8 * kk;
        f32x4 acc[2][5];
#pragma unroll
        for (int g2 = 0; g2 < 2; ++g2)
#pragma unroll
            for (int nb = 0; nb < 5; ++nb) acc[g2][nb] = (f32x4){0.f, 0.f, 0.f, 0.f};
        float ss0 = 0.f, ss1 = 0.f;
#pragma unroll 4
        for (int kb8 = 0; kb8 < 8; ++kb8) {
            bf16x8 ah[2], al[2];
#pragma unroll
            for (int g2 = 0; g2 < 2; ++g2) {
                const float* ap = (g2 ? ap1 : ap0) + 32 * kb8;
                const f32x4 v0 = *(const f32x4*)ap, v1 = *(const f32x4*)(ap + 4);
                const float sq = v0[0] * v0[0] + v0[1] * v0[1] + v0[2] * v0[2] + v0[3] * v0[3] + v1[0] * v1[0] + v1[1] * v1[1] + v1[2] * v1[2] + v1[3] * v1[3];
                if (g2) ss1 += sq; else ss0 += sq;
                u32x4 h, l;
                h.x = pack_bf16(v0[0], v0[1]); h.y = pack_bf16(v0[2], v0[3]); h.z = pack_bf16(v1[0], v1[1]); h.w = pack_bf16(v1[2], v1[3]);
                l.x = pack_bf16(v0[0] - __uint_as_float(h.x << 16), v0[1] - __uint_as_float(h.x & 0xffff0000u));
                l.y = pack_bf16(v0[2] - __uint_as_float(h.y << 16), v0[3] - __uint_as_float(h.y & 0xffff0000u));
                l.z = pack_bf16(v1[0] - __uint_as_float(h.z << 16), v1[1] - __uint_as_float(h.z & 0xffff0000u));
                l.w = pack_bf16(v1[2] - __uint_as_float(h.w << 16), v1[3] - __uint_as_float(h.w & 0xffff0000u));
                ah[g2] = __builtin_bit_cast(bf16x8, h); al[g2] = __builtin_bit_cast(bf16x8, l);
            }
#pragma unroll
            for (int nb = 0; nb < 5; ++nb) {
                const bf16x8 bh = *(const bf16x8*)(bph + (size_t)nb * 16 * D + 32 * kb8), bl = *(const bf16x8*)(bpl + (size_t)nb * 16 * D + 32 * kb8);
#pragma unroll
                for (int g2 = 0; g2 < 2; ++g2) {
                    acc[g2][nb] = __builtin_amdgcn_mfma_f32_16x16x32_bf16(ah[g2], bh, acc[g2][nb], 0, 0, 0);
                    acc[g2][nb] = __builtin_amdgcn_mfma_f32_16x16x32_bf16(ah[g2], bl, acc[g2][nb], 0, 0, 0);
                    acc[g2][nb] = __builtin_amdgcn_mfma_f32_16x16x32_bf16(al[g2], bh, acc[g2][nb], 0, 0, 0);
                }
            }
        }
        ss0 += __shfl_xor(ss0, 16); ss0 += __shfl_xor(ss0, 32);
        ss1 += __shfl_xor(ss1, 16); ss1 += __shfl_xor(ss1, 32);
        __syncthreads();
#pragma unroll
        for (int g2 = 0; g2 < 2; ++g2)
#pragma unroll
            for (int nb = 0; nb < 5; ++nb)
#pragma unroll
                for (int r = 0; r < 4; ++r) red[(c.wid * 32 + g2 * 16 + 4 * kk + r) * 80 + nb * 16 + i16] = acc[g2][nb][r];
        if (kk == 0) { ssr[c.wid * 32 + i16] = ss0; ssr[c.wid * 32 + 16 + i16] = ss1; }
        __syncthreads();
        if (c.tid < 32) {
            const int t = c.tid;
            float ssum = 0.f;
#pragma unroll
            for (int q = 0; q < 8; ++q) ssum += ssr[q * 32 + t];
            const float rstd = rsqrtf(ssum * (1.0f / D) + EPS);
            rs[t] = rstd;
            float gl[8];
#pragma unroll
            for (int j = 0; j < 8; ++j) {
                float a = 0.f;
#pragma unroll
                for (int q = 0; q < 8; ++q) a += red[(q * 32 + t) * 80 + j];
                gl[j] = a * rstd + cb[b * 80 + j];
            }
            int gi = 0; float gmax = gl[0];
#pragma unroll
            for (int j = 1; j < 8; ++j) if (gl[j] > gmax) { gmax = gl[j]; gi = j; }
            float gsum = 0.f;
#pragma unroll
            for (int j = 0; j < 8; ++j) gsum += __expf(gl[j] - gmax);
            const float pg = 1.0f / gsum;
            float el[8];
#pragma unroll
            for (int j = 0; j < 8; ++j) {
                float a = 0.f;
#pragma unroll
                for (int q = 0; q < 8; ++q) a += red[(q * 32 + t) * 80 + 8 + gi * 8 + j];
                el[j] = a * rstd + cb[b * 80 + 8 + gi * 8 + j];
            }
            int i1 = 0; float e1 = el[0];
#pragma unroll
            for (int j = 1; j < 8; ++j) if (el[j] > e1) { e1 = el[j]; i1 = j; }
            int i2 = -1; float e2 = -3.0e38f;
#pragma unroll
            for (int j = 0; j < 8; ++j) if (j != i1 && el[j] > e2) { e2 = el[j]; i2 = j; }
            const float r2 = __expf(e2 - e1);
            const float tp1 = 1.0f / (1.0f + r2), tp2 = r2 / (1.0f + r2);
            const int row = tok0 + t;
            const int ea = gi * 8 + i1, eb = gi * 8 + i2;
            const unsigned sa = atomicAdd(&cnt[ea], 1u), sb = atomicAdd(&cnt[eb], 1u);
            ltok[ea * NTOK + sa] = row * 2; lw[ea * NTOK + sa] = pg * tp1;
            ltok[eb * NTOK + sb] = row * 2 + 1; lw[eb * NTOK + sb] = pg * tp2;
            if (!dummy) { u32x4 rec; rec.x = ((unsigned)ea << 13) | sa; rec.y = __float_as_uint(pg * tp1); rec.z = ((unsigned)eb << 13) | sb; rec.w = __float_as_uint(pg * tp2);
                *(u32x4*)(p.ws + WS_TREC + (size_t)row * 16) = rec; }
        }
        float rstd4[4];
#pragma unroll
        for (int q = 0; q < 4; ++q) {
            float ssum = 0.f;
#pragma unroll
            for (int q8 = 0; q8 < 8; ++q8) ssum += ssr[q8 * 32 + c.wid * 4 + q];
            rstd4[q] = rsqrtf(ssum * (1.0f / D) + EPS);
        }
#pragma unroll 2
        for (int i = 0; i < 8; ++i) {
            const int col = i * 256 + c.lane * 4;
            const f32x4 gg = *(const f32x4*)(g + col), sh = *(const f32x4*)(mod + b * NMOD + 3 * D + col), scl = *(const f32x4*)(mod + b * NMOD + 4 * D + col);
            f32x4 v[4];
#pragma unroll
            for (int q = 0; q < 4; ++q) v[q] = *(const f32x4*)(x1 + (size_t)(tok0 + c.wid * 4 + q) * D + col);
#pragma unroll
            for (int q = 0; q < 4; ++q) {
                float o[4];
#pragma unroll
                for (int j = 0; j < 4; ++j) o[j] = (v[q][j] * rstd4[q] * gg[j]) * (1.0f + scl[j]) + sh[j];
                u32x2 w; w.x = pack_bf16(o[0], o[1]); w.y = pack_bf16(o[2], o[3]);
                *(u32x2*)(h2 + (size_t)(tok0 + c.wid * 4 + q) * D + col) = w;
            }
        }
    }
}

constexpr int MOE_TAB = 100 * 1024;
__device__ __forceinline__ void moe_table(const Params& p, const Ctx& c) {
    const unsigned* cnt = (const unsigned*)(p.ws + WS_CTL) + CW_CNT;
    LAS int* tab = (LAS int*)(c.lds + MOE_TAB);
    __syncthreads();
    if (c.tid == 0) {
        int rp = 0;
        for (int e = 0; e < NE; ++e) { const int n = (int)cnt[e]; tab[e] = n; tab[64 + e] = rp; rp += n; }
        tab[64 + 64] = rp;
        for (int q = 0; q < 8; ++q) { int ip = 0; for (int j = 0; j < 8; ++j) { tab[256 + 16 * q + j] = ip; ip += ((tab[q + 8 * j] + 255) >> 8) * 16; } tab[256 + 16 * q + 8] = ip; }
    }
    __syncthreads();
}
__device__ __forceinline__ bool moe_next(XQueue& q, const Ctx& c, int& e, int& mt, int& ntile, int& cnt_e, int& rbase) {
    LAS int* tab = (LAS int*)(c.lds + MOE_TAB);
    while (q.v < 8) {
        const int qi = (q.x + q.v) & 7;
        const int L = next_item(q.heads + qi * 64, c);
        if (L < tab[256 + 16 * qi + 8]) {
            int j = 0;
#pragma unroll
            for (int k = 1; k < 8; ++k) if (tab[256 + 16 * qi + k] <= L) j = k;
            e = qi + 8 * j;
            while (tab[e] == 0 && j > 0) { --j; e -= 8; }
            cnt_e = tab[e]; rbase = tab[64 + e];
            const int loc = L - tab[256 + 16 * qi + j], nmt = (cnt_e + 255) >> 8;
            ntile = loc / nmt; mt = loc - ntile * nmt;
            return true;
        }
        ++q.v;
    }
    return false;
}

__device__ __forceinline__ void phase_moe1(const Params& p, const Ctx& c, int qsel = 1) {
    const bf16_t* h2 = (const bf16_t*)(p.ws + WS_H2);
    const int* ltok = (const int*)(p.ws + WS_LTOK);
    bf16_t* act = (bf16_t*)(p.ws + WS_ACT);
    const float* wg = p.in[20]; const float* wu = p.in[21];
    moe_table(p, c);
    XQueue q = xq_make(p, qsel);
    for (;;) {
        int e, mt, ntile, cnt_e, rbase;
        if (!moe_next(q, c, e, mt, ntile, cnt_e, rbase)) break;
        const int n0 = ntile * 64;
        const bf16_t* arow[4];
#pragma unroll
        for (int i = 0; i < 4; ++i) {
            const int r = mt * 256 + a_piece_row(c, i);
            const int tok = r < cnt_e ? (ltok[e * NTOK + r] >> 1) : 0;
            arow[i] = h2 + (size_t)tok * D + a_piece_col(c);
        }
        const int nq = b_nq(c), blk = nq >> 2;
        const float* wsrc = ((blk & 1) ? wu : wg) + (size_t)e * D * DE;
        const float* bptr = wsrc + (size_t)b_k0(c) * DE + n0 + 16 * (blk >> 1) + 4 * (nq & 3);
        f32x4 acc[8][2]; zero_acc(acc);
        gemm_mainloop<MOE_NT, D>(acc, arow, bptr, DE, c);
#pragma unroll
        for (int mi = 0; mi < 8; ++mi) {
            const int r = mt * 256 + 128 * c.wr + 16 * mi + c.fr;
            if (r < cnt_e) {
                const int col = n0 + 16 * c.wc + 4 * c.fq;
                float o[4];
#pragma unroll
                for (int j = 0; j < 4; ++j) { const float a = acc[mi][0][j], u = acc[mi][1][j]; o[j] = a / (1.0f + __expf(-a)) * u; }
                u32x2 w; w.x = pack_bf16(o[0], o[1]); w.y = pack_bf16(o[2], o[3]);
                *(u32x2*)(act + (size_t)(rbase + r) * DE + col) = w;
            }
        }
    }
}
__device__ __forceinline__ void phase_moe2(const Params& p, const Ctx& c, int qsel = 2) {
    const int* ltok = (const int*)(p.ws + WS_LTOK); const float* lw = (const float*)(p.ws + WS_LW);
    const bf16_t* act = (const bf16_t*)(p.ws + WS_ACT);
    float* y = (float*)(p.ws + WS_Y);
    const float* wd = p.in[22];
    moe_table(p, c);
    XQueue q = xq_make(p, qsel);
    for (;;) {
        int e, mt, ntile, cnt_e, rbase;
        if (!moe_next(q, c, e, mt, ntile, cnt_e, rbase)) break;
        const int n0 = ntile * 128;
        const bf16_t* arow[4];
#pragma unroll
        for (int i = 0; i < 4; ++i) arow[i] = act + (size_t)(rbase + mt * 256 + a_piece_row(c, i)) * DE + a_piece_col(c);
        const float* bptr = wd + (size_t)e * DE * D + (size_t)b_k0(c) * D + n0 + 4 * b_nq(c);
        f32x4 acc[8][2]; zero_acc(acc);
        gemm_mainloop<MOE_NT, DE>(acc, arow, bptr, D, c);
#pragma unroll
        for (int mi = 0; mi < 8; ++mi) {
            const int r = mt * 256 + 128 * c.wr + 16 * mi + c.fr;
            if (r < cnt_e) {
                const int ent = ltok[e * NTOK + r]; const float w = lw[e * NTOK + r];
#pragma unroll
                for (int ni = 0; ni < 2; ++ni) {
                    const int col = n0 + 32 * c.wc + 16 * ni + 4 * c.fq;
                    *(f32x4*)(y + (size_t)ent * D + col) = acc[mi][ni] * w;
                }
            }
        }
    }
}

constexpr int MOE_TAB2 = 132 * 1024;
__device__ __forceinline__ void moe_table2(const Params& p, const Ctx& c) {
    const unsigned* cnt = (const unsigned*)(p.ws + WS_CTL) + CW_CNT;
    LAS int* tab = (LAS int*)(c.lds + MOE_TAB2);
    __syncthreads();
    if (c.tid == 0) {
        int rp = 0;
        for (int e = 0; e < NE; ++e) { const int n = (int)cnt[e]; tab[e] = n; tab[64 + e] = rp; rp += n; }
        tab[64 + 64] = rp;
        for (int q = 0; q < 8; ++q) { int ip = 0; for (int j = 0; j < 8; ++j) { tab[256 + 16 * q + j] = ip; ip += ((tab[q + 8 * j] + 255) >> 8) * 8; } tab[256 + 16 * q + 8] = ip; }
    }
    __syncthreads();
}
__device__ __forceinline__ bool moe_next2(XQueue& q, const Ctx& c, int& e, int& mt, int& ntile, int& cnt_e, int& rbase) {
    LAS int* tab = (LAS int*)(c.lds + MOE_TAB2);
    while (q.v < 8) {
        const int qi = (q.x + q.v) & 7;
        const int L = next_item(q.heads + qi * 64, c);
        if (L < tab[256 + 16 * qi + 8]) {
            int j = 0;
#pragma unroll
            for (int k = 1; k < 8; ++k) if (tab[256 + 16 * qi + k] <= L) j = k;
            e = qi + 8 * j;
            while (tab[e] == 0 && j > 0) { --j; e -= 8; }
            cnt_e = tab[e]; rbase = tab[64 + e];
            const int loc = L - tab[256 + 16 * qi + j], nmt = (cnt_e + 255) >> 8;
            ntile = loc / nmt; mt = loc - ntile * nmt;
            return true;
        }
        ++q.v;
    }
    return false;
}
__device__ __forceinline__ void zero_acc4(f32x4 (&acc)[8][4]) {
#pragma unroll
    for (int mi = 0; mi < 8; ++mi)
#pragma unroll
        for (int ni = 0; ni < 4; ++ni) acc[mi][ni] = (f32x4){0.f, 0.f, 0.f, 0.f};
}
__device__ __forceinline__ void phase_moe1w(const Params& p, const Ctx& c, int qsel = 1) {
    const bf16_t* h2 = (const bf16_t*)(p.ws + WS_H2);
    const int* ltok = (const int*)(p.ws + WS_LTOK);
    bf16_t* act = (bf16_t*)(p.ws + WS_ACT);
    const float* wg = p.in[20]; const float* wu = p.in[21];
    moe_table2(p, c);
    XQueue q = xq_make(p, qsel);
    const int blk = c.lane >> 2;
    const float* wsel = (blk & 1) ? wu : wg;
    const int bcol = 16 * (blk >> 1) + 4 * (c.lane & 3);
    int e, mt, ntile, cnt_e, rbase;
    if (!moe_next2(q, c, e, mt, ntile, cnt_e, rbase)) return;
    int aoff[4];
#pragma unroll
    for (int i = 0; i < 4; ++i) { const int r = mt * 256 + a_piece_row(c, i); const int tok = r < cnt_e ? (ltok[e * NTOK + r] >> 1) : 0; aoff[i] = tok * D + a_piece_col(c); }
    const float* bptr = wsel + (size_t)e * D * DE + (size_t)(8 * c.wid) * DE + ntile * 128 + bcol;
    bool staged = false;
    f32x4 rb[8];
    for (;;) {
        int en, mtn, ntilen, cntn, rbasen;
        const bool hn = moe_next2(q, c, en, mtn, ntilen, cntn, rbasen);
        int aoffn[4]; const float* bptrn; int nrn;
        if (hn) {
#pragma unroll
            for (int i = 0; i < 4; ++i) { const int r = mtn * 256 + a_piece_row(c, i); const int tok = r < cntn ? (ltok[en * NTOK + r] >> 1) : 0; aoffn[i] = tok * D + a_piece_col(c); }
            bptrn = wsel + (size_t)en * D * DE + (size_t)(8 * c.wid) * DE + ntilen * 128 + bcol; nrn = cntn - mtn * 256;
        } else {
#pragma unroll
            for (int i = 0; i < 4; ++i) aoffn[i] = aoff[i] + (D / 64 - 1) * 64;
            bptrn = bptr + (size_t)((D / 64 - 1) * 64) * DE; nrn = cnt_e - mt * 256;
        }
        const int n0 = ntile * 128;
        f32x4 acc[8][4]; zero_acc4(acc);
        gemm_mainloop256<D>(acc, rb, h2, aoff, bptr, DE, cnt_e - mt * 256, c, staged, aoffn, bptrn, nrn, hn);
#pragma unroll
        for (int mi = 0; mi < 8; ++mi) {
            const int r = mt * 256 + 128 * c.wr + 16 * mi + c.fr;
            if (r < cnt_e) {
#pragma unroll
                for (int hh = 0; hh < 2; ++hh) {
                    const int col = n0 + 16 * (2 * c.wc + hh) + 4 * c.fq;
                    float o[4];
#pragma unroll
                    for (int j = 0; j < 4; ++j) { const float a = acc[mi][2 * hh][j], u = acc[mi][2 * hh + 1][j]; o[j] = a * sigmoidf_(a) * u; }
                    u32x2 w; w.x = pack_bf16(o[0], o[1]); w.y = pack_bf16(o[2], o[3]);
                    *(u32x2*)(act + (size_t)(rbase + r) * DE + col) = w;
                }
            }
        }
        if (!hn) break;
        e = en; mt = mtn; ntile = ntilen; cnt_e = cntn; rbase = rbasen; bptr = bptrn; staged = true;
#pragma unroll
        for (int i = 0; i < 4; ++i) aoff[i] = aoffn[i];
    }
    asm volatile("s_waitcnt vmcnt(0)" ::: "memory");
}
__device__ __forceinline__ void phase_moe2w(const Params& p, const Ctx& c, int qsel = 2) {
    const bf16_t* act = (const bf16_t*)(p.ws + WS_ACT);
    bf16_t* yb = (bf16_t*)(p.ws + WS_Y);
    const float* wd = p.in[22];
    moe_table2(p, c);
    XQueue q = xq_make(p, qsel);
    int e, mt, ntile, cnt_e, rbase;
    if (!moe_next2(q, c, e, mt, ntile, cnt_e, rbase)) return;
    int aoff[4];
#pragma unroll
    for (int i = 0; i < 4; ++i) aoff[i] = (rbase + mt * 256 + a_piece_row(c, i)) * DE + a_piece_col(c);
    const float* bptr = wd + (size_t)e * DE * D + (size_t)(8 * c.wid) * D + ntile * 256 + 4 * c.lane;
    bool staged = false;
    f32x4 rb[8];
    for (;;) {
        int en, mtn, ntilen, cntn, rbasen;
        const bool hn = moe_next2(q, c, en, mtn, ntilen, cntn, rbasen);
        int aoffn[4]; const float* bptrn; int nrn;
        if (hn) {
#pragma unroll
            for (int i = 0; i < 4; ++i) aoffn[i] = (rbasen + mtn * 256 + a_piece_row(c, i)) * DE + a_piece_col(c);
            bptrn = wd + (size_t)en * DE * D + (size_t)(8 * c.wid) * D + ntilen * 256 + 4 * c.lane; nrn = cntn - mtn * 256;
        } else {
#pragma unroll
            for (int i = 0; i < 4; ++i) aoffn[i] = aoff[i] + (DE / 64 - 1) * 64;
            bptrn = bptr + (size_t)((DE / 64 - 1) * 64) * D; nrn = cnt_e - mt * 256;
        }
        const int n0 = ntile * 256;
        f32x4 acc[8][4]; zero_acc4(acc);
        gemm_mainloop256<DE>(acc, rb, act, aoff, bptr, D, cnt_e - mt * 256, c, staged, aoffn, bptrn, nrn, hn);
#pragma unroll
        for (int mi = 0; mi < 8; ++mi) {
            const int r = mt * 256 + 128 * c.wr + 16 * mi + c.fr;
            if (r < cnt_e) {
#pragma unroll
                for (int ni = 0; ni < 4; ++ni) {
                    const int col = n0 + 64 * c.wc + 16 * ni + 4 * c.fq;
                    const f32x4 v = acc[mi][ni];
                    u32x2 pk; pk.x = pack_bf16(v[0], v[1]); pk.y = pack_bf16(v[2], v[3]);
                    *(u32x2*)(yb + (size_t)(rbase + r) * D + col) = pk;
                }
            }
        }
        if (!hn) break;
        e = en; mt = mtn; ntile = ntilen; cnt_e = cntn; rbase = rbasen; bptr = bptrn; staged = true;
#pragma unroll
        for (int i = 0; i < 4; ++i) aoff[i] = aoffn[i];
    }
    asm volatile("s_waitcnt vmcnt(0)" ::: "memory");
}

__device__ __forceinline__ void phase_final(const Params& p, const Ctx& c) {
    const float* x1 = (const float*)(p.ws + WS_X1); const bf16_t* yb = (const bf16_t*)(p.ws + WS_Y);
    const float* mod = (const float*)(p.ws + WS_MOD); const float* g = p.in[23];
    const unsigned* cnt = (const unsigned*)(p.ws + WS_CTL) + CW_CNT;
    LAS int* rpre = (LAS int*)c.lds;
    __syncthreads();
    if (c.tid == 0) { int rp = 0; for (int e = 0; e < NE; ++e) { rpre[e] = rp; rp += (int)cnt[e]; } }
    __syncthreads();
    for (int row = c.bid * 8 + c.wid; row < NTOK; row += c.nblk * 8) {
        const int b = row >> 11;
        const u32x4 rec = *(const u32x4*)(p.ws + WS_TREC + (size_t)row * 16);
        const size_t r0 = (size_t)(rpre[rec.x >> 13] + (int)(rec.x & 8191u)), r1 = (size_t)(rpre[rec.z >> 13] + (int)(rec.z & 8191u));
        const float w0 = __uint_as_float(rec.y), w1 = __uint_as_float(rec.w);
        f32x4 v[8]; float ss = 0.f;
#pragma unroll
        for (int i = 0; i < 8; ++i) {
            const int col = i * 256 + c.lane * 4;
            const f32x4 xv = *(const f32x4*)(x1 + (size_t)row * D + col);
            const u32x2 a0 = *(const u32x2*)(yb + r0 * D + col), a1 = *(const u32x2*)(yb + r1 * D + col);
            f32x4 y0, y1;
            y0[0] = __uint_as_float(a0.x << 16); y0[1] = __uint_as_float(a0.x & 0xffff0000u); y0[2] = __uint_as_float(a0.y << 16); y0[3] = __uint_as_float(a0.y & 0xffff0000u);
            y1[0] = __uint_as_float(a1.x << 16); y1[1] = __uint_as_float(a1.x & 0xffff0000u); y1[2] = __uint_as_float(a1.y << 16); y1[3] = __uint_as_float(a1.y & 0xffff0000u);
            const f32x4 gf = *(const f32x4*)(mod + b * NMOD + 5 * D + col);
            v[i] = xv + gf * (y0 * w0 + y1 * w1);
            ss += v[i][0] * v[i][0] + v[i][1] * v[i][1] + v[i][2] * v[i][2] + v[i][3] * v[i][3];
        }
        ss = wave_sum(ss);
        const float rstd = rsqrtf(ss * (1.0f / D) + EPS);
#pragma unroll
        for (int i = 0; i < 8; ++i) {
            const int col = i * 256 + c.lane * 4;
            const f32x4 gg = *(const f32x4*)(g + col);
            *(f32x4*)(p.out + (size_t)row * D + col) = v[i] * rstd * gg;
        }
    }
}

struct EpiProjIn {
    static constexpr bool PERM = false, AFTER_DRAIN = false;
    unsigned char* ws;
    __device__ __forceinline__ void operator()(const pg8::f32x4 (&acc)[2][2][4][2], const pg8::Unit& u, int wr, int wc, int fr, int fq) const {
        const int region = (u.pn * 256) >> 10;
#pragma unroll
        for (int ai = 0; ai < 2; ++ai)
#pragma unroll
            for (int m = 0; m < 4; ++m) {
                const int row = u.pm * 256 + ai * 128 + wr * 64 + m * 16 + fr;
#pragma unroll
                for (int bj = 0; bj < 2; ++bj)
#pragma unroll
                    for (int n = 0; n < 2; ++n) {
                        const int col = u.pn * 256 + bj * 128 + wc * 32 + n * 16 + 4 * fq;
                        const f32x4 a = acc[ai][bj][m][n];
                        if (region < 6) {
                            const int cin = col & 1023;
                            if (region == 2 || region == 5) {
                                bf16_t* vt = (bf16_t*)(ws + (region == 2 ? WS_VAT : WS_VBT));
                                const int b = row >> 11, s0 = row & 2047, hh = cin >> 7, d = cin & 127;
                                const int s = (s0 & ~31) | ((s0 & 12) << 1) | ((s0 & 16) >> 2) | (s0 & 3);
                                const unsigned w0 = pack_bf16(a[0], a[1]), w1 = pack_bf16(a[2], a[3]);
                                bf16_t* base = vt + ((size_t)((b * 8 + hh) * 128 + d)) * SEQ + s;
                                base[0] = (bf16_t)(w0 & 0xffff); base[SEQ] = (bf16_t)(w0 >> 16); base[2 * SEQ] = (bf16_t)(w1 & 0xffff); base[3 * SEQ] = (bf16_t)(w1 >> 16);
                            } else {
                                const size_t off = region == 0 ? WS_QA : region == 1 ? WS_KA : region == 3 ? WS_QB : WS_KB;
                                bf16_t* dst = (bf16_t*)(ws + off);
                                u32x2 w; w.x = pack_bf16(a[0], a[1]); w.y = pack_bf16(a[2], a[3]);
                                *(u32x2*)(dst + (size_t)row * 1024 + cin) = w;
                            }
                        } else {
                            bf16_t* dst = (bf16_t*)(ws + (region < 8 ? WS_GA : WS_GB));
                            const int cin = col - (region < 8 ? 6144 : 8192);
                            u32x2 w; w.x = pack_bf16(sigmoidf_(a[0]), sigmoidf_(a[1])); w.y = pack_bf16(sigmoidf_(a[2]), sigmoidf_(a[3]));
                            *(u32x2*)(dst + (size_t)row * D + cin) = w;
                        }
                    }
            }
    }
};
template <int PASS> struct EpiGate {
    static constexpr bool PERM = false, AFTER_DRAIN = false;
    const bf16_t* G; float* tmp; bf16_t* out;
    __device__ __forceinline__ void operator()(const pg8::f32x4 (&acc)[2][2][4][2], const pg8::Unit& u, int wr, int wc, int fr, int fq) const {
#pragma unroll
        for (int ai = 0; ai < 2; ++ai)
#pragma unroll
            for (int m = 0; m < 4; ++m) {
                const int row = u.pm * 256 + ai * 128 + wr * 64 + m * 16 + fr;
#pragma unroll
                for (int bj = 0; bj < 2; ++bj)
#pragma unroll
                    for (int n = 0; n < 2; ++n) {
                        const int col = u.pn * 256 + bj * 128 + wc * 32 + n * 16 + 4 * fq;
                        const u32x2 gw = *(const u32x2*)(G + (size_t)row * D + col);
                        f32x4 g; g[0] = __uint_as_float(gw.x << 16); g[1] = __uint_as_float(gw.x & 0xffff0000u); g[2] = __uint_as_float(gw.y << 16); g[3] = __uint_as_float(gw.y & 0xffff0000u);
                        f32x4 v = acc[ai][bj][m][n] * g;
                        if (PASS == 0) *(f32x4*)(tmp + (size_t)row * D + col) = v;
                        else {
                            v += *(const f32x4*)(tmp + (size_t)row * D + col);
                            u32x2 w; w.x = pack_bf16(v[0], v[1]); w.y = pack_bf16(v[2], v[3]);
                            *(u32x2*)(out + (size_t)row * D + col) = w;
                        }
                    }
            }
    }
};
struct EpiX1 {
    static constexpr bool PERM = false, AFTER_DRAIN = false;
    const float* x; const float* mod; float* x1;
    __device__ __forceinline__ void operator()(const pg8::f32x4 (&acc)[2][2][4][2], const pg8::Unit& u, int wr, int wc, int fr, int fq) const {
        const int b = (u.pm * 256) >> 11;
#pragma unroll
        for (int ai = 0; ai < 2; ++ai)
#pragma unroll
            for (int m = 0; m < 4; ++m) {
                const int row = u.pm * 256 + ai * 128 + wr * 64 + m * 16 + fr;
#pragma unroll
                for (int bj = 0; bj < 2; ++bj)
#pragma unroll
                    for (int n = 0; n < 2; ++n) {
                        const int col = u.pn * 256 + bj * 128 + wc * 32 + n * 16 + 4 * fq;
                        const f32x4 gm = *(const f32x4*)(mod + b * NMOD + 2 * D + col);
                        const f32x4 xv = *(const f32x4*)(x + (size_t)row * D + col);
                        *(f32x4*)(x1 + (size_t)row * D + col) = xv + gm * acc[ai][bj][m][n];
                    }
            }
    }
};
__device__ __forceinline__ void phase_proj_in2(const Params& p, const Ctx& c) {
    pg8::Gemm g{(const bf16_t*)(p.ws + WS_H), (const bf16_t*)(p.ws + WS_WIN_T), NTOK, INC, D};
    pg8::StaticOrder S; S.init(NTOK, INC, c.nblk, c.bid);
    EpiProjIn E{p.ws};
    pg8::gemm_phase<EpiProjIn, pg8::StaticOrder>(c.lds, g, S, E, nullptr, c.wid);
}
__device__ __forceinline__ void phase_merge2(const Params& p, const Ctx& c) {
    float* tmp = (float*)(p.ws + WS_X1);
    {
        pg8::Gemm g{(const bf16_t*)(p.ws + WS_OA), (const bf16_t*)(p.ws + WS_WPA_T), NTOK, D, 1024};
        pg8::StaticOrder S; S.init(NTOK, D, c.nblk, c.bid);
        EpiGate<0> E{(const bf16_t*)(p.ws + WS_GA), tmp, nullptr};
        pg8::gemm_phase<EpiGate<0>, pg8::StaticOrder>(c.lds, g, S, E, nullptr, c.wid);
    }
    {
        pg8::Gemm g{(const bf16_t*)(p.ws + WS_OB), (const bf16_t*)(p.ws + WS_WPB_T), NTOK, D, 1024};
        pg8::StaticOrder S; S.init(NTOK, D, c.nblk, c.bid);
        EpiGate<1> E{(const bf16_t*)(p.ws + WS_GB), tmp, (bf16_t*)(p.ws + WS_MRG)};
        pg8::gemm_phase<EpiGate<1>, pg8::StaticOrder>(c.lds, g, S, E, nullptr, c.wid);
    }
}
struct MidGate {
    static constexpr int AT = 16;
    const bf16_t* GA; const bf16_t* GB;
    __device__ __forceinline__ void operator()(pg8::f32x4 (&acc)[2][2][4][2], const pg8::Unit& u, int wr, int wc, int fr, int fq) const {
        int off0 = (u.pm * 256 + wr * 64 + fr) * D + u.pn * 256 + wc * 32 + 4 * fq;
        asm volatile("" : "+v"(off0));
#pragma unroll
        for (int ai = 0; ai < 2; ++ai)
#pragma unroll
            for (int m = 0; m < 4; ++m) {
#pragma unroll
                for (int bj = 0; bj < 2; ++bj)
#pragma unroll
                    for (int n = 0; n < 2; ++n) {
                        const int off = off0 + (ai * 128 + m * 16) * D + bj * 128 + n * 16;
                        const u32x2 a = *(const u32x2*)(GA + off), b = *(const u32x2*)(GB + off);
                        f32x4 r;
                        r[0] = __uint_as_float(a.x << 16) * __builtin_amdgcn_rcpf(__uint_as_float(b.x << 16)); r[1] = __uint_as_float(a.x & 0xffff0000u) * __builtin_amdgcn_rcpf(__uint_as_float(b.x & 0xffff0000u));
                        r[2] = __uint_as_float(a.y << 16) * __builtin_amdgcn_rcpf(__uint_as_float(b.y << 16)); r[3] = __uint_as_float(a.y & 0xffff0000u) * __builtin_amdgcn_rcpf(__uint_as_float(b.y & 0xffff0000u));
                        acc[ai][bj][m][n] *= r;
                    }
                asm volatile("" ::: "memory");
            }
    }
};
struct EpiGateB {
    static constexpr bool PERM = false, AFTER_DRAIN = false;
    const bf16_t* GB; bf16_t* out;
    __device__ __forceinline__ void operator()(const pg8::f32x4 (&acc)[2][2][4][2], const pg8::Unit& u, int wr, int wc, int fr, int fq) const {
#pragma unroll
        for (int ai = 0; ai < 2; ++ai)
#pragma unroll
            for (int m = 0; m < 4; ++m) {
                const int row = u.pm * 256 + ai * 128 + wr * 64 + m * 16 + fr;
#pragma unroll
                for (int bj = 0; bj < 2; ++bj)
#pragma unroll
                    for (int n = 0; n < 2; ++n) {
                        const int col = u.pn * 256 + bj * 128 + wc * 32 + n * 16 + 4 * fq;
                        const u32x2 gw = *(const u32x2*)(GB + (size_t)row * D + col);
                        f32x4 g; g[0] = __uint_as_float(gw.x << 16); g[1] = __uint_as_float(gw.x & 0xffff0000u); g[2] = __uint_as_float(gw.y << 16); g[3] = __uint_as_float(gw.y & 0xffff0000u);
                        const f32x4 v = acc[ai][bj][m][n] * g;
                        u32x2 w; w.x = pack_bf16(v[0], v[1]); w.y = pack_bf16(v[2], v[3]);
                        *(u32x2*)(out + (size_t)row * D + col) = w;
                    }
            }
    }
};
__device__ __forceinline__ void phase_merge3(const Params& p, const Ctx& c) {
    pg8::Gemm g{(const bf16_t*)(p.ws + WS_OA), (const bf16_t*)(p.ws + WS_WPA_T), NTOK, D, D};
    pg8::StaticOrder S; S.init(NTOK, D, c.nblk, c.bid);
    EpiGateB E{(const bf16_t*)(p.ws + WS_GB), (bf16_t*)(p.ws + WS_MRG)};
    MidGate M{(const bf16_t*)(p.ws + WS_GA), (const bf16_t*)(p.ws + WS_GB)};
    pg8::gemm_phase<EpiGateB, pg8::StaticOrder, false, MidGate>(c.lds, g, S, E, nullptr, c.wid, M);
}
__device__ __forceinline__ void phase_out2(const Params& p, const Ctx& c) {
    pg8::Gemm g{(const bf16_t*)(p.ws + WS_MRG), (const bf16_t*)(p.ws + WS_WOUT_T), NTOK, D, D};
    pg8::StaticOrder S; S.init(NTOK, D, c.nblk, c.bid);
    EpiX1 E{p.in[0], (const float*)(p.ws + WS_MOD), (float*)(p.ws + WS_X1)};
    pg8::gemm_phase<EpiX1, pg8::StaticOrder>(c.lds, g, S, E, nullptr, c.wid);
}

constexpr int LDS_BYTES = 160 * 1024;
__global__ void __launch_bounds__(512, 2) mk_fwd(Params p) {
    extern __shared__ __attribute__((aligned(16))) unsigned char smem[];
    LAS unsigned char* ldsb = (LAS unsigned char*)smem;
    Ctx c; c.lds = ldsb; c.tid = threadIdx.x; c.lane = c.tid & 63; c.wid = __builtin_amdgcn_readfirstlane(c.tid >> 6); c.wr = c.wid >> 2; c.wc = c.wid & 3;
    c.fr = c.lane & 15; c.fq = c.lane >> 4; c.bid = blockIdx.x; c.nblk = gridDim.x;
#define MKCTX() do {} while (0)
#define LEADER() (c.tid == 0)
    volatile LAS unsigned* bst = (volatile LAS unsigned*)(ldsb + LDS_BYTES - 32);
    if (LEADER()) { bst[0] = 0u; bst[1] = 0u; }
    __syncthreads();
    unsigned* barw = (unsigned*)(p.ws + WS_CTL);
    XcdBarrier bar; bar.bar = barw; bar.x = 0; bar.st = bst;
#if !MK_SPLIT
    bar = xcd_barrier_post(barw, bst, LEADER());
#define GRID_BAR() xcd_barrier(bar, LEADER())
#else
#define GRID_BAR() do {} while (0)
#endif
    const int lo = p.ph_lo, hi = p.ph_hi;
#define IN(k) (lo <= (k) && (k) < hi)
#define BOTH(k) (IN(k) && IN((k) + 1))
#define DUP(k) ((DUP_MASK >> (k)) & 1)
    if (IN(0)) { MKCTX(); phase_mod(p, c); phase_convert(p, c); if (DUP(0)) { GRID_BAR(); phase_mod(p, c); phase_convert(p, c); } if (BOTH(0)) GRID_BAR(); }
    if (IN(1)) { MKCTX(); phase_norm1(p, c); phase_router_prep(p, c); if (DUP(1)) { GRID_BAR(); phase_norm1(p, c); } if (BOTH(1)) GRID_BAR(); }
    if (IN(2)) { MKCTX(); phase_proj_in2(p, c); if (DUP(2)) { GRID_BAR(); phase_proj_in2(p, c); } if (BOTH(2)) GRID_BAR(); }
    if (IN(3)) { MKCTX(); phase_attn(p, c, 0); if (DUP(3)) { GRID_BAR(); phase_attn(p, c, 3); } if (BOTH(3)) GRID_BAR(); }
    if (IN(4)) { MKCTX(); phase_merge3(p, c); if (DUP(4)) { GRID_BAR(); phase_merge3(p, c); } if (BOTH(4)) GRID_BAR(); }
    if (IN(5)) { MKCTX(); phase_out2(p, c); if (DUP(5)) { GRID_BAR(); phase_out2(p, c); } if (BOTH(5)) GRID_BAR(); }
    if (IN(6)) { MKCTX(); phase_norm2_route2(p, c); if (DUP(6)) { GRID_BAR(); phase_norm2_route2(p, c, 1); } if (BOTH(6)) GRID_BAR(); }
    if (IN(7)) { MKCTX(); phase_moe1w(p, c, 1); if (DUP(7)) { GRID_BAR(); phase_moe1w(p, c, 4); } if (BOTH(7)) GRID_BAR(); }
    if (IN(8)) { MKCTX(); phase_moe2w(p, c, 2); if (DUP(8)) { GRID_BAR(); phase_moe2w(p, c, 5); } if (BOTH(8)) GRID_BAR(); }
    if (IN(9)) { MKCTX(); phase_final(p, c); if (DUP(9)) { GRID_BAR(); phase_final(p, c); } }
}

extern "C" void kernel_launch(void* const* d_in, const int* in_sizes, int n_in, void* d_out, int out_size, void* d_ws, size_t ws_size, hipStream_t stream) {
    static int grid = 0;
    if (grid == 0) {
        if (n_in != 24 || out_size != NTOK * D || ws_size < WS_END) { fprintf(stderr, "kernel_launch: unexpected shapes (n_in %d out %d ws %zu need %zu)\n", n_in, out_size, ws_size, (size_t)WS_END); grid = -1; return; }
        int dev = 0, cus = 0, per_cu = 0;
        (void)hipGetDevice(&dev); (void)hipDeviceGetAttribute(&cus, hipDeviceAttributeMultiprocessorCount, dev);
        if (hipFuncSetAttribute((const void*)mk_fwd, hipFuncAttributeMaxDynamicSharedMemorySize, LDS_BYTES) != hipSuccess) { fprintf(stderr, "kernel_launch: hipFuncSetAttribute failed\n"); grid = -1; return; }
        if (hipOccupancyMaxActiveBlocksPerMultiprocessor(&per_cu, (const void*)mk_fwd, 512, LDS_BYTES) != hipSuccess || per_cu < 1) { fprintf(stderr, "kernel_launch: occupancy query says %d\n", per_cu); }
        (void)hipGetLastError();
        grid = cus > 0 ? cus : 256;
    }
    if (grid < 0) return;
    (void)hipMemsetAsync((char*)d_ws + WS_CTL, 0, CTL_BYTES, stream);
    Params p{};
    for (int i = 0; i < 24; ++i) p.in[i] = (const float*)d_in[i];
    p.out = (float*)d_out; p.ws = (unsigned char*)d_ws;
#if MK_SPLIT
    for (int ph = 0; ph < NPHASE; ++ph) { p.ph_lo = ph; p.ph_hi = ph + 1; hipLaunchKernelGGL(mk_fwd, dim3(grid), dim3(512), LDS_BYTES, stream, p); }
#else
    p.ph_lo = 0; p.ph_hi = NPHASE;
    hipLaunchKernelGGL(mk_fwd, dim3(grid), dim3(512), LDS_BYTES, stream, p);
#endif
}
```
